# Optimizing an MI355X kernel written in HIP

```python
import math
import jax, jax.numpy as jnp
from jax import lax
import numpy as np

D_MODEL = 1024
BATCH = 8
SEQ = 2048
DEPTH = 2

ATT_HEADS = 8
ATT_HEAD_DIM = 64
ATT_QK_WIDTH = ATT_HEADS * 2 * ATT_HEAD_DIM
ATT_V_WIDTH = ATT_HEADS * 2 * ATT_HEAD_DIM
BLOCK_Q = 128
SSM_WIDTH = 512
SSM_GROUP = 16
SSM_GROUPS = SSM_WIDTH // SSM_GROUP
SSM_STATE = 64
DT_MIN = 0.001
DT_MAX = 0.1
N_BRANCH = 2
IN_WIDTH = 2 * ATT_QK_WIDTH + ATT_V_WIDTH + SSM_WIDTH + N_BRANCH * D_MODEL
N_GROUPS = 4
EXPERTS_PER_GROUP = 8
N_EXPERTS = N_GROUPS * EXPERTS_PER_GROUP
EXPERT_FF = 256
TOP_K_INNER = 2
PLE_DIM = 256
EPS = 1e-6

kernel_name = 'hybrid_s5_diffattn_hiermoe_ple'


def rms_norm(x, g):
    xf = x.astype(jnp.float32)
    y = xf * lax.rsqrt(jnp.mean(xf * xf, axis=-1, keepdims=True) + EPS)
    return (y * g.astype(jnp.float32)).astype(x.dtype)


def lambda_init_for(layer_idx):
    return 0.8 - 0.6 * math.exp(-0.3 * layer_idx)


def diff_attention(q, k, v, lam):
    s = q.shape[1]
    scale = ATT_HEAD_DIM ** -0.5
    outs = []
    for blk in range(s // BLOCK_Q):
        q0 = blk * BLOCK_Q
        kv_len = q0 + BLOCK_Q
        qb = q[:, q0:kv_len]
        kb = k[:, :kv_len]
        vb = v[:, :kv_len]
        scores = jnp.einsum('bqhmd,bkhmd->bhmqk', qb, kb).astype(jnp.float32) * scale
        q_pos = q0 + jnp.arange(BLOCK_Q)[:, None]
        k_pos = jnp.arange(kv_len)[None, :]
        scores = jnp.where(k_pos <= q_pos, scores, -jnp.inf)
        probs = jax.nn.softmax(scores, axis=-1)
        w = probs[:, :, 0] - lam * probs[:, :, 1]
        outs.append(jnp.einsum('bhqk,bkhe->bqhe', w.astype(v.dtype), vb))
    return jnp.concatenate(outs, axis=1)


def _complex_linear_combine(e1, e2):
    a1r, a1i, b1r, b1i = e1
    a2r, a2i, b2r, b2i = e2
    ar = a2r * a1r - a2i * a1i
    ai = a2r * a1i + a2i * a1r
    br = a2r * b1r - a2i * b1i + b2r
    bi = a2r * b1i + a2i * b1r + b2i
    return (ar, ai, br, bi)


def s5_ssm(u, lam_re, lam_im, log_step, b_re, b_im, c_re, c_im, d_skip):
    f32 = jnp.float32
    bsz, s, _ = u.shape
    uf = u.astype(f32).reshape(bsz, s, SSM_GROUPS, SSM_GROUP)
    lr = lam_re.astype(f32)
    li = lam_im.astype(f32)
    dt = jnp.exp(log_step.astype(f32))[:, None]
    mag = jnp.exp(lr * dt)
    ab_re = mag * jnp.cos(li * dt)
    ab_im = mag * jnp.sin(li * dt)
    den = lr * lr + li * li
    nr = ab_re - 1.0
    coef_re = (nr * lr + ab_im * li) / den
    coef_im = (ab_im * lr - nr * li) / den
    br = b_re.astype(f32)
    bi = b_im.astype(f32)
    bb_re = coef_re[..., None] * br - coef_im[..., None] * bi
    bb_im = coef_re[..., None] * bi + coef_im[..., None] * br
    bu_re = jnp.einsum('bsgh,gph->bsgp', uf, bb_re)
    bu_im = jnp.einsum('bsgh,gph->bsgp', uf, bb_im)
    a_re = jnp.broadcast_to(ab_re, bu_re.shape)
    a_im = jnp.broadcast_to(ab_im, bu_im.shape)
    _, _, st_re, st_im = lax.associative_scan(_complex_linear_combine, (a_re, a_im, bu_re, bu_im), axis=1)
    y = (jnp.einsum('bsgp,ghp->bsgh', st_re, c_re.astype(f32))
         - jnp.einsum('bsgp,ghp->bsgh', st_im, c_im.astype(f32))
         + d_skip.astype(f32) * uf)
    return y.reshape(bsz, s, SSM_WIDTH).astype(u.dtype)


def hier_moe(h, w_rg, b_rg, w_re, b_re, w_g, w_u, w_d):
    f32 = jnp.float32
    bsz, s, d = h.shape
    t = h.reshape(-1, d)
    logits_grp = (t @ w_rg + b_rg).astype(f32)
    probs_grp = jax.nn.softmax(logits_grp, axis=-1)
    grp = jnp.argmax(logits_grp, axis=-1)
    p_grp = jnp.take_along_axis(probs_grp, grp[:, None], axis=-1)
    logits_exp = (jnp.einsum('td,nde->tne', t, w_re) + b_re).astype(f32)
    logits_sel = jnp.take_along_axis(logits_exp, grp[:, None, None], axis=1)[:, 0]
    top_vals, top_idx = lax.top_k(logits_sel, TOP_K_INNER)
    top_w = jax.nn.softmax(top_vals, axis=-1) * p_grp
    w_local = jnp.einsum('tk,tke->te', top_w, jax.nn.one_hot(top_idx, EXPERTS_PER_GROUP, dtype=f32))
    out = jnp.zeros_like(t)
    for n in range(N_GROUPS):
        w_n = jnp.where((grp == n)[:, None], w_local, 0.0).astype(t.dtype)
        hg = jnp.einsum('td,edf->tef', t, w_g[n])
        hu = jnp.einsum('td,edf->tef', t, w_u[n])
        act = jax.nn.silu(hg) * hu * w_n[:, :, None]
        out = out + jnp.einsum('tef,efd->td', act, w_d[n])
    return out.reshape(bsz, s, d)


def setup_inputs(seed: int = 0) -> dict:
    key = jax.random.key(seed)
    ks = jax.random.split(key, 40)
    f32 = jnp.float32

    def nrm(k, shape, scale):
        return jax.random.normal(k, shape, f32) * scale

    def gain(k, shape):
        return 1.0 + 0.02 * jax.random.normal(k, shape, f32)

    G, P, H = SSM_GROUPS, SSM_STATE, SSM_GROUP
    lam_im_base = jnp.pi * jnp.arange(P, dtype=f32)
    return {
        'x': nrm(ks[0], (BATCH, SEQ, D_MODEL), 1.0),
        'p': nrm(ks[1], (DEPTH, BATCH, SEQ, PLE_DIM), 1.0),
        'attn_norm_g': gain(ks[2], (DEPTH, D_MODEL)),
        'w_in': nrm(ks[3], (DEPTH, D_MODEL, IN_WIDTH), D_MODEL ** -0.5),
        'b_gate': nrm(ks[4], (DEPTH, N_BRANCH * D_MODEL), 0.01),
        'q_norm_g': gain(ks[5], (DEPTH, 2, ATT_HEAD_DIM)),
        'k_norm_g': gain(ks[6], (DEPTH, 2, ATT_HEAD_DIM)),
        'lam_qk': nrm(ks[7], (DEPTH, 4, ATT_HEAD_DIM), 0.1),
        'subln_g': gain(ks[8], (DEPTH, 2 * ATT_HEAD_DIM)),
        'w_attn_up': nrm(ks[9], (DEPTH, ATT_V_WIDTH, D_MODEL), ATT_V_WIDTH ** -0.5),
        'ssm_lam_re': -0.5 + 0.01 * jax.random.normal(ks[10], (DEPTH, G, P), f32),
        'ssm_lam_im': lam_im_base + 0.01 * jax.random.normal(ks[11], (DEPTH, G, P), f32),
        'ssm_log_step': jax.random.uniform(ks[12], (DEPTH, G), f32, math.log(DT_MIN), math.log(DT_MAX)),
        'ssm_b_re': nrm(ks[13], (DEPTH, G, P, H), (2 * H) ** -0.5),
        'ssm_b_im': nrm(ks[14], (DEPTH, G, P, H), (2 * H) ** -0.5),
        'ssm_c_re': nrm(ks[15], (DEPTH, G, H, P), (2 * P) ** -0.5),
        'ssm_c_im': nrm(ks[16], (DEPTH, G, H, P), (2 * P) ** -0.5),
        'ssm_d': nrm(ks[17], (DEPTH, G, H), 1.0),
        'w_glu': nrm(ks[18], (DEPTH, SSM_WIDTH, SSM_WIDTH), SSM_WIDTH ** -0.5),
        'b_glu': nrm(ks[19], (DEPTH, SSM_WIDTH), 0.01),
        'w_ssm_up': nrm(ks[20], (DEPTH, SSM_WIDTH, D_MODEL), SSM_WIDTH ** -0.5),
        'w_out': nrm(ks[21], (DEPTH, D_MODEL, D_MODEL), D_MODEL ** -0.5),
        'ffn_norm_g': gain(ks[22], (DEPTH, D_MODEL)),
        'w_router_group': nrm(ks[23], (DEPTH, D_MODEL, N_GROUPS), D_MODEL ** -0.5),
        'b_router_group': nrm(ks[24], (DEPTH, N_GROUPS), 0.01),
        'w_router_expert': nrm(ks[25], (DEPTH, N_GROUPS, D_MODEL, EXPERTS_PER_GROUP), D_MODEL ** -0.5),
        'b_router_expert': nrm(ks[26], (DEPTH, N_GROUPS, EXPERTS_PER_GROUP), 0.01),
        'w_exp_gate': nrm(ks[27], (DEPTH, N_GROUPS, EXPERTS_PER_GROUP, D_MODEL, EXPERT_FF), D_MODEL ** -0.5),
        'w_exp_up': nrm(ks[28], (DEPTH, N_GROUPS, EXPERTS_PER_GROUP, D_MODEL, EXPERT_FF), D_MODEL ** -0.5),
        'w_exp_down': nrm(ks[29], (DEPTH, N_GROUPS, EXPERTS_PER_GROUP, EXPERT_FF, D_MODEL), EXPERT_FF ** -0.5),
        'ple_norm_g': gain(ks[30], (DEPTH, D_MODEL)),
        'w_ple_gate': nrm(ks[31], (DEPTH, D_MODEL, D_MODEL), D_MODEL ** -0.5),
        'w_ple': nrm(ks[32], (DEPTH, PLE_DIM, D_MODEL), PLE_DIM ** -0.5),
    }


def reference(x, p, attn_norm_g, w_in, b_gate, q_norm_g, k_norm_g, lam_qk, subln_g, w_attn_up,
              ssm_lam_re, ssm_lam_im, ssm_log_step, ssm_b_re, ssm_b_im, ssm_c_re, ssm_c_im, ssm_d,
              w_glu, b_glu, w_ssm_up, w_out, ffn_norm_g, w_router_group, b_router_group,
              w_router_expert, b_router_expert, w_exp_gate, w_exp_up, w_exp_down,
              ple_norm_g, w_ple_gate, w_ple):
    bsz, s, _ = x.shape
    split_points = [ATT_QK_WIDTH, 2 * ATT_QK_WIDTH, 2 * ATT_QK_WIDTH + ATT_V_WIDTH,
                    2 * ATT_QK_WIDTH + ATT_V_WIDTH + SSM_WIDTH]
    for i in range(DEPTH):
        lam_init = lambda_init_for(i)
        h = rms_norm(x, attn_norm_g[i])
        proj = h @ w_in[i]
        q, k, v, u, g = jnp.split(proj, split_points, axis=-1)
        q = rms_norm(q.reshape(bsz, s, ATT_HEADS, 2, ATT_HEAD_DIM), q_norm_g[i])
        k = rms_norm(k.reshape(bsz, s, ATT_HEADS, 2, ATT_HEAD_DIM), k_norm_g[i])
        v = v.reshape(bsz, s, ATT_HEADS, 2 * ATT_HEAD_DIM)
        lq = lam_qk[i].astype(jnp.float32)
        lam = jnp.exp(jnp.sum(lq[0] * lq[1])) - jnp.exp(jnp.sum(lq[2] * lq[3])) + lam_init
        o = diff_attention(q, k, v, lam)
        o = rms_norm(o, subln_g[i]) * (1.0 - lam_init)
        y_att = o.reshape(bsz, s, ATT_V_WIDTH) @ w_attn_up[i]

        y_s = s5_ssm(u, ssm_lam_re[i], ssm_lam_im[i], ssm_log_step[i], ssm_b_re[i], ssm_b_im[i],
                     ssm_c_re[i], ssm_c_im[i], ssm_d[i])
        z = jax.nn.gelu(y_s)
        z = z * jax.nn.sigmoid(z @ w_glu[i] + b_glu[i])
        y_ssm = z @ w_ssm_up[i]

        gates = jax.nn.sigmoid(g + b_gate[i]).reshape(bsz, s, N_BRANCH, D_MODEL)
        mixed = gates[:, :, 0] * y_att + gates[:, :, 1] * y_ssm
        x = x + mixed @ w_out[i]
        x = x + hier_moe(rms_norm(x, ffn_norm_g[i]), w_router_group[i], b_router_group[i],
                         w_router_expert[i], b_router_expert[i], w_exp_gate[i], w_exp_up[i],
                         w_exp_down[i])
        ple_gate = jax.nn.sigmoid(rms_norm(x, ple_norm_g[i]) @ w_ple_gate[i])
        x = x + ple_gate * (p[i] @ w_ple[i])
    return x
```

```cpp
#include <hip/hip_runtime.h>
#include <cstdio>
#include <cstdint>
#include <cmath>

#define GAS __attribute__((address_space(1)))
#define LAS __attribute__((address_space(3)))
typedef unsigned short bf16;
typedef unsigned v4u __attribute__((ext_vector_type(4)));
typedef unsigned v2u __attribute__((ext_vector_type(2)));
typedef float f32x4 __attribute__((ext_vector_type(4)));

constexpr int DM = 1024, BATCH = 8, SEQ = 2048, T = BATCH * SEQ, DEPTH = 2;
constexpr int NH = 8, HD = 64, QKW = 1024, VW = 1024, SSMW = 512, SG = 16, NG = 32, SP = 64;
constexpr int INW = 5632, NGRP = 4, EPG = 8, NEXP = 32, EFF = 256, PLE = 256;
constexpr float EPS = 1e-6f;
constexpr float C2 = 0.125f * 1.4426950408889634f;
constexpr int NWAVES = 8, NTHREADS = 512;

enum { I_X = 0, I_P, I_ATTN_G, I_WIN, I_BGATE, I_QG, I_KG, I_LAMQK, I_SUBLN, I_WAU, I_LRE, I_LIM, I_LSTEP, I_BRE, I_BIM, I_CRE, I_CIM,
       I_SSMD, I_WGLU, I_BGLU, I_WSU, I_WOUT, I_FFN_G, I_WRG, I_BRG, I_WRE, I_BRE2, I_WEG, I_WEU, I_WED, I_PLE_G, I_WPG, I_WPLE, N_IN };

constexpr size_t MiB = 1u << 20;
constexpr size_t WS_CTL = 0, CTL_ZERO_BYTES = 1 * MiB;
constexpr size_t WS_PART = 1 * MiB;
constexpr size_t WS_MISC = 3 * MiB;
constexpr size_t WS_X0 = 84 * MiB, WS_X1 = 116 * MiB;
constexpr size_t WS_Q = 148 * MiB, WS_K = 180 * MiB, WS_V = 212 * MiB;
constexpr size_t WS_U = 244 * MiB, WS_Z = 260 * MiB;
constexpr size_t WS_GATES = 276 * MiB;
constexpr size_t WS_PB = 340 * MiB;
constexpr size_t WS_END = 356 * MiB;
constexpr size_t WS_Z2 = WS_K, WS_MIXED = WS_K, WS_PARTS = WS_V, WS_PLE = WS_GATES, WS_OTMP = WS_X0;
constexpr int CW_BAR = 4096;

__device__ __forceinline__ unsigned f2bf(float f) { unsigned u = __builtin_bit_cast(unsigned, f); return (u + 0x7fffu + ((u >> 16) & 1u)) >> 16; }
__device__ __forceinline__ float bf2f(unsigned b) { return __builtin_bit_cast(float, b << 16); }
__device__ __forceinline__ float bflo(unsigned w) { return __builtin_bit_cast(float, w << 16); }
__device__ __forceinline__ float bfhi(unsigned w) { return __builtin_bit_cast(float, w & 0xffff0000u); }
__device__ __forceinline__ float wave_sum(float v) {
#pragma unroll
    for (int o = 1; o < 64; o <<= 1) v += __shfl_xor(v, o);
    return v;
}
__device__ __forceinline__ float sigmoidf_(float x) { return 1.f / (1.f + __expf(-x)); }
__device__ __forceinline__ float gelu_tanh(float x) { const float u = 0.7978845608028654f * (x + 0.044715f * x * x * x); return 0.5f * x * (1.f + tanhf(u)); }
__device__ __forceinline__ float rowscale(const float* part, int row) {
    const f32x4* p = (const f32x4*)(part + (size_t)row * 16);
    float s = 0.f;
#pragma unroll
    for (int i = 0; i < 4; ++i) { const f32x4 v = p[i]; s += v.x; s += v.y; s += v.z; s += v.w; }
    return rsqrtf(s * (1.f / DM) + EPS);
}
__host__ __device__ inline float lam_init_for(int i) { return 0.8f - 0.6f * expf(-0.3f * (float)i); }

#define XB_TMO      128
#define XB_XCNT(j)  (256  + 64 * (j))
#define XB_XSUB(j)  (1280 + 64 * (j))
#define XB_XGEN(j)  (2304 + 64 * (j))
#define XB_TOP      3328
#define XB_TOPGEN   3392
#define XCD_BAR_WORDS 3456
#define XB_SPIN_CAP (1u << 22)
__device__ __forceinline__ unsigned xb_ld(unsigned* p)              { return __hip_atomic_load(p, __ATOMIC_RELAXED, __HIP_MEMORY_SCOPE_AGENT); }
__device__ __forceinline__ unsigned xb_add(unsigned* p, unsigned v) { return __hip_atomic_fetch_add(p, v, __ATOMIC_RELAXED, __HIP_MEMORY_SCOPE_AGENT); }
__device__ __forceinline__ unsigned xb_xcc_id() { return (unsigned)__builtin_amdgcn_s_getreg((3 << 11) | 20) & 0xFu; }
#define XB_SPIN(cond, bar) do { unsigned _sp = 0; while (cond) { __builtin_amdgcn_s_sleep(1); \
    if ((++_sp & 255u) == 0u) { if (xb_ld(&(bar)[XB_TMO])) break; if (_sp > XB_SPIN_CAP) { atomicAdd(&(bar)[XB_TMO], 1u); break; } } } } while (0)
struct XcdBarrier { unsigned* bar; unsigned x; volatile LAS unsigned* st; };
__device__ __forceinline__ XcdBarrier xcd_barrier_post(unsigned* bar, volatile LAS unsigned* st) {
    XcdBarrier b; b.bar = bar; b.x = xb_xcc_id(); b.st = st;
    if (threadIdx.x == 0) (void)xb_add(&bar[XB_XCNT(b.x)], 1u);
    return b;
}
__device__ __forceinline__ void xcd_barrier_complete(unsigned* bar, unsigned x, unsigned& nloc, unsigned& nx) {
    const unsigned G = gridDim.x * gridDim.y * gridDim.z;
    unsigned sum, cnt, mine, sp = 0u;
    for (;;) {
        sum = 0u; cnt = 0u; mine = 0u;
#pragma unroll
        for (unsigned j = 0; j < 16; ++j) { const unsigned c = xb_ld(&bar[XB_XCNT(j)]); sum += c; cnt += (c > 0u) ? 1u : 0u; mine = (j == x) ? c : mine; }
        if (sum == G) break;
        __builtin_amdgcn_s_sleep(1);
        if ((++sp & 255u) == 0u) { if (xb_ld(&bar[XB_TMO])) break; if (sp > XB_SPIN_CAP) { atomicAdd(&bar[XB_TMO], 1u); break; } }
    }
    nloc = mine > 0u ? mine : 1u; nx = cnt > 0u ? cnt : 1u;
}
__device__ __forceinline__ void xcd_barrier(const XcdBarrier& b) {
    asm volatile("s_waitcnt vmcnt(0)" ::: "memory");
    __syncthreads();
    if (threadIdx.x == 0) {
        unsigned* bar = b.bar;
        __builtin_amdgcn_s_waitcnt(0);
        unsigned nloc = b.st[0], nx = b.st[1];
        if (nloc == 0u) { xcd_barrier_complete(bar, b.x, nloc, nx); b.st[0] = nloc; b.st[1] = nx; }
        const unsigned old = xb_add(&bar[XB_XSUB(b.x)], 1u);
        const unsigned gen = old / nloc;
        if (old + 1u == (gen + 1u) * nloc) {
            __builtin_amdgcn_fence(__ATOMIC_RELEASE, "agent");
            asm volatile("s_waitcnt vmcnt(0)" ::: "memory");
            const unsigned og = xb_add(&bar[XB_TOP], 1u);
            const unsigned tg = og / nx;
            if (og + 1u == (tg + 1u) * nx) xb_add(&bar[XB_TOPGEN], 1u);
            else XB_SPIN(xb_ld(&bar[XB_TOPGEN]) == tg, bar);
            __builtin_amdgcn_fence(__ATOMIC_ACQUIRE, "agent");
            xb_add(&bar[XB_XGEN(b.x)], 1u);
            asm volatile("s_waitcnt vmcnt(0)" ::: "memory");
        } else {
            XB_SPIN(xb_ld(&bar[XB_XGEN(b.x)]) == gen, bar);
            __builtin_amdgcn_fence(__ATOMIC_ACQUIRE, "agent");
            asm volatile("s_waitcnt vmcnt(0)" ::: "memory");
        }
    }
    __syncthreads();
}

constexpr int LDS_BYTES = 160 * 1024 - 1024;
constexpr int MISC_OFF = LDS_BYTES - 256;
constexpr int PTAB_OFF = LDS_BYTES - 1024;

struct Args { const float* in[N_IN]; float* out; unsigned char* ws; };

struct Frame {
    LAS unsigned char* lds;
    int tid, lane, wave, vcu, G;
};
__device__ __forceinline__ Frame refresh(const Frame& F0) {
    Frame F = F0; int t = F0.tid; asm volatile("" : "+v"(t)); F.tid = t; F.lane = t & 63; F.wave = __builtin_amdgcn_readfirstlane(t >> 6); return F;
}
__device__ __forceinline__ const float* inp(const Frame& F, int i) {
    const LAS unsigned* p = (const LAS unsigned*)(F.lds + PTAB_OFF) + 2 * i;
    const unsigned lo = __builtin_amdgcn_readfirstlane(p[0]), hi = __builtin_amdgcn_readfirstlane(p[1]);
    return (const float*)(((unsigned long long)hi << 32) | lo);
}

constexpr int NG_LD = 132, NG_CT = 129;
template <class Epi>
__device__ __forceinline__ void ngemm(const Frame& F0, const bf16* A, int lda, const float* W, const float* gain, int M, int N, int K, const Epi& epi) {
    const Frame F = refresh(F0);
    LAS float* As = (LAS float*)F.lds;
    LAS float* Bs = As + 16 * NG_LD;
    LAS float* Ct = Bs + 16 * NG_LD;
    const int tid = F.tid, tx = tid & 15, ty = tid >> 4;
    const int ntn = N / 128, ntiles = (M / 128) * ntn;
    for (int tile = F.vcu; tile < ntiles; tile += F.G) {
        const int tm = tile / ntn, tn = tile % ntn, row0 = tm * 128, col0 = tn * 128;
        float acc[4][8];
#pragma unroll
        for (int i = 0; i < 4; ++i)
#pragma unroll
            for (int j = 0; j < 8; ++j) acc[i][j] = 0.f;
        for (int k0 = 0; k0 < K; k0 += 16) {
            { const int r = tid >> 2, kq = (tid & 3) * 4;
              const v2u raw = *(const v2u*)(A + (size_t)(row0 + r) * lda + k0 + kq);
              As[(kq + 0) * NG_LD + r] = bflo(raw.x); As[(kq + 1) * NG_LD + r] = bfhi(raw.x);
              As[(kq + 2) * NG_LD + r] = bflo(raw.y); As[(kq + 3) * NG_LD + r] = bfhi(raw.y); }
            { const int kk = tid >> 5, n4 = (tid & 31) * 4;
              f32x4 w = *(const f32x4*)(W + (size_t)(k0 + kk) * N + col0 + n4);
              const float gs = gain ? gain[k0 + kk] : 1.f;
              w = w * gs;
              *(LAS f32x4*)(Bs + kk * NG_LD + n4) = w; }
            __syncthreads();
#pragma unroll
            for (int kk = 0; kk < 16; ++kk) {
                const f32x4 a = *(LAS f32x4*)(As + kk * NG_LD + ty * 4);
                const f32x4 b0 = *(LAS f32x4*)(Bs + kk * NG_LD + tx * 8), b1 = *(LAS f32x4*)(Bs + kk * NG_LD + tx * 8 + 4);
                const float av[4] = {a.x, a.y, a.z, a.w};
                const float bv[8] = {b0.x, b0.y, b0.z, b0.w, b1.x, b1.y, b1.z, b1.w};
#pragma unroll
                for (int i = 0; i < 4; ++i)
#pragma unroll
                    for (int j = 0; j < 8; ++j) acc[i][j] += av[i] * bv[j];
            }
            __syncthreads();
        }
#pragma unroll
        for (int i = 0; i < 4; ++i)
#pragma unroll
            for (int j = 0; j < 8; ++j) Ct[(ty * 4 + i) * NG_CT + tx * 8 + j] = acc[i][j];
        __syncthreads();
        epi(row0, col0, Ct, tid);
        __syncthreads();
    }
}

struct EpiWin {
    const float* part; bf16 *q, *k, *v, *u, *gates; const float *qg, *kg, *bgate;
    __device__ __forceinline__ void operator()(int row0, int col0, LAS float* Ct, int tid) const {
        LAS float* rsl = Ct + 128 * NG_CT;
        if (tid < 128) rsl[tid] = rowscale(part, row0 + tid);
        __syncthreads();
        if (col0 < 2048) {
            if (tid < 256) {
                const int r = tid >> 1, grp = tid & 1, c = col0 + grp * 64; const bool isq = c < 1024; const int cc = c & 1023, m = (cc >> 6) & 1;
                const float rs = rsl[r]; float ss = 0.f;
                for (int j = 0; j < 64; ++j) { const float v = Ct[r * NG_CT + grp * 64 + j] * rs; ss += v * v; }
                const float inv = rsqrtf(ss * (1.f / 64.f) + EPS);
                const float* gn = (isq ? qg : kg) + m * 64; const float sc = isq ? C2 : 1.f;
                bf16* dst = (isq ? q : k) + (size_t)(row0 + r) * 1024 + cc;
                for (int j = 0; j < 64; ++j) dst[j] = (bf16)f2bf(Ct[r * NG_CT + grp * 64 + j] * rs * inv * gn[j] * sc);
            }
        } else {
            for (int idx = tid; idx < 128 * 128; idx += NTHREADS) {
                const int r = idx >> 7, c = idx & 127, col = col0 + c; const float v = Ct[r * NG_CT + c] * rsl[r]; const size_t row = row0 + r;
                if (col < 3072) v_store(v, row, col); else if (col < 3584) u[row * 512 + (col - 3072)] = (bf16)f2bf(v);
                else gates[row * 2048 + (col - 3584)] = (bf16)f2bf(sigmoidf_(v + bgate[col - 3584]));
            }
        }
    }
    __device__ __forceinline__ void v_store(float val, size_t row, int col) const { v[row * 1024 + (col - 2048)] = (bf16)f2bf(val); }
};
struct EpiGlu {
    const bf16* z; bf16* z2; const float* b;
    __device__ __forceinline__ void operator()(int row0, int col0, LAS float* Ct, int tid) const {
        for (int idx = tid; idx < 128 * 128; idx += NTHREADS) { const int r = idx >> 7, c = idx & 127; const size_t o = (size_t)(row0 + r) * 512 + col0 + c;
            z2[o] = (bf16)f2bf(bf2f(z[o]) * sigmoidf_(Ct[r * NG_CT + c] + b[col0 + c])); }
    }
};
struct EpiPlain {
    bf16* o; int ldo;
    __device__ __forceinline__ void operator()(int row0, int col0, LAS float* Ct, int tid) const {
        for (int idx = tid; idx < 128 * 128; idx += NTHREADS) { const int r = idx >> 7, c = idx & 127; o[(size_t)(row0 + r) * ldo + col0 + c] = (bf16)f2bf(Ct[r * NG_CT + c]); }
    }
};
struct EpiGate {
    const bf16* gates; int goff; const bf16* add; bf16* o;
    __device__ __forceinline__ void operator()(int row0, int col0, LAS float* Ct, int tid) const {
        for (int idx = tid; idx < 128 * 128; idx += NTHREADS) { const int r = idx >> 7, c = idx & 127; const size_t row = row0 + r; const int col = col0 + c;
            float v = bf2f(gates[row * 2048 + goff + col]) * Ct[r * NG_CT + c]; if (add) v += bf2f(add[row * 1024 + col]);
            o[row * 1024 + col] = (bf16)f2bf(v); }
    }
};
struct EpiRes {
    const float* base; float* out; bf16* xb; float* part;
    __device__ __forceinline__ void operator()(int row0, int col0, LAS float* Ct, int tid) const {
        for (int idx = tid; idx < 128 * 128; idx += NTHREADS) { const int r = idx >> 7, c = idx & 127; const size_t o = (size_t)(row0 + r) * 1024 + col0 + c;
            const float v = base[o] + Ct[r * NG_CT + c]; out[o] = v; xb[o] = (bf16)f2bf(v); Ct[r * NG_CT + c] = v; }
        __syncthreads();
        if (tid < 128) { float ss = 0.f; for (int j = 0; j < 128; ++j) { const float v = Ct[tid * NG_CT + j]; ss += v * v; }
            float* pr = part + (size_t)(row0 + tid) * 16; pr[col0 >> 7] = ss; if (col0 == 0) { for (int j = 8; j < 16; ++j) pr[j] = 0.f; } }
    }
};
struct EpiPle {
    const float* part_in; const bf16* ple; float* out; bf16* xb; float* part_out;
    __device__ __forceinline__ void operator()(int row0, int col0, LAS float* Ct, int tid) const {
        LAS float* rsl = Ct + 128 * NG_CT;
        if (tid < 128) rsl[tid] = rowscale(part_in, row0 + tid);
        __syncthreads();
        for (int idx = tid; idx < 128 * 128; idx += NTHREADS) { const int r = idx >> 7, c = idx & 127; const size_t o = (size_t)(row0 + r) * 1024 + col0 + c;
            const float v = out[o] + sigmoidf_(Ct[r * NG_CT + c] * rsl[r]) * bf2f(ple[o]); Ct[r * NG_CT + c] = v; }
        __syncthreads();
        for (int idx = tid; idx < 128 * 128; idx += NTHREADS) { const int r = idx >> 7, c = idx & 127; const size_t o = (size_t)(row0 + r) * 1024 + col0 + c;
            const float v = Ct[r * NG_CT + c]; out[o] = v; xb[o] = (bf16)f2bf(v); }
        if (tid < 128) { float ss = 0.f; for (int j = 0; j < 128; ++j) { const float v = Ct[tid * NG_CT + j]; ss += v * v; }
            float* pr = part_out + (size_t)(row0 + tid) * 16; pr[col0 >> 7] = ss; if (col0 == 0) { for (int j = 8; j < 16; ++j) pr[j] = 0.f; } }
    }
};

__device__ __forceinline__ float ndot64(const float (&qv)[64], const bf16* krow) {
    const v4u* kp = (const v4u*)krow; float s = 0.f;
#pragma unroll
    for (int i = 0; i < 8; ++i) { const v4u w = kp[i]; s += qv[8 * i + 0] * bflo(w.x); s += qv[8 * i + 1] * bfhi(w.x); s += qv[8 * i + 2] * bflo(w.y); s += qv[8 * i + 3] * bfhi(w.y);
        s += qv[8 * i + 4] * bflo(w.z); s += qv[8 * i + 5] * bfhi(w.z); s += qv[8 * i + 6] * bflo(w.w); s += qv[8 * i + 7] * bfhi(w.w); }
    return s;
}
__device__ __forceinline__ void nattn_item(int item, int lane, const bf16* Q, const bf16* K, const bf16* V, bf16* O, float* tmp, float lam, const float* subln, float one_m_li) {
    const int qb = item & 31, h = (item >> 5) & 7, b = item >> 8;
    const int t = qb * 64 + lane; const size_t row = (size_t)b * SEQ + t;
    const int tmax = qb * 64 + 63;
    float* trow = tmp + row * 1024 + h * 128;
    float ss = 0.f;
    for (int m = 0; m < 2; ++m) {
        const int hh = 2 * h + m;
        float qv[64];
        { const v4u* qp = (const v4u*)(Q + row * 1024 + hh * 64);
#pragma unroll
          for (int i = 0; i < 8; ++i) { const v4u w = qp[i]; qv[8 * i + 0] = bflo(w.x); qv[8 * i + 1] = bfhi(w.x); qv[8 * i + 2] = bflo(w.y); qv[8 * i + 3] = bfhi(w.y);
              qv[8 * i + 4] = bflo(w.z); qv[8 * i + 5] = bfhi(w.z); qv[8 * i + 6] = bflo(w.w); qv[8 * i + 7] = bfhi(w.w); } }
        const bf16* kbase = K + (size_t)b * SEQ * 1024 + hh * 64;
        float mx = -3.0e38f;
#pragma unroll 1
        for (int j = 0; j <= tmax; ++j) { const float s = ndot64(qv, kbase + (size_t)j * 1024); if (j <= t) mx = fmaxf(mx, s); }
#pragma unroll 1
        for (int vq = 0; vq < 4; ++vq) {
            const bf16* vbase = V + (size_t)b * SEQ * 1024 + h * 128 + vq * 32;
            float l = 0.f; float acc[32];
#pragma unroll
            for (int e = 0; e < 32; ++e) acc[e] = 0.f;
#pragma unroll 1
            for (int j = 0; j <= tmax; ++j) {
                const float s = ndot64(qv, kbase + (size_t)j * 1024);
                const float p = (j <= t) ? exp2f(s - mx) : 0.f; l += p;
                const v4u* vp = (const v4u*)(vbase + (size_t)j * 1024);
#pragma unroll
                for (int i = 0; i < 4; ++i) { const v4u w = vp[i]; acc[8 * i + 0] += p * bflo(w.x); acc[8 * i + 1] += p * bfhi(w.x); acc[8 * i + 2] += p * bflo(w.y); acc[8 * i + 3] += p * bfhi(w.y);
                    acc[8 * i + 4] += p * bflo(w.z); acc[8 * i + 5] += p * bfhi(w.z); acc[8 * i + 6] += p * bflo(w.w); acc[8 * i + 7] += p * bfhi(w.w); }
            }
            const float il = 1.f / l;
            if (m == 0) {
#pragma unroll
                for (int e = 0; e < 32; ++e) trow[vq * 32 + e] = acc[e] * il;
            } else {
#pragma unroll
                for (int e = 0; e < 32; ++e) { const float d = trow[vq * 32 + e] - lam * acc[e] * il; trow[vq * 32 + e] = d; ss += d * d; }
            }
        }
    }
    const float inv = rsqrtf(ss * (1.f / 128.f) + EPS) * one_m_li;
    bf16* orow = O + row * 1024 + h * 128;
    for (int e = 0; e < 128; ++e) orow[e] = (bf16)f2bf(trow[e] * inv * subln[e]);
}

__device__ __forceinline__ void nssm_item(int item, int lane, const bf16* U, bf16* Z, const float* lre, const float* lim, const float* lstep,
                                          const float* bre, const float* bim, const float* cre, const float* cim, const float* dsk) {
    const int g = item & 31, b = item >> 5, p = lane;
    const float dt = expf(lstep[g]);
    const float lr = lre[g * SP + p], li = lim[g * SP + p];
    const float mag = expf(lr * dt);
    float sn, cs; sincosf(li * dt, &sn, &cs);
    const float ab_re = mag * cs, ab_im = mag * sn;
    const float den = lr * lr + li * li, nr = ab_re - 1.f;
    const float coef_re = (nr * lr + ab_im * li) / den, coef_im = (ab_im * lr - nr * li) / den;
    float bbr[16], bbi[16], cr[16], ci[16], dk[16];
#pragma unroll
    for (int h = 0; h < 16; ++h) { const float br = bre[(g * SP + p) * SG + h], bi = bim[(g * SP + p) * SG + h];
        bbr[h] = coef_re * br - coef_im * bi; bbi[h] = coef_re * bi + coef_im * br;
        cr[h] = cre[(g * SG + h) * SP + p]; ci[h] = cim[(g * SG + h) * SP + p]; dk[h] = dsk[g * SG + h]; }
    float s_re = 0.f, s_im = 0.f;
    for (int t = 0; t < SEQ; ++t) {
        const size_t row = (size_t)b * SEQ + t;
        const v4u* up = (const v4u*)(U + row * 512 + g * 16);
        const v4u w0 = up[0], w1 = up[1];
        float ut[16] = {bflo(w0.x), bfhi(w0.x), bflo(w0.y), bfhi(w0.y), bflo(w0.z), bfhi(w0.z), bflo(w0.w), bfhi(w0.w),
                        bflo(w1.x), bfhi(w1.x), bflo(w1.y), bfhi(w1.y), bflo(w1.z), bfhi(w1.z), bflo(w1.w), bfhi(w1.w)};
        float bur = 0.f, bui = 0.f;
#pragma unroll
        for (int h = 0; h < 16; ++h) { bur += bbr[h] * ut[h]; bui += bbi[h] * ut[h]; }
        const float nre = ab_re * s_re - ab_im * s_im + bur, nim = ab_re * s_im + ab_im * s_re + bui;
        s_re = nre; s_im = nim;
        float mine = 0.f;
#pragma unroll
        for (int h = 0; h < 16; ++h) { const float y = wave_sum(cr[h] * s_re - ci[h] * s_im) + dk[h] * ut[h]; if (lane == h) mine = y; }
        if (lane < 16) Z[row * 512 + g * 16 + lane] = (bf16)f2bf(gelu_tanh(mine));
    }
}

__device__ __forceinline__ void nmoe_item(const Frame& F0, int t, float* xio, const float* gffn, const float* wrg, const float* brg, const float* wre, const float* bre2,
                                          const float* weg, const float* weu, const float* wed, bf16* xb, float* part) {
    const Frame F = refresh(F0);
    LAS float* xn = (LAS float*)F.lds;
    LAS float* act = xn + 1024;
    LAS float* red = act + 256;
    const int tid = F.tid, lane = F.lane, wave = F.wave;
    float* xr = xio + (size_t)t * 1024;
    const float x0 = xr[tid], x1 = xr[tid + 512];
    { float s = wave_sum(x0 * x0 + x1 * x1); if (lane == 0) red[wave] = s; }
    __syncthreads();
    float tot = 0.f;
#pragma unroll
    for (int i = 0; i < 8; ++i) tot += red[i];
    const float rs = rsqrtf(tot * (1.f / DM) + EPS);
    xn[tid] = x0 * rs * gffn[tid]; xn[tid + 512] = x1 * rs * gffn[tid + 512];
    __syncthreads();
    if (wave < 4) { float s = 0.f; for (int k = lane; k < DM; k += 64) s += xn[k] * wrg[k * NGRP + wave]; s = wave_sum(s); if (lane == 0) red[16 + wave] = s + brg[wave]; }
    __syncthreads();
    int grp = 0; float gmax = red[16];
#pragma unroll
    for (int j = 1; j < 4; ++j) { const float v = red[16 + j]; if (v > gmax) { gmax = v; grp = j; } }
    float gden = 0.f;
#pragma unroll
    for (int j = 0; j < 4; ++j) gden += __expf(red[16 + j] - gmax);
    const float p_grp = 1.f / gden;
    { float s = 0.f; const float* w = wre + (size_t)grp * DM * EPG; for (int k = lane; k < DM; k += 64) s += xn[k] * w[k * EPG + wave]; s = wave_sum(s); if (lane == 0) red[32 + wave] = s + bre2[grp * EPG + wave]; }
    __syncthreads();
    int i0 = 0; float v0 = red[32];
#pragma unroll
    for (int j = 1; j < 8; ++j) { const float v = red[32 + j]; if (v > v0) { v0 = v; i0 = j; } }
    int i1 = -1; float v1 = -3.0e38f;
#pragma unroll
    for (int j = 0; j < 8; ++j) { const float v = red[32 + j]; if (j != i0 && v > v1) { v1 = v; i1 = j; } }
    const float e1 = __expf(v1 - v0);
    const float wk[2] = {p_grp / (1.f + e1), p_grp * e1 / (1.f + e1)};
    const int ek[2] = {grp * EPG + i0, grp * EPG + i1};
    float r0 = x0, r1 = x1;
#pragma unroll
    for (int k = 0; k < 2; ++k) {
        const int e = ek[k];
        const float* wsel = (tid < 256 ? weg : weu) + (size_t)e * DM * EFF + (tid & 255);
        float s = 0.f;
#pragma unroll 8
        for (int d = 0; d < DM; ++d) s += xn[d] * wsel[(size_t)d * EFF];
        __syncthreads();
        if (tid >= 256) act[tid - 256] = s;
        __syncthreads();
        float a = 0.f;
        if (tid < 256) { a = s / (1.f + __expf(-s)) * act[tid] * wk[k]; }
        __syncthreads();
        if (tid < 256) act[tid] = a;
        __syncthreads();
        const float* wd = wed + (size_t)e * EFF * DM;
        float o0 = 0.f, o1 = 0.f;
#pragma unroll 8
        for (int f = 0; f < EFF; ++f) { const float av = act[f]; o0 += av * wd[(size_t)f * DM + tid]; o1 += av * wd[(size_t)f * DM + tid + 512]; }
        r0 += o0; r1 += o1;
    }
    xr[tid] = r0; xr[tid + 512] = r1;
    xb[(size_t)t * 1024 + tid] = (bf16)f2bf(r0); xb[(size_t)t * 1024 + tid + 512] = (bf16)f2bf(r1);
    __syncthreads();
    { float s = wave_sum(r0 * r0 + r1 * r1); if (lane == 0) red[wave] = s; }
    __syncthreads();
    if (tid < 16) { float v = 0.f; if (tid == 0) { for (int i = 0; i < 8; ++i) v += red[i]; } part[(size_t)t * 16 + tid] = v; }
    __syncthreads();
}

__global__ void __launch_bounds__(NTHREADS, 2) mega_fwd(Args args) {
    extern __shared__ __attribute__((aligned(16))) unsigned char lds_raw[];
    Frame Fk;
    Fk.lds = (LAS unsigned char*)lds_raw;
    Fk.tid = threadIdx.x; Fk.lane = Fk.tid & 63; Fk.wave = __builtin_amdgcn_readfirstlane(Fk.tid >> 6);
    Fk.G = gridDim.x; { const int bx = blockIdx.x; Fk.vcu = (Fk.G % 8 == 0) ? (bx % 8) * (Fk.G / 8) + bx / 8 : bx; }
    const Frame& F = Fk;
    volatile LAS unsigned* MISC = (volatile LAS unsigned*)(F.lds + MISC_OFF);
    if (F.tid < 64) MISC[F.tid] = 0u;
    if (F.tid < N_IN) ((LAS unsigned long long*)(F.lds + PTAB_OFF))[F.tid] = (unsigned long long)args.in[F.tid];
    __syncthreads();
    unsigned char* ws = args.ws;
    unsigned* ctl = (unsigned*)(ws + WS_CTL);
    XcdBarrier bar = xcd_barrier_post(ctl + CW_BAR, MISC + 8);
#define GRID_BAR() xcd_barrier(bar)
    float* part = (float*)(ws + WS_PART);
    float* part2 = part + (size_t)T * 16;
    float* lamv = (float*)(ws + WS_MISC);
    bf16* X0 = (bf16*)(ws + WS_X0); bf16* X1 = (bf16*)(ws + WS_X1);
    bf16* Qb = (bf16*)(ws + WS_Q); bf16* Kb = (bf16*)(ws + WS_K); bf16* Vb = (bf16*)(ws + WS_V);
    bf16* Ub = (bf16*)(ws + WS_U); bf16* Zb = (bf16*)(ws + WS_Z); bf16* Gb = (bf16*)(ws + WS_GATES);
    bf16* PB = (bf16*)(ws + WS_PB);
    bf16* Z2b = (bf16*)(ws + WS_Z2); bf16* MIXb = (bf16*)(ws + WS_MIXED); bf16* PARTSb = (bf16*)(ws + WS_PARTS); bf16* PLEb = (bf16*)(ws + WS_PLE);
    float* OTMP = (float*)(ws + WS_OTMP);
    const int NGW = F.G * NWAVES;

    { const Frame F = refresh(Fk); const int gw = F.vcu * NWAVES + F.wave;
    for (int m = gw; m < T; m += NGW) {
        const f32x4* xr = (const f32x4*)(inp(F, I_X) + (size_t)m * DM) + F.lane; float s = 0.f;
        v2u* o8 = (v2u*)(X0 + (size_t)m * DM) + F.lane;
#pragma unroll
        for (int j = 0; j < 4; ++j) { const f32x4 v = xr[64 * j]; s += v.x * v.x + v.y * v.y + v.z * v.z + v.w * v.w;
            v2u w; w.x = f2bf(v.x) | (f2bf(v.y) << 16); w.y = f2bf(v.z) | (f2bf(v.w) << 16); o8[64 * j] = w; }
        s = wave_sum(s);
        if (F.lane < 16) part[(size_t)m * 16 + F.lane] = (F.lane == 0) ? s : 0.f;
    }
    for (size_t i = (size_t)(blockIdx.x * NTHREADS + F.tid) * 4; i < (size_t)DEPTH * T * PLE; i += (size_t)F.G * NTHREADS * 4) {
        const f32x4 v = *(const f32x4*)(inp(F, I_P) + i); v2u w; w.x = f2bf(v.x) | (f2bf(v.y) << 16); w.y = f2bf(v.z) | (f2bf(v.w) << 16); *(v2u*)(PB + i) = w; }
    if (blockIdx.x == 0 && F.tid < DEPTH) {
        const float* lq = inp(F, I_LAMQK) + F.tid * 4 * HD; float s1 = 0.f, s2 = 0.f;
        for (int j = 0; j < HD; ++j) { s1 += lq[j] * lq[HD + j]; s2 += lq[2 * HD + j] * lq[3 * HD + j]; }
        lamv[F.tid] = expf(s1) - expf(s2) + lam_init_for(F.tid);
    }
    }
    GRID_BAR();

    for (int L = 0; L < DEPTH; ++L) {
        bf16* XA = (L & 1) ? X1 : X0;
        bf16* XB = (L & 1) ? X0 : X1;
        const float* xbase = (L == 0) ? inp(F, I_X) : args.out;
        { EpiWin E{part, Qb, Kb, Vb, Ub, Gb, inp(F, I_QG) + L * 2 * HD, inp(F, I_KG) + L * 2 * HD, inp(F, I_BGATE) + L * 2 * DM};
          ngemm(F, XA, DM, inp(F, I_WIN) + (size_t)L * DM * INW, inp(F, I_ATTN_G) + L * DM, T, INW, DM, E); }
        GRID_BAR();
        { const Frame F = refresh(Fk); const int gw = F.vcu * NWAVES + F.wave;
        if (F.wave == 0) {
            for (int it = F.vcu; it < BATCH * NG; it += F.G)
                nssm_item(it, F.lane, Ub, Zb, inp(F, I_LRE) + L * NG * SP, inp(F, I_LIM) + L * NG * SP, inp(F, I_LSTEP) + L * NG, inp(F, I_BRE) + (size_t)L * NG * SP * SG, inp(F, I_BIM) + (size_t)L * NG * SP * SG,
                          inp(F, I_CRE) + (size_t)L * NG * SG * SP, inp(F, I_CIM) + (size_t)L * NG * SG * SP, inp(F, I_SSMD) + L * NG * SG);
        }
        { const float lam = lamv[L]; const float oml = 1.f - lam_init_for(L);
          for (int it = NGW - 1 - gw; it < BATCH * NH * 32; it += NGW) nattn_item(it, F.lane, Qb, Kb, Vb, Qb, OTMP, lam, inp(F, I_SUBLN) + L * 2 * HD, oml); }
        }
        GRID_BAR();
        { EpiGlu E{Zb, Z2b, inp(F, I_BGLU) + L * SSMW}; ngemm(F, Zb, SSMW, inp(F, I_WGLU) + (size_t)L * SSMW * SSMW, nullptr, T, SSMW, SSMW, E); }
        GRID_BAR();
        { EpiGate E{Gb, DM, nullptr, PARTSb}; ngemm(F, Z2b, SSMW, inp(F, I_WSU) + (size_t)L * SSMW * DM, nullptr, T, DM, SSMW, E); }
        GRID_BAR();
        { EpiGate E{Gb, 0, PARTSb, MIXb}; ngemm(F, Qb, DM, inp(F, I_WAU) + (size_t)L * VW * DM, nullptr, T, DM, VW, E); }
        GRID_BAR();
        { EpiRes E{xbase, args.out, XB, part2}; ngemm(F, MIXb, DM, inp(F, I_WOUT) + (size_t)L * DM * DM, nullptr, T, DM, DM, E); }
        GRID_BAR();
        { EpiPlain E{PLEb, DM}; ngemm(F, PB + (size_t)L * T * PLE, PLE, inp(F, I_WPLE) + (size_t)L * PLE * DM, nullptr, T, DM, PLE, E); }
        for (int t = F.vcu; t < T; t += F.G)
            nmoe_item(F, t, args.out, inp(F, I_FFN_G) + L * DM, inp(F, I_WRG) + (size_t)L * DM * NGRP, inp(F, I_BRG) + L * NGRP, inp(F, I_WRE) + (size_t)L * NGRP * DM * EPG, inp(F, I_BRE2) + L * NGRP * EPG,
                      inp(F, I_WEG) + (size_t)L * NEXP * DM * EFF, inp(F, I_WEU) + (size_t)L * NEXP * DM * EFF, inp(F, I_WED) + (size_t)L * NEXP * EFF * DM, XA, part);
        GRID_BAR();
        { EpiPle E{part, PLEb, args.out, XB, part2}; ngemm(F, XA, DM, inp(F, I_WPG) + (size_t)L * DM * DM, inp(F, I_PLE_G) + L * DM, T, DM, DM, E); }
        GRID_BAR();
        { float* tmpp = part; part = part2; part2 = tmpp; }
    }
}

extern "C" void kernel_launch(void* const* d_in, const int* in_sizes, int n_in, void* d_out, int out_size, void* d_ws, size_t ws_size, hipStream_t stream) {
    static int grid = 0;
    if (grid == 0) {
        if (n_in != N_IN || in_sizes[0] != T * DM || out_size != T * DM || ws_size < WS_END) {
            fprintf(stderr, "kernel_launch: unexpected problem (n_in %d, in0 %d, out %d, ws %zu); nothing launched\n", n_in, n_in > 0 ? in_sizes[0] : -1, out_size, ws_size); grid = -1; return; }
        int dev = 0, cus = 0, per_cu = 0;
        if (hipGetDevice(&dev) != hipSuccess || hipDeviceGetAttribute(&cus, hipDeviceAttributeMultiprocessorCount, dev) != hipSuccess) { grid = -1; return; }
        if (hipFuncSetAttribute((const void*)mega_fwd, hipFuncAttributeMaxDynamicSharedMemorySize, LDS_BYTES) != hipSuccess) { fprintf(stderr, "kernel_launch: hipFuncSetAttribute failed\n"); grid = -1; return; }
        if (hipOccupancyMaxActiveBlocksPerMultiprocessor(&per_cu, (const void*)mega_fwd, NTHREADS, LDS_BYTES) != hipSuccess || per_cu < 1)
            fprintf(stderr, "kernel_launch: note: occupancy query reports %d workgroups per CU\n", per_cu);
        (void)hipGetLastError();
        grid = cus;
    }
    if (grid < 0) return;
    if (hipMemsetAsync((char*)d_ws + WS_CTL, 0, CTL_ZERO_BYTES, stream) != hipSuccess) { fprintf(stderr, "kernel_launch: memset failed\n"); return; }
    Args a{};
    for (int i = 0; i < N_IN; ++i) a.in[i] = (const float*)d_in[i];
    a.out = (float*)d_out; a.ws = (unsigned char*)d_ws;
    hipLaunchKernelGGL(mega_fwd, dim3(grid), dim3(NTHREADS), LDS_BYTES, stream, a);
    const hipError_t le = hipPeekAtLastError();
    if (le != hipSuccess) fprintf(stderr, "kernel_launch: launch failed: %s\n", hipGetErrorName(le));
}
```

```cpp
#include <hip/hip_runtime.h>
#include <cstdio>
#include <cstdint>
#include <cmath>
#include <hip/hip_bf16.h>

#define GAS __attribute__((address_space(1)))
#define LAS __attribute__((address_space(3)))
typedef unsigned short bf16;
typedef unsigned v4u __attribute__((ext_vector_type(4)));
typedef unsigned v2u __attribute__((ext_vector_type(2)));
typedef float f32x4 __attribute__((ext_vector_type(4)));

constexpr int DM = 1024, BATCH = 8, SEQ = 2048, T = BATCH * SEQ, DEPTH = 2;
constexpr int NH = 8, HD = 64, QKW = 1024, VW = 1024, SSMW = 512, SG = 16, NG = 32, SP = 64;
constexpr int INW = 5632, NGRP = 4, EPG = 8, NEXP = 32, EFF = 256, PLE = 256;
constexpr float EPS = 1e-6f;
constexpr float C2 = 0.125f * 1.4426950408889634f;
constexpr int NWAVES = 8, NTHREADS = 512;

enum { I_X = 0, I_P, I_ATTN_G, I_WIN, I_BGATE, I_QG, I_KG, I_LAMQK, I_SUBLN, I_WAU, I_LRE, I_LIM, I_LSTEP, I_BRE, I_BIM, I_CRE, I_CIM,
       I_SSMD, I_WGLU, I_BGLU, I_WSU, I_WOUT, I_FFN_G, I_WRG, I_BRG, I_WRE, I_BRE2, I_WEG, I_WEU, I_WED, I_PLE_G, I_WPG, I_WPLE, N_IN };

constexpr size_t MiB = 1u << 20;
constexpr size_t WS_CTL = 0, CTL_ZERO_BYTES = 1 * MiB;
constexpr size_t WS_PART = 1 * MiB;
constexpr size_t WS_MISC = 3 * MiB;
constexpr size_t WS_SLOT = 4 * MiB;
constexpr size_t WS_WT = 16 * MiB;
constexpr size_t WS_X0 = 84 * MiB, WS_X1 = 116 * MiB;
constexpr size_t WS_Q = 148 * MiB, WS_K = 180 * MiB, WS_V = 212 * MiB;
constexpr size_t WS_U = 244 * MiB, WS_Z = 260 * MiB;
constexpr size_t WS_GATES = 276 * MiB;
constexpr size_t WS_PB = 340 * MiB;
constexpr size_t WS_END = 356 * MiB;
constexpr size_t WS_Z2 = WS_K, WS_MIXED = WS_K, WS_PARTS = WS_V, WS_PLE = WS_GATES, WS_OTMP = WS_X0, WS_ACT = WS_V;
struct SlotInfo { int token; float w; };
constexpr int CW_BAR = 4096;
constexpr int CW_CNT = 8192;

__device__ __forceinline__ unsigned f2bf(float f) { unsigned u = __builtin_bit_cast(unsigned, f); return (u + 0x7fffu + ((u >> 16) & 1u)) >> 16; }
__device__ __forceinline__ float bf2f(unsigned b) { return __builtin_bit_cast(float, b << 16); }
__device__ __forceinline__ float bflo(unsigned w) { return __builtin_bit_cast(float, w << 16); }
__device__ __forceinline__ float bfhi(unsigned w) { return __builtin_bit_cast(float, w & 0xffff0000u); }
__device__ __forceinline__ float wave_sum(float v) {
#pragma unroll
    for (int o = 1; o < 64; o <<= 1) v += __shfl_xor(v, o);
    return v;
}
__device__ __forceinline__ float sigmoidf_(float x) { return 1.f / (1.f + __expf(-x)); }
__device__ __forceinline__ float gelu_tanh(float x) { const float u = 0.7978845608028654f * (x + 0.044715f * x * x * x); return 0.5f * x * (1.f + tanhf(u)); }
__device__ __forceinline__ float rowscale(const float* part, int row) {
    const f32x4* p = (const f32x4*)(part + (size_t)row * 16);
    float s = 0.f;
#pragma unroll
    for (int i = 0; i < 4; ++i) { const f32x4 v = p[i]; s += v.x; s += v.y; s += v.z; s += v.w; }
    return rsqrtf(s * (1.f / DM) + EPS);
}
__host__ __device__ inline float lam_init_for(int i) { return 0.8f - 0.6f * expf(-0.3f * (float)i); }

#define XB_TMO      128
#define XB_XCNT(j)  (256  + 64 * (j))
#define XB_XSUB(j)  (1280 + 64 * (j))
#define XB_XGEN(j)  (2304 + 64 * (j))
#define XB_TOP      3328
#define XB_TOPGEN   3392
#define XCD_BAR_WORDS 3456
#define XB_SPIN_CAP (1u << 22)
__device__ __forceinline__ unsigned xb_ld(unsigned* p)              { return __hip_atomic_load(p, __ATOMIC_RELAXED, __HIP_MEMORY_SCOPE_AGENT); }
__device__ __forceinline__ unsigned xb_add(unsigned* p, unsigned v) { return __hip_atomic_fetch_add(p, v, __ATOMIC_RELAXED, __HIP_MEMORY_SCOPE_AGENT); }
__device__ __forceinline__ unsigned xb_xcc_id() { return (unsigned)__builtin_amdgcn_s_getreg((3 << 11) | 20) & 0xFu; }
#define XB_SPIN(cond, bar) do { unsigned _sp = 0; while (cond) { __builtin_amdgcn_s_sleep(1); \
    if ((++_sp & 255u) == 0u) { if (xb_ld(&(bar)[XB_TMO])) break; if (_sp > XB_SPIN_CAP) { atomicAdd(&(bar)[XB_TMO], 1u); break; } } } } while (0)
struct XcdBarrier { unsigned* bar; unsigned x; volatile LAS unsigned* st; };
__device__ __forceinline__ XcdBarrier xcd_barrier_post(unsigned* bar, volatile LAS unsigned* st) {
    XcdBarrier b; b.bar = bar; b.x = 0; b.st = st;
    if (threadIdx.x == 0) { const unsigned x = xb_xcc_id(); st[2] = x; (void)xb_add(&bar[XB_XCNT(x)], 1u); }
    return b;
}
__device__ __forceinline__ void xcd_barrier_complete(unsigned* bar, unsigned x, unsigned& nloc, unsigned& nx) {
    const unsigned G = gridDim.x * gridDim.y * gridDim.z;
    unsigned sum, cnt, mine, sp = 0u;
    for (;;) {
        sum = 0u; cnt = 0u; mine = 0u;
#pragma unroll
        for (unsigned j = 0; j < 16; ++j) { const unsigned c = xb_ld(&bar[XB_XCNT(j)]); sum += c; cnt += (c > 0u) ? 1u : 0u; mine = (j == x) ? c : mine; }
        if (sum == G) break;
        __builtin_amdgcn_s_sleep(1);
        if ((++sp & 255u) == 0u) { if (xb_ld(&bar[XB_TMO])) break; if (sp > XB_SPIN_CAP) { atomicAdd(&bar[XB_TMO], 1u); break; } }
    }
    nloc = mine > 0u ? mine : 1u; nx = cnt > 0u ? cnt : 1u;
}
__device__ __forceinline__ void xcd_barrier(const XcdBarrier& b) {
    asm volatile("s_waitcnt vmcnt(0)" ::: "memory");
    __syncthreads();
    if (threadIdx.x == 0) {
        unsigned* bar = b.bar;
        __builtin_amdgcn_s_waitcnt(0);
        unsigned nloc = b.st[0], nx = b.st[1]; const unsigned bx = b.st[2];
        if (nloc == 0u) { xcd_barrier_complete(bar, bx, nloc, nx); b.st[0] = nloc; b.st[1] = nx; }
        const unsigned old = xb_add(&bar[XB_XSUB(bx)], 1u);
        const unsigned gen = old / nloc;
        if (old + 1u == (gen + 1u) * nloc) {
            __builtin_amdgcn_fence(__ATOMIC_RELEASE, "agent");
            asm volatile("s_waitcnt vmcnt(0)" ::: "memory");
            const unsigned og = xb_add(&bar[XB_TOP], 1u);
            const unsigned tg = og / nx;
            if (og + 1u == (tg + 1u) * nx) xb_add(&bar[XB_TOPGEN], 1u);
            else XB_SPIN(xb_ld(&bar[XB_TOPGEN]) == tg, bar);
            __builtin_amdgcn_fence(__ATOMIC_ACQUIRE, "agent");
            xb_add(&bar[XB_XGEN(bx)], 1u);
            asm volatile("s_waitcnt vmcnt(0)" ::: "memory");
        } else {
            XB_SPIN(xb_ld(&bar[XB_XGEN(bx)]) == gen, bar);
            __builtin_amdgcn_fence(__ATOMIC_ACQUIRE, "agent");
            asm volatile("s_waitcnt vmcnt(0)" ::: "memory");
        }
    }
    __syncthreads();
}

constexpr int LDS_BYTES = 160 * 1024 - 1024;
constexpr int MISC_OFF = LDS_BYTES - 256;
constexpr int PTAB_OFF = LDS_BYTES - 1024;

struct Args { const float* in[N_IN]; float* out; unsigned char* ws; };

struct Frame {
    LAS unsigned char* lds;
    int tid, lane, wave, vcu, G;
};
__device__ __forceinline__ Frame refresh(const Frame& F0) {
    Frame F = F0; int t = F0.tid; asm volatile("" : "+v"(t)); F.tid = t; F.lane = t & 63; F.wave = __builtin_amdgcn_readfirstlane(t >> 6); return F;
}
__device__ __forceinline__ const float* inp(const Frame& F, int i) {
    const LAS unsigned* p = (const LAS unsigned*)(F.lds + PTAB_OFF) + 2 * i;
    const unsigned lo = __builtin_amdgcn_readfirstlane(p[0]), hi = __builtin_amdgcn_readfirstlane(p[1]);
    return (const float*)(const GAS float*)(((unsigned long long)hi << 32) | lo);
}

namespace pg8 {
#define PG8_LAS __attribute__((address_space(3)))
typedef unsigned short bf16_t;
typedef short bf16x8 __attribute__((ext_vector_type(8)));
typedef float f32x4 __attribute__((ext_vector_type(4)));
typedef unsigned u32x4 __attribute__((ext_vector_type(4)));
constexpr int BM = 256, BK = 64, HALF = 128, HTB = HALF * BK * 2  , STAGE_BYTES = 8 * HTB, NXCD = 8, WGM = 8;

__host__ __device__ __forceinline__ int lds_byte(int r, int c) { const int st = (r >> 4) * 2 + (c >> 5), rr = r & 15, cc = c & 31, ob = rr * 64 + cc * 2; return st * 1024 + (ob ^ (((ob >> 9) & 1) << 5)); }
__host__ __device__ __forceinline__ void stage_rc(int b, int& R, int& C) { const int st = b / 1024, sb = b % 1024, swz = sb ^ (((sb >> 9) & 1) << 5); R = (st >> 1) * 16 + swz / 64; C = (st & 1) * 32 + (swz % 64) / 2; }
__host__ __device__ __forceinline__ int perm32(int rho) { const int n = rho >> 4, i = rho & 15; return 8 * (i >> 2) + 4 * n + (i & 3); }

struct Unit { int pm, pn, e, mt, cnt, pl, k, slot; };
struct Gemm { const bf16_t* A; const bf16_t* Bt; int M, N, K; };

struct StaticOrder {
    int nM, nN, nwg, G, c;
    __host__ __device__ void init(int M, int N, int G_, int c_) { nM = M / BM; nN = N / BM; nwg = nM * nN; G = G_; c = c_; }
    __host__ __device__ bool next(int i, Unit& u) const {
        const long L = (long)i * G + c; if (L >= nwg) return false;
        int wgid = (int)L; { const int q = nwg / NXCD, r = nwg % NXCD, xcd = wgid % NXCD, off = wgid / NXCD; wgid = (xcd < r ? xcd * (q + 1) : r * (q + 1) + (xcd - r) * q) + off; }
        const int nig = WGM * nN, gid = wgid / nig, fm = gid * WGM, gsz = (nM - fm) < WGM ? (nM - fm) : WGM;
        u.pm = fm + ((wgid % nig) % gsz); u.pn = (wgid % nig) / gsz; return true;
    }
    __device__ __forceinline__ void a_ready(const Unit&) const {}
    __device__ __forceinline__ void done(const Unit&) const {}
};
typedef float f32x2_t __attribute__((ext_vector_type(2))); typedef __bf16 bf16x2_t __attribute__((ext_vector_type(2)));
__device__ __forceinline__ unsigned cvt_pk_bf16(float lo, float hi) { f32x2_t v = {lo, hi}; bf16x2_t b = __builtin_convertvector(v, bf16x2_t); return __builtin_bit_cast(unsigned, b); }

__device__ __forceinline__ float rowscale16(const float* part, int row) {
    const f32x4* p = (const f32x4*)(part + (size_t)row * 16); float s = 0.f;
#pragma unroll
    for (int i = 0; i < 4; ++i) { const f32x4 v = p[i]; s += v[0]; s += v[1]; s += v[2]; s += v[3]; }
    return rsqrtf(s * (1.f / 1024.f) + EPS);
}
__device__ __forceinline__ u32x4 pack8(f32x4 a, f32x4 b) { u32x4 w; w.x = cvt_pk_bf16(a[0], a[1]); w.y = cvt_pk_bf16(a[2], a[3]); w.z = cvt_pk_bf16(b[0], b[1]); w.w = cvt_pk_bf16(b[2], b[3]); return w; }
__device__ __forceinline__ void unpack8(u32x4 w, f32x4& a, f32x4& b) {
    a = (f32x4){__builtin_bit_cast(float, w.x << 16), __builtin_bit_cast(float, w.x & 0xffff0000u), __builtin_bit_cast(float, w.y << 16), __builtin_bit_cast(float, w.y & 0xffff0000u)};
    b = (f32x4){__builtin_bit_cast(float, w.z << 16), __builtin_bit_cast(float, w.z & 0xffff0000u), __builtin_bit_cast(float, w.w << 16), __builtin_bit_cast(float, w.w & 0xffff0000u)};
}
__device__ __forceinline__ float sig1(float x) { return __builtin_amdgcn_rcpf(1.f + __builtin_amdgcn_exp2f(-1.4426950408889634f * x)); }
__device__ __forceinline__ f32x4 sig4(f32x4 x) { return (f32x4){sig1(x[0]), sig1(x[1]), sig1(x[2]), sig1(x[3])}; }
__device__ __forceinline__ float dot4(f32x4 x) { return (x[0] * x[0] + x[1] * x[1]) + (x[2] * x[2] + x[3] * x[3]); }

struct EpiWinF {
    static constexpr bool PERM = false, AFTER_DRAIN = false;
    const float* part; bf16_t *q, *k, *v, *u, *gates; const float *qg, *kg, *bgate;
    __device__ __forceinline__ void operator()(const f32x4 (&acc)[2][2][4][2], const Unit& un, int wr, int wc, int, int) const {
        int l_ = threadIdx.x; asm volatile("" : "+v"(l_)); const int fr = l_ & 15, fq = (l_ >> 4) & 3;
        const int pn = un.pn, row0 = un.pm * BM + wr * 64 + fr;
        if (pn < 8) {
            const bool isq = pn < 4; bf16_t* dst = isq ? q : k; const int cb = (pn & 3) * 256 + wc * 64 + fq * 8;
            const float* gn = (isq ? qg : kg) + (wc & 1) * 64 + fq * 8; const float sc = isq ? C2 : 1.f;
            f32x4 gv[2][2];
#pragma unroll
            for (int bj = 0; bj < 2; ++bj)
#pragma unroll
                for (int n = 0; n < 2; ++n) gv[bj][n] = *(const f32x4*)(gn + bj * 32 + n * 4) * sc;
#pragma unroll
            for (int ai = 0; ai < 2; ++ai)
#pragma unroll
                for (int m = 0; m < 4; ++m) {
                    const int row = row0 + ai * HALF + m * 16; const float rs = rowscale16(part, row);
                    float ss = (dot4(acc[ai][0][m][0]) + dot4(acc[ai][0][m][1])) + (dot4(acc[ai][1][m][0]) + dot4(acc[ai][1][m][1]));
                    ss += __shfl_xor(ss, 16); ss += __shfl_xor(ss, 32);
                    const float inv = rsqrtf(ss * rs * rs * (1.f / 64.f) + EPS) * rs;
                    bf16_t* rowp = dst + (size_t)row * 1024 + cb;
#pragma unroll
                    for (int bj = 0; bj < 2; ++bj) *(u32x4*)(rowp + bj * 32) = pack8(acc[ai][bj][m][0] * inv * gv[bj][0], acc[ai][bj][m][1] * inv * gv[bj][1]);
                }
        } else if (pn < 14) {
            bf16_t* dst; int ld, cb;
            if (pn < 12) { dst = v; ld = 1024; cb = (pn - 8) * 256; } else { dst = u; ld = 512; cb = (pn - 12) * 256; }
            cb += wc * 64 + fq * 8;
#pragma unroll
            for (int ai = 0; ai < 2; ++ai)
#pragma unroll
                for (int m = 0; m < 4; ++m) {
                    const int row = row0 + ai * HALF + m * 16; const float rs = rowscale16(part, row);
                    bf16_t* rowp = dst + (size_t)row * ld + cb;
#pragma unroll
                    for (int bj = 0; bj < 2; ++bj) *(u32x4*)(rowp + bj * 32) = pack8(acc[ai][bj][m][0] * rs, acc[ai][bj][m][1] * rs);
                }
        } else {
            const int cb = (pn - 14) * 256 + wc * 64 + fq * 8;
            f32x4 bv[2][2];
#pragma unroll
            for (int bj = 0; bj < 2; ++bj)
#pragma unroll
                for (int n = 0; n < 2; ++n) bv[bj][n] = *(const f32x4*)(bgate + cb + bj * 32 + n * 4);
#pragma unroll
            for (int ai = 0; ai < 2; ++ai)
#pragma unroll
                for (int m = 0; m < 4; ++m) {
                    const int row = row0 + ai * HALF + m * 16; const float rs = rowscale16(part, row);
                    bf16_t* rowp = gates + (size_t)row * 2048 + cb;
#pragma unroll
                    for (int bj = 0; bj < 2; ++bj) *(u32x4*)(rowp + bj * 32) = pack8(sig4(acc[ai][bj][m][0] * rs + bv[bj][0]), sig4(acc[ai][bj][m][1] * rs + bv[bj][1]));
                }
        }
    }
};
struct EpiGluF {
    static constexpr bool PERM = false, AFTER_DRAIN = false;
    const bf16_t* z; bf16_t* z2; const float* b;
    __device__ __forceinline__ void operator()(const f32x4 (&acc)[2][2][4][2], const Unit& un, int wr, int wc, int, int) const {
        int l_ = threadIdx.x; asm volatile("" : "+v"(l_)); const int fr = l_ & 15, fq = (l_ >> 4) & 3;
        const int row0 = un.pm * BM + wr * 64 + fr, cb = un.pn * 256 + wc * 64 + fq * 8;
        f32x4 bv[2][2];
#pragma unroll
        for (int bj = 0; bj < 2; ++bj)
#pragma unroll
            for (int n = 0; n < 2; ++n) bv[bj][n] = *(const f32x4*)(b + cb + bj * 32 + n * 4);
#pragma unroll
        for (int ai = 0; ai < 2; ++ai)
#pragma unroll
            for (int m = 0; m < 4; ++m) {
                const int row = row0 + ai * HALF + m * 16;
#pragma unroll
                for (int bj = 0; bj < 2; ++bj) { const size_t o = (size_t)row * 512 + cb + bj * 32; f32x4 z0, z1; unpack8(*(const u32x4*)(z + o), z0, z1);
                    *(u32x4*)(z2 + o) = pack8(z0 * sig4(acc[ai][bj][m][0] + bv[bj][0]), z1 * sig4(acc[ai][bj][m][1] + bv[bj][1])); }
            }
    }
};
struct EpiPlainF {
    static constexpr bool PERM = false, AFTER_DRAIN = false;
    bf16_t* o; int ld;
    __device__ __forceinline__ void operator()(const f32x4 (&acc)[2][2][4][2], const Unit& un, int wr, int wc, int, int) const {
        int l_ = threadIdx.x; asm volatile("" : "+v"(l_)); const int fr = l_ & 15, fq = (l_ >> 4) & 3;
        const int row0 = un.pm * BM + wr * 64 + fr, cb = un.pn * 256 + wc * 64 + fq * 8;
#pragma unroll
        for (int ai = 0; ai < 2; ++ai)
#pragma unroll
            for (int m = 0; m < 4; ++m) {
                const int row = row0 + ai * HALF + m * 16;
#pragma unroll
                for (int bj = 0; bj < 2; ++bj) *(u32x4*)(o + (size_t)row * ld + cb + bj * 32) = pack8(acc[ai][bj][m][0], acc[ai][bj][m][1]);
            }
    }
};
struct EpiGateF {
    static constexpr bool PERM = false, AFTER_DRAIN = false;
    const bf16_t* gates; int goff; const bf16_t* add; bf16_t* o;
    __device__ __forceinline__ void operator()(const f32x4 (&acc)[2][2][4][2], const Unit& un, int wr, int wc, int, int) const {
        int l_ = threadIdx.x; asm volatile("" : "+v"(l_)); const int fr = l_ & 15, fq = (l_ >> 4) & 3;
        const int row0 = un.pm * BM + wr * 64 + fr, cb = un.pn * 256 + wc * 64 + fq * 8;
#pragma unroll
        for (int ai = 0; ai < 2; ++ai)
#pragma unroll
            for (int m = 0; m < 4; ++m) {
                const int row = row0 + ai * HALF + m * 16;
#pragma unroll
                for (int bj = 0; bj < 2; ++bj) { const int c = cb + bj * 32; f32x4 g0, g1; unpack8(*(const u32x4*)(gates + (size_t)row * 2048 + goff + c), g0, g1);
                    f32x4 v0 = g0 * acc[ai][bj][m][0], v1 = g1 * acc[ai][bj][m][1];
                    if (add) { f32x4 a0, a1; unpack8(*(const u32x4*)(add + (size_t)row * 1024 + c), a0, a1); v0 += a0; v1 += a1; }
                    *(u32x4*)(o + (size_t)row * 1024 + c) = pack8(v0, v1); }
            }
    }
};
struct EpiResF {
    static constexpr bool PERM = false, AFTER_DRAIN = false;
    const float* base; float* out; bf16_t* xb; float* part;
    __device__ __forceinline__ void operator()(const f32x4 (&acc)[2][2][4][2], const Unit& un, int wr, int wc, int, int) const {
        int l_ = threadIdx.x; asm volatile("" : "+v"(l_)); const int fr = l_ & 15, fq = (l_ >> 4) & 3;
        const int row0 = un.pm * BM + wr * 64 + fr, cb = un.pn * 256 + wc * 64 + fq * 8;
#pragma unroll
        for (int ai = 0; ai < 2; ++ai)
#pragma unroll
            for (int m = 0; m < 4; ++m) {
                const int row = row0 + ai * HALF + m * 16; float ss = 0.f;
#pragma unroll
                for (int bj = 0; bj < 2; ++bj) { const size_t o = (size_t)row * 1024 + cb + bj * 32;
                    const f32x4 v0 = *(const f32x4*)(base + o) + acc[ai][bj][m][0], v1 = *(const f32x4*)(base + o + 4) + acc[ai][bj][m][1];
                    *(f32x4*)(out + o) = v0; *(f32x4*)(out + o + 4) = v1; *(u32x4*)(xb + o) = pack8(v0, v1); ss += dot4(v0) + dot4(v1); }
                ss += __shfl_xor(ss, 16); ss += __shfl_xor(ss, 32);
                if (fq == 0) part[(size_t)row * 16 + un.pn * 4 + wc] = ss;
            }
    }
};
struct EpiPleF {
    static constexpr bool PERM = false, AFTER_DRAIN = false;
    const float* part_in; const bf16_t* ple; float* out; bf16_t* xb; float* part_out;
    __device__ __forceinline__ void operator()(const f32x4 (&acc)[2][2][4][2], const Unit& un, int wr, int wc, int, int) const {
        int l_ = threadIdx.x; asm volatile("" : "+v"(l_)); const int fr = l_ & 15, fq = (l_ >> 4) & 3;
        const int row0 = un.pm * BM + wr * 64 + fr, cb = un.pn * 256 + wc * 64 + fq * 8;
#pragma unroll
        for (int ai = 0; ai < 2; ++ai)
#pragma unroll
            for (int m = 0; m < 4; ++m) {
                const int row = row0 + ai * HALF + m * 16; const float rs = rowscale16(part_in, row); float ss = 0.f;
#pragma unroll
                for (int bj = 0; bj < 2; ++bj) { const size_t o = (size_t)row * 1024 + cb + bj * 32; f32x4 p0, p1; unpack8(*(const u32x4*)(ple + o), p0, p1);
                    const f32x4 v0 = *(const f32x4*)(out + o) + sig4(acc[ai][bj][m][0] * rs) * p0, v1 = *(const f32x4*)(out + o + 4) + sig4(acc[ai][bj][m][1] * rs) * p1;
                    *(f32x4*)(out + o) = v0; *(f32x4*)(out + o + 4) = v1; *(u32x4*)(xb + o) = pack8(v0, v1); ss += dot4(v0) + dot4(v1); }
                ss += __shfl_xor(ss, 16); ss += __shfl_xor(ss, 32);
                if (fq == 0) part_out[(size_t)row * 16 + un.pn * 4 + wc] = ss;
            }
    }
};
template <class Epi, class Sched, bool ALIGN_EPI = false, bool SP2 = false>
__device__ __forceinline__ void gemm_phase(PG8_LAS unsigned char* lds, const Gemm g, const Sched& S, const Epi& E) {
    int tid_ = threadIdx.x; asm volatile("" : "+v"(tid_)); const int tid = tid_, wid = __builtin_amdgcn_readfirstlane(tid >> 6), lane = tid & 63, wr = wid >> 2, wc = wid & 3, fr = lane & 15, fq = lane >> 4;
    const int K = g.K, nt = K / BK;
    unsigned voffA[2], voffB[2];
#pragma unroll
    for (int i = 0; i < 2; ++i) { int R, C; stage_rc(tid * 16 + i * 8192, R, C); const int Rb = Epi::PERM ? ((R & ~31) + perm32(R & 31)) : R;
        voffA[i] = (unsigned)(R * K + C) * 2u; voffB[i] = (unsigned)(Rb * K + C) * 2u; }
    const size_t kstep = (size_t)(BK * 2);
    const size_t hstep = (size_t)HALF * K * 2;
    const size_t tstep = 2 * hstep;
    const unsigned ldsw = (unsigned)wid * 1024u;
    const int aoff = lds_byte(wr * 64 + fr, fq * 8), boff = lds_byte(wc * 32 + fr, fq * 8);
#define PG8_SA(b, h) (((b) * 2 + (h)) * HTB)
#define PG8_SB(b, h) ((4 + (b) * 2 + (h)) * HTB)
#define PG8_STAGE(bufoff, gbase, voff) do { _Pragma("unroll") for (int _i = 0; _i < 2; ++_i) \
        __builtin_amdgcn_global_load_lds((const unsigned*)((const char*)(gbase) + (voff)[_i]), (PG8_LAS unsigned*)(lds + (bufoff) + ldsw + _i * 8192), 16, 0, 0); } while (0)
#define PG8_LDA(dst, b, h) do { _Pragma("unroll") for (int m = 0; m < 4; ++m) _Pragma("unroll") for (int k = 0; k < 2; ++k) dst[m][k] = *(const PG8_LAS bf16x8*)(lds + PG8_SA(b, h) + aoff + m * 2048 + k * 1024); } while (0)
#define PG8_LDB(dst, b, h) do { _Pragma("unroll") for (int n = 0; n < 2; ++n) _Pragma("unroll") for (int k = 0; k < 2; ++k) dst[n][k] = *(const PG8_LAS bf16x8*)(lds + PG8_SB(b, h) + boff + n * 2048 + k * 1024); } while (0)
#define PG8_MMA(ai, bj, At, Bt) do { __builtin_amdgcn_s_setprio(1); _Pragma("unroll") for (int m = 0; m < 4; ++m) _Pragma("unroll") for (int n = 0; n < 2; ++n) _Pragma("unroll") for (int k = 0; k < 2; ++k) \
        acc[ai][bj][m][n] = __builtin_amdgcn_mfma_f32_16x16x32_bf16(Bt[n][k], At[m][k], acc[ai][bj][m][n], 0, 0, 0); __builtin_amdgcn_s_setprio(0); } while (0)
#define PG8_WAIT_V(n) asm volatile("s_waitcnt vmcnt(" #n ")" ::: "memory")
#define PG8_WAIT_L(n) asm volatile("s_waitcnt lgkmcnt(" #n ")" ::: "memory")
#define PG8_BAR __builtin_amdgcn_s_barrier()
#define PG8_SCHED __builtin_amdgcn_sched_barrier(0)
    Unit cur, nxt; int ui = 0;
    if (!S.next(0, cur)) return;
    f32x4 acc[2][2][4][2];
#pragma unroll
    for (int a = 0; a < 2; ++a)
#pragma unroll
        for (int b = 0; b < 2; ++b)
#pragma unroll
            for (int m = 0; m < 4; ++m)
#pragma unroll
                for (int n = 0; n < 2; ++n) acc[a][b][m][n] = (f32x4){0.f, 0.f, 0.f, 0.f};
    bf16x8 At[4][2], B0[2][2], B1[2][2];
    const char* cA = (const char*)g.A + (size_t)cur.pm * tstep; const char* cB = (const char*)g.Bt + (size_t)cur.pn * tstep;
    S.a_ready(cur);
    if constexpr (SP2) {
        PG8_STAGE(PG8_SB(0, 0), cB, voffB); PG8_STAGE(PG8_SB(0, 1), cB + hstep, voffB); PG8_STAGE(PG8_SA(0, 0), cA, voffA); PG8_STAGE(PG8_SA(0, 1), cA + hstep, voffA);
        if (wr == 1) PG8_BAR;
        PG8_WAIT_V(2); PG8_BAR;
        PG8_STAGE(PG8_SB(1, 0), cB + kstep, voffB); PG8_STAGE(PG8_SA(1, 0), cA + kstep, voffA); PG8_STAGE(PG8_SB(1, 1), cB + hstep + kstep, voffB);
        PG8_WAIT_V(6); PG8_BAR;
    } else {
        PG8_STAGE(PG8_SB(0, 0), cB, voffB); PG8_STAGE(PG8_SA(0, 0), cA, voffA); PG8_STAGE(PG8_SB(0, 1), cB + hstep, voffB); PG8_STAGE(PG8_SA(0, 1), cA + hstep, voffA);
        if (wr == 1) PG8_BAR;
        PG8_WAIT_V(4); PG8_BAR;
        PG8_STAGE(PG8_SB(1, 0), cB + kstep, voffB); PG8_STAGE(PG8_SA(1, 0), cA + kstep, voffA); PG8_STAGE(PG8_SB(1, 1), cB + hstep + kstep, voffB);
        PG8_WAIT_V(6); PG8_BAR;
    }
    for (;;) {
        const bool has_next = S.next(ui + 1, nxt);
        const char* nA = has_next ? (const char*)g.A + (size_t)nxt.pm * tstep : cA; const char* nB = has_next ? (const char*)g.Bt + (size_t)nxt.pn * tstep : cB;
#pragma unroll 1
        for (int t = 0; t < nt; t += 2) {
            const bool last = (t == nt - 2);
            const char* a1 = cA + (size_t)(t + 1) * kstep;
            const char* a2 = last ? nA : cA + (size_t)(t + 2) * kstep; const char* b2 = last ? nB : cB + (size_t)(t + 2) * kstep;
            const char* a3 = a2 + kstep; const char* b3 = b2 + kstep;
            if (last && has_next) S.a_ready(nxt);
            if constexpr (SP2) {
            PG8_LDB(B0, 0, 0); PG8_LDB(B1, 0, 1); PG8_SCHED; PG8_LDA(At, 0, 0); PG8_STAGE(PG8_SA(1, 1), a1 + hstep, voffA);
            PG8_WAIT_V(8); PG8_WAIT_L(0); PG8_BAR; PG8_MMA(0, 0, At, B0); PG8_MMA(0, 1, At, B1); PG8_BAR; PG8_SCHED;
            PG8_LDA(At, 0, 1); PG8_STAGE(PG8_SB(0, 0), b2, voffB); PG8_STAGE(PG8_SB(0, 1), b2 + hstep, voffB); PG8_STAGE(PG8_SA(0, 0), a2, voffA);
            PG8_WAIT_V(8); PG8_WAIT_L(0); PG8_BAR; PG8_MMA(1, 0, At, B0); PG8_MMA(1, 1, At, B1); PG8_BAR; PG8_SCHED;
            PG8_LDB(B0, 1, 0); PG8_LDB(B1, 1, 1); PG8_SCHED; PG8_LDA(At, 1, 0); PG8_STAGE(PG8_SA(0, 1), a2 + hstep, voffA);
            PG8_WAIT_V(8); PG8_WAIT_L(0); PG8_BAR; PG8_MMA(0, 0, At, B0); PG8_MMA(0, 1, At, B1); PG8_BAR; PG8_SCHED;
            PG8_LDA(At, 1, 1); PG8_STAGE(PG8_SB(1, 0), b3, voffB); PG8_STAGE(PG8_SB(1, 1), b3 + hstep, voffB); PG8_STAGE(PG8_SA(1, 0), a3, voffA);
            PG8_WAIT_V(8); PG8_WAIT_L(0); PG8_BAR; PG8_MMA(1, 0, At, B0); PG8_MMA(1, 1, At, B1); PG8_BAR; PG8_SCHED;
            } else {
            PG8_LDB(B0, 0, 0); PG8_SCHED; PG8_LDA(At, 0, 0); PG8_STAGE(PG8_SA(1, 1), a1 + hstep, voffA);
            PG8_WAIT_L(8); PG8_BAR; PG8_WAIT_L(0); PG8_MMA(0, 0, At, B0); PG8_BAR; PG8_SCHED;
            PG8_LDB(B1, 0, 1); PG8_STAGE(PG8_SB(0, 0), b2, voffB);
            PG8_BAR; PG8_WAIT_L(0); PG8_MMA(0, 1, At, B1); PG8_BAR;
            PG8_LDA(At, 0, 1); PG8_STAGE(PG8_SA(0, 0), a2, voffA);
            PG8_BAR; PG8_WAIT_L(0); PG8_MMA(1, 0, At, B0); PG8_BAR; PG8_SCHED;
            PG8_STAGE(PG8_SB(0, 1), b2 + hstep, voffB);
            PG8_WAIT_V(6); PG8_BAR; PG8_MMA(1, 1, At, B1); PG8_BAR;
            PG8_LDB(B0, 1, 0); PG8_SCHED; PG8_LDA(At, 1, 0); PG8_STAGE(PG8_SA(0, 1), a2 + hstep, voffA);
            PG8_WAIT_L(8); PG8_BAR; PG8_WAIT_L(0); PG8_MMA(0, 0, At, B0); PG8_BAR; PG8_SCHED;
            PG8_LDB(B1, 1, 1); PG8_STAGE(PG8_SB(1, 0), b3, voffB);
            PG8_BAR; PG8_WAIT_L(0); PG8_MMA(0, 1, At, B1); PG8_BAR;
            PG8_LDA(At, 1, 1); PG8_STAGE(PG8_SA(1, 0), a3, voffA);
            PG8_BAR; PG8_WAIT_L(0); PG8_MMA(1, 0, At, B0); PG8_BAR; PG8_SCHED;
            PG8_STAGE(PG8_SB(1, 1), b3 + hstep, voffB);
            PG8_WAIT_V(6); PG8_BAR; PG8_MMA(1, 1, At, B1); PG8_BAR;
            }
        }
        if constexpr (ALIGN_EPI) { if (wr == 0) PG8_BAR; }
        if constexpr (!Epi::AFTER_DRAIN) { E(acc, cur, wr, wc, fr, fq); S.done(cur); }
        if (!has_next) break;
#pragma unroll
        for (int a = 0; a < 2; ++a)
#pragma unroll
            for (int b = 0; b < 2; ++b)
#pragma unroll
                for (int m = 0; m < 4; ++m)
#pragma unroll
                    for (int n = 0; n < 2; ++n) acc[a][b][m][n] = (f32x4){0.f, 0.f, 0.f, 0.f};
        cur = nxt; cA = nA; cB = nB; ++ui;
        if constexpr (ALIGN_EPI) { if (wr == 1) PG8_BAR; }
    }
    PG8_WAIT_V(0);
    if constexpr (!ALIGN_EPI) { if (wr == 0) PG8_BAR; }
    PG8_BAR;
    if constexpr (Epi::AFTER_DRAIN) { E.fused(acc, cur, wr, wc, fr, fq, lds, wid, lane); S.done(cur); }
#undef PG8_SA
#undef PG8_SB
#undef PG8_STAGE
#undef PG8_LDA
#undef PG8_LDB
#undef PG8_MMA
#undef PG8_WAIT_V
#undef PG8_WAIT_L
#undef PG8_BAR
#undef PG8_SCHED
}

#define PG8_TOKOFF_OFF 131072
#define PG8_ROWINFO_OFF 135168
struct EpiActF {
    static constexpr bool PERM = false, AFTER_DRAIN = false;
    const float* part; bf16_t* act; PG8_LAS const unsigned char* lds;
    __device__ __forceinline__ void operator()(const f32x4 (&acc)[2][2][4][2], const Unit& un, int wr, int wc, int, int) const {
        int l_ = threadIdx.x; asm volatile("" : "+v"(l_)); const int fr = l_ & 15, fq = (l_ >> 4) & 3;
        PG8_LAS const SlotInfo* ri = (PG8_LAS const SlotInfo*)(lds + PG8_ROWINFO_OFF) + un.slot * 256;
#pragma unroll
        for (int ai = 0; ai < 2; ++ai)
#pragma unroll
            for (int m = 0; m < 4; ++m) {
                const int r = ai * HALF + wr * 64 + m * 16 + fr; const int tok_ = ri[r].token; const float w = ri[r].w; const float rs = rowscale16(part, tok_);
                f32x4 a[2];
#pragma unroll
                for (int n = 0; n < 2; ++n) { const f32x4 g = acc[ai][0][m][n] * rs, u = acc[ai][1][m][n] * rs; a[n] = g * sig4(g) * u * w; }
                *(u32x4*)(act + ((size_t)un.pm * 256 + r) * 256 + un.pl * 128 + wc * 32 + fq * 8) = pack8(a[0], a[1]);
            }
    }
};
template <int KK> struct EpiDownF {
    static constexpr bool PERM = false, AFTER_DRAIN = false;
    const SlotInfo* slots; float* out; bf16_t* xb; float* part;
    __device__ __forceinline__ void operator()(const f32x4 (&acc)[2][2][4][2], const Unit& un, int wr, int wc, int, int) const {
        int l_ = threadIdx.x; asm volatile("" : "+v"(l_)); const int fr = l_ & 15, fq = (l_ >> 4) & 3;
        const int cb = un.pl * 256 + wc * 64 + fq * 8;
        const SlotInfo* sl = slots + (size_t)(KK * 32 + un.e) * 16384 + un.mt * 256;
#pragma unroll
        for (int ai = 0; ai < 2; ++ai)
#pragma unroll
            for (int m = 0; m < 4; ++m) {
                const int r = ai * HALF + wr * 64 + m * 16 + fr; const bool valid = (un.mt * 256 + r) < un.cnt;
                const int token = valid ? sl[r].token : 0; float ss = 0.f;
#pragma unroll
                for (int bj = 0; bj < 2; ++bj) { const size_t o = (size_t)token * 1024 + cb + bj * 32;
                    const f32x4 v0 = *(const f32x4*)(out + o) + acc[ai][bj][m][0], v1 = *(const f32x4*)(out + o + 4) + acc[ai][bj][m][1];
                    if (valid) { *(f32x4*)(out + o) = v0; *(f32x4*)(out + o + 4) = v1; if (KK) *(u32x4*)(xb + o) = pack8(v0, v1); }
                    ss += dot4(v0) + dot4(v1); }
                if (KK) { ss += __shfl_xor(ss, 16); ss += __shfl_xor(ss, 32); if (valid && fq == 0) part[(size_t)token * 16 + un.pl * 4 + wc] = ss; }
            }
    }
};
__device__ __forceinline__ int ldsu(PG8_LAS const int* p) { return __builtin_amdgcn_readfirstlane(*p); }
struct MoeSched {
    PG8_LAS const int* tb; PG8_LAS const int* tc; int G, c, mode;
    __device__ __forceinline__ bool next(int i, Unit& u) const {
        const int gi = i * G + c; int ti, pl;
        if (mode == 0) { ti = gi >> 1; pl = gi & 1; if (ti >= ldsu(tb + 64)) return false; }
        else { ti = gi >> 2; pl = gi & 3; const int n0 = ldsu(tb + 32); if (mode == 2) { ti += n0; if (ti >= ldsu(tb + 64)) return false; } else if (ti >= n0) return false; }
        int ke = 0;
        for (int j = 1; j < 64; ++j) if (ldsu(tb + j) <= ti) ke = j;
        u.pm = ti; u.e = ke & 31; u.k = ke >> 5; u.mt = ti - ldsu(tb + ke); u.cnt = ldsu(tc + ke); u.pl = pl; u.slot = i; u.pn = (ke & 31) * (mode == 0 ? 2 : 4) + pl;
        return true;
    }
    __device__ __forceinline__ void a_ready(const Unit&) const {}
    __device__ __forceinline__ void done(const Unit&) const {}
};
template <class Epi, class Sched>
__device__ __forceinline__ void gemm_phase_g(PG8_LAS unsigned char* lds, const Gemm g, const Sched& S, const Epi& E) {
    int tid_ = threadIdx.x; asm volatile("" : "+v"(tid_)); const int tid = tid_, wid = __builtin_amdgcn_readfirstlane(tid >> 6), lane = tid & 63, wr = wid >> 2, wc = wid & 3, fr = lane & 15, fq = lane >> 4;
    const int K = g.K, nt = K / BK;
    unsigned voffB[2]; int RA[2]; unsigned CA2[2];
#pragma unroll
    for (int i = 0; i < 2; ++i) { int R, C; stage_rc(tid * 16 + i * 8192, R, C); voffB[i] = (unsigned)(R * K + C) * 2u; RA[i] = R; CA2[i] = (unsigned)C * 2u; }
    const size_t kstep = (size_t)(BK * 2), hstep = (size_t)HALF * K * 2, tstep = 2 * hstep;
    const unsigned ldsw = (unsigned)wid * 1024u;
    const int aoff = lds_byte(wr * 64 + fr, fq * 8), boff = lds_byte(wc * 32 + fr, fq * 8);
    PG8_LAS const unsigned* tokoff = (PG8_LAS const unsigned*)(lds + PG8_TOKOFF_OFF);
#define PG8_SA(b, h) (((b) * 2 + (h)) * HTB)
#define PG8_SB(b, h) ((4 + (b) * 2 + (h)) * HTB)
#define PG8_STAGE(bufoff, gbase, voff) do { _Pragma("unroll") for (int _i = 0; _i < 2; ++_i) \
        __builtin_amdgcn_global_load_lds((const unsigned*)((const char*)(gbase) + (voff)[_i]), (PG8_LAS unsigned*)(lds + (bufoff) + ldsw + _i * 8192), 16, 0, 0); } while (0)
#define PG8_STAGE_A(bufoff, gbase, o0, o1) do { \
        __builtin_amdgcn_global_load_lds((const unsigned*)((const char*)(gbase) + (o0)), (PG8_LAS unsigned*)(lds + (bufoff) + ldsw), 16, 0, 0); \
        __builtin_amdgcn_global_load_lds((const unsigned*)((const char*)(gbase) + (o1)), (PG8_LAS unsigned*)(lds + (bufoff) + ldsw + 8192), 16, 0, 0); } while (0)
#define PG8_GOFF(slot, d00, d01, d10, d11) do { PG8_LAS const unsigned* t_ = tokoff + (slot) * 256; \
        d00 = t_[RA[0]] + CA2[0]; d01 = t_[RA[1]] + CA2[1]; d10 = t_[128 + RA[0]] + CA2[0]; d11 = t_[128 + RA[1]] + CA2[1]; } while (0)
#define PG8_LDA(dst, b, h) do { _Pragma("unroll") for (int m = 0; m < 4; ++m) _Pragma("unroll") for (int k = 0; k < 2; ++k) dst[m][k] = *(const PG8_LAS bf16x8*)(lds + PG8_SA(b, h) + aoff + m * 2048 + k * 1024); } while (0)
#define PG8_LDB(dst, b, h) do { _Pragma("unroll") for (int n = 0; n < 2; ++n) _Pragma("unroll") for (int k = 0; k < 2; ++k) dst[n][k] = *(const PG8_LAS bf16x8*)(lds + PG8_SB(b, h) + boff + n * 2048 + k * 1024); } while (0)
#define PG8_MMA(ai, bj, At, Bt) do { __builtin_amdgcn_s_setprio(1); _Pragma("unroll") for (int m = 0; m < 4; ++m) _Pragma("unroll") for (int n = 0; n < 2; ++n) _Pragma("unroll") for (int k = 0; k < 2; ++k) \
        acc[ai][bj][m][n] = __builtin_amdgcn_mfma_f32_16x16x32_bf16(Bt[n][k], At[m][k], acc[ai][bj][m][n], 0, 0, 0); __builtin_amdgcn_s_setprio(0); } while (0)
#define PG8_WAIT_V(n) asm volatile("s_waitcnt vmcnt(" #n ")" ::: "memory")
#define PG8_WAIT_L(n) asm volatile("s_waitcnt lgkmcnt(" #n ")" ::: "memory")
#define PG8_BAR __builtin_amdgcn_s_barrier()
#define PG8_SCHED __builtin_amdgcn_sched_barrier(0)
    Unit cur, nxt; int ui = 0;
    if (!S.next(0, cur)) return;
    f32x4 acc[2][2][4][2];
#pragma unroll
    for (int a = 0; a < 2; ++a)
#pragma unroll
        for (int b = 0; b < 2; ++b)
#pragma unroll
            for (int m = 0; m < 4; ++m)
#pragma unroll
                for (int n = 0; n < 2; ++n) acc[a][b][m][n] = (f32x4){0.f, 0.f, 0.f, 0.f};
    bf16x8 At[4][2], B0[2][2], B1[2][2];
    unsigned gc00, gc01, gc10, gc11;
    PG8_GOFF(0, gc00, gc01, gc10, gc11);
    const char* A0 = (const char*)g.A; const char* cB = (const char*)g.Bt + (size_t)cur.pn * tstep;
    PG8_STAGE(PG8_SB(0, 0), cB, voffB); PG8_STAGE(PG8_SB(0, 1), cB + hstep, voffB); PG8_STAGE_A(PG8_SA(0, 0), A0, gc00, gc01); PG8_STAGE_A(PG8_SA(0, 1), A0, gc10, gc11);
    if (wr == 1) PG8_BAR;
    PG8_WAIT_V(2); PG8_BAR;
    PG8_STAGE(PG8_SB(1, 0), cB + kstep, voffB); PG8_STAGE_A(PG8_SA(1, 0), A0 + kstep, gc00, gc01); PG8_STAGE(PG8_SB(1, 1), cB + hstep + kstep, voffB);
    PG8_WAIT_V(6); PG8_BAR;
    for (;;) {
        const bool has_next = S.next(ui + 1, nxt);
        const char* nB = has_next ? (const char*)g.Bt + (size_t)nxt.pn * tstep : cB;
#pragma unroll 1
        for (int t = 0; t < nt; t += 2) {
            const bool last = (t == nt - 2);
            const char* a1 = A0 + (size_t)(t + 1) * kstep;
            const char* a2 = last ? A0 : A0 + (size_t)(t + 2) * kstep; const char* b2 = last ? nB : cB + (size_t)(t + 2) * kstep;
            const char* a3 = a2 + kstep; const char* b3 = b2 + kstep;
            unsigned g200 = gc00, g201 = gc01, g210 = gc10, g211 = gc11;
            if (last && has_next) { PG8_GOFF(ui + 1, g200, g201, g210, g211); }
            PG8_LDB(B0, 0, 0); PG8_LDB(B1, 0, 1); PG8_SCHED; PG8_LDA(At, 0, 0); PG8_STAGE_A(PG8_SA(1, 1), a1, gc10, gc11);
            PG8_WAIT_V(8); PG8_WAIT_L(0); PG8_BAR; PG8_MMA(0, 0, At, B0); PG8_MMA(0, 1, At, B1); PG8_BAR; PG8_SCHED;
            PG8_LDA(At, 0, 1); PG8_STAGE(PG8_SB(0, 0), b2, voffB); PG8_STAGE(PG8_SB(0, 1), b2 + hstep, voffB); PG8_STAGE_A(PG8_SA(0, 0), a2, g200, g201);
            PG8_WAIT_V(8); PG8_WAIT_L(0); PG8_BAR; PG8_MMA(1, 0, At, B0); PG8_MMA(1, 1, At, B1); PG8_BAR; PG8_SCHED;
            PG8_LDB(B0, 1, 0); PG8_LDB(B1, 1, 1); PG8_SCHED; PG8_LDA(At, 1, 0); PG8_STAGE_A(PG8_SA(0, 1), a2, g210, g211);
            PG8_WAIT_V(8); PG8_WAIT_L(0); PG8_BAR; PG8_MMA(0, 0, At, B0); PG8_MMA(0, 1, At, B1); PG8_BAR; PG8_SCHED;
            PG8_LDA(At, 1, 1); PG8_STAGE(PG8_SB(1, 0), b3, voffB); PG8_STAGE(PG8_SB(1, 1), b3 + hstep, voffB); PG8_STAGE_A(PG8_SA(1, 0), a3, g200, g201);
            PG8_WAIT_V(8); PG8_WAIT_L(0); PG8_BAR; PG8_MMA(1, 0, At, B0); PG8_MMA(1, 1, At, B1); PG8_BAR; PG8_SCHED;
        }
        if (wr == 0) PG8_BAR;
        E(acc, cur, wr, wc, fr, fq);
        if (!has_next) break;
#pragma unroll
        for (int a = 0; a < 2; ++a)
#pragma unroll
            for (int b = 0; b < 2; ++b)
#pragma unroll
                for (int m = 0; m < 4; ++m)
#pragma unroll
                    for (int n = 0; n < 2; ++n) acc[a][b][m][n] = (f32x4){0.f, 0.f, 0.f, 0.f};
        cur = nxt; cB = nB; ++ui; PG8_GOFF(ui, gc00, gc01, gc10, gc11);
        if (wr == 1) PG8_BAR;
    }
    PG8_WAIT_V(0);
    PG8_BAR;
#undef PG8_SA
#undef PG8_SB
#undef PG8_STAGE
#undef PG8_STAGE_A
#undef PG8_GOFF
#undef PG8_LDA
#undef PG8_LDB
#undef PG8_MMA
#undef PG8_WAIT_V
#undef PG8_WAIT_L
#undef PG8_BAR
#undef PG8_SCHED
}

}

__device__ __forceinline__ int p64_row(int c) { const int cl = c & 255; return (c & ~255) + 128 * ((cl >> 5) & 1) + 32 * (cl >> 6) + 16 * ((cl >> 2) & 1) + 4 * ((cl >> 3) & 3) + (cl & 3); }
__device__ __forceinline__ unsigned pk2(float lo, float hi) { return f2bf(lo) | (f2bf(hi) << 16); }
__device__ __forceinline__ int gu_row(int ff, int isup) { const int fl = ff & 127; return 256 * (ff >> 7) + 128 * isup + 32 * (fl >> 5) + 16 * ((fl >> 2) & 1) + 4 * ((fl >> 3) & 3) + (fl & 3); }
template <int MODE>
__device__ __forceinline__ void transpose_item(const float* W, int K, int N, bf16* WT, const float* gain, LAS float* scr, int item, int lane) {
    const int nblk = N / 32, kb = item / nblk, nb = item % nblk, k0 = 64 * kb, n0 = 32 * nb;
#pragma unroll 8
    for (int i = 0; i < 32; ++i) { const int kk = 2 * i + (lane >> 5); float w = W[(size_t)(k0 + kk) * N + n0 + (lane & 31)]; if (gain) w *= gain[k0 + kk]; scr[kk * 33 + (lane & 31)] = w; }
    asm volatile("s_waitcnt lgkmcnt(0)" ::: "memory");
    const int c = lane & 7;
#pragma unroll
    for (int j = 0; j < 4; ++j) { const int n = (lane >> 3) + 8 * j; const LAS float* s = scr + (8 * c) * 33 + n;
        v4u o; o.x = pk2(s[0 * 33], s[1 * 33]); o.y = pk2(s[2 * 33], s[3 * 33]); o.z = pk2(s[4 * 33], s[5 * 33]); o.w = pk2(s[6 * 33], s[7 * 33]);
        const int drow = MODE == 0 ? p64_row(n0 + n) : gu_row(n0 + n, MODE == 2);
        *(v4u*)(WT + (size_t)drow * K + k0 + 8 * c) = o; }
    asm volatile("s_waitcnt lgkmcnt(0)" ::: "memory");
}
constexpr size_t WT_WIN = 0, WT_WAU = 12 * MiB, WT_WOUT = 14 * MiB, WT_WPG = 16 * MiB, WT_WGLU = 18 * MiB, WT_WSU = 18 * MiB + 512 * 1024, WT_WPLE = 19 * MiB + 512 * 1024, WT_WGU = 20 * MiB, WT_WD = 52 * MiB;
__device__ __forceinline__ void convert_weights(const Frame& F0, int L, unsigned char* wt) {
    const Frame F = refresh(F0);
    LAS float* scr = (LAS float*)(F.lds + F.wave * 16384);
    const int gw = F.vcu * NWAVES + F.wave, NGW = F.G * NWAVES;
    constexpr int I_IN = (DM / 64) * (INW / 32), I_SQ = (DM / 64) * (DM / 32), I_GLU = (SSMW / 64) * (SSMW / 32), I_SU = (SSMW / 64) * (DM / 32), I_PL = (PLE / 64) * (DM / 32);
    constexpr int I_EX = NEXP * 128;
    constexpr int NIT = I_IN + 3 * I_SQ + I_GLU + I_SU + I_PL + 3 * I_EX;
    for (int it = gw; it < NIT; it += NGW) {
        int r = it;
        if (r < I_IN) { transpose_item<0>(inp(F, I_WIN) + (size_t)L * DM * INW, DM, INW, (bf16*)(wt + WT_WIN), inp(F, I_ATTN_G) + L * DM, scr, r, F.lane); continue; } r -= I_IN;
        if (r < I_SQ) { transpose_item<0>(inp(F, I_WAU) + (size_t)L * DM * DM, DM, DM, (bf16*)(wt + WT_WAU), nullptr, scr, r, F.lane); continue; } r -= I_SQ;
        if (r < I_SQ) { transpose_item<0>(inp(F, I_WOUT) + (size_t)L * DM * DM, DM, DM, (bf16*)(wt + WT_WOUT), nullptr, scr, r, F.lane); continue; } r -= I_SQ;
        if (r < I_SQ) { transpose_item<0>(inp(F, I_WPG) + (size_t)L * DM * DM, DM, DM, (bf16*)(wt + WT_WPG), inp(F, I_PLE_G) + L * DM, scr, r, F.lane); continue; } r -= I_SQ;
        if (r < I_GLU) { transpose_item<0>(inp(F, I_WGLU) + (size_t)L * SSMW * SSMW, SSMW, SSMW, (bf16*)(wt + WT_WGLU), nullptr, scr, r, F.lane); continue; } r -= I_GLU;
        if (r < I_SU) { transpose_item<0>(inp(F, I_WSU) + (size_t)L * SSMW * DM, SSMW, DM, (bf16*)(wt + WT_WSU), nullptr, scr, r, F.lane); continue; } r -= I_SU;
        if (r < I_PL) { transpose_item<0>(inp(F, I_WPLE) + (size_t)L * PLE * DM, PLE, DM, (bf16*)(wt + WT_WPLE), nullptr, scr, r, F.lane); continue; } r -= I_PL;
        if (r < I_EX) { const int e = r >> 7; transpose_item<1>(inp(F, I_WEG) + ((size_t)L * NEXP + e) * DM * EFF, DM, EFF, (bf16*)(wt + WT_WGU) + (size_t)e * 512 * DM, inp(F, I_FFN_G) + L * DM, scr, r & 127, F.lane); continue; } r -= I_EX;
        if (r < I_EX) { const int e = r >> 7; transpose_item<2>(inp(F, I_WEU) + ((size_t)L * NEXP + e) * DM * EFF, DM, EFF, (bf16*)(wt + WT_WGU) + (size_t)e * 512 * DM, inp(F, I_FFN_G) + L * DM, scr, r & 127, F.lane); continue; } r -= I_EX;
        { const int e = r >> 7; transpose_item<0>(inp(F, I_WED) + ((size_t)L * NEXP + e) * EFF * DM, EFF, DM, (bf16*)(wt + WT_WD) + (size_t)e * DM * EFF, nullptr, scr, r & 127, F.lane); }
    }
}
#include <hip/hip_bf16.h>
namespace attn_body {
using bf16=__hip_bfloat16;
using bf16x8=__attribute__((ext_vector_type(8)))short;
using s16x4=__attribute__((ext_vector_type(4)))short;
using f32x16=__attribute__((ext_vector_type(16)))float;
using u32x4=__attribute__((ext_vector_type(4)))unsigned;
constexpr int BATCH=8,NHEAD=16,SEQ=2048,D=64,DM=NHEAD*D;
constexpr int NW=8,QBLK=32,QB=QBLK*NW,KVBLK=64,NQB=SEQ/QB;
constexpr int ATTN_PITCH=DM, ATTN_UNIT_ROWS=QB;
__device__ __forceinline__ int crow(int r,int hi){return (r&3)+8*(r>>2)+4*hi;}
#define SBAR() __builtin_amdgcn_sched_barrier(0)
__device__ __forceinline__ void cmask(f32x16&p0,f32x16&p1,int jb,int qrel,int hi){
  const float NEG=-INFINITY; int kb=64*jb+4*hi;
  #pragma unroll
  for(int r=0;r<16;++r){int kv=kb+(r&3)+8*(r>>2); if(kv>qrel)p0[r]=NEG; if(kv+32>qrel)p1[r]=NEG;}
}

constexpr int NSLOT=3, SLOTB=8192;
constexpr int LDS_K=0, LDS_V=NSLOT*SLOTB, LDS_WS=2*NSLOT*SLOTB, LDS_OST=LDS_WS+NW*64*4, LDS_BYTES=LDS_OST+NW*4096;
constexpr float C2=0.125f*1.4426950408889634f;
__device__ __forceinline__ void glds16(const void*gsrc,unsigned lds_dst){unsigned keep;
  asm volatile("s_mov_b32 %0, m0\n\ts_mov_b32 m0, %2\n\ts_nop 0\n\tglobal_load_lds_dwordx4 %1, off\n\ts_mov_b32 m0, %0":"=&s"(keep):"v"(gsrc),"s"(lds_dst):"memory");}
__device__ __forceinline__ float max3f(float a,float b,float c){float r;asm("v_max3_f32 %0, %1, %2, %3":"=v"(r):"v"(a),"v"(b),"v"(c));return r;}
__device__ __forceinline__ float max2f(float a,float b){float r;asm("v_max_f32_e32 %0, %1, %2":"=v"(r):"v"(a),"v"(b));return r;}
__device__ __forceinline__ float fadd_s(float a,float b){float r;asm("v_add_f32_e32 %0, %1, %2":"=v"(r):"v"(a),"v"(b));return r;}
__device__ __forceinline__ float fsub_s(float a,float b){float r;asm("v_sub_f32_e32 %0, %1, %2":"=v"(r):"v"(a),"v"(b));return r;}
typedef float f32x2_t __attribute__((ext_vector_type(2))); typedef __bf16 bf16x2_t __attribute__((ext_vector_type(2)));
__device__ __forceinline__ unsigned cvtpk_s(float lo,float hi){f32x2_t v={lo,hi};bf16x2_t b=__builtin_convertvector(v,bf16x2_t);return __builtin_bit_cast(unsigned,b);}
#define WAIT_BAR(N) asm volatile("s_waitcnt vmcnt(" #N ") lgkmcnt(0)\n\ts_barrier":::"memory")

__device__ __forceinline__ void qkt(f32x16&p0,f32x16&p1,const char*Kslot,const bf16x8*qr,const f32x16&negm,int r32,int hi){
  const char*kb=Kslot+hi*1024+r32*16;
  #pragma unroll
  for(int d0=0;d0<4;++d0){
    const bf16x8 b0=*reinterpret_cast<const bf16x8*>(kb+d0*2048);
    const bf16x8 b1=*reinterpret_cast<const bf16x8*>(kb+d0*2048+512);
    if(d0==0){p0=__builtin_amdgcn_mfma_f32_32x32x16_bf16(b0,qr[0],negm,0,0,0);p1=__builtin_amdgcn_mfma_f32_32x32x16_bf16(b1,qr[0],negm,0,0,0);}
    else{p0=__builtin_amdgcn_mfma_f32_32x32x16_bf16(b0,qr[d0],p0,0,0,0);p1=__builtin_amdgcn_mfma_f32_32x32x16_bf16(b1,qr[d0],p1,0,0,0);}}
}
typedef __attribute__((address_space(3))) const char* lds_cptr;
typedef short v4i16_t __attribute__((ext_vector_type(4)));
__device__ __forceinline__ void kload8(bf16x8*kf,lds_cptr kp){
  kf[0]=*(const __attribute__((address_space(3))) bf16x8*)(kp);      kf[1]=*(const __attribute__((address_space(3))) bf16x8*)(kp+512);
  kf[2]=*(const __attribute__((address_space(3))) bf16x8*)(kp+2048); kf[3]=*(const __attribute__((address_space(3))) bf16x8*)(kp+2560);
  kf[4]=*(const __attribute__((address_space(3))) bf16x8*)(kp+4096); kf[5]=*(const __attribute__((address_space(3))) bf16x8*)(kp+4608);
  kf[6]=*(const __attribute__((address_space(3))) bf16x8*)(kp+6144); kf[7]=*(const __attribute__((address_space(3))) bf16x8*)(kp+6656);
}
__device__ __forceinline__ void kload2(bf16x8*kf,lds_cptr kp,int j){ kf[2*j]=*(const __attribute__((address_space(3))) bf16x8*)(kp+j*2048); kf[2*j+1]=*(const __attribute__((address_space(3))) bf16x8*)(kp+j*2048+512); }
__device__ __forceinline__ s16x4 vtr(lds_cptr p){ return __builtin_bit_cast(s16x4,__builtin_amdgcn_ds_read_tr16_b64_v4i16((__attribute__((address_space(3))) v4i16_t*)p)); }
__device__ __forceinline__ float rowmax(const f32x16&p0,const f32x16&p1){
  float a=max3f(p0[0],p0[1],p1[0]),b=max3f(p0[2],p0[3],p1[1]);a=max3f(a,p1[2],p1[3]);
  #pragma unroll
  for(int r=4;r<16;r+=4){a=max3f(a,p0[r],p0[r+1]);b=max3f(b,p0[r+2],p0[r+3]);a=max3f(a,p1[r],p1[r+1]);b=max3f(b,p1[r+2],p1[r+3]);}
  const float m=max2f(a,b);
  auto rr=__builtin_amdgcn_permlane32_swap(__float_as_uint(m),__float_as_uint(m),false,false);
  return max2f(__uint_as_float(rr[0]),__uint_as_float(rr[1]));
}
__device__ __forceinline__ void pv(f32x16*o,int vb,bf16x8 pa0,bf16x8 pa1,bf16x8 pa2,bf16x8 pa3){
  #pragma unroll
  for(int d0=0;d0<2;++d0){s16x4 lo[4],hi[4];
    #pragma unroll
    for(int ks=0;ks<4;++ks){
      asm volatile("ds_read_b64_tr_b16 %0,%1 offset:%c2":"=&v"(lo[ks]):"v"(vb),"i"(d0*4096+ks*1024):"memory");
      asm volatile("ds_read_b64_tr_b16 %0,%1 offset:%c2":"=&v"(hi[ks]):"v"(vb),"i"(d0*4096+ks*1024+512):"memory");}
    asm volatile("s_waitcnt lgkmcnt(0)":::"memory");SBAR();
    #define PK(k) (bf16x8){lo[k][0],lo[k][1],lo[k][2],lo[k][3],hi[k][0],hi[k][1],hi[k][2],hi[k][3]}
    o[d0]=__builtin_amdgcn_mfma_f32_32x32x16_bf16(pa0,PK(0),o[d0],0,0,0);
    o[d0]=__builtin_amdgcn_mfma_f32_32x32x16_bf16(pa1,PK(1),o[d0],0,0,0);
    o[d0]=__builtin_amdgcn_mfma_f32_32x32x16_bf16(pa2,PK(2),o[d0],0,0,0);
    o[d0]=__builtin_amdgcn_mfma_f32_32x32x16_bf16(pa3,PK(3),o[d0],0,0,0);
    #undef PK
  }
}

#ifndef ATTN_STORE16
#define ATTN_STORE16(p,v) (*(u32x4*)(p)=(v))
#endif
template<int THRL> __device__ __forceinline__ void attn_pass(int b,int hq,int hv,int qb,const bf16*Q,const bf16*K,const bf16*V,char*shm,f32x16 (&o)[2],float (&rli)[16]){
  int tid_=threadIdx.x; asm volatile("":"+v"(tid_)); const int tid=tid_,lane=tid&63,r32=lane&31,hi=lane>>5; const int wid=__builtin_amdgcn_readfirstlane(tid>>6);
  const long rowbase=(long)b*SEQ; const int q0=qb*QB;
  const bf16*Qw=Q+(rowbase+q0+wid*QBLK)*DM+hq*D;
  const bf16*Kh=K+rowbase*DM+hq*D,*Vh=V+rowbase*DM+hv*D;
  const unsigned lds0=(unsigned)(uintptr_t)shm;
  float*wsf=(float*)(shm+LDS_WS)+wid*64;
  const bf16*ksrc=Kh+(long)lane*DM+wid*8;
  const bf16*vsrc=Vh+(long)(16*(wid&3)+(lane>>2))*DM+(wid>>2)*32+(lane&3)*8;
  const unsigned kdst=lds0+LDS_K+wid*1024, vdst=lds0+LDS_V+wid*1024;
  #define DMA_K(t,slot) glds16(ksrc+(long)(t)*KVBLK*DM,(unsigned)__builtin_amdgcn_readfirstlane(kdst+(slot)))
  #define DMA_V(t,slot) glds16(vsrc+(long)(t)*KVBLK*DM,(unsigned)__builtin_amdgcn_readfirstlane(vdst+(slot)))
  const int vb0=(int)(lds0+LDS_V)+((lane>>4)&1)*32+(lane&3)*8+(4*hi+((lane&15)>>2))*64;
  const char*Kbase=shm+LDS_K; bf16x8 kf[8];
  const lds_cptr shm3=(lds_cptr)shm; const lds_cptr kp0=shm3+LDS_K+hi*1024+r32*16; const lds_cptr vp0=shm3+LDS_V+((lane>>4)&1)*32+(lane&3)*8+(4*hi+((lane&15)>>2))*64;
  const int NT=(q0+QB)/KVBLK;
  DMA_K(0,0);DMA_V(0,0);DMA_K(1,SLOTB);
  bf16x8 qr[4];
  #pragma unroll
  for(int d0=0;d0<4;++d0)qr[d0]=*reinterpret_cast<const bf16x8*>(&Qw[(long)r32*DM+d0*16+hi*8]);
  float mhat=0.f,l_reg=0.f;o[0]=f32x16{};o[1]=f32x16{};f32x16 negm=f32x16{};asm volatile("":"+v"(negm));
  const int qrel=wid*QBLK+r32;
  #define CMASK(P0,P1,t) do{int jb_=(t)-(NT-4); if(jb_>=0)cmask(P0,P1,jb_,qrel,hi);}while(0)
  bool resc=false;
  #define START(P0,P1) do{ const float rm=rowmax(P0,P1); resc=false; \
    { const float dl=rm; mhat=fadd_s(mhat,dl); \
      _Pragma("unroll") for(int r=0;r<16;++r){P0[r]=fsub_s(P0[r],dl);P1[r]=fsub_s(P1[r],dl);} \
      _Pragma("unroll") for(int r=0;r<16;++r)negm[r]=-mhat; asm volatile("":"+v"(negm)); } \
    _Pragma("unroll") for(int r=0;r<16;++r)P0[r]=__builtin_amdgcn_exp2f(P0[r]); }while(0)
  #define RESC() do{ if(resc){ asm volatile("s_waitcnt lgkmcnt(0)":::"memory"); \
      _Pragma("unroll") for(int d_=0;d_<2;++d_) _Pragma("unroll") for(int r=0;r<16;++r)o[d_][r]*=wsf[crow(r,hi)]; } }while(0)
  f32x16 pA0,pA1,pB0,pB1;
  int sl_prev=0,sl_cur=0,sl_next=SLOTB;
  #define ROT() do{sl_prev=sl_cur;sl_cur=sl_next;sl_next=(sl_next==(NSLOT-1)*SLOTB)?0:sl_next+SLOTB;}while(0)
  DMA_K(2,2*SLOTB);
  WAIT_BAR(3);
  qkt(pA0,pA1,Kbase,qr,negm,r32,hi);asm volatile("s_nop 15\n\ts_nop 7":"+v"(pA0),"+v"(pA1));CMASK(pA0,pA1,0);
  START(pA0,pA1);
  _Pragma("unroll") for(int r=0;r<16;++r)pA1[r]=__builtin_amdgcn_exp2f(pA1[r]);
  WAIT_BAR(0);
  DMA_K(3,0);DMA_V(1,SLOTB);
  ROT();
  kload8(kf,kp0+sl_cur);
  WAIT_BAR(2);
  s16x4 vlo[8],vhi[8]; u32x4 pw0,pw1,pw2,pw3;
  #define PKW(P,B) cvtpk_s(P[B],P[B+1])
  #define PAF(k) __builtin_bit_cast(bf16x8,pw##k)
  #define VFR(i) (bf16x8){vlo[i][0],vlo[i][1],vlo[i][2],vlo[i][3],vhi[i][0],vhi[i][1],vhi[i][2],vhi[i][3]}
  #define PIN(x) asm volatile("":"+v"(x))
  #define MX3(a,b,c) __builtin_fmaxf(__builtin_fmaxf((a),(b)),(c))
  #define GAPA(MF,A0,A1,A2,A3,W0,W1,PW) do{ MF; sacc+=A0; sacc+=A1; sacc+=A2; sacc+=A3; PIN(sacc); W0; W1; PIN(PW); SBAR(); }while(0)
  #define EX(v) __builtin_amdgcn_exp2f(v)
  #define GAPB(MF,X,B) do{ MF; X[B]=EX(X[B]); X[B+1]=EX(X[B+1]); X[B+2]=EX(X[B+2]); X[B+3]=EX(X[B+3]); PIN(X); SBAR(); }while(0)
  #define VRD(i) do{ vlo[i]=vtr(vp_+(((i)>>2)*4096+((i)&3)*1024)); vhi[i]=vtr(vp_+(((i)>>2)*4096+((i)&3)*1024+512)); }while(0)
  #define KRD(G,j) do{ if(G){ kload2(kf,kp0+sl_next,j); SBAR(); } }while(0)
  #define STEP(C0,C1,P0,P1,t,GK,GV,GL) do{ SBAR(); \
    const lds_cptr vp_=vp0+sl_prev; \
    VRD(0); SBAR(); float sacc=(P0[0]+P0[1]); \
    GAPA(C0=__builtin_amdgcn_mfma_f32_32x32x16_bf16(kf[0],qr[0],negm,0,0,0), P0[2],P0[3],P0[4],P0[5],     pw0[0]=PKW(P0,0), pw0[1]=PKW(P0,2), pw0); \
    VRD(4); SBAR(); GAPA(C1=__builtin_amdgcn_mfma_f32_32x32x16_bf16(kf[1],qr[0],negm,0,0,0), P0[6],P0[7],P0[8],P0[9],     pw0[2]=PKW(P0,4), pw0[3]=PKW(P0,6), pw0); \
    VRD(1); SBAR(); GAPA(C0=__builtin_amdgcn_mfma_f32_32x32x16_bf16(kf[2],qr[1],C0,0,0,0),   P0[10],P0[11],P0[12],P0[13], pw1[0]=PKW(P0,8), pw1[1]=PKW(P0,10), pw1); \
    VRD(5); SBAR(); GAPA(C1=__builtin_amdgcn_mfma_f32_32x32x16_bf16(kf[3],qr[1],C1,0,0,0),   P0[14],P0[15],P1[0],P1[1],   pw1[2]=PKW(P0,12),pw1[3]=PKW(P0,14), pw1); \
    VRD(2); SBAR(); GAPA(C0=__builtin_amdgcn_mfma_f32_32x32x16_bf16(kf[4],qr[2],C0,0,0,0),   P1[2],P1[3],P1[4],P1[5],     pw2[0]=PKW(P1,0), pw2[1]=PKW(P1,2), pw2); \
    VRD(6); SBAR(); GAPA(C1=__builtin_amdgcn_mfma_f32_32x32x16_bf16(kf[5],qr[2],C1,0,0,0),   P1[6],P1[7],P1[8],P1[9],     pw2[2]=PKW(P1,4), pw2[3]=PKW(P1,6), pw2); \
    VRD(3); SBAR(); GAPA(C0=__builtin_amdgcn_mfma_f32_32x32x16_bf16(kf[6],qr[3],C0,0,0,0),   P1[10],P1[11],P1[12],P1[13], pw3[0]=PKW(P1,8), pw3[1]=PKW(P1,10), pw3); \
    VRD(7); SBAR(); GAPA(C1=__builtin_amdgcn_mfma_f32_32x32x16_bf16(kf[7],qr[3],C1,0,0,0),   P1[14],P1[15],0.f,0.f,       pw3[2]=PKW(P1,12),pw3[3]=PKW(P1,14), pw3); \
    l_reg+=sacc; \
    if(GK){DMA_K((t)+3,sl_cur);} if(GV){DMA_V((t)+1,sl_next);} \
    CMASK(C0,C1,t); \
    { float a=MX3(C0[0],C0[1],C1[0]),b=MX3(C0[2],C0[3],C1[1]); a=MX3(a,C1[2],C1[3]); \
      _Pragma("unroll") for(int r=4;r<16;r+=4){a=MX3(a,C0[r],C0[r+1]);b=MX3(b,C0[r+2],C0[r+3]);a=MX3(a,C1[r],C1[r+1]);b=MX3(b,C1[r+2],C1[r+3]);} \
      float rm=__builtin_fmaxf(a,b); { auto rr=__builtin_amdgcn_permlane32_swap(__float_as_uint(rm),__float_as_uint(rm),false,false); rm=__builtin_fmaxf(__uint_as_float(rr[0]),__uint_as_float(rr[1])); } \
      resc=false; \
      if(__builtin_expect(__any(rm>(float)THRL),0)){ const float dl=__builtin_fmaxf(rm,0.f); mhat+=dl; \
        _Pragma("unroll") for(int r=0;r<16;++r){C0[r]-=dl;C1[r]-=dl;} \
        _Pragma("unroll") for(int r=0;r<16;++r)negm[r]=-mhat; asm volatile("":"+v"(negm)); \
        const float f=__builtin_amdgcn_exp2f(-dl); l_reg*=f; if(hi==0)wsf[r32]=f; resc=true; } } \
    SBAR(); \
    GAPB(o[0]=__builtin_amdgcn_mfma_f32_32x32x16_bf16(PAF(0),VFR(0),o[0],0,0,0), C0,0); \
    GAPB(o[1]=__builtin_amdgcn_mfma_f32_32x32x16_bf16(PAF(0),VFR(4),o[1],0,0,0), C0,4); \
    KRD(GL,0); GAPB(o[0]=__builtin_amdgcn_mfma_f32_32x32x16_bf16(PAF(1),VFR(1),o[0],0,0,0), C0,8); \
    KRD(GL,1); GAPB(o[1]=__builtin_amdgcn_mfma_f32_32x32x16_bf16(PAF(1),VFR(5),o[1],0,0,0), C0,12); \
    KRD(GL,2); GAPB(o[0]=__builtin_amdgcn_mfma_f32_32x32x16_bf16(PAF(2),VFR(2),o[0],0,0,0), C1,0); \
    KRD(GL,3); GAPB(o[1]=__builtin_amdgcn_mfma_f32_32x32x16_bf16(PAF(2),VFR(6),o[1],0,0,0), C1,4); \
    GAPB(o[0]=__builtin_amdgcn_mfma_f32_32x32x16_bf16(PAF(3),VFR(3),o[0],0,0,0), C1,8); \
    GAPB(o[1]=__builtin_amdgcn_mfma_f32_32x32x16_bf16(PAF(3),VFR(7),o[1],0,0,0), C1,12); \
    }while(0)
  int t=1;
  #undef CMASK
  #define CMASK(P0,P1,t) do{}while(0)
  for(;t+5<NT;t+=2){
    STEP(pB0,pB1,pA0,pA1,t,true,true,true);     WAIT_BAR(2); RESC(); ROT();
    STEP(pA0,pA1,pB0,pB1,t+1,true,true,true);   WAIT_BAR(2); RESC(); ROT();
  }
  #undef CMASK
  #define CMASK(P0,P1,t) do{int jb_=(t)-(NT-4); if(jb_>=0)cmask(P0,P1,jb_,qrel,hi);}while(0)
  #define ENDW(tt) do{ if((tt)+3<NT){WAIT_BAR(2);} else if((tt)+2<NT){WAIT_BAR(1);} else {WAIT_BAR(0);} }while(0)
  for(;t+1<NT;t+=2){
    STEP(pB0,pB1,pA0,pA1,t,(t+3<NT),(t+1<NT),(t+1<NT));       ENDW(t);   RESC(); ROT();
    STEP(pA0,pA1,pB0,pB1,t+1,(t+4<NT),(t+2<NT),(t+2<NT));     ENDW(t+1); RESC(); ROT();
  }
  STEP(pB0,pB1,pA0,pA1,NT-1,false,false,false); RESC();
  { float sacc=pB0[0]+pB0[1]; _Pragma("unroll") for(int r=2;r<16;++r)sacc+=pB0[r]; _Pragma("unroll") for(int r=0;r<16;++r)sacc+=pB1[r]; l_reg+=sacc;
    pw0=(u32x4){PKW(pB0,0),PKW(pB0,2),PKW(pB0,4),PKW(pB0,6)};pw1=(u32x4){PKW(pB0,8),PKW(pB0,10),PKW(pB0,12),PKW(pB0,14)};pw2=(u32x4){PKW(pB1,0),PKW(pB1,2),PKW(pB1,4),PKW(pB1,6)};pw3=(u32x4){PKW(pB1,8),PKW(pB1,10),PKW(pB1,12),PKW(pB1,14)};
    SBAR(); pv(o,vb0+sl_cur,PAF(0),PAF(1),PAF(2),PAF(3)); }
  #undef PKW
  #undef PAF
  #undef VFR
  #undef PIN
  #undef MX3
  #undef GAPA
  #undef GAPB
  #undef EX
  #undef VRD
  #undef KRD
  #undef STEP
  #undef ENDW
  {auto rr=__builtin_amdgcn_permlane32_swap(__float_as_uint(l_reg),__float_as_uint(l_reg),false,false);l_reg=__uint_as_float(rr[0])+__uint_as_float(rr[1]);}
  if(hi==0)wsf[32+r32]=l_reg;asm volatile("s_waitcnt lgkmcnt(0)":::"memory");
  #pragma unroll
  for(int r=0;r<16;++r)rli[r]=__builtin_amdgcn_rcpf(wsf[32+crow(r,hi)]);
  asm volatile("s_waitcnt lgkmcnt(0)\n\ts_barrier":::"memory");
  #undef DMA_K
  #undef DMA_V
  #undef CMASK
  #undef START
  #undef RESC
  #undef ROT
}
constexpr int LDS_STASH=LDS_BYTES, LDS_SSQ=LDS_STASH+NW*8192, ATTN_LDS_BYTES=LDS_SSQ+NW*128;
template<int THRL> __device__ __forceinline__ void dattn_unit(int b,int h,int qb,const bf16*Q,const bf16*K,const bf16*V,bf16*O,char*shm,float lam,const float*subln,float oml){
  #pragma unroll 1
  for(int pass=0;pass<4;++pass){
    const int m=pass&1,vh=pass>>1;
    f32x16 o[2]; float rli[16];
    attn_pass<THRL>(b,2*h+m,2*h+vh,qb,Q,K,V,shm,o,rli);
    int tid_=threadIdx.x; asm volatile("":"+v"(tid_)); const int tid=tid_,lane=tid&63,r32=lane&31,hi=lane>>5; const int wid=__builtin_amdgcn_readfirstlane(tid>>6);
    float*stash=(float*)(shm+LDS_STASH)+wid*2048; float*ssq0=(float*)(shm+LDS_SSQ)+wid*32; float*wsf=(float*)(shm+LDS_WS)+wid*64;
    unsigned short*stg=(unsigned short*)(shm+LDS_OST)+wid*2048;
    const long orow0=((long)b*SEQ+(long)qb*QB+wid*QBLK)*DM+h*128;
    if(m==0){
      #pragma unroll
      for(int d0=0;d0<2;++d0)
        #pragma unroll
        for(int r=0;r<16;++r)stash[(d0*16+r)*64+lane]=o[d0][r]*rli[r];
    }else{
      float sq[16];
      #pragma unroll
      for(int r=0;r<16;++r){ const float a0=stash[r*64+lane]-lam*o[0][r]*rli[r], a1=stash[(16+r)*64+lane]-lam*o[1][r]*rli[r]; o[0][r]=a0;o[1][r]=a1;sq[r]=a0*a0+a1*a1; }
      #pragma unroll
      for(int r=0;r<16;++r){ float s=sq[r]; s+=__shfl_xor(s,1);s+=__shfl_xor(s,2);s+=__shfl_xor(s,4);s+=__shfl_xor(s,8);s+=__shfl_xor(s,16); sq[r]=s; }
      if(vh==0){
        if(r32==0){
          #pragma unroll
          for(int r=0;r<16;++r)ssq0[crow(r,hi)]=sq[r]; }
        #pragma unroll
        for(int r=0;r<16;++r){const int orow=crow(r,hi); stg[orow*64+r32]=(unsigned short)(cvtpk_s(o[0][r],0.f)&0xffffu); stg[orow*64+32+r32]=(unsigned short)(cvtpk_s(o[1][r],0.f)&0xffffu);}
      }else{
        float rsc[16];
        #pragma unroll
        for(int r=0;r<16;++r)rsc[r]=__builtin_amdgcn_rsqf((sq[r]+ssq0[crow(r,hi)])*(1.f/128.f)+1e-6f)*oml;
        if(r32==0){
          #pragma unroll
          for(int r=0;r<16;++r)wsf[32+crow(r,hi)]=rsc[r]; }
        asm volatile("s_waitcnt lgkmcnt(0)":::"memory");
        { const int ch=lane&7; const float4 g0=*(const float4*)(subln+ch*8),g1=*(const float4*)(subln+ch*8+4);
          #pragma unroll
          for(int i=0;i<4;++i){const int row=i*8+(lane>>3); const u32x4 v=*(const u32x4*)(stg+row*64+ch*8); const float rs_=wsf[32+row];
            u32x4 w;
            w.x=cvtpk_s(__uint_as_float(v.x<<16)*rs_*g0.x,__uint_as_float(v.x&0xffff0000u)*rs_*g0.y); w.y=cvtpk_s(__uint_as_float(v.y<<16)*rs_*g0.z,__uint_as_float(v.y&0xffff0000u)*rs_*g0.w);
            w.z=cvtpk_s(__uint_as_float(v.z<<16)*rs_*g1.x,__uint_as_float(v.z&0xffff0000u)*rs_*g1.y); w.w=cvtpk_s(__uint_as_float(v.w<<16)*rs_*g1.z,__uint_as_float(v.w&0xffff0000u)*rs_*g1.w);
            *(u32x4*)((unsigned short*)O+orow0+(long)row*DM+ch*8)=w; } }
        asm volatile("s_waitcnt lgkmcnt(0)":::"memory");
        { const float ga=subln[64+r32],gb=subln[96+r32];
          #pragma unroll
          for(int r=0;r<16;++r){const int orow=crow(r,hi); stg[orow*64+r32]=(unsigned short)(cvtpk_s(o[0][r]*rsc[r]*ga,0.f)&0xffffu); stg[orow*64+32+r32]=(unsigned short)(cvtpk_s(o[1][r]*rsc[r]*gb,0.f)&0xffffu);}
          asm volatile("s_waitcnt lgkmcnt(0)":::"memory");
          #pragma unroll
          for(int i=0;i<4;++i){const int row=i*8+(lane>>3),ch=lane&7; const u32x4 v=*(const u32x4*)(stg+row*64+ch*8); *(u32x4*)((unsigned short*)O+orow0+(long)row*DM+64+ch*8)=v;} }
        asm volatile("s_waitcnt lgkmcnt(0)":::"memory");
      }
    }
  }
}
#undef SBAR
#undef WAIT_BAR
}

__device__ __forceinline__ void nssm_item(int item, int lane, const bf16* U, bf16* Z, const float* lre, const float* lim, const float* lstep,
                                          const float* bre, const float* bim, const float* cre, const float* cim, const float* dsk) {
    const int g = item & 31, b = item >> 5, p = lane;
    const float dt = expf(lstep[g]);
    const float lr = lre[g * SP + p], li = lim[g * SP + p];
    const float mag = expf(lr * dt);
    float sn, cs; sincosf(li * dt, &sn, &cs);
    const float ab_re = mag * cs, ab_im = mag * sn;
    const float den = lr * lr + li * li, nr = ab_re - 1.f;
    const float coef_re = (nr * lr + ab_im * li) / den, coef_im = (ab_im * lr - nr * li) / den;
    float bbr[16], bbi[16], cr[16], ci[16], dk[16];
#pragma unroll
    for (int h = 0; h < 16; ++h) { const float br = bre[(g * SP + p) * SG + h], bi = bim[(g * SP + p) * SG + h];
        bbr[h] = coef_re * br - coef_im * bi; bbi[h] = coef_re * bi + coef_im * br;
        cr[h] = cre[(g * SG + h) * SP + p]; ci[h] = cim[(g * SG + h) * SP + p]; dk[h] = dsk[g * SG + h]; }
    float s_re = 0.f, s_im = 0.f;
    for (int t = 0; t < SEQ; ++t) {
        const size_t row = (size_t)b * SEQ + t;
        const v4u* up = (const v4u*)(U + row * 512 + g * 16);
        const v4u w0 = up[0], w1 = up[1];
        float ut[16] = {bflo(w0.x), bfhi(w0.x), bflo(w0.y), bfhi(w0.y), bflo(w0.z), bfhi(w0.z), bflo(w0.w), bfhi(w0.w),
                        bflo(w1.x), bfhi(w1.x), bflo(w1.y), bfhi(w1.y), bflo(w1.z), bfhi(w1.z), bflo(w1.w), bfhi(w1.w)};
        float bur = 0.f, bui = 0.f;
#pragma unroll
        for (int h = 0; h < 16; ++h) { bur += bbr[h] * ut[h]; bui += bbi[h] * ut[h]; }
        const float nre = ab_re * s_re - ab_im * s_im + bur, nim = ab_re * s_im + ab_im * s_re + bui;
        s_re = nre; s_im = nim;
        float mine = 0.f;
#pragma unroll
        for (int h = 0; h < 16; ++h) { const float y = wave_sum(cr[h] * s_re - ci[h] * s_im) + dk[h] * ut[h]; if (lane == h) mine = y; }
        if (lane < 16) Z[row * 512 + g * 16 + lane] = (bf16)f2bf(gelu_tanh(mine));
    }
}

__device__ __forceinline__ void router_phase(const Frame& F0, int L, const float* xio, unsigned* ctl, unsigned char* ws) {
    const Frame F = refresh(F0);
    LAS f32x4* Wg = (LAS f32x4*)F.lds; LAS f32x4* Wl = (LAS f32x4*)(F.lds + 16384); LAS f32x4* Wh = (LAS f32x4*)(F.lds + 81920);
    const float* gf = inp(F, I_FFN_G) + L * DM; const float* wrg = inp(F, I_WRG) + (size_t)L * DM * NGRP; const float* wre = inp(F, I_WRE) + (size_t)L * NGRP * DM * EPG;
    for (int k = F.tid; k < DM; k += NTHREADS) Wg[k] = *(const f32x4*)(wrg + (size_t)k * 4) * gf[k];
    for (int idx = F.tid; idx < NGRP * DM; idx += NTHREADS) { const float g = gf[idx & (DM - 1)]; const f32x4* s = (const f32x4*)(wre + (size_t)idx * 8); Wl[idx] = s[0] * g; Wh[idx] = s[1] * g; }
    __syncthreads();
    const float* brg = inp(F, I_BRG) + L * NGRP; const float* bre = inp(F, I_BRE2) + L * NGRP * EPG;
    unsigned* cnt = ctl + CW_CNT + L * 64; SlotInfo* slots = (SlotInfo*)(ws + WS_SLOT);
    const int gw = F.vcu * NWAVES + F.wave, NGW = F.G * NWAVES;
    for (int t = gw; t < T; t += NGW) {
        const float* xr = xio + (size_t)t * DM + F.lane;
        float xv[16]; float ss = 0.f;
#pragma unroll
        for (int j = 0; j < 16; ++j) { xv[j] = xr[64 * j]; ss += xv[j] * xv[j]; }
        const float rs = rsqrtf(wave_sum(ss) * (1.f / DM) + EPS);
        f32x4 ag = {0.f, 0.f, 0.f, 0.f};
#pragma unroll
        for (int j = 0; j < 16; ++j) ag += Wg[F.lane + 64 * j] * xv[j];
        float lg[4];
#pragma unroll
        for (int c = 0; c < 4; ++c) lg[c] = wave_sum(ag[c]) * rs + brg[c];
        int grp = 0; float gmax = lg[0];
#pragma unroll
        for (int c = 1; c < 4; ++c) if (lg[c] > gmax) { gmax = lg[c]; grp = c; }
        float gden = 0.f;
#pragma unroll
        for (int c = 0; c < 4; ++c) gden += __expf(lg[c] - gmax);
        const float p_grp = 1.f / gden;
        grp = __builtin_amdgcn_readfirstlane(grp);
        f32x4 al = {0.f, 0.f, 0.f, 0.f}, ah = {0.f, 0.f, 0.f, 0.f};
#pragma unroll
        for (int j = 0; j < 16; ++j) { const int idx = grp * DM + F.lane + 64 * j; al += Wl[idx] * xv[j]; ah += Wh[idx] * xv[j]; }
        float le[8];
#pragma unroll
        for (int c = 0; c < 4; ++c) { le[c] = wave_sum(al[c]) * rs + bre[grp * EPG + c]; le[4 + c] = wave_sum(ah[c]) * rs + bre[grp * EPG + 4 + c]; }
        int i0 = 0; float v0 = le[0];
#pragma unroll
        for (int c = 1; c < 8; ++c) if (le[c] > v0) { v0 = le[c]; i0 = c; }
        int i1 = -1; float v1 = -3.0e38f;
#pragma unroll
        for (int c = 0; c < 8; ++c) if (c != i0 && le[c] > v1) { v1 = le[c]; i1 = c; }
        const float e1 = __expf(v1 - v0);
        const float w0 = p_grp / (1.f + e1), w1 = p_grp * e1 / (1.f + e1);
        if (F.lane == 0) {
            const int ex0 = grp * EPG + i0, ex1 = grp * EPG + i1;
            const unsigned p0 = atomicAdd(cnt + ex0, 1u), p1 = atomicAdd(cnt + 32 + ex1, 1u);
            slots[(size_t)ex0 * T + p0] = SlotInfo{t, w0}; slots[(size_t)(32 + ex1) * T + p1] = SlotInfo{t, w1};
        }
    }
}
constexpr int LDS_TB_OFF = 143360;
__device__ __forceinline__ void moe_tables(const Frame& F0, int L, unsigned* ctl) {
    const Frame F = refresh(F0);
    LAS int* tb = (LAS int*)(F.lds + LDS_TB_OFF); LAS int* tc = tb + 80;
    if (F.tid < 64) tc[F.tid] = (int)__hip_atomic_load(ctl + CW_CNT + L * 64 + F.tid, __ATOMIC_RELAXED, __HIP_MEMORY_SCOPE_AGENT);
    __syncthreads();
    if (F.tid == 0) { int s = 0; for (int i = 0; i < 64; ++i) { tb[i] = s; s += (tc[i] + 255) >> 8; } tb[64] = s; }
    __syncthreads();
}
__device__ __forceinline__ void moe_gather_tables(const Frame& F0, const pg8::MoeSched& S, const SlotInfo* slots) {
    const Frame F = refresh(F0);
    LAS unsigned* tokoff = (LAS unsigned*)(F.lds + PG8_TOKOFF_OFF); LAS SlotInfo* ri = (LAS SlotInfo*)(F.lds + PG8_ROWINFO_OFF);
    pg8::Unit u;
    for (int i = 0; i < 4 && S.next(i, u); ++i) {
        if (F.tid < 256) { const int p = u.mt * 256 + F.tid; SlotInfo si = SlotInfo{0, 0.f};
            if (p < u.cnt) si = slots[(size_t)(u.k * 32 + u.e) * T + p];
            tokoff[i * 256 + F.tid] = (unsigned)si.token * (unsigned)(DM * 2); ri[i * 256 + F.tid].token = si.token; ri[i * 256 + F.tid].w = si.w; }
    }
    __syncthreads();
}

__global__ void __launch_bounds__(NTHREADS, 2) mega_fwd(Args args) {
    extern __shared__ __attribute__((aligned(16))) unsigned char lds_raw[];
    Frame Fk;
    Fk.lds = (LAS unsigned char*)lds_raw;
    Fk.tid = threadIdx.x; Fk.lane = Fk.tid & 63; Fk.wave = __builtin_amdgcn_readfirstlane(Fk.tid >> 6);
    Fk.G = gridDim.x; { const int bx = blockIdx.x; Fk.vcu = (Fk.G % 8 == 0) ? (bx % 8) * (Fk.G / 8) + bx / 8 : bx; }
    const Frame& F = Fk;
    volatile LAS unsigned* MISC = (volatile LAS unsigned*)(F.lds + MISC_OFF);
    if (F.tid < 64) MISC[F.tid] = 0u;
    if (F.tid < N_IN) ((LAS unsigned long long*)(F.lds + PTAB_OFF))[F.tid] = (unsigned long long)args.in[F.tid];
    __syncthreads();
    unsigned char* const ws = args.ws;
    XcdBarrier bar = xcd_barrier_post((unsigned*)(ws + WS_CTL) + CW_BAR, MISC + 8);
#define GRID_BAR() xcd_barrier(bar)
#define PHASE_WS unsigned long long wv_ = (unsigned long long)ws; asm volatile("" : "+s"(wv_)); GAS unsigned char* const w_ = (GAS unsigned char*)wv_
    constexpr size_t PARTSZ = (size_t)T * 16 * 4;
    const int NGW = F.G * NWAVES;

    { PHASE_WS; const Frame F = refresh(Fk); const int gw = F.vcu * NWAVES + F.wave;
      float* part = (float*)(w_ + WS_PART); bf16* X0 = (bf16*)(w_ + WS_X0); bf16* PB = (bf16*)(w_ + WS_PB); float* lamv = (float*)(w_ + WS_MISC);
    for (int m = gw; m < T; m += NGW) {
        const f32x4* xr = (const f32x4*)(inp(F, I_X) + (size_t)m * DM) + F.lane; float s = 0.f;
        v2u* o8 = (v2u*)(X0 + (size_t)m * DM) + F.lane;
#pragma unroll
        for (int j = 0; j < 4; ++j) { const f32x4 v = xr[64 * j]; s += v.x * v.x + v.y * v.y + v.z * v.z + v.w * v.w;
            v2u w; w.x = f2bf(v.x) | (f2bf(v.y) << 16); w.y = f2bf(v.z) | (f2bf(v.w) << 16); o8[64 * j] = w; }
        s = wave_sum(s);
        if (F.lane < 16) part[(size_t)m * 16 + F.lane] = (F.lane == 0) ? s : 0.f;
    }
    for (size_t i = (size_t)(blockIdx.x * NTHREADS + F.tid) * 4; i < (size_t)DEPTH * T * PLE; i += (size_t)F.G * NTHREADS * 4) {
        const f32x4 v = *(const f32x4*)(inp(F, I_P) + i); v2u w; w.x = f2bf(v.x) | (f2bf(v.y) << 16); w.y = f2bf(v.z) | (f2bf(v.w) << 16); *(v2u*)(PB + i) = w; }
    if (blockIdx.x == 0 && F.tid < DEPTH) {
        const float* lq = inp(F, I_LAMQK) + F.tid * 4 * HD; float s1 = 0.f, s2 = 0.f;
        for (int j = 0; j < HD; ++j) { s1 += lq[j] * lq[HD + j]; s2 += lq[2 * HD + j] * lq[3 * HD + j]; }
        lamv[F.tid] = expf(s1) - expf(s2) + lam_init_for(F.tid);
    }
    convert_weights(Fk, 0, (unsigned char*)(w_ + WS_WT));
    }
    GRID_BAR();

#define GEMM_PHASE(EPI, Aptr, WOFF, N_, K_, E_) do { pg8::Gemm g_{(const pg8::bf16_t*)(Aptr), (const pg8::bf16_t*)(unsigned char*)(w_ + WS_WT + (WOFF)), T, (N_), (K_)}; pg8::StaticOrder S_; S_.init(T, (N_), F.G, (int)blockIdx.x); \
        pg8::gemm_phase<EPI, pg8::StaticOrder, true, true>(F.lds, g_, S_, E_); } while (0)
#define P_XA ((bf16*)(unsigned char*)(w_ + ((L & 1) ? WS_X1 : WS_X0)))
#define P_XB ((bf16*)(unsigned char*)(w_ + ((L & 1) ? WS_X0 : WS_X1)))
#define P_PART ((float*)(unsigned char*)(w_ + WS_PART + (size_t)(L & 1) * PARTSZ))
#define P_PART2 ((float*)(unsigned char*)(w_ + WS_PART + (size_t)((L & 1) ^ 1) * PARTSZ))
#define P_(T_, OFF) ((T_*)(unsigned char*)(w_ + (OFF)))
#pragma unroll 1
    for (int L = 0; L < DEPTH; ++L) {
        if (L > 0) { { PHASE_WS; convert_weights(Fk, L, (unsigned char*)(w_ + WS_WT)); } GRID_BAR(); }
        { PHASE_WS; pg8::EpiWinF E{P_PART, P_(bf16, WS_Q), P_(bf16, WS_K), P_(bf16, WS_V), P_(bf16, WS_U), P_(bf16, WS_GATES), inp(F, I_QG) + L * 2 * HD, inp(F, I_KG) + L * 2 * HD, inp(F, I_BGATE) + L * 2 * DM};
          GEMM_PHASE(pg8::EpiWinF, P_XA, WT_WIN, INW, DM, E); }
        GRID_BAR();
        { PHASE_WS; const Frame F = refresh(Fk);
        if (F.wave == 0) {
            for (int it = F.vcu; it < BATCH * NG; it += F.G)
                nssm_item(it, F.lane, P_(bf16, WS_U), P_(bf16, WS_Z), inp(F, I_LRE) + L * NG * SP, inp(F, I_LIM) + L * NG * SP, inp(F, I_LSTEP) + L * NG, inp(F, I_BRE) + (size_t)L * NG * SP * SG, inp(F, I_BIM) + (size_t)L * NG * SP * SG,
                          inp(F, I_CRE) + (size_t)L * NG * SG * SP, inp(F, I_CIM) + (size_t)L * NG * SG * SP, inp(F, I_SSMD) + L * NG * SG);
        }
        __syncthreads();
        }
        { PHASE_WS; const Frame F = refresh(Fk);
          const float lam = P_(float, WS_MISC)[L]; const float oml = 1.f - lam_init_for(L); const float* subln = inp(F, I_SUBLN) + L * 2 * HD;
          static_assert(attn_body::ATTN_LDS_BYTES <= PTAB_OFF, "attention LDS");
          for (int v = F.vcu; v < BATCH * NH * 4; v += F.G) {
              const int bh = v >> 2, s = v & 3;
#pragma unroll 1
              for (int i = 0; i < 2; ++i)
                  attn_body::dattn_unit<8>(bh >> 3, bh & 7, i ? s : 7 - s, P_(const attn_body::bf16, WS_Q), P_(const attn_body::bf16, WS_K), P_(const attn_body::bf16, WS_V), P_(attn_body::bf16, WS_Q), (char*)lds_raw, lam, subln, oml);
          } }
        GRID_BAR();
        { PHASE_WS; pg8::EpiGluF E{P_(bf16, WS_Z), P_(bf16, WS_Z2), inp(F, I_BGLU) + L * SSMW}; GEMM_PHASE(pg8::EpiGluF, P_(bf16, WS_Z), WT_WGLU, SSMW, SSMW, E); }
        GRID_BAR();
        { PHASE_WS; pg8::EpiGateF E{P_(bf16, WS_GATES), DM, nullptr, P_(bf16, WS_PARTS)}; GEMM_PHASE(pg8::EpiGateF, P_(bf16, WS_Z2), WT_WSU, DM, SSMW, E); }
        GRID_BAR();
        { PHASE_WS; pg8::EpiGateF E{P_(bf16, WS_GATES), 0, P_(bf16, WS_PARTS), P_(bf16, WS_MIXED)}; GEMM_PHASE(pg8::EpiGateF, P_(bf16, WS_Q), WT_WAU, DM, VW, E); }
        GRID_BAR();
        { PHASE_WS; const float* xbase = (L == 0) ? inp(F, I_X) : args.out;
          pg8::EpiResF E{xbase, args.out, P_XB, P_PART2}; GEMM_PHASE(pg8::EpiResF, P_(bf16, WS_MIXED), WT_WOUT, DM, DM, E); }
        GRID_BAR();
        { PHASE_WS; pg8::EpiPlainF E{P_(bf16, WS_PLE), DM}; GEMM_PHASE(pg8::EpiPlainF, P_(bf16, WS_PB) + (size_t)L * T * PLE, WT_WPLE, DM, PLE, E);
          router_phase(Fk, L, args.out, P_(unsigned, WS_CTL), (unsigned char*)w_); }
        GRID_BAR();
        { PHASE_WS; moe_tables(Fk, L, P_(unsigned, WS_CTL));
          pg8::MoeSched S{(LAS const int*)(F.lds + LDS_TB_OFF), (LAS const int*)(F.lds + LDS_TB_OFF) + 80, F.G, (int)blockIdx.x, 0};
          moe_gather_tables(Fk, S, P_(const SlotInfo, WS_SLOT));
          pg8::Gemm g{(const pg8::bf16_t*)P_XB, (const pg8::bf16_t*)(unsigned char*)(w_ + WS_WT + WT_WGU), T, 512, DM};
          pg8::EpiActF E{P_PART2, P_(pg8::bf16_t, WS_ACT), F.lds};
          pg8::gemm_phase_g<pg8::EpiActF, pg8::MoeSched>(F.lds, g, S, E); }
        GRID_BAR();
        { PHASE_WS; moe_tables(Fk, L, P_(unsigned, WS_CTL));
          pg8::MoeSched S{(LAS const int*)(F.lds + LDS_TB_OFF), (LAS const int*)(F.lds + LDS_TB_OFF) + 80, F.G, (int)blockIdx.x, 1};
          pg8::Gemm g{P_(const pg8::bf16_t, WS_ACT), (const pg8::bf16_t*)(unsigned char*)(w_ + WS_WT + WT_WD), T, DM, EFF};
          pg8::EpiDownF<0> E{P_(const SlotInfo, WS_SLOT), args.out, P_XA, P_PART};
          pg8::gemm_phase<pg8::EpiDownF<0>, pg8::MoeSched, true, true>(F.lds, g, S, E); }
        GRID_BAR();
        { PHASE_WS; moe_tables(Fk, L, P_(unsigned, WS_CTL));
          pg8::MoeSched S{(LAS const int*)(F.lds + LDS_TB_OFF), (LAS const int*)(F.lds + LDS_TB_OFF) + 80, F.G, (int)blockIdx.x, 2};
          pg8::Gemm g{P_(const pg8::bf16_t, WS_ACT), (const pg8::bf16_t*)(unsigned char*)(w_ + WS_WT + WT_WD), T, DM, EFF};
          pg8::EpiDownF<1> E{P_(const SlotInfo, WS_SLOT), args.out, P_XA, P_PART};
          pg8::gemm_phase<pg8::EpiDownF<1>, pg8::MoeSched, true, true>(F.lds, g, S, E); }
        GRID_BAR();
        { PHASE_WS; pg8::EpiPleF E{P_PART, P_(bf16, WS_PLE), args.out, P_XB, P_PART2}; GEMM_PHASE(pg8::EpiPleF, P_XA, WT_WPG, DM, DM, E); }
        GRID_BAR();
    }
}

extern "C" void kernel_launch(void* const* d_in, const int* in_sizes, int n_in, void* d_out, int out_size, void* d_ws, size_t ws_size, hipStream_t stream) {
    static int grid = 0;
    if (grid == 0) {
        if (n_in != N_IN || in_sizes[0] != T * DM || out_size != T * DM || ws_size < WS_END) {
            fprintf(stderr, "kernel_launch: unexpected problem (n_in %d, in0 %d, out %d, ws %zu); nothing launched\n", n_in, n_in > 0 ? in_sizes[0] : -1, out_size, ws_size); grid = -1; return; }
        int dev = 0, cus = 0, per_cu = 0;
        if (hipGetDevice(&dev) != hipSuccess || hipDeviceGetAttribute(&cus, hipDeviceAttributeMultiprocessorCount, dev) != hipSuccess) { grid = -1; return; }
        if (hipFuncSetAttribute((const void*)mega_fwd, hipFuncAttributeMaxDynamicSharedMemorySize, LDS_BYTES) != hipSuccess) { fprintf(stderr, "kernel_launch: hipFuncSetAttribute failed\n"); grid = -1; return; }
        if (hipOccupancyMaxActiveBlocksPerMultiprocessor(&per_cu, (const void*)mega_fwd, NTHREADS, LDS_BYTES) != hipSuccess || per_cu < 1)
            fprintf(stderr, "kernel_launch: note: occupancy query reports %d workgroups per CU\n", per_cu);
        (void)hipGetLastError();
        grid = cus;
    }
    if (grid < 0) return;
    if (hipMemsetAsync((char*)d_ws + WS_CTL, 0, CTL_ZERO_BYTES, stream) != hipSuccess) { fprintf(stderr, "kernel_launch: memset failed\n"); return; }
    Args a{};
    for (int i = 0; i < N_IN; ++i) a.in[i] = (const float*)d_in[i];
    a.out = (float*)d_out; a.ws = (unsigned char*)d_ws;
    hipLaunchKernelGGL(mega_fwd, dim3(grid), dim3(NTHREADS), LDS_BYTES, stream, a);
    const hipError_t le = hipPeekAtLastError();
    if (le != hipSuccess) fprintf(stderr, "kernel_launch: launch failed: %s\n", hipGetErrorName(le));
}
```

```cpp
#include <hip/hip_runtime.h>
#include <cstdio>
#include <cstdint>
#include <cmath>
#include <hip/hip_bf16.h>

#define GAS __attribute__((address_space(1)))
#define LAS __attribute__((address_space(3)))
typedef unsigned short bf16;
typedef unsigned v4u __attribute__((ext_vector_type(4)));
typedef unsigned v2u __attribute__((ext_vector_type(2)));
typedef float f32x4 __attribute__((ext_vector_type(4)));

constexpr int DM = 1024, BATCH = 8, SEQ = 2048, T = BATCH * SEQ, DEPTH = 2;
constexpr int NH = 8, HD = 64, QKW = 1024, VW = 1024, SSMW = 512, SG = 16, NG = 32, SP = 64;
constexpr int INW = 5632, NGRP = 4, EPG = 8, NEXP = 32, EFF = 256, PLE = 256;
constexpr float EPS = 1e-6f;
constexpr float C2 = 0.125f * 1.4426950408889634f;
constexpr int NWAVES = 8, NTHREADS = 512;

enum { I_X = 0, I_P, I_ATTN_G, I_WIN, I_BGATE, I_QG, I_KG, I_LAMQK, I_SUBLN, I_WAU, I_LRE, I_LIM, I_LSTEP, I_BRE, I_BIM, I_CRE, I_CIM,
       I_SSMD, I_WGLU, I_BGLU, I_WSU, I_WOUT, I_FFN_G, I_WRG, I_BRG, I_WRE, I_BRE2, I_WEG, I_WEU, I_WED, I_PLE_G, I_WPG, I_WPLE, N_IN };

constexpr size_t MiB = 1u << 20;
constexpr size_t WS_CTL = 0, CTL_ZERO_BYTES = 1 * MiB;
constexpr size_t WS_PART = 1 * MiB;
constexpr size_t WS_MISC = 3 * MiB;
constexpr size_t WS_SLOT = 4 * MiB;
constexpr size_t WS_WT = 16 * MiB;
constexpr size_t WS_X0 = 84 * MiB, WS_X1 = 116 * MiB;
constexpr size_t WS_Q = 148 * MiB, WS_K = 180 * MiB, WS_V = 212 * MiB;
constexpr size_t WS_U = 244 * MiB, WS_Z = 260 * MiB;
constexpr size_t WS_GATES = 276 * MiB;
constexpr size_t WS_PB = 340 * MiB;
constexpr size_t WS_END = 356 * MiB;
constexpr size_t WS_Z2 = WS_K, WS_MIXED = WS_K, WS_PARTS = WS_V, WS_PLE = WS_GATES, WS_OTMP = WS_X0, WS_ACT = WS_V;
struct SlotInfo { int token; float w; };
constexpr int CW_BAR = 4096;
constexpr int CW_CNT = 8192;

__device__ __forceinline__ unsigned f2bf(float f) { unsigned u = __builtin_bit_cast(unsigned, f); return (u + 0x7fffu + ((u >> 16) & 1u)) >> 16; }
__device__ __forceinline__ float bf2f(unsigned b) { return __builtin_bit_cast(float, b << 16); }
__device__ __forceinline__ float bflo(unsigned w) { return __builtin_bit_cast(float, w << 16); }
__device__ __forceinline__ float bfhi(unsigned w) { return __builtin_bit_cast(float, w & 0xffff0000u); }
__device__ __forceinline__ float wave_sum(float v) {
#pragma unroll
    for (int o = 1; o < 64; o <<= 1) v += __shfl_xor(v, o);
    return v;
}
__device__ __forceinline__ float sigmoidf_(float x) { return 1.f / (1.f + __expf(-x)); }
__device__ __forceinline__ float gelu_tanh(float x) { const float u = 0.7978845608028654f * (x + 0.044715f * x * x * x); return 0.5f * x * (1.f + tanhf(u)); }
__device__ __forceinline__ float rowscale(const float* part, int row) {
    const f32x4* p = (const f32x4*)(part + (size_t)row * 16);
    float s = 0.f;
#pragma unroll
    for (int i = 0; i < 4; ++i) { const f32x4 v = p[i]; s += v.x; s += v.y; s += v.z; s += v.w; }
    return rsqrtf(s * (1.f / DM) + EPS);
}
__host__ __device__ inline float lam_init_for(int i) { return 0.8f - 0.6f * expf(-0.3f * (float)i); }

#define XB_TMO      128
#define XB_XCNT(j)  (256  + 64 * (j))
#define XB_XSUB(j)  (1280 + 64 * (j))
#define XB_XGEN(j)  (2304 + 64 * (j))
#define XB_TOP      3328
#define XB_TOPGEN   3392
#define XCD_BAR_WORDS 3456
#define XB_SPIN_CAP (1u << 22)
__device__ __forceinline__ unsigned xb_ld(unsigned* p)              { return __hip_atomic_load(p, __ATOMIC_RELAXED, __HIP_MEMORY_SCOPE_AGENT); }
__device__ __forceinline__ unsigned xb_add(unsigned* p, unsigned v) { return __hip_atomic_fetch_add(p, v, __ATOMIC_RELAXED, __HIP_MEMORY_SCOPE_AGENT); }
__device__ __forceinline__ unsigned xb_xcc_id() { return (unsigned)__builtin_amdgcn_s_getreg((3 << 11) | 20) & 0xFu; }
#define XB_SPIN(cond, bar) do { unsigned _sp = 0; while (cond) { __builtin_amdgcn_s_sleep(1); \
    if ((++_sp & 255u) == 0u) { if (xb_ld(&(bar)[XB_TMO])) break; if (_sp > XB_SPIN_CAP) { atomicAdd(&(bar)[XB_TMO], 1u); break; } } } } while (0)
struct XcdBarrier { unsigned* bar; unsigned x; volatile LAS unsigned* st; };
__device__ __forceinline__ XcdBarrier xcd_barrier_post(unsigned* bar, volatile LAS unsigned* st) {
    XcdBarrier b; b.bar = bar; b.x = 0; b.st = st;
    if (threadIdx.x == 0) { const unsigned x = xb_xcc_id(); st[2] = x; (void)xb_add(&bar[XB_XCNT(x)], 1u); }
    return b;
}
__device__ __forceinline__ void xcd_barrier_complete(unsigned* bar, unsigned x, unsigned& nloc, unsigned& nx) {
    const unsigned G = gridDim.x * gridDim.y * gridDim.z;
    unsigned sum, cnt, mine, sp = 0u;
    for (;;) {
        sum = 0u; cnt = 0u; mine = 0u;
#pragma unroll
        for (unsigned j = 0; j < 16; ++j) { const unsigned c = xb_ld(&bar[XB_XCNT(j)]); sum += c; cnt += (c > 0u) ? 1u : 0u; mine = (j == x) ? c : mine; }
        if (sum == G) break;
        __builtin_amdgcn_s_sleep(1);
        if ((++sp & 255u) == 0u) { if (xb_ld(&bar[XB_TMO])) break; if (sp > XB_SPIN_CAP) { atomicAdd(&bar[XB_TMO], 1u); break; } }
    }
    nloc = mine > 0u ? mine : 1u; nx = cnt > 0u ? cnt : 1u;
}
__device__ __forceinline__ void xcd_barrier(const XcdBarrier& b) {
    asm volatile("s_waitcnt vmcnt(0)" ::: "memory");
    __syncthreads();
    if (threadIdx.x == 0) {
        unsigned* bar = b.bar;
        __builtin_amdgcn_s_waitcnt(0);
        unsigned nloc = b.st[0], nx = b.st[1]; const unsigned bx = b.st[2];
        if (nloc == 0u) { xcd_barrier_complete(bar, bx, nloc, nx); b.st[0] = nloc; b.st[1] = nx; }
        const unsigned old = xb_add(&bar[XB_XSUB(bx)], 1u);
        const unsigned gen = old / nloc;
        if (old + 1u == (gen + 1u) * nloc) {
            __builtin_amdgcn_fence(__ATOMIC_RELEASE, "agent");
            asm volatile("s_waitcnt vmcnt(0)" ::: "memory");
            const unsigned og = xb_add(&bar[XB_TOP], 1u);
            const unsigned tg = og / nx;
            if (og + 1u == (tg + 1u) * nx) xb_add(&bar[XB_TOPGEN], 1u);
            else XB_SPIN(xb_ld(&bar[XB_TOPGEN]) == tg, bar);
            __builtin_amdgcn_fence(__ATOMIC_ACQUIRE, "agent");
            xb_add(&bar[XB_XGEN(bx)], 1u);
            asm volatile("s_waitcnt vmcnt(0)" ::: "memory");
        } else {
            XB_SPIN(xb_ld(&bar[XB_XGEN(bx)]) == gen, bar);
            __builtin_amdgcn_fence(__ATOMIC_ACQUIRE, "agent");
            asm volatile("s_waitcnt vmcnt(0)" ::: "memory");
        }
    }
    __syncthreads();
}

constexpr int LDS_BYTES = 160 * 1024 - 1024;
constexpr int MISC_OFF = LDS_BYTES - 256;
constexpr int PTAB_OFF = LDS_BYTES - 1024;

struct Args { const float* in[N_IN]; float* out; unsigned char* ws; };

struct Frame {
    LAS unsigned char* lds;
    int tid, lane, wave, vcu, G;
};
__device__ __forceinline__ Frame refresh(const Frame& F0) {
    Frame F = F0; int t = F0.tid; asm volatile("" : "+v"(t)); F.tid = t; F.lane = t & 63; F.wave = __builtin_amdgcn_readfirstlane(t >> 6); return F;
}
__device__ __forceinline__ const float* inp(const Frame& F, int i) {
    const LAS unsigned* p = (const LAS unsigned*)(F.lds + PTAB_OFF) + 2 * i;
    const unsigned lo = __builtin_amdgcn_readfirstlane(p[0]), hi = __builtin_amdgcn_readfirstlane(p[1]);
    return (const float*)(const GAS float*)(((unsigned long long)hi << 32) | lo);
}

namespace pg8 {
#define PG8_LAS __attribute__((address_space(3)))
typedef unsigned short bf16_t;
typedef short bf16x8 __attribute__((ext_vector_type(8)));
typedef float f32x4 __attribute__((ext_vector_type(4)));
typedef unsigned u32x4 __attribute__((ext_vector_type(4)));
constexpr int BM = 256, BK = 64, HALF = 128, HTB = HALF * BK * 2  , STAGE_BYTES = 8 * HTB, NXCD = 8, WGM = 8;

__host__ __device__ __forceinline__ int lds_byte(int r, int c) { const int st = (r >> 4) * 2 + (c >> 5), rr = r & 15, cc = c & 31, ob = rr * 64 + cc * 2; return st * 1024 + (ob ^ (((ob >> 9) & 1) << 5)); }
__host__ __device__ __forceinline__ void stage_rc(int b, int& R, int& C) { const int st = b / 1024, sb = b % 1024, swz = sb ^ (((sb >> 9) & 1) << 5); R = (st >> 1) * 16 + swz / 64; C = (st & 1) * 32 + (swz % 64) / 2; }
__host__ __device__ __forceinline__ int perm32(int rho) { const int n = rho >> 4, i = rho & 15; return 8 * (i >> 2) + 4 * n + (i & 3); }

struct Unit { int pm, pn, e, mt, cnt, pl, k, slot; };
struct Gemm { const bf16_t* A; const bf16_t* Bt; int M, N, K; };

struct StaticOrder {
    int nM, nN, nwg, G, c;
    __host__ __device__ void init(int M, int N, int G_, int c_) { nM = M / BM; nN = N / BM; nwg = nM * nN; G = G_; c = c_; }
    __host__ __device__ bool next(int i, Unit& u) const {
        const long L = (long)i * G + c; if (L >= nwg) return false;
        int wgid = (int)L; { const int q = nwg / NXCD, r = nwg % NXCD, xcd = wgid % NXCD, off = wgid / NXCD; wgid = (xcd < r ? xcd * (q + 1) : r * (q + 1) + (xcd - r) * q) + off; }
        const int nig = WGM * nN, gid = wgid / nig, fm = gid * WGM, gsz = (nM - fm) < WGM ? (nM - fm) : WGM;
        u.pm = fm + ((wgid % nig) % gsz); u.pn = (wgid % nig) / gsz; return true;
    }
    __device__ __forceinline__ void a_ready(const Unit&) const {}
    __device__ __forceinline__ void done(const Unit&) const {}
};
typedef float f32x2_t __attribute__((ext_vector_type(2))); typedef __bf16 bf16x2_t __attribute__((ext_vector_type(2)));
__device__ __forceinline__ unsigned cvt_pk_bf16(float lo, float hi) { f32x2_t v = {lo, hi}; bf16x2_t b = __builtin_convertvector(v, bf16x2_t); return __builtin_bit_cast(unsigned, b); }

__device__ __forceinline__ float rowscale16(const float* part, int row) {
    const f32x4* p = (const f32x4*)(part + (size_t)row * 16); float s = 0.f;
#pragma unroll
    for (int i = 0; i < 4; ++i) { const f32x4 v = p[i]; s += v[0]; s += v[1]; s += v[2]; s += v[3]; }
    return rsqrtf(s * (1.f / 1024.f) + EPS);
}
__device__ __forceinline__ u32x4 pack8(f32x4 a, f32x4 b) { u32x4 w; w.x = cvt_pk_bf16(a[0], a[1]); w.y = cvt_pk_bf16(a[2], a[3]); w.z = cvt_pk_bf16(b[0], b[1]); w.w = cvt_pk_bf16(b[2], b[3]); return w; }
__device__ __forceinline__ void unpack8(u32x4 w, f32x4& a, f32x4& b) {
    a = (f32x4){__builtin_bit_cast(float, w.x << 16), __builtin_bit_cast(float, w.x & 0xffff0000u), __builtin_bit_cast(float, w.y << 16), __builtin_bit_cast(float, w.y & 0xffff0000u)};
    b = (f32x4){__builtin_bit_cast(float, w.z << 16), __builtin_bit_cast(float, w.z & 0xffff0000u), __builtin_bit_cast(float, w.w << 16), __builtin_bit_cast(float, w.w & 0xffff0000u)};
}
__device__ __forceinline__ float sig1(float x) { return __builtin_amdgcn_rcpf(1.f + __builtin_amdgcn_exp2f(-1.4426950408889634f * x)); }
__device__ __forceinline__ f32x4 sig4(f32x4 x) { return (f32x4){sig1(x[0]), sig1(x[1]), sig1(x[2]), sig1(x[3])}; }
__device__ __forceinline__ float dot4(f32x4 x) { return (x[0] * x[0] + x[1] * x[1]) + (x[2] * x[2] + x[3] * x[3]); }

struct EpiWinF {
    static constexpr bool PERM = false, AFTER_DRAIN = false;
    const float* part; bf16_t *q, *k, *v, *u, *gates; const float *qg, *kg, *bgate;
    __device__ __forceinline__ void operator()(const f32x4 (&acc)[2][2][4][2], const Unit& un, int wr, int wc, int, int) const {
        int l_ = threadIdx.x; asm volatile("" : "+v"(l_)); const int fr = l_ & 15, fq = (l_ >> 4) & 3;
        const int pn = un.pn, row0 = un.pm * BM + wr * 64 + fr;
        if (pn < 8) {
            const bool isq = pn < 4; bf16_t* dst = isq ? q : k; const int cb = (pn & 3) * 256 + wc * 64 + fq * 8;
            const float* gn = (isq ? qg : kg) + (wc & 1) * 64 + fq * 8; const float sc = isq ? C2 : 1.f;
            f32x4 gv[2][2];
#pragma unroll
            for (int bj = 0; bj < 2; ++bj)
#pragma unroll
                for (int n = 0; n < 2; ++n) gv[bj][n] = *(const f32x4*)(gn + bj * 32 + n * 4) * sc;
#pragma unroll
            for (int ai = 0; ai < 2; ++ai)
#pragma unroll
                for (int m = 0; m < 4; ++m) {
                    const int row = row0 + ai * HALF + m * 16; const float rs = rowscale16(part, row);
                    float ss = (dot4(acc[ai][0][m][0]) + dot4(acc[ai][0][m][1])) + (dot4(acc[ai][1][m][0]) + dot4(acc[ai][1][m][1]));
                    ss += __shfl_xor(ss, 16); ss += __shfl_xor(ss, 32);
                    const float inv = rsqrtf(ss * rs * rs * (1.f / 64.f) + EPS) * rs;
                    bf16_t* rowp = dst + (size_t)row * 1024 + cb;
#pragma unroll
                    for (int bj = 0; bj < 2; ++bj) *(u32x4*)(rowp + bj * 32) = pack8(acc[ai][bj][m][0] * inv * gv[bj][0], acc[ai][bj][m][1] * inv * gv[bj][1]);
                }
        } else if (pn < 14) {
            bf16_t* dst; int ld, cb;
            if (pn < 12) { dst = v; ld = 1024; cb = (pn - 8) * 256; } else { dst = u; ld = 512; cb = (pn - 12) * 256; }
            cb += wc * 64 + fq * 8;
#pragma unroll
            for (int ai = 0; ai < 2; ++ai)
#pragma unroll
                for (int m = 0; m < 4; ++m) {
                    const int row = row0 + ai * HALF + m * 16; const float rs = rowscale16(part, row);
                    bf16_t* rowp = dst + (size_t)row * ld + cb;
#pragma unroll
                    for (int bj = 0; bj < 2; ++bj) *(u32x4*)(rowp + bj * 32) = pack8(acc[ai][bj][m][0] * rs, acc[ai][bj][m][1] * rs);
                }
        } else {
            const int cb = (pn - 14) * 256 + wc * 64 + fq * 8;
            f32x4 bv[2][2];
#pragma unroll
            for (int bj = 0; bj < 2; ++bj)
#pragma unroll
                for (int n = 0; n < 2; ++n) bv[bj][n] = *(const f32x4*)(bgate + cb + bj * 32 + n * 4);
#pragma unroll
            for (int ai = 0; ai < 2; ++ai)
#pragma unroll
                for (int m = 0; m < 4; ++m) {
                    const int row = row0 + ai * HALF + m * 16; const float rs = rowscale16(part, row);
                    bf16_t* rowp = gates + (size_t)row * 2048 + cb;
#pragma unroll
                    for (int bj = 0; bj < 2; ++bj) *(u32x4*)(rowp + bj * 32) = pack8(sig4(acc[ai][bj][m][0] * rs + bv[bj][0]), sig4(acc[ai][bj][m][1] * rs + bv[bj][1]));
                }
        }
    }
};
struct EpiGluF {
    static constexpr bool PERM = false, AFTER_DRAIN = false;
    const bf16_t* z; bf16_t* z2; const float* b;
    __device__ __forceinline__ void operator()(const f32x4 (&acc)[2][2][4][2], const Unit& un, int wr, int wc, int, int) const {
        int l_ = threadIdx.x; asm volatile("" : "+v"(l_)); const int fr = l_ & 15, fq = (l_ >> 4) & 3;
        const int row0 = un.pm * BM + wr * 64 + fr, cb = un.pn * 256 + wc * 64 + fq * 8;
        f32x4 bv[2][2];
#pragma unroll
        for (int bj = 0; bj < 2; ++bj)
#pragma unroll
            for (int n = 0; n < 2; ++n) bv[bj][n] = *(const f32x4*)(b + cb + bj * 32 + n * 4);
#pragma unroll
        for (int ai = 0; ai < 2; ++ai)
#pragma unroll
            for (int m = 0; m < 4; ++m) {
                const int row = row0 + ai * HALF + m * 16;
#pragma unroll
                for (int bj = 0; bj < 2; ++bj) { const size_t o = (size_t)row * 512 + cb + bj * 32; f32x4 z0, z1; unpack8(*(const u32x4*)(z + o), z0, z1);
                    *(u32x4*)(z2 + o) = pack8(z0 * sig4(acc[ai][bj][m][0] + bv[bj][0]), z1 * sig4(acc[ai][bj][m][1] + bv[bj][1])); }
            }
    }
};
struct EpiPlainF {
    static constexpr bool PERM = false, AFTER_DRAIN = false;
    bf16_t* o; int ld;
    __device__ __forceinline__ void operator()(const f32x4 (&acc)[2][2][4][2], const Unit& un, int wr, int wc, int, int) const {
        int l_ = threadIdx.x; asm volatile("" : "+v"(l_)); const int fr = l_ & 15, fq = (l_ >> 4) & 3;
        const int row0 = un.pm * BM + wr * 64 + fr, cb = un.pn * 256 + wc * 64 + fq * 8;
#pragma unroll
        for (int ai = 0; ai < 2; ++ai)
#pragma unroll
            for (int m = 0; m < 4; ++m) {
                const int row = row0 + ai * HALF + m * 16;
#pragma unroll
                for (int bj = 0; bj < 2; ++bj) *(u32x4*)(o + (size_t)row * ld + cb + bj * 32) = pack8(acc[ai][bj][m][0], acc[ai][bj][m][1]);
            }
    }
};
struct EpiGateF {
    static constexpr bool PERM = false, AFTER_DRAIN = false;
    const bf16_t* gates; int goff; const bf16_t* add; bf16_t* o;
    __device__ __forceinline__ void operator()(const f32x4 (&acc)[2][2][4][2], const Unit& un, int wr, int wc, int, int) const {
        int l_ = threadIdx.x; asm volatile("" : "+v"(l_)); const int fr = l_ & 15, fq = (l_ >> 4) & 3;
        const int row0 = un.pm * BM + wr * 64 + fr, cb = un.pn * 256 + wc * 64 + fq * 8;
#pragma unroll
        for (int ai = 0; ai < 2; ++ai)
#pragma unroll
            for (int m = 0; m < 4; ++m) {
                const int row = row0 + ai * HALF + m * 16;
#pragma unroll
                for (int bj = 0; bj < 2; ++bj) { const int c = cb + bj * 32; f32x4 g0, g1; unpack8(*(const u32x4*)(gates + (size_t)row * 2048 + goff + c), g0, g1);
                    f32x4 v0 = g0 * acc[ai][bj][m][0], v1 = g1 * acc[ai][bj][m][1];
                    if (add) { f32x4 a0, a1; unpack8(*(const u32x4*)(add + (size_t)row * 1024 + c), a0, a1); v0 += a0; v1 += a1; }
                    *(u32x4*)(o + (size_t)row * 1024 + c) = pack8(v0, v1); }
            }
    }
};
struct EpiResF {
    static constexpr bool PERM = false, AFTER_DRAIN = false;
    const float* base; float* out; bf16_t* xb; float* part;
    __device__ __forceinline__ void operator()(const f32x4 (&acc)[2][2][4][2], const Unit& un, int wr, int wc, int, int) const {
        int l_ = threadIdx.x; asm volatile("" : "+v"(l_)); const int fr = l_ & 15, fq = (l_ >> 4) & 3;
        const int row0 = un.pm * BM + wr * 64 + fr, cb = un.pn * 256 + wc * 64 + fq * 8;
#pragma unroll
        for (int ai = 0; ai < 2; ++ai)
#pragma unroll
            for (int m = 0; m < 4; ++m) {
                const int row = row0 + ai * HALF + m * 16; float ss = 0.f;
#pragma unroll
                for (int bj = 0; bj < 2; ++bj) { const size_t o = (size_t)row * 1024 + cb + bj * 32;
                    const f32x4 v0 = *(const f32x4*)(base + o) + acc[ai][bj][m][0], v1 = *(const f32x4*)(base + o + 4) + acc[ai][bj][m][1];
                    *(f32x4*)(out + o) = v0; *(f32x4*)(out + o + 4) = v1; *(u32x4*)(xb + o) = pack8(v0, v1); ss += dot4(v0) + dot4(v1); }
                ss += __shfl_xor(ss, 16); ss += __shfl_xor(ss, 32);
                if (fq == 0) part[(size_t)row * 16 + un.pn * 4 + wc] = ss;
            }
    }
};
struct EpiPleF {
    static constexpr bool PERM = false, AFTER_DRAIN = false;
    const float* part_in; const bf16_t* ple; float* out; bf16_t* xb; float* part_out;
    __device__ __forceinline__ void operator()(const f32x4 (&acc)[2][2][4][2], const Unit& un, int wr, int wc, int, int) const {
        int l_ = threadIdx.x; asm volatile("" : "+v"(l_)); const int fr = l_ & 15, fq = (l_ >> 4) & 3;
        const int row0 = un.pm * BM + wr * 64 + fr, cb = un.pn * 256 + wc * 64 + fq * 8;
#pragma unroll
        for (int ai = 0; ai < 2; ++ai)
#pragma unroll
            for (int m = 0; m < 4; ++m) {
                const int row = row0 + ai * HALF + m * 16; const float rs = rowscale16(part_in, row); float ss = 0.f;
#pragma unroll
                for (int bj = 0; bj < 2; ++bj) { const size_t o = (size_t)row * 1024 + cb + bj * 32; f32x4 p0, p1; unpack8(*(const u32x4*)(ple + o), p0, p1);
                    const f32x4 v0 = *(const f32x4*)(out + o) + sig4(acc[ai][bj][m][0] * rs) * p0, v1 = *(const f32x4*)(out + o + 4) + sig4(acc[ai][bj][m][1] * rs) * p1;
                    *(f32x4*)(out + o) = v0; *(f32x4*)(out + o + 4) = v1; *(u32x4*)(xb + o) = pack8(v0, v1); ss += dot4(v0) + dot4(v1); }
                ss += __shfl_xor(ss, 16); ss += __shfl_xor(ss, 32);
                if (fq == 0) part_out[(size_t)row * 16 + un.pn * 4 + wc] = ss;
            }
    }
};
template <class Epi, class Sched, bool ALIGN_EPI = false, bool SP2 = false>
__device__ __forceinline__ void gemm_phase(PG8_LAS unsigned char* lds, const Gemm g, const Sched& S, const Epi& E) {
    int tid_ = threadIdx.x; asm volatile("" : "+v"(tid_)); const int tid = tid_, wid = __builtin_amdgcn_readfirstlane(tid >> 6), lane = tid & 63, wr = wid >> 2, wc = wid & 3, fr = lane & 15, fq = lane >> 4;
    const int K = g.K, nt = K / BK;
    unsigned voffA[2], voffB[2];
#pragma unroll
    for (int i = 0; i < 2; ++i) { int R, C; stage_rc(tid * 16 + i * 8192, R, C); const int Rb = Epi::PERM ? ((R & ~31) + perm32(R & 31)) : R;
        voffA[i] = (unsigned)(R * K + C) * 2u; voffB[i] = (unsigned)(Rb * K + C) * 2u; }
    const size_t kstep = (size_t)(BK * 2);
    const size_t hstep = (size_t)HALF * K * 2;
    const size_t tstep = 2 * hstep;
    const unsigned ldsw = (unsigned)wid * 1024u;
    const int aoff = lds_byte(wr * 64 + fr, fq * 8), boff = lds_byte(wc * 32 + fr, fq * 8);
#define PG8_SA(b, h) (((b) * 2 + (h)) * HTB)
#define PG8_SB(b, h) ((4 + (b) * 2 + (h)) * HTB)
#define PG8_STAGE(bufoff, gbase, voff) do { _Pragma("unroll") for (int _i = 0; _i < 2; ++_i) \
        __builtin_amdgcn_global_load_lds((const unsigned*)((const char*)(gbase) + (voff)[_i]), (PG8_LAS unsigned*)(lds + (bufoff) + ldsw + _i * 8192), 16, 0, 0); } while (0)
#define PG8_LDA(dst, b, h) do { _Pragma("unroll") for (int m = 0; m < 4; ++m) _Pragma("unroll") for (int k = 0; k < 2; ++k) dst[m][k] = *(const PG8_LAS bf16x8*)(lds + PG8_SA(b, h) + aoff + m * 2048 + k * 1024); } while (0)
#define PG8_LDB(dst, b, h) do { _Pragma("unroll") for (int n = 0; n < 2; ++n) _Pragma("unroll") for (int k = 0; k < 2; ++k) dst[n][k] = *(const PG8_LAS bf16x8*)(lds + PG8_SB(b, h) + boff + n * 2048 + k * 1024); } while (0)
#define PG8_MMA(ai, bj, At, Bt) do { __builtin_amdgcn_s_setprio(1); _Pragma("unroll") for (int m = 0; m < 4; ++m) _Pragma("unroll") for (int n = 0; n < 2; ++n) _Pragma("unroll") for (int k = 0; k < 2; ++k) \
        acc[ai][bj][m][n] = __builtin_amdgcn_mfma_f32_16x16x32_bf16(Bt[n][k], At[m][k], acc[ai][bj][m][n], 0, 0, 0); __builtin_amdgcn_s_setprio(0); } while (0)
#define PG8_WAIT_V(n) asm volatile("s_waitcnt vmcnt(" #n ")" ::: "memory")
#define PG8_WAIT_L(n) asm volatile("s_waitcnt lgkmcnt(" #n ")" ::: "memory")
#define PG8_BAR __builtin_amdgcn_s_barrier()
#define PG8_SCHED __builtin_amdgcn_sched_barrier(0)
    Unit cur, nxt; int ui = 0;
    if (!S.next(0, cur)) return;
    f32x4 acc[2][2][4][2];
#pragma unroll
    for (int a = 0; a < 2; ++a)
#pragma unroll
        for (int b = 0; b < 2; ++b)
#pragma unroll
            for (int m = 0; m < 4; ++m)
#pragma unroll
                for (int n = 0; n < 2; ++n) acc[a][b][m][n] = (f32x4){0.f, 0.f, 0.f, 0.f};
    bf16x8 At[4][2], B0[2][2], B1[2][2];
    const char* cA = (const char*)g.A + (size_t)cur.pm * tstep; const char* cB = (const char*)g.Bt + (size_t)cur.pn * tstep;
    S.a_ready(cur);
    if constexpr (SP2) {
        PG8_STAGE(PG8_SB(0, 0), cB, voffB); PG8_STAGE(PG8_SB(0, 1), cB + hstep, voffB); PG8_STAGE(PG8_SA(0, 0), cA, voffA); PG8_STAGE(PG8_SA(0, 1), cA + hstep, voffA);
        if (wr == 1) PG8_BAR;
        PG8_WAIT_V(2); PG8_BAR;
        PG8_STAGE(PG8_SB(1, 0), cB + kstep, voffB); PG8_STAGE(PG8_SA(1, 0), cA + kstep, voffA); PG8_STAGE(PG8_SB(1, 1), cB + hstep + kstep, voffB);
        PG8_WAIT_V(6); PG8_BAR;
    } else {
        PG8_STAGE(PG8_SB(0, 0), cB, voffB); PG8_STAGE(PG8_SA(0, 0), cA, voffA); PG8_STAGE(PG8_SB(0, 1), cB + hstep, voffB); PG8_STAGE(PG8_SA(0, 1), cA + hstep, voffA);
        if (wr == 1) PG8_BAR;
        PG8_WAIT_V(4); PG8_BAR;
        PG8_STAGE(PG8_SB(1, 0), cB + kstep, voffB); PG8_STAGE(PG8_SA(1, 0), cA + kstep, voffA); PG8_STAGE(PG8_SB(1, 1), cB + hstep + kstep, voffB);
        PG8_WAIT_V(6); PG8_BAR;
    }
    for (;;) {
        const bool has_next = S.next(ui + 1, nxt);
        const char* nA = has_next ? (const char*)g.A + (size_t)nxt.pm * tstep : cA; const char* nB = has_next ? (const char*)g.Bt + (size_t)nxt.pn * tstep : cB;
#pragma unroll 1
        for (int t = 0; t < nt; t += 2) {
            const bool last = (t == nt - 2);
            const char* a1 = cA + (size_t)(t + 1) * kstep;
            const char* a2 = last ? nA : cA + (size_t)(t + 2) * kstep; const char* b2 = last ? nB : cB + (size_t)(t + 2) * kstep;
            const char* a3 = a2 + kstep; const char* b3 = b2 + kstep;
            if (last && has_next) S.a_ready(nxt);
            if constexpr (SP2) {
            PG8_LDB(B0, 0, 0); PG8_LDB(B1, 0, 1); PG8_SCHED; PG8_LDA(At, 0, 0); PG8_STAGE(PG8_SA(1, 1), a1 + hstep, voffA);
            PG8_WAIT_V(8); PG8_WAIT_L(0); PG8_BAR; PG8_MMA(0, 0, At, B0); PG8_MMA(0, 1, At, B1); PG8_BAR; PG8_SCHED;
            PG8_LDA(At, 0, 1); PG8_STAGE(PG8_SB(0, 0), b2, voffB); PG8_STAGE(PG8_SB(0, 1), b2 + hstep, voffB); PG8_STAGE(PG8_SA(0, 0), a2, voffA);
            PG8_WAIT_V(8); PG8_WAIT_L(0); PG8_BAR; PG8_MMA(1, 0, At, B0); PG8_MMA(1, 1, At, B1); PG8_BAR; PG8_SCHED;
            PG8_LDB(B0, 1, 0); PG8_LDB(B1, 1, 1); PG8_SCHED; PG8_LDA(At, 1, 0); PG8_STAGE(PG8_SA(0, 1), a2 + hstep, voffA);
            PG8_WAIT_V(8); PG8_WAIT_L(0); PG8_BAR; PG8_MMA(0, 0, At, B0); PG8_MMA(0, 1, At, B1); PG8_BAR; PG8_SCHED;
            PG8_LDA(At, 1, 1); PG8_STAGE(PG8_SB(1, 0), b3, voffB); PG8_STAGE(PG8_SB(1, 1), b3 + hstep, voffB); PG8_STAGE(PG8_SA(1, 0), a3, voffA);
            PG8_WAIT_V(8); PG8_WAIT_L(0); PG8_BAR; PG8_MMA(1, 0, At, B0); PG8_MMA(1, 1, At, B1); PG8_BAR; PG8_SCHED;
            } else {
            PG8_LDB(B0, 0, 0); PG8_SCHED; PG8_LDA(At, 0, 0); PG8_STAGE(PG8_SA(1, 1), a1 + hstep, voffA);
            PG8_WAIT_L(8); PG8_BAR; PG8_WAIT_L(0); PG8_MMA(0, 0, At, B0); PG8_BAR; PG8_SCHED;
            PG8_LDB(B1, 0, 1); PG8_STAGE(PG8_SB(0, 0), b2, voffB);
            PG8_BAR; PG8_WAIT_L(0); PG8_MMA(0, 1, At, B1); PG8_BAR;
            PG8_LDA(At, 0, 1); PG8_STAGE(PG8_SA(0, 0), a2, voffA);
            PG8_BAR; PG8_WAIT_L(0); PG8_MMA(1, 0, At, B0); PG8_BAR; PG8_SCHED;
            PG8_STAGE(PG8_SB(0, 1), b2 + hstep, voffB);
            PG8_WAIT_V(6); PG8_BAR; PG8_MMA(1, 1, At, B1); PG8_BAR;
            PG8_LDB(B0, 1, 0); PG8_SCHED; PG8_LDA(At, 1, 0); PG8_STAGE(PG8_SA(0, 1), a2 + hstep, voffA);
            PG8_WAIT_L(8); PG8_BAR; PG8_WAIT_L(0); PG8_MMA(0, 0, At, B0); PG8_BAR; PG8_SCHED;
            PG8_LDB(B1, 1, 1); PG8_STAGE(PG8_SB(1, 0), b3, voffB);
            PG8_BAR; PG8_WAIT_L(0); PG8_MMA(0, 1, At, B1); PG8_BAR;
            PG8_LDA(At, 1, 1); PG8_STAGE(PG8_SA(1, 0), a3, voffA);
            PG8_BAR; PG8_WAIT_L(0); PG8_MMA(1, 0, At, B0); PG8_BAR; PG8_SCHED;
            PG8_STAGE(PG8_SB(1, 1), b3 + hstep, voffB);
            PG8_WAIT_V(6); PG8_BAR; PG8_MMA(1, 1, At, B1); PG8_BAR;
            }
        }
        if constexpr (ALIGN_EPI) { if (wr == 0) PG8_BAR; }
        if constexpr (!Epi::AFTER_DRAIN) { E(acc, cur, wr, wc, fr, fq); S.done(cur); }
        if (!has_next) break;
#pragma unroll
        for (int a = 0; a < 2; ++a)
#pragma unroll
            for (int b = 0; b < 2; ++b)
#pragma unroll
                for (int m = 0; m < 4; ++m)
#pragma unroll
                    for (int n = 0; n < 2; ++n) acc[a][b][m][n] = (f32x4){0.f, 0.f, 0.f, 0.f};
        cur = nxt; cA = nA; cB = nB; ++ui;
        if constexpr (ALIGN_EPI) { if (wr == 1) PG8_BAR; }
    }
    PG8_WAIT_V(0);
    if constexpr (!ALIGN_EPI) { if (wr == 0) PG8_BAR; }
    PG8_BAR;
    if constexpr (Epi::AFTER_DRAIN) { E.fused(acc, cur, wr, wc, fr, fq, lds, wid, lane); S.done(cur); }
#undef PG8_SA
#undef PG8_SB
#undef PG8_STAGE
#undef PG8_LDA
#undef PG8_LDB
#undef PG8_MMA
#undef PG8_WAIT_V
#undef PG8_WAIT_L
#undef PG8_BAR
#undef PG8_SCHED
}

#define PG8_TOKOFF_OFF 131072
#define PG8_ROWINFO_OFF 135168
struct EpiActF {
    static constexpr bool PERM = false, AFTER_DRAIN = false;
    const float* part; bf16_t* act; PG8_LAS const unsigned char* lds;
    __device__ __forceinline__ void operator()(const f32x4 (&acc)[2][2][4][2], const Unit& un, int wr, int wc, int, int) const {
        int l_ = threadIdx.x; asm volatile("" : "+v"(l_)); const int fr = l_ & 15, fq = (l_ >> 4) & 3;
        PG8_LAS const SlotInfo* ri = (PG8_LAS const SlotInfo*)(lds + PG8_ROWINFO_OFF) + un.slot * 256;
#pragma unroll
        for (int ai = 0; ai < 2; ++ai)
#pragma unroll
            for (int m = 0; m < 4; ++m) {
                const int r = ai * HALF + wr * 64 + m * 16 + fr; const int tok_ = ri[r].token; const float w = ri[r].w; const float rs = rowscale16(part, tok_);
                f32x4 a[2];
#pragma unroll
                for (int n = 0; n < 2; ++n) { const f32x4 g = acc[ai][0][m][n] * rs, u = acc[ai][1][m][n] * rs; a[n] = g * sig4(g) * u * w; }
                *(u32x4*)(act + ((size_t)un.pm * 256 + r) * 256 + un.pl * 128 + wc * 32 + fq * 8) = pack8(a[0], a[1]);
            }
    }
};
template <int KK> struct EpiDownF {
    static constexpr bool PERM = false, AFTER_DRAIN = false;
    const SlotInfo* slots; float* out; bf16_t* xb; float* part;
    __device__ __forceinline__ void operator()(const f32x4 (&acc)[2][2][4][2], const Unit& un, int wr, int wc, int, int) const {
        int l_ = threadIdx.x; asm volatile("" : "+v"(l_)); const int fr = l_ & 15, fq = (l_ >> 4) & 3;
        const int cb = un.pl * 256 + wc * 64 + fq * 8;
        const SlotInfo* sl = slots + (size_t)(KK * 32 + un.e) * 16384 + un.mt * 256;
#pragma unroll
        for (int ai = 0; ai < 2; ++ai)
#pragma unroll
            for (int m = 0; m < 4; ++m) {
                const int r = ai * HALF + wr * 64 + m * 16 + fr; const bool valid = (un.mt * 256 + r) < un.cnt;
                const int token = valid ? sl[r].token : 0; float ss = 0.f;
#pragma unroll
                for (int bj = 0; bj < 2; ++bj) { const size_t o = (size_t)token * 1024 + cb + bj * 32;
                    const f32x4 v0 = *(const f32x4*)(out + o) + acc[ai][bj][m][0], v1 = *(const f32x4*)(out + o + 4) + acc[ai][bj][m][1];
                    if (valid) { *(f32x4*)(out + o) = v0; *(f32x4*)(out + o + 4) = v1; if (KK) *(u32x4*)(xb + o) = pack8(v0, v1); }
                    ss += dot4(v0) + dot4(v1); }
                if (KK) { ss += __shfl_xor(ss, 16); ss += __shfl_xor(ss, 32); if (valid && fq == 0) part[(size_t)token * 16 + un.pl * 4 + wc] = ss; }
            }
    }
};
__device__ __forceinline__ int ldsu(PG8_LAS const int* p) { return __builtin_amdgcn_readfirstlane(*p); }
struct MoeSched {
    PG8_LAS const int* tb; PG8_LAS const int* tc; int G, c, mode;
    __device__ __forceinline__ bool next(int i, Unit& u) const {
        const int gi = i * G + c; int ti, pl;
        if (mode == 0) { ti = gi >> 1; pl = gi & 1; if (ti >= ldsu(tb + 64)) return false; }
        else { ti = gi >> 2; pl = gi & 3; const int n0 = ldsu(tb + 32); if (mode == 2) { ti += n0; if (ti >= ldsu(tb + 64)) return false; } else if (ti >= n0) return false; }
        int ke = 0;
        for (int j = 1; j < 64; ++j) if (ldsu(tb + j) <= ti) ke = j;
        u.pm = ti; u.e = ke & 31; u.k = ke >> 5; u.mt = ti - ldsu(tb + ke); u.cnt = ldsu(tc + ke); u.pl = pl; u.slot = i; u.pn = (ke & 31) * (mode == 0 ? 2 : 4) + pl;
        return true;
    }
    __device__ __forceinline__ void a_ready(const Unit&) const {}
    __device__ __forceinline__ void done(const Unit&) const {}
};
template <class Epi, class Sched>
__device__ __forceinline__ void gemm_phase_g(PG8_LAS unsigned char* lds, const Gemm g, const Sched& S, const Epi& E) {
    int tid_ = threadIdx.x; asm volatile("" : "+v"(tid_)); const int tid = tid_, wid = __builtin_amdgcn_readfirstlane(tid >> 6), lane = tid & 63, wr = wid >> 2, wc = wid & 3, fr = lane & 15, fq = lane >> 4;
    const int K = g.K, nt = K / BK;
    unsigned voffB[2]; int RA[2]; unsigned CA2[2];
#pragma unroll
    for (int i = 0; i < 2; ++i) { int R, C; stage_rc(tid * 16 + i * 8192, R, C); voffB[i] = (unsigned)(R * K + C) * 2u; RA[i] = R; CA2[i] = (unsigned)C * 2u; }
    const size_t kstep = (size_t)(BK * 2), hstep = (size_t)HALF * K * 2, tstep = 2 * hstep;
    const unsigned ldsw = (unsigned)wid * 1024u;
    const int aoff = lds_byte(wr * 64 + fr, fq * 8), boff = lds_byte(wc * 32 + fr, fq * 8);
    PG8_LAS const unsigned* tokoff = (PG8_LAS const unsigned*)(lds + PG8_TOKOFF_OFF);
#define PG8_SA(b, h) (((b) * 2 + (h)) * HTB)
#define PG8_SB(b, h) ((4 + (b) * 2 + (h)) * HTB)
#define PG8_STAGE(bufoff, gbase, voff) do { _Pragma("unroll") for (int _i = 0; _i < 2; ++_i) \
        __builtin_amdgcn_global_load_lds((const unsigned*)((const char*)(gbase) + (voff)[_i]), (PG8_LAS unsigned*)(lds + (bufoff) + ldsw + _i * 8192), 16, 0, 0); } while (0)
#define PG8_STAGE_A(bufoff, gbase, o0, o1) do { \
        __builtin_amdgcn_global_load_lds((const unsigned*)((const char*)(gbase) + (o0)), (PG8_LAS unsigned*)(lds + (bufoff) + ldsw), 16, 0, 0); \
        __builtin_amdgcn_global_load_lds((const unsigned*)((const char*)(gbase) + (o1)), (PG8_LAS unsigned*)(lds + (bufoff) + ldsw + 8192), 16, 0, 0); } while (0)
#define PG8_GOFF(slot, d00, d01, d10, d11) do { PG8_LAS const unsigned* t_ = tokoff + (slot) * 256; \
        d00 = t_[RA[0]] + CA2[0]; d01 = t_[RA[1]] + CA2[1]; d10 = t_[128 + RA[0]] + CA2[0]; d11 = t_[128 + RA[1]] + CA2[1]; } while (0)
#define PG8_LDA(dst, b, h) do { _Pragma("unroll") for (int m = 0; m < 4; ++m) _Pragma("unroll") for (int k = 0; k < 2; ++k) dst[m][k] = *(const PG8_LAS bf16x8*)(lds + PG8_SA(b, h) + aoff + m * 2048 + k * 1024); } while (0)
#define PG8_LDB(dst, b, h) do { _Pragma("unroll") for (int n = 0; n < 2; ++n) _Pragma("unroll") for (int k = 0; k < 2; ++k) dst[n][k] = *(const PG8_LAS bf16x8*)(lds + PG8_SB(b, h) + boff + n * 2048 + k * 1024); } while (0)
#define PG8_MMA(ai, bj, At, Bt) do { __builtin_amdgcn_s_setprio(1); _Pragma("unroll") for (int m = 0; m < 4; ++m) _Pragma("unroll") for (int n = 0; n < 2; ++n) _Pragma("unroll") for (int k = 0; k < 2; ++k) \
        acc[ai][bj][m][n] = __builtin_amdgcn_mfma_f32_16x16x32_bf16(Bt[n][k], At[m][k], acc[ai][bj][m][n], 0, 0, 0); __builtin_amdgcn_s_setprio(0); } while (0)
#define PG8_WAIT_V(n) asm volatile("s_waitcnt vmcnt(" #n ")" ::: "memory")
#define PG8_WAIT_L(n) asm volatile("s_waitcnt lgkmcnt(" #n ")" ::: "memory")
#define PG8_BAR __builtin_amdgcn_s_barrier()
#define PG8_SCHED __builtin_amdgcn_sched_barrier(0)
    Unit cur, nxt; int ui = 0;
    if (!S.next(0, cur)) return;
    f32x4 acc[2][2][4][2];
#pragma unroll
    for (int a = 0; a < 2; ++a)
#pragma unroll
        for (int b = 0; b < 2; ++b)
#pragma unroll
            for (int m = 0; m < 4; ++m)
#pragma unroll
                for (int n = 0; n < 2; ++n) acc[a][b][m][n] = (f32x4){0.f, 0.f, 0.f, 0.f};
    bf16x8 At[4][2], B0[2][2], B1[2][2];
    unsigned gc00, gc01, gc10, gc11;
    PG8_GOFF(0, gc00, gc01, gc10, gc11);
    const char* A0 = (const char*)g.A; const char* cB = (const char*)g.Bt + (size_t)cur.pn * tstep;
    PG8_STAGE(PG8_SB(0, 0), cB, voffB); PG8_STAGE(PG8_SB(0, 1), cB + hstep, voffB); PG8_STAGE_A(PG8_SA(0, 0), A0, gc00, gc01); PG8_STAGE_A(PG8_SA(0, 1), A0, gc10, gc11);
    if (wr == 1) PG8_BAR;
    PG8_WAIT_V(2); PG8_BAR;
    PG8_STAGE(PG8_SB(1, 0), cB + kstep, voffB); PG8_STAGE_A(PG8_SA(1, 0), A0 + kstep, gc00, gc01); PG8_STAGE(PG8_SB(1, 1), cB + hstep + kstep, voffB);
    PG8_WAIT_V(6); PG8_BAR;
    for (;;) {
        const bool has_next = S.next(ui + 1, nxt);
        const char* nB = has_next ? (const char*)g.Bt + (size_t)nxt.pn * tstep : cB;
#pragma unroll 1
        for (int t = 0; t < nt; t += 2) {
            const bool last = (t == nt - 2);
            const char* a1 = A0 + (size_t)(t + 1) * kstep;
            const char* a2 = last ? A0 : A0 + (size_t)(t + 2) * kstep; const char* b2 = last ? nB : cB + (size_t)(t + 2) * kstep;
            const char* a3 = a2 + kstep; const char* b3 = b2 + kstep;
            unsigned g200 = gc00, g201 = gc01, g210 = gc10, g211 = gc11;
            if (last && has_next) { PG8_GOFF(ui + 1, g200, g201, g210, g211); }
            PG8_LDB(B0, 0, 0); PG8_LDB(B1, 0, 1); PG8_SCHED; PG8_LDA(At, 0, 0); PG8_STAGE_A(PG8_SA(1, 1), a1, gc10, gc11);
            PG8_WAIT_V(8); PG8_WAIT_L(0); PG8_BAR; PG8_MMA(0, 0, At, B0); PG8_MMA(0, 1, At, B1); PG8_BAR; PG8_SCHED;
            PG8_LDA(At, 0, 1); PG8_STAGE(PG8_SB(0, 0), b2, voffB); PG8_STAGE(PG8_SB(0, 1), b2 + hstep, voffB); PG8_STAGE_A(PG8_SA(0, 0), a2, g200, g201);
            PG8_WAIT_V(8); PG8_WAIT_L(0); PG8_BAR; PG8_MMA(1, 0, At, B0); PG8_MMA(1, 1, At, B1); PG8_BAR; PG8_SCHED;
            PG8_LDB(B0, 1, 0); PG8_LDB(B1, 1, 1); PG8_SCHED; PG8_LDA(At, 1, 0); PG8_STAGE_A(PG8_SA(0, 1), a2, g210, g211);
            PG8_WAIT_V(8); PG8_WAIT_L(0); PG8_BAR; PG8_MMA(0, 0, At, B0); PG8_MMA(0, 1, At, B1); PG8_BAR; PG8_SCHED;
            PG8_LDA(At, 1, 1); PG8_STAGE(PG8_SB(1, 0), b3, voffB); PG8_STAGE(PG8_SB(1, 1), b3 + hstep, voffB); PG8_STAGE_A(PG8_SA(1, 0), a3, g200, g201);
            PG8_WAIT_V(8); PG8_WAIT_L(0); PG8_BAR; PG8_MMA(1, 0, At, B0); PG8_MMA(1, 1, At, B1); PG8_BAR; PG8_SCHED;
        }
        if (wr == 0) PG8_BAR;
        E(acc, cur, wr, wc, fr, fq);
        if (!has_next) break;
#pragma unroll
        for (int a = 0; a < 2; ++a)
#pragma unroll
            for (int b = 0; b < 2; ++b)
#pragma unroll
                for (int m = 0; m < 4; ++m)
#pragma unroll
                    for (int n = 0; n < 2; ++n) acc[a][b][m][n] = (f32x4){0.f, 0.f, 0.f, 0.f};
        cur = nxt; cB = nB; ++ui; PG8_GOFF(ui, gc00, gc01, gc10, gc11);
        if (wr == 1) PG8_BAR;
    }
    PG8_WAIT_V(0);
    PG8_BAR;
#undef PG8_SA
#undef PG8_SB
#undef PG8_STAGE
#undef PG8_STAGE_A
#undef PG8_GOFF
#undef PG8_LDA
#undef PG8_LDB
#undef PG8_MMA
#undef PG8_WAIT_V
#undef PG8_WAIT_L
#undef PG8_BAR
#undef PG8_SCHED
}

}

__device__ __forceinline__ int p64_row(int c) { const int cl = c & 255; return (c & ~255) + 128 * ((cl >> 5) & 1) + 32 * (cl >> 6) + 16 * ((cl >> 2) & 1) + 4 * ((cl >> 3) & 3) + (cl & 3); }
__device__ __forceinline__ unsigned pk2(float lo, float hi) { return f2bf(lo) | (f2bf(hi) << 16); }
__device__ __forceinline__ int gu_row(int ff, int isup) { const int fl = ff & 127; return 256 * (ff >> 7) + 128 * isup + 32 * (fl >> 5) + 16 * ((fl >> 2) & 1) + 4 * ((fl >> 3) & 3) + (fl & 3); }
template <int MODE>
__device__ __forceinline__ void transpose_item(const float* W, int K, int N, bf16* WT, const float* gain, LAS float* scr, int item, int lane) {
    const int nblk = N / 32, kb = item / nblk, nb = item % nblk, k0 = 64 * kb, n0 = 32 * nb;
#pragma unroll 8
    for (int i = 0; i < 32; ++i) { const int kk = 2 * i + (lane >> 5); float w = W[(size_t)(k0 + kk) * N + n0 + (lane & 31)]; if (gain) w *= gain[k0 + kk]; scr[kk * 33 + (lane & 31)] = w; }
    asm volatile("s_waitcnt lgkmcnt(0)" ::: "memory");
    const int c = lane & 7;
#pragma unroll
    for (int j = 0; j < 4; ++j) { const int n = (lane >> 3) + 8 * j; const LAS float* s = scr + (8 * c) * 33 + n;
        v4u o; o.x = pk2(s[0 * 33], s[1 * 33]); o.y = pk2(s[2 * 33], s[3 * 33]); o.z = pk2(s[4 * 33], s[5 * 33]); o.w = pk2(s[6 * 33], s[7 * 33]);
        const int drow = MODE == 0 ? p64_row(n0 + n) : gu_row(n0 + n, MODE == 2);
        *(v4u*)(WT + (size_t)drow * K + k0 + 8 * c) = o; }
    asm volatile("s_waitcnt lgkmcnt(0)" ::: "memory");
}
constexpr size_t WT_WIN = 0, WT_WAU = 12 * MiB, WT_WOUT = 14 * MiB, WT_WPG = 16 * MiB, WT_WGLU = 18 * MiB, WT_WSU = 18 * MiB + 512 * 1024, WT_WPLE = 19 * MiB + 512 * 1024, WT_WGU = 20 * MiB, WT_WD = 52 * MiB;
__device__ __forceinline__ void convert_weights(const Frame& F0, int L, unsigned char* wt) {
    const Frame F = refresh(F0);
    LAS float* scr = (LAS float*)(F.lds + F.wave * 16384);
    const int gw = F.vcu * NWAVES + F.wave, NGW = F.G * NWAVES;
    constexpr int I_IN = (DM / 64) * (INW / 32), I_SQ = (DM / 64) * (DM / 32), I_GLU = (SSMW / 64) * (SSMW / 32), I_SU = (SSMW / 64) * (DM / 32), I_PL = (PLE / 64) * (DM / 32);
    constexpr int I_EX = NEXP * 128;
    constexpr int NIT = I_IN + 3 * I_SQ + I_GLU + I_SU + I_PL + 3 * I_EX;
    for (int it = gw; it < NIT; it += NGW) {
        int r = it;
        if (r < I_IN) { transpose_item<0>(inp(F, I_WIN) + (size_t)L * DM * INW, DM, INW, (bf16*)(wt + WT_WIN), inp(F, I_ATTN_G) + L * DM, scr, r, F.lane); continue; } r -= I_IN;
        if (r < I_SQ) { transpose_item<0>(inp(F, I_WAU) + (size_t)L * DM * DM, DM, DM, (bf16*)(wt + WT_WAU), nullptr, scr, r, F.lane); continue; } r -= I_SQ;
        if (r < I_SQ) { transpose_item<0>(inp(F, I_WOUT) + (size_t)L * DM * DM, DM, DM, (bf16*)(wt + WT_WOUT), nullptr, scr, r, F.lane); continue; } r -= I_SQ;
        if (r < I_SQ) { transpose_item<0>(inp(F, I_WPG) + (size_t)L * DM * DM, DM, DM, (bf16*)(wt + WT_WPG), inp(F, I_PLE_G) + L * DM, scr, r, F.lane); continue; } r -= I_SQ;
        if (r < I_GLU) { transpose_item<0>(inp(F, I_WGLU) + (size_t)L * SSMW * SSMW, SSMW, SSMW, (bf16*)(wt + WT_WGLU), nullptr, scr, r, F.lane); continue; } r -= I_GLU;
        if (r < I_SU) { transpose_item<0>(inp(F, I_WSU) + (size_t)L * SSMW * DM, SSMW, DM, (bf16*)(wt + WT_WSU), nullptr, scr, r, F.lane); continue; } r -= I_SU;
        if (r < I_PL) { transpose_item<0>(inp(F, I_WPLE) + (size_t)L * PLE * DM, PLE, DM, (bf16*)(wt + WT_WPLE), nullptr, scr, r, F.lane); continue; } r -= I_PL;
        if (r < I_EX) { const int e = r >> 7; transpose_item<1>(inp(F, I_WEG) + ((size_t)L * NEXP + e) * DM * EFF, DM, EFF, (bf16*)(wt + WT_WGU) + (size_t)e * 512 * DM, inp(F, I_FFN_G) + L * DM, scr, r & 127, F.lane); continue; } r -= I_EX;
        if (r < I_EX) { const int e = r >> 7; transpose_item<2>(inp(F, I_WEU) + ((size_t)L * NEXP + e) * DM * EFF, DM, EFF, (bf16*)(wt + WT_WGU) + (size_t)e * 512 * DM, inp(F, I_FFN_G) + L * DM, scr, r & 127, F.lane); continue; } r -= I_EX;
        { const int e = r >> 7; transpose_item<0>(inp(F, I_WED) + ((size_t)L * NEXP + e) * EFF * DM, EFF, DM, (bf16*)(wt + WT_WD) + (size_t)e * DM * EFF, nullptr, scr, r & 127, F.lane); }
    }
}
#include <hip/hip_bf16.h>
namespace attn_body {
using bf16=__hip_bfloat16;
using bf16x8=__attribute__((ext_vector_type(8)))short;
using s16x4=__attribute__((ext_vector_type(4)))short;
using f32x16=__attribute__((ext_vector_type(16)))float;
using u32x4=__attribute__((ext_vector_type(4)))unsigned;
constexpr int BATCH=8,NHEAD=16,SEQ=2048,D=64,DM=NHEAD*D;
constexpr int NW=8,QBLK=32,QB=QBLK*NW,KVBLK=64,NQB=SEQ/QB;
constexpr int ATTN_PITCH=DM, ATTN_UNIT_ROWS=QB;
__device__ __forceinline__ int crow(int r,int hi){return (r&3)+8*(r>>2)+4*hi;}
#define SBAR() __builtin_amdgcn_sched_barrier(0)
__device__ __forceinline__ void cmask(f32x16&p0,f32x16&p1,int jb,int qrel,int hi){
  const float NEG=-INFINITY; int kb=64*jb+4*hi;
  #pragma unroll
  for(int r=0;r<16;++r){int kv=kb+(r&3)+8*(r>>2); if(kv>qrel)p0[r]=NEG; if(kv+32>qrel)p1[r]=NEG;}
}

constexpr int NSLOT=3, SLOTB=8192;
constexpr int LDS_K=0, LDS_V=NSLOT*SLOTB, LDS_WS=2*NSLOT*SLOTB, LDS_OST=LDS_WS+NW*64*4, LDS_BYTES=LDS_OST+NW*4096;
constexpr float C2=0.125f*1.4426950408889634f;
__device__ __forceinline__ void glds16(const void*gsrc,unsigned lds_dst){unsigned keep;
  asm volatile("s_mov_b32 %0, m0\n\ts_mov_b32 m0, %2\n\ts_nop 0\n\tglobal_load_lds_dwordx4 %1, off\n\ts_mov_b32 m0, %0":"=&s"(keep):"v"(gsrc),"s"(lds_dst):"memory");}
__device__ __forceinline__ float max3f(float a,float b,float c){float r;asm("v_max3_f32 %0, %1, %2, %3":"=v"(r):"v"(a),"v"(b),"v"(c));return r;}
__device__ __forceinline__ float max2f(float a,float b){float r;asm("v_max_f32_e32 %0, %1, %2":"=v"(r):"v"(a),"v"(b));return r;}
__device__ __forceinline__ float fadd_s(float a,float b){float r;asm("v_add_f32_e32 %0, %1, %2":"=v"(r):"v"(a),"v"(b));return r;}
__device__ __forceinline__ float fsub_s(float a,float b){float r;asm("v_sub_f32_e32 %0, %1, %2":"=v"(r):"v"(a),"v"(b));return r;}
typedef float f32x2_t __attribute__((ext_vector_type(2))); typedef __bf16 bf16x2_t __attribute__((ext_vector_type(2)));
__device__ __forceinline__ unsigned cvtpk_s(float lo,float hi){f32x2_t v={lo,hi};bf16x2_t b=__builtin_convertvector(v,bf16x2_t);return __builtin_bit_cast(unsigned,b);}
#define WAIT_BAR(N) asm volatile("s_waitcnt vmcnt(" #N ") lgkmcnt(0)\n\ts_barrier":::"memory")

__device__ __forceinline__ void qkt(f32x16&p0,f32x16&p1,const char*Kslot,const bf16x8*qr,const f32x16&negm,int r32,int hi){
  const char*kb=Kslot+hi*1024+r32*16;
  #pragma unroll
  for(int d0=0;d0<4;++d0){
    const bf16x8 b0=*reinterpret_cast<const bf16x8*>(kb+d0*2048);
    const bf16x8 b1=*reinterpret_cast<const bf16x8*>(kb+d0*2048+512);
    if(d0==0){p0=__builtin_amdgcn_mfma_f32_32x32x16_bf16(b0,qr[0],negm,0,0,0);p1=__builtin_amdgcn_mfma_f32_32x32x16_bf16(b1,qr[0],negm,0,0,0);}
    else{p0=__builtin_amdgcn_mfma_f32_32x32x16_bf16(b0,qr[d0],p0,0,0,0);p1=__builtin_amdgcn_mfma_f32_32x32x16_bf16(b1,qr[d0],p1,0,0,0);}}
}
typedef __attribute__((address_space(3))) const char* lds_cptr;
typedef short v4i16_t __attribute__((ext_vector_type(4)));
__device__ __forceinline__ void kload8(bf16x8*kf,lds_cptr kp){
  kf[0]=*(const __attribute__((address_space(3))) bf16x8*)(kp);      kf[1]=*(const __attribute__((address_space(3))) bf16x8*)(kp+512);
  kf[2]=*(const __attribute__((address_space(3))) bf16x8*)(kp+2048); kf[3]=*(const __attribute__((address_space(3))) bf16x8*)(kp+2560);
  kf[4]=*(const __attribute__((address_space(3))) bf16x8*)(kp+4096); kf[5]=*(const __attribute__((address_space(3))) bf16x8*)(kp+4608);
  kf[6]=*(const __attribute__((address_space(3))) bf16x8*)(kp+6144); kf[7]=*(const __attribute__((address_space(3))) bf16x8*)(kp+6656);
}
__device__ __forceinline__ void kload2(bf16x8*kf,lds_cptr kp,int j){ kf[2*j]=*(const __attribute__((address_space(3))) bf16x8*)(kp+j*2048); kf[2*j+1]=*(const __attribute__((address_space(3))) bf16x8*)(kp+j*2048+512); }
__device__ __forceinline__ s16x4 vtr(lds_cptr p){ return __builtin_bit_cast(s16x4,__builtin_amdgcn_ds_read_tr16_b64_v4i16((__attribute__((address_space(3))) v4i16_t*)p)); }
__device__ __forceinline__ float rowmax(const f32x16&p0,const f32x16&p1){
  float a=max3f(p0[0],p0[1],p1[0]),b=max3f(p0[2],p0[3],p1[1]);a=max3f(a,p1[2],p1[3]);
  #pragma unroll
  for(int r=4;r<16;r+=4){a=max3f(a,p0[r],p0[r+1]);b=max3f(b,p0[r+2],p0[r+3]);a=max3f(a,p1[r],p1[r+1]);b=max3f(b,p1[r+2],p1[r+3]);}
  const float m=max2f(a,b);
  auto rr=__builtin_amdgcn_permlane32_swap(__float_as_uint(m),__float_as_uint(m),false,false);
  return max2f(__uint_as_float(rr[0]),__uint_as_float(rr[1]));
}
__device__ __forceinline__ void pv(f32x16*o,int vb,bf16x8 pa0,bf16x8 pa1,bf16x8 pa2,bf16x8 pa3){
  #pragma unroll
  for(int d0=0;d0<2;++d0){s16x4 lo[4],hi[4];
    #pragma unroll
    for(int ks=0;ks<4;++ks){
      asm volatile("ds_read_b64_tr_b16 %0,%1 offset:%c2":"=&v"(lo[ks]):"v"(vb),"i"(d0*4096+ks*1024):"memory");
      asm volatile("ds_read_b64_tr_b16 %0,%1 offset:%c2":"=&v"(hi[ks]):"v"(vb),"i"(d0*4096+ks*1024+512):"memory");}
    asm volatile("s_waitcnt lgkmcnt(0)":::"memory");SBAR();
    #define PK(k) (bf16x8){lo[k][0],lo[k][1],lo[k][2],lo[k][3],hi[k][0],hi[k][1],hi[k][2],hi[k][3]}
    o[d0]=__builtin_amdgcn_mfma_f32_32x32x16_bf16(pa0,PK(0),o[d0],0,0,0);
    o[d0]=__builtin_amdgcn_mfma_f32_32x32x16_bf16(pa1,PK(1),o[d0],0,0,0);
    o[d0]=__builtin_amdgcn_mfma_f32_32x32x16_bf16(pa2,PK(2),o[d0],0,0,0);
    o[d0]=__builtin_amdgcn_mfma_f32_32x32x16_bf16(pa3,PK(3),o[d0],0,0,0);
    #undef PK
  }
}

#ifndef ATTN_STORE16
#define ATTN_STORE16(p,v) (*(u32x4*)(p)=(v))
#endif
template<int THRL> __device__ __forceinline__ void attn_pass(int b,int hq,int hv,int qb,const bf16*Q,const bf16*K,const bf16*V,char*shm,f32x16 (&o)[2],float (&rli)[16]){
  int tid_=threadIdx.x; asm volatile("":"+v"(tid_)); const int tid=tid_,lane=tid&63,r32=lane&31,hi=lane>>5; const int wid=__builtin_amdgcn_readfirstlane(tid>>6);
  const long rowbase=(long)b*SEQ; const int q0=qb*QB;
  const bf16*Qw=Q+(rowbase+q0+wid*QBLK)*DM+hq*D;
  const bf16*Kh=K+rowbase*DM+hq*D,*Vh=V+rowbase*DM+hv*D;
  const unsigned lds0=(unsigned)(uintptr_t)shm;
  float*wsf=(float*)(shm+LDS_WS)+wid*64;
  const bf16*ksrc=Kh+(long)lane*DM+wid*8;
  const bf16*vsrc=Vh+(long)(16*(wid&3)+(lane>>2))*DM+(wid>>2)*32+(lane&3)*8;
  const unsigned kdst=lds0+LDS_K+wid*1024, vdst=lds0+LDS_V+wid*1024;
  #define DMA_K(t,slot) glds16(ksrc+(long)(t)*KVBLK*DM,(unsigned)__builtin_amdgcn_readfirstlane(kdst+(slot)))
  #define DMA_V(t,slot) glds16(vsrc+(long)(t)*KVBLK*DM,(unsigned)__builtin_amdgcn_readfirstlane(vdst+(slot)))
  const int vb0=(int)(lds0+LDS_V)+((lane>>4)&1)*32+(lane&3)*8+(4*hi+((lane&15)>>2))*64;
  const char*Kbase=shm+LDS_K; bf16x8 kf[8];
  const lds_cptr shm3=(lds_cptr)shm; const lds_cptr kp0=shm3+LDS_K+hi*1024+r32*16; const lds_cptr vp0=shm3+LDS_V+((lane>>4)&1)*32+(lane&3)*8+(4*hi+((lane&15)>>2))*64;
  const int NT=(q0+QB)/KVBLK;
  DMA_K(0,0);DMA_V(0,0);DMA_K(1,SLOTB);
  bf16x8 qr[4];
  #pragma unroll
  for(int d0=0;d0<4;++d0)qr[d0]=*reinterpret_cast<const bf16x8*>(&Qw[(long)r32*DM+d0*16+hi*8]);
  float mhat=0.f,l_reg=0.f;o[0]=f32x16{};o[1]=f32x16{};f32x16 negm=f32x16{};asm volatile("":"+v"(negm));
  const int qrel=wid*QBLK+r32;
  #define CMASK(P0,P1,t) do{int jb_=(t)-(NT-4); if(jb_>=0)cmask(P0,P1,jb_,qrel,hi);}while(0)
  bool resc=false;
  #define START(P0,P1) do{ const float rm=rowmax(P0,P1); resc=false; \
    { const float dl=rm; mhat=fadd_s(mhat,dl); \
      _Pragma("unroll") for(int r=0;r<16;++r){P0[r]=fsub_s(P0[r],dl);P1[r]=fsub_s(P1[r],dl);} \
      _Pragma("unroll") for(int r=0;r<16;++r)negm[r]=-mhat; asm volatile("":"+v"(negm)); } \
    _Pragma("unroll") for(int r=0;r<16;++r)P0[r]=__builtin_amdgcn_exp2f(P0[r]); }while(0)
  #define RESC() do{ if(resc){ asm volatile("s_waitcnt lgkmcnt(0)":::"memory"); \
      _Pragma("unroll") for(int d_=0;d_<2;++d_) _Pragma("unroll") for(int r=0;r<16;++r)o[d_][r]*=wsf[crow(r,hi)]; } }while(0)
  f32x16 pA0,pA1,pB0,pB1;
  int sl_prev=0,sl_cur=0,sl_next=SLOTB;
  #define ROT() do{sl_prev=sl_cur;sl_cur=sl_next;sl_next=(sl_next==(NSLOT-1)*SLOTB)?0:sl_next+SLOTB;}while(0)
  DMA_K(2,2*SLOTB);
  WAIT_BAR(3);
  qkt(pA0,pA1,Kbase,qr,negm,r32,hi);asm volatile("s_nop 15\n\ts_nop 7":"+v"(pA0),"+v"(pA1));CMASK(pA0,pA1,0);
  START(pA0,pA1);
  _Pragma("unroll") for(int r=0;r<16;++r)pA1[r]=__builtin_amdgcn_exp2f(pA1[r]);
  WAIT_BAR(0);
  DMA_K(3,0);DMA_V(1,SLOTB);
  ROT();
  kload8(kf,kp0+sl_cur);
  WAIT_BAR(2);
  s16x4 vlo[8],vhi[8]; u32x4 pw0,pw1,pw2,pw3;
  #define PKW(P,B) cvtpk_s(P[B],P[B+1])
  #define PAF(k) __builtin_bit_cast(bf16x8,pw##k)
  #define VFR(i) (bf16x8){vlo[i][0],vlo[i][1],vlo[i][2],vlo[i][3],vhi[i][0],vhi[i][1],vhi[i][2],vhi[i][3]}
  #define PIN(x) asm volatile("":"+v"(x))
  #define MX3(a,b,c) __builtin_fmaxf(__builtin_fmaxf((a),(b)),(c))
  #define GAPA(MF,A0,A1,A2,A3,W0,W1,PW) do{ MF; sacc+=A0; sacc+=A1; sacc+=A2; sacc+=A3; PIN(sacc); W0; W1; PIN(PW); SBAR(); }while(0)
  #define EX(v) __builtin_amdgcn_exp2f(v)
  #define GAPB(MF,X,B) do{ MF; X[B]=EX(X[B]); X[B+1]=EX(X[B+1]); X[B+2]=EX(X[B+2]); X[B+3]=EX(X[B+3]); PIN(X); SBAR(); }while(0)
  #define VRD(i) do{ vlo[i]=vtr(vp_+(((i)>>2)*4096+((i)&3)*1024)); vhi[i]=vtr(vp_+(((i)>>2)*4096+((i)&3)*1024+512)); }while(0)
  #define KRD(G,j) do{ if(G){ kload2(kf,kp0+sl_next,j); SBAR(); } }while(0)
  #define STEP(C0,C1,P0,P1,t,GK,GV,GL) do{ SBAR(); \
    const lds_cptr vp_=vp0+sl_prev; \
    VRD(0); SBAR(); float sacc=(P0[0]+P0[1]); \
    GAPA(C0=__builtin_amdgcn_mfma_f32_32x32x16_bf16(kf[0],qr[0],negm,0,0,0), P0[2],P0[3],P0[4],P0[5],     pw0[0]=PKW(P0,0), pw0[1]=PKW(P0,2), pw0); \
    VRD(4); SBAR(); GAPA(C1=__builtin_amdgcn_mfma_f32_32x32x16_bf16(kf[1],qr[0],negm,0,0,0), P0[6],P0[7],P0[8],P0[9],     pw0[2]=PKW(P0,4), pw0[3]=PKW(P0,6), pw0); \
    VRD(1); SBAR(); GAPA(C0=__builtin_amdgcn_mfma_f32_32x32x16_bf16(kf[2],qr[1],C0,0,0,0),   P0[10],P0[11],P0[12],P0[13], pw1[0]=PKW(P0,8), pw1[1]=PKW(P0,10), pw1); \
    VRD(5); SBAR(); GAPA(C1=__builtin_amdgcn_mfma_f32_32x32x16_bf16(kf[3],qr[1],C1,0,0,0),   P0[14],P0[15],P1[0],P1[1],   pw1[2]=PKW(P0,12),pw1[3]=PKW(P0,14), pw1); \
    VRD(2); SBAR(); GAPA(C0=__builtin_amdgcn_mfma_f32_32x32x16_bf16(kf[4],qr[2],C0,0,0,0),   P1[2],P1[3],P1[4],P1[5],     pw2[0]=PKW(P1,0), pw2[1]=PKW(P1,2), pw2); \
    VRD(6); SBAR(); GAPA(C1=__builtin_amdgcn_mfma_f32_32x32x16_bf16(kf[5],qr[2],C1,0,0,0),   P1[6],P1[7],P1[8],P1[9],     pw2[2]=PKW(P1,4), pw2[3]=PKW(P1,6), pw2); \
    VRD(3); SBAR(); GAPA(C0=__builtin_amdgcn_mfma_f32_32x32x16_bf16(kf[6],qr[3],C0,0,0,0),   P1[10],P1[11],P1[12],P1[13], pw3[0]=PKW(P1,8), pw3[1]=PKW(P1,10), pw3); \
    VRD(7); SBAR(); GAPA(C1=__builtin_amdgcn_mfma_f32_32x32x16_bf16(kf[7],qr[3],C1,0,0,0),   P1[14],P1[15],0.f,0.f,       pw3[2]=PKW(P1,12),pw3[3]=PKW(P1,14), pw3); \
    l_reg+=sacc; \
    if(GK){DMA_K((t)+3,sl_cur);} if(GV){DMA_V((t)+1,sl_next);} \
    CMASK(C0,C1,t); \
    { float a=MX3(C0[0],C0[1],C1[0]),b=MX3(C0[2],C0[3],C1[1]); a=MX3(a,C1[2],C1[3]); \
      _Pragma("unroll") for(int r=4;r<16;r+=4){a=MX3(a,C0[r],C0[r+1]);b=MX3(b,C0[r+2],C0[r+3]);a=MX3(a,C1[r],C1[r+1]);b=MX3(b,C1[r+2],C1[r+3]);} \
      float rm=__builtin_fmaxf(a,b); { auto rr=__builtin_amdgcn_permlane32_swap(__float_as_uint(rm),__float_as_uint(rm),false,false); rm=__builtin_fmaxf(__uint_as_float(rr[0]),__uint_as_float(rr[1])); } \
      resc=false; \
      if(__builtin_expect(__any(rm>(float)THRL),0)){ const float dl=__builtin_fmaxf(rm,0.f); mhat+=dl; \
        _Pragma("unroll") for(int r=0;r<16;++r){C0[r]-=dl;C1[r]-=dl;} \
        _Pragma("unroll") for(int r=0;r<16;++r)negm[r]=-mhat; asm volatile("":"+v"(negm)); \
        const float f=__builtin_amdgcn_exp2f(-dl); l_reg*=f; if(hi==0)wsf[r32]=f; resc=true; } } \
    SBAR(); \
    GAPB(o[0]=__builtin_amdgcn_mfma_f32_32x32x16_bf16(PAF(0),VFR(0),o[0],0,0,0), C0,0); \
    GAPB(o[1]=__builtin_amdgcn_mfma_f32_32x32x16_bf16(PAF(0),VFR(4),o[1],0,0,0), C0,4); \
    KRD(GL,0); GAPB(o[0]=__builtin_amdgcn_mfma_f32_32x32x16_bf16(PAF(1),VFR(1),o[0],0,0,0), C0,8); \
    KRD(GL,1); GAPB(o[1]=__builtin_amdgcn_mfma_f32_32x32x16_bf16(PAF(1),VFR(5),o[1],0,0,0), C0,12); \
    KRD(GL,2); GAPB(o[0]=__builtin_amdgcn_mfma_f32_32x32x16_bf16(PAF(2),VFR(2),o[0],0,0,0), C1,0); \
    KRD(GL,3); GAPB(o[1]=__builtin_amdgcn_mfma_f32_32x32x16_bf16(PAF(2),VFR(6),o[1],0,0,0), C1,4); \
    GAPB(o[0]=__builtin_amdgcn_mfma_f32_32x32x16_bf16(PAF(3),VFR(3),o[0],0,0,0), C1,8); \
    GAPB(o[1]=__builtin_amdgcn_mfma_f32_32x32x16_bf16(PAF(3),VFR(7),o[1],0,0,0), C1,12); \
    }while(0)
  int t=1;
  #undef CMASK
  #define CMASK(P0,P1,t) do{}while(0)
  for(;t+5<NT;t+=2){
    STEP(pB0,pB1,pA0,pA1,t,true,true,true);     WAIT_BAR(2); RESC(); ROT();
    STEP(pA0,pA1,pB0,pB1,t+1,true,true,true);   WAIT_BAR(2); RESC(); ROT();
  }
  #undef CMASK
  #define CMASK(P0,P1,t) do{int jb_=(t)-(NT-4); if(jb_>=0)cmask(P0,P1,jb_,qrel,hi);}while(0)
  #define ENDW(tt) do{ if((tt)+3<NT){WAIT_BAR(2);} else if((tt)+2<NT){WAIT_BAR(1);} else {WAIT_BAR(0);} }while(0)
  for(;t+1<NT;t+=2){
    STEP(pB0,pB1,pA0,pA1,t,(t+3<NT),(t+1<NT),(t+1<NT));       ENDW(t);   RESC(); ROT();
    STEP(pA0,pA1,pB0,pB1,t+1,(t+4<NT),(t+2<NT),(t+2<NT));     ENDW(t+1); RESC(); ROT();
  }
  STEP(pB0,pB1,pA0,pA1,NT-1,false,false,false); RESC();
  { float sacc=pB0[0]+pB0[1]; _Pragma("unroll") for(int r=2;r<16;++r)sacc+=pB0[r]; _Pragma("unroll") for(int r=0;r<16;++r)sacc+=pB1[r]; l_reg+=sacc;
    pw0=(u32x4){PKW(pB0,0),PKW(pB0,2),PKW(pB0,4),PKW(pB0,6)};pw1=(u32x4){PKW(pB0,8),PKW(pB0,10),PKW(pB0,12),PKW(pB0,14)};pw2=(u32x4){PKW(pB1,0),PKW(pB1,2),PKW(pB1,4),PKW(pB1,6)};pw3=(u32x4){PKW(pB1,8),PKW(pB1,10),PKW(pB1,12),PKW(pB1,14)};
    SBAR(); pv(o,vb0+sl_cur,PAF(0),PAF(1),PAF(2),PAF(3)); }
  #undef PKW
  #undef PAF
  #undef VFR
  #undef PIN
  #undef MX3
  #undef GAPA
  #undef GAPB
  #undef EX
  #undef VRD
  #undef KRD
  #undef STEP
  #undef ENDW
  {auto rr=__builtin_amdgcn_permlane32_swap(__float_as_uint(l_reg),__float_as_uint(l_reg),false,false);l_reg=__uint_as_float(rr[0])+__uint_as_float(rr[1]);}
  if(hi==0)wsf[32+r32]=l_reg;asm volatile("s_waitcnt lgkmcnt(0)":::"memory");
  #pragma unroll
  for(int r=0;r<16;++r)rli[r]=__builtin_amdgcn_rcpf(wsf[32+crow(r,hi)]);
  asm volatile("s_waitcnt lgkmcnt(0)\n\ts_barrier":::"memory");
  #undef DMA_K
  #undef DMA_V
  #undef CMASK
  #undef START
  #undef RESC
  #undef ROT
}
constexpr int LDS_STASH=LDS_BYTES, LDS_SSQ=LDS_STASH+NW*8192, ATTN_LDS_BYTES=LDS_SSQ+NW*128;
template<int THRL> __device__ __forceinline__ void dattn_unit(int b,int h,int qb,const bf16*Q,const bf16*K,const bf16*V,bf16*O,char*shm,float lam,const float*subln,float oml){
  #pragma unroll 1
  for(int pass=0;pass<4;++pass){
    const int m=pass&1,vh=pass>>1;
    f32x16 o[2]; float rli[16];
    attn_pass<THRL>(b,2*h+m,2*h+vh,qb,Q,K,V,shm,o,rli);
    int tid_=threadIdx.x; asm volatile("":"+v"(tid_)); const int tid=tid_,lane=tid&63,r32=lane&31,hi=lane>>5; const int wid=__builtin_amdgcn_readfirstlane(tid>>6);
    float*stash=(float*)(shm+LDS_STASH)+wid*2048; float*ssq0=(float*)(shm+LDS_SSQ)+wid*32; float*wsf=(float*)(shm+LDS_WS)+wid*64;
    unsigned short*stg=(unsigned short*)(shm+LDS_OST)+wid*2048;
    const long orow0=((long)b*SEQ+(long)qb*QB+wid*QBLK)*DM+h*128;
    if(m==0){
      #pragma unroll
      for(int d0=0;d0<2;++d0)
        #pragma unroll
        for(int r=0;r<16;++r)stash[(d0*16+r)*64+lane]=o[d0][r]*rli[r];
    }else{
      float sq[16];
      #pragma unroll
      for(int r=0;r<16;++r){ const float a0=stash[r*64+lane]-lam*o[0][r]*rli[r], a1=stash[(16+r)*64+lane]-lam*o[1][r]*rli[r]; o[0][r]=a0;o[1][r]=a1;sq[r]=a0*a0+a1*a1; }
      #pragma unroll
      for(int r=0;r<16;++r){ float s=sq[r]; s+=__shfl_xor(s,1);s+=__shfl_xor(s,2);s+=__shfl_xor(s,4);s+=__shfl_xor(s,8);s+=__shfl_xor(s,16); sq[r]=s; }
      if(vh==0){
        if(r32==0){
          #pragma unroll
          for(int r=0;r<16;++r)ssq0[crow(r,hi)]=sq[r]; }
        #pragma unroll
        for(int r=0;r<16;++r){const int orow=crow(r,hi); stg[orow*64+r32]=(unsigned short)(cvtpk_s(o[0][r],0.f)&0xffffu); stg[orow*64+32+r32]=(unsigned short)(cvtpk_s(o[1][r],0.f)&0xffffu);}
      }else{
        float rsc[16];
        #pragma unroll
        for(int r=0;r<16;++r)rsc[r]=__builtin_amdgcn_rsqf((sq[r]+ssq0[crow(r,hi)])*(1.f/128.f)+1e-6f)*oml;
        if(r32==0){
          #pragma unroll
          for(int r=0;r<16;++r)wsf[32+crow(r,hi)]=rsc[r]; }
        asm volatile("s_waitcnt lgkmcnt(0)":::"memory");
        { const int ch=lane&7; const float4 g0=*(const float4*)(subln+ch*8),g1=*(const float4*)(subln+ch*8+4);
          #pragma unroll
          for(int i=0;i<4;++i){const int row=i*8+(lane>>3); const u32x4 v=*(const u32x4*)(stg+row*64+ch*8); const float rs_=wsf[32+row];
            u32x4 w;
            w.x=cvtpk_s(__uint_as_float(v.x<<16)*rs_*g0.x,__uint_as_float(v.x&0xffff0000u)*rs_*g0.y); w.y=cvtpk_s(__uint_as_float(v.y<<16)*rs_*g0.z,__uint_as_float(v.y&0xffff0000u)*rs_*g0.w);
            w.z=cvtpk_s(__uint_as_float(v.z<<16)*rs_*g1.x,__uint_as_float(v.z&0xffff0000u)*rs_*g1.y); w.w=cvtpk_s(__uint_as_float(v.w<<16)*rs_*g1.z,__uint_as_float(v.w&0xffff0000u)*rs_*g1.w);
            *(u32x4*)((unsigned short*)O+orow0+(long)row*DM+ch*8)=w; } }
        asm volatile("s_waitcnt lgkmcnt(0)":::"memory");
        { const float ga=subln[64+r32],gb=subln[96+r32];
          #pragma unroll
          for(int r=0;r<16;++r){const int orow=crow(r,hi); stg[orow*64+r32]=(unsigned short)(cvtpk_s(o[0][r]*rsc[r]*ga,0.f)&0xffffu); stg[orow*64+32+r32]=(unsigned short)(cvtpk_s(o[1][r]*rsc[r]*gb,0.f)&0xffffu);}
          asm volatile("s_waitcnt lgkmcnt(0)":::"memory");
          #pragma unroll
          for(int i=0;i<4;++i){const int row=i*8+(lane>>3),ch=lane&7; const u32x4 v=*(const u32x4*)(stg+row*64+ch*8); *(u32x4*)((unsigned short*)O+orow0+(long)row*DM+64+ch*8)=v;} }
        asm volatile("s_waitcnt lgkmcnt(0)":::"memory");
      }
    }
  }
}
#undef SBAR
#undef WAIT_BAR
}

constexpr size_t SSM_F16_OFF = 0, SSM_TG_OFF = 2 * MiB, SSM_V_OFF = 8 * MiB;
constexpr int SSM_XLD = 392;
typedef short bf16x8_t __attribute__((ext_vector_type(8)));
__device__ __forceinline__ void ssm_tables(const Frame& F0, int L, unsigned char* base) {
    const Frame F = refresh(F0);
    LAS float* ap_re = (LAS float*)F.lds; LAS float* ap_im = ap_re + 17 * 64;
    LAS float* bb_re = ap_im + 17 * 64;   LAS float* bb_im = bb_re + 1024;
    LAS float* cc_re = bb_im + 1024;      LAS float* cc_im = cc_re + 1024;
    LAS float* kt = cc_im + 1024;         LAS float* dd = kt + 4096;
    const int tid = F.tid;
    for (int g = F.vcu; g < NG; g += F.G) {
        __syncthreads();
        if (tid < 64) {
            const int p = tid; const float dt = expf(inp(F, I_LSTEP)[L * NG + g]);
            const float lr = inp(F, I_LRE)[(L * NG + g) * SP + p], li = inp(F, I_LIM)[(L * NG + g) * SP + p];
            for (int tau = 0; tau <= 16; ++tau) { const float mg = expf(lr * dt * (float)tau); float sn, cs; sincosf(li * dt * (float)tau, &sn, &cs); ap_re[tau * 64 + p] = mg * cs; ap_im[tau * 64 + p] = mg * sn; }
            const float ab_re = ap_re[64 + p], ab_im = ap_im[64 + p];
            const float den = lr * lr + li * li, nr = ab_re - 1.f;
            const float coef_re = (nr * lr + ab_im * li) / den, coef_im = (ab_im * lr - nr * li) / den;
            const float* br = inp(F, I_BRE) + ((size_t)(L * NG + g) * SP + p) * SG; const float* bi = inp(F, I_BIM) + ((size_t)(L * NG + g) * SP + p) * SG;
            for (int h = 0; h < 16; ++h) { bb_re[p * 16 + h] = coef_re * br[h] - coef_im * bi[h]; bb_im[p * 16 + h] = coef_re * bi[h] + coef_im * br[h]; }
        }
        for (int i = tid; i < 1024; i += NTHREADS) { cc_re[i] = inp(F, I_CRE)[(size_t)(L * NG + g) * SG * SP + i]; cc_im[i] = inp(F, I_CIM)[(size_t)(L * NG + g) * SG * SP + i]; }
        if (tid < 16) dd[tid] = inp(F, I_SSMD)[(L * NG + g) * SG + tid];
        __syncthreads();
        unsigned* F16 = (unsigned*)(base + SSM_F16_OFF) + (size_t)g * 128 * 128;
        for (int i2 = tid; i2 < 128 * 128; i2 += NTHREADS) {
            const int row = i2 >> 7, col = (i2 & 127) * 2, p = row & 63, j = col >> 4, h0 = col & 15;
            const float ar = ap_re[(15 - j) * 64 + p], ai = ap_im[(15 - j) * 64 + p];
            float v[2];
#pragma unroll
            for (int q = 0; q < 2; ++q) { const float br = bb_re[p * 16 + h0 + q], bi = bb_im[p * 16 + h0 + q]; v[q] = row < 64 ? (ar * br - ai * bi) : (ar * bi + ai * br); }
            F16[i2] = f2bf(v[0]) | (f2bf(v[1]) << 16);
        }
        for (int i = tid; i < 4096; i += NTHREADS) {
            const int tau = i >> 8, h = (i >> 4) & 15, hp = i & 15; float acc = 0.f;
            for (int p = 0; p < 64; ++p) { const float ar = ap_re[tau * 64 + p], ai = ap_im[tau * 64 + p], br = bb_re[p * 16 + hp], bi = bb_im[p * 16 + hp];
                const float er = ar * br - ai * bi, ei = ar * bi + ai * br; acc += cc_re[h * 64 + p] * er - cc_im[h * 64 + p] * ei; }
            kt[i] = acc;
        }
        __syncthreads();
        unsigned* TG = (unsigned*)(base + SSM_TG_OFF) + (size_t)g * 256 * 192;
        for (int i2 = tid; i2 < 256 * 128; i2 += NTHREADS) {
            const int row = i2 >> 7, col = (i2 & 127) * 2, i = row >> 4, h = row & 15, j = col >> 4, h0 = col & 15;
            float v[2] = {0.f, 0.f};
            if (j <= i) {
#pragma unroll
                for (int q = 0; q < 2; ++q) { v[q] = kt[((i - j) * 16 + h) * 16 + h0 + q]; if (i == j && h == h0 + q) v[q] += dd[h]; } }
            TG[row * 192 + (i2 & 127)] = f2bf(v[0]) | (f2bf(v[1]) << 16);
        }
        for (int i2 = tid; i2 < 256 * 64; i2 += NTHREADS) {
            const int row = i2 >> 6, c = (i2 & 63) * 2, i = row >> 4, h = row & 15;
            float v[2];
#pragma unroll
            for (int q = 0; q < 2; ++q) { const int p = (c + q) & 63; const float ar = ap_re[(i + 1) * 64 + p], ai = ap_im[(i + 1) * 64 + p], cr = cc_re[h * 64 + p], ci = cc_im[h * 64 + p];
                v[q] = (c + q) < 64 ? (cr * ar - ci * ai) : -(cr * ai + ci * ar); }
            TG[row * 192 + 128 + (i2 & 63)] = f2bf(v[0]) | (f2bf(v[1]) << 16);
        }
    }
    __syncthreads();
}
__device__ __forceinline__ float gelu_fast(float x) { const float u = 1.5957691216057308f * (x + 0.044715f * x * x * x); return x - x * __builtin_amdgcn_rcpf(1.f + __expf(u)); }
__device__ __forceinline__ void ssm_item_mfma(const Frame& F0, int L, int it, const bf16* U, bf16* Z, const unsigned char* tbase, float* vscr) {
    const Frame F = refresh(F0);
    const int g = it & 31, b = it >> 5, tid = F.tid, lane = F.lane, w = F.wave, lr16 = lane & 15, q = lane >> 4;
    LAS unsigned char* X = F.lds;
    { const bf16* ub = U + (size_t)b * SEQ * SSMW + g * 16;
#pragma unroll
      for (int r = 0; r < 4; ++r) { const int t = tid + r * NTHREADS; const v4u* sp = (const v4u*)(ub + (size_t)t * SSMW); const v4u a = sp[0], c = sp[1];
          LAS v4u* dp = (LAS v4u*)(X + (t >> 4) * (SSM_XLD * 2) + (t & 15) * 32); dp[0] = a; dp[1] = c; } }
    __syncthreads();
    { const bf16* F16 = (const bf16*)(tbase + SSM_F16_OFF) + (size_t)g * 128 * 256 + (size_t)(16 * w + lr16) * 256 + 8 * q;
      bf16x8_t af[8];
#pragma unroll
      for (int ks = 0; ks < 8; ++ks) af[ks] = *(const bf16x8_t*)(F16 + ks * 32);
#pragma unroll 1
      for (int nt = 0; nt < 8; ++nt) {
          f32x4 acc = {0.f, 0.f, 0.f, 0.f};
          LAS const unsigned char* xr = X + (16 * nt + lr16) * (SSM_XLD * 2) + 16 * q;
#pragma unroll
          for (int ks = 0; ks < 8; ++ks) { const bf16x8_t bf = *(LAS const bf16x8_t*)(xr + ks * 64); acc = __builtin_amdgcn_mfma_f32_16x16x32_bf16(af[ks], bf, acc, 0, 0, 0); }
          *(f32x4*)(vscr + (size_t)(16 * nt + lr16) * 128 + 16 * w + 4 * q) = acc;
      } }
    asm volatile("s_waitcnt vmcnt(0)" ::: "memory");
    __syncthreads();
    if (w == 0) {
        __builtin_amdgcn_fence(__ATOMIC_ACQUIRE, "agent");
        const int p = lane; const float dt = expf(inp(F, I_LSTEP)[L * NG + g]);
        const float lr = inp(F, I_LRE)[(L * NG + g) * SP + p], li = inp(F, I_LIM)[(L * NG + g) * SP + p];
        const float mg = expf(lr * dt * 16.f); float sn, cs; sincosf(li * dt * 16.f, &sn, &cs); const float a_re = mg * cs, a_im = mg * sn;
        float s_re = 0.f, s_im = 0.f;
        LAS unsigned short* xs = (LAS unsigned short*)X + 256 + p;
        float vr = vscr[p], vi = vscr[64 + p];
#pragma unroll 4
        for (int sc = 0; sc < 128; ++sc) {
            const int nx = sc < 127 ? sc + 1 : sc; const float nvr = vscr[nx * 128 + p], nvi = vscr[nx * 128 + 64 + p];
            xs[sc * SSM_XLD] = (unsigned short)f2bf(s_re); xs[sc * SSM_XLD + 64] = (unsigned short)f2bf(s_im);
            const float t_re = a_re * s_re - a_im * s_im + vr, t_im = a_re * s_im + a_im * s_re + vi; s_re = t_re; s_im = t_im; vr = nvr; vi = nvi;
        }
    }
    __syncthreads();
    { const int mA = w, mB = 15 - w, limA = mA >> 1, limB = mB >> 1;
      const bf16* TGa = (const bf16*)(tbase + SSM_TG_OFF) + (size_t)g * 256 * 384 + (size_t)(16 * mA + lr16) * 384 + 8 * q;
      const bf16* TGb = (const bf16*)(tbase + SSM_TG_OFF) + (size_t)g * 256 * 384 + (size_t)(16 * mB + lr16) * 384 + 8 * q;
      bf16x8_t fa[12], fb[12];
#pragma unroll
      for (int ks = 0; ks < 12; ++ks) { const bf16x8_t zz = {0, 0, 0, 0, 0, 0, 0, 0}; fa[ks] = (ks >= 8 || ks <= limA) ? *(const bf16x8_t*)(TGa + ks * 32) : zz; fb[ks] = (ks >= 8 || ks <= limB) ? *(const bf16x8_t*)(TGb + ks * 32) : zz; }
      bf16* zb = Z + (size_t)b * SEQ * SSMW + g * 16 + 4 * q;
#pragma unroll 1
      for (int nt = 0; nt < 8; ++nt) {
          f32x4 accA = {0.f, 0.f, 0.f, 0.f}, accB = {0.f, 0.f, 0.f, 0.f};
          LAS const unsigned char* xr = X + (16 * nt + lr16) * (SSM_XLD * 2) + 16 * q;
#pragma unroll
          for (int ks = 0; ks < 12; ++ks) { const bf16x8_t bf = *(LAS const bf16x8_t*)(xr + ks * 64);
              if (ks >= 8 || ks <= limA) accA = __builtin_amdgcn_mfma_f32_16x16x32_bf16(fa[ks], bf, accA, 0, 0, 0);
              if (ks >= 8 || ks <= limB) accB = __builtin_amdgcn_mfma_f32_16x16x32_bf16(fb[ks], bf, accB, 0, 0, 0); }
          const int sc = 16 * nt + lr16;
          { v2u o; o.x = f2bf(gelu_fast(accA[0])) | (f2bf(gelu_fast(accA[1])) << 16); o.y = f2bf(gelu_fast(accA[2])) | (f2bf(gelu_fast(accA[3])) << 16); *(v2u*)(zb + (size_t)(16 * sc + mA) * SSMW) = o; }
          { v2u o; o.x = f2bf(gelu_fast(accB[0])) | (f2bf(gelu_fast(accB[1])) << 16); o.y = f2bf(gelu_fast(accB[2])) | (f2bf(gelu_fast(accB[3])) << 16); *(v2u*)(zb + (size_t)(16 * sc + mB) * SSMW) = o; }
      } }
    __syncthreads();
}

__device__ __forceinline__ void router_phase(const Frame& F0, int L, const float* xio, unsigned* ctl, unsigned char* ws) {
    const Frame F = refresh(F0);
    LAS f32x4* Wg = (LAS f32x4*)F.lds; LAS f32x4* Wl = (LAS f32x4*)(F.lds + 16384); LAS f32x4* Wh = (LAS f32x4*)(F.lds + 81920);
    const float* gf = inp(F, I_FFN_G) + L * DM; const float* wrg = inp(F, I_WRG) + (size_t)L * DM * NGRP; const float* wre = inp(F, I_WRE) + (size_t)L * NGRP * DM * EPG;
    for (int k = F.tid; k < DM; k += NTHREADS) Wg[k] = *(const f32x4*)(wrg + (size_t)k * 4) * gf[k];
    for (int idx = F.tid; idx < NGRP * DM; idx += NTHREADS) { const float g = gf[idx & (DM - 1)]; const f32x4* s = (const f32x4*)(wre + (size_t)idx * 8); Wl[idx] = s[0] * g; Wh[idx] = s[1] * g; }
    __syncthreads();
    const float* brg = inp(F, I_BRG) + L * NGRP; const float* bre = inp(F, I_BRE2) + L * NGRP * EPG;
    unsigned* cnt = ctl + CW_CNT + L * 64; SlotInfo* slots = (SlotInfo*)(ws + WS_SLOT);
    const int gw = F.vcu * NWAVES + F.wave, NGW = F.G * NWAVES;
    for (int t = gw; t < T; t += NGW) {
        const float* xr = xio + (size_t)t * DM + F.lane;
        float xv[16]; float ss = 0.f;
#pragma unroll
        for (int j = 0; j < 16; ++j) { xv[j] = xr[64 * j]; ss += xv[j] * xv[j]; }
        const float rs = rsqrtf(wave_sum(ss) * (1.f / DM) + EPS);
        f32x4 ag = {0.f, 0.f, 0.f, 0.f};
#pragma unroll
        for (int j = 0; j < 16; ++j) ag += Wg[F.lane + 64 * j] * xv[j];
        float lg[4];
#pragma unroll
        for (int c = 0; c < 4; ++c) lg[c] = wave_sum(ag[c]) * rs + brg[c];
        int grp = 0; float gmax = lg[0];
#pragma unroll
        for (int c = 1; c < 4; ++c) if (lg[c] > gmax) { gmax = lg[c]; grp = c; }
        float gden = 0.f;
#pragma unroll
        for (int c = 0; c < 4; ++c) gden += __expf(lg[c] - gmax);
        const float p_grp = 1.f / gden;
        grp = __builtin_amdgcn_readfirstlane(grp);
        f32x4 al = {0.f, 0.f, 0.f, 0.f}, ah = {0.f, 0.f, 0.f, 0.f};
#pragma unroll
        for (int j = 0; j < 16; ++j) { const int idx = grp * DM + F.lane + 64 * j; al += Wl[idx] * xv[j]; ah += Wh[idx] * xv[j]; }
        float le[8];
#pragma unroll
        for (int c = 0; c < 4; ++c) { le[c] = wave_sum(al[c]) * rs + bre[grp * EPG + c]; le[4 + c] = wave_sum(ah[c]) * rs + bre[grp * EPG + 4 + c]; }
        int i0 = 0; float v0 = le[0];
#pragma unroll
        for (int c = 1; c < 8; ++c) if (le[c] > v0) { v0 = le[c]; i0 = c; }
        int i1 = -1; float v1 = -3.0e38f;
#pragma unroll
        for (int c = 0; c < 8; ++c) if (c != i0 && le[c] > v1) { v1 = le[c]; i1 = c; }
        const float e1 = __expf(v1 - v0);
        const float w0 = p_grp / (1.f + e1), w1 = p_grp * e1 / (1.f + e1);
        if (F.lane == 0) {
            const int ex0 = grp * EPG + i0, ex1 = grp * EPG + i1;
            const unsigned p0 = atomicAdd(cnt + ex0, 1u), p1 = atomicAdd(cnt + 32 + ex1, 1u);
            slots[(size_t)ex0 * T + p0] = SlotInfo{t, w0}; slots[(size_t)(32 + ex1) * T + p1] = SlotInfo{t, w1};
        }
    }
}
constexpr int LDS_TB_OFF = 143360;
__device__ __forceinline__ void moe_tables(const Frame& F0, int L, unsigned* ctl) {
    const Frame F = refresh(F0);
    LAS int* tb = (LAS int*)(F.lds + LDS_TB_OFF); LAS int* tc = tb + 80;
    if (F.tid < 64) tc[F.tid] = (int)__hip_atomic_load(ctl + CW_CNT + L * 64 + F.tid, __ATOMIC_RELAXED, __HIP_MEMORY_SCOPE_AGENT);
    __syncthreads();
    if (F.tid == 0) { int s = 0; for (int i = 0; i < 64; ++i) { tb[i] = s; s += (tc[i] + 255) >> 8; } tb[64] = s; }
    __syncthreads();
}
__device__ __forceinline__ void moe_gather_tables(const Frame& F0, const pg8::MoeSched& S, const SlotInfo* slots) {
    const Frame F = refresh(F0);
    LAS unsigned* tokoff = (LAS unsigned*)(F.lds + PG8_TOKOFF_OFF); LAS SlotInfo* ri = (LAS SlotInfo*)(F.lds + PG8_ROWINFO_OFF);
    pg8::Unit u;
    for (int i = 0; i < 4 && S.next(i, u); ++i) {
        if (F.tid < 256) { const int p = u.mt * 256 + F.tid; SlotInfo si = SlotInfo{0, 0.f};
            if (p < u.cnt) si = slots[(size_t)(u.k * 32 + u.e) * T + p];
            tokoff[i * 256 + F.tid] = (unsigned)si.token * (unsigned)(DM * 2); ri[i * 256 + F.tid].token = si.token; ri[i * 256 + F.tid].w = si.w; }
    }
    __syncthreads();
}

__global__ void __launch_bounds__(NTHREADS, 2) mega_fwd(Args args) {
    extern __shared__ __attribute__((aligned(16))) unsigned char lds_raw[];
    Frame Fk;
    Fk.lds = (LAS unsigned char*)lds_raw;
    Fk.tid = threadIdx.x; Fk.lane = Fk.tid & 63; Fk.wave = __builtin_amdgcn_readfirstlane(Fk.tid >> 6);
    Fk.G = gridDim.x; { const int bx = blockIdx.x; Fk.vcu = (Fk.G % 8 == 0) ? (bx % 8) * (Fk.G / 8) + bx / 8 : bx; }
    const Frame& F = Fk;
    volatile LAS unsigned* MISC = (volatile LAS unsigned*)(F.lds + MISC_OFF);
    if (F.tid < 64) MISC[F.tid] = 0u;
    if (F.tid < N_IN) ((LAS unsigned long long*)(F.lds + PTAB_OFF))[F.tid] = (unsigned long long)args.in[F.tid];
    __syncthreads();
    unsigned char* const ws = args.ws;
    XcdBarrier bar = xcd_barrier_post((unsigned*)(ws + WS_CTL) + CW_BAR, MISC + 8);
#define GRID_BAR() xcd_barrier(bar)
#define PHASE_WS unsigned long long wv_ = (unsigned long long)ws; asm volatile("" : "+s"(wv_)); GAS unsigned char* const w_ = (GAS unsigned char*)wv_
    constexpr size_t PARTSZ = (size_t)T * 16 * 4;
    const int NGW = F.G * NWAVES;

    { PHASE_WS; const Frame F = refresh(Fk); const int gw = F.vcu * NWAVES + F.wave;
      float* part = (float*)(w_ + WS_PART); bf16* X0 = (bf16*)(w_ + WS_X0); bf16* PB = (bf16*)(w_ + WS_PB); float* lamv = (float*)(w_ + WS_MISC);
    for (int m = gw; m < T; m += NGW) {
        const f32x4* xr = (const f32x4*)(inp(F, I_X) + (size_t)m * DM) + F.lane; float s = 0.f;
        v2u* o8 = (v2u*)(X0 + (size_t)m * DM) + F.lane;
#pragma unroll
        for (int j = 0; j < 4; ++j) { const f32x4 v = xr[64 * j]; s += v.x * v.x + v.y * v.y + v.z * v.z + v.w * v.w;
            v2u w; w.x = f2bf(v.x) | (f2bf(v.y) << 16); w.y = f2bf(v.z) | (f2bf(v.w) << 16); o8[64 * j] = w; }
        s = wave_sum(s);
        if (F.lane < 16) part[(size_t)m * 16 + F.lane] = (F.lane == 0) ? s : 0.f;
    }
    for (size_t i = (size_t)(blockIdx.x * NTHREADS + F.tid) * 4; i < (size_t)DEPTH * T * PLE; i += (size_t)F.G * NTHREADS * 4) {
        const f32x4 v = *(const f32x4*)(inp(F, I_P) + i); v2u w; w.x = f2bf(v.x) | (f2bf(v.y) << 16); w.y = f2bf(v.z) | (f2bf(v.w) << 16); *(v2u*)(PB + i) = w; }
    if (blockIdx.x == 0 && F.tid < DEPTH) {
        const float* lq = inp(F, I_LAMQK) + F.tid * 4 * HD; float s1 = 0.f, s2 = 0.f;
        for (int j = 0; j < HD; ++j) { s1 += lq[j] * lq[HD + j]; s2 += lq[2 * HD + j] * lq[3 * HD + j]; }
        lamv[F.tid] = expf(s1) - expf(s2) + lam_init_for(F.tid);
    }
    convert_weights(Fk, 0, (unsigned char*)(w_ + WS_WT));
    ssm_tables(Fk, 0, (unsigned char*)(w_ + WS_X1));
    }
    GRID_BAR();

#define GEMM_PHASE(EPI, Aptr, WOFF, N_, K_, E_) do { pg8::Gemm g_{(const pg8::bf16_t*)(Aptr), (const pg8::bf16_t*)(unsigned char*)(w_ + WS_WT + (WOFF)), T, (N_), (K_)}; pg8::StaticOrder S_; S_.init(T, (N_), F.G, (int)blockIdx.x); \
        pg8::gemm_phase<EPI, pg8::StaticOrder, true, true>(F.lds, g_, S_, E_); } while (0)
#define P_XA ((bf16*)(unsigned char*)(w_ + ((L & 1) ? WS_X1 : WS_X0)))
#define P_XB ((bf16*)(unsigned char*)(w_ + ((L & 1) ? WS_X0 : WS_X1)))
#define P_PART ((float*)(unsigned char*)(w_ + WS_PART + (size_t)(L & 1) * PARTSZ))
#define P_PART2 ((float*)(unsigned char*)(w_ + WS_PART + (size_t)((L & 1) ^ 1) * PARTSZ))
#define P_(T_, OFF) ((T_*)(unsigned char*)(w_ + (OFF)))
#pragma unroll 1
    for (int L = 0; L < DEPTH; ++L) {
        if (L > 0) { { PHASE_WS; convert_weights(Fk, L, (unsigned char*)(w_ + WS_WT)); ssm_tables(Fk, L, (unsigned char*)P_XB); } GRID_BAR(); }
        { PHASE_WS; pg8::EpiWinF E{P_PART, P_(bf16, WS_Q), P_(bf16, WS_K), P_(bf16, WS_V), P_(bf16, WS_U), P_(bf16, WS_GATES), inp(F, I_QG) + L * 2 * HD, inp(F, I_KG) + L * 2 * HD, inp(F, I_BGATE) + L * 2 * DM};
          GEMM_PHASE(pg8::EpiWinF, P_XA, WT_WIN, INW, DM, E); }
        GRID_BAR();
        { PHASE_WS;
          for (int it = F.vcu; it < BATCH * NG; it += F.G)
              ssm_item_mfma(Fk, L, it, P_(const bf16, WS_U), P_(bf16, WS_Z), (const unsigned char*)P_XB, (float*)((unsigned char*)P_XB + SSM_V_OFF) + (size_t)F.vcu * 16384); }
        { PHASE_WS; const Frame F = refresh(Fk);
          const float lam = P_(float, WS_MISC)[L]; const float oml = 1.f - lam_init_for(L); const float* subln = inp(F, I_SUBLN) + L * 2 * HD;
          static_assert(attn_body::ATTN_LDS_BYTES <= PTAB_OFF, "attention LDS");
          for (int v = F.vcu; v < BATCH * NH * 4; v += F.G) {
              const int bh = v >> 2, s = v & 3;
#pragma unroll 1
              for (int i = 0; i < 2; ++i)
                  attn_body::dattn_unit<8>(bh >> 3, bh & 7, i ? s : 7 - s, P_(const attn_body::bf16, WS_Q), P_(const attn_body::bf16, WS_K), P_(const attn_body::bf16, WS_V), P_(attn_body::bf16, WS_Q), (char*)lds_raw, lam, subln, oml);
          } }
        GRID_BAR();
        { PHASE_WS; pg8::EpiGluF E{P_(bf16, WS_Z), P_(bf16, WS_Z2), inp(F, I_BGLU) + L * SSMW}; GEMM_PHASE(pg8::EpiGluF, P_(bf16, WS_Z), WT_WGLU, SSMW, SSMW, E); }
        GRID_BAR();
        { PHASE_WS; pg8::EpiGateF E{P_(bf16, WS_GATES), DM, nullptr, P_(bf16, WS_PARTS)}; GEMM_PHASE(pg8::EpiGateF, P_(bf16, WS_Z2), WT_WSU, DM, SSMW, E); }
        GRID_BAR();
        { PHASE_WS; pg8::EpiGateF E{P_(bf16, WS_GATES), 0, P_(bf16, WS_PARTS), P_(bf16, WS_MIXED)}; GEMM_PHASE(pg8::EpiGateF, P_(bf16, WS_Q), WT_WAU, DM, VW, E); }
        GRID_BAR();
        { PHASE_WS; const float* xbase = (L == 0) ? inp(F, I_X) : args.out;
          pg8::EpiResF E{xbase, args.out, P_XB, P_PART2}; GEMM_PHASE(pg8::EpiResF, P_(bf16, WS_MIXED), WT_WOUT, DM, DM, E); }
        GRID_BAR();
        { PHASE_WS; pg8::EpiPlainF E{P_(bf16, WS_PLE), DM}; GEMM_PHASE(pg8::EpiPlainF, P_(bf16, WS_PB) + (size_t)L * T * PLE, WT_WPLE, DM, PLE, E);
          router_phase(Fk, L, args.out, P_(unsigned, WS_CTL), (unsigned char*)w_); }
        GRID_BAR();
        { PHASE_WS; moe_tables(Fk, L, P_(unsigned, WS_CTL));
          pg8::MoeSched S{(LAS const int*)(F.lds + LDS_TB_OFF), (LAS const int*)(F.lds + LDS_TB_OFF) + 80, F.G, (int)blockIdx.x, 0};
          moe_gather_tables(Fk, S, P_(const SlotInfo, WS_SLOT));
          pg8::Gemm g{(const pg8::bf16_t*)P_XB, (const pg8::bf16_t*)(unsigned char*)(w_ + WS_WT + WT_WGU), T, 512, DM};
          pg8::EpiActF E{P_PART2, P_(pg8::bf16_t, WS_ACT), F.lds};
          pg8::gemm_phase_g<pg8::EpiActF, pg8::MoeSched>(F.lds, g, S, E); }
        GRID_BAR();
        { PHASE_WS; moe_tables(Fk, L, P_(unsigned, WS_CTL));
          pg8::MoeSched S{(LAS const int*)(F.lds + LDS_TB_OFF), (LAS const int*)(F.lds + LDS_TB_OFF) + 80, F.G, (int)blockIdx.x, 1};
          pg8::Gemm g{P_(const pg8::bf16_t, WS_ACT), (const pg8::bf16_t*)(unsigned char*)(w_ + WS_WT + WT_WD), T, DM, EFF};
          pg8::EpiDownF<0> E{P_(const SlotInfo, WS_SLOT), args.out, P_XA, P_PART};
          pg8::gemm_phase<pg8::EpiDownF<0>, pg8::MoeSched, true, true>(F.lds, g, S, E); }
        GRID_BAR();
        { PHASE_WS; moe_tables(Fk, L, P_(unsigned, WS_CTL));
          pg8::MoeSched S{(LAS const int*)(F.lds + LDS_TB_OFF), (LAS const int*)(F.lds + LDS_TB_OFF) + 80, F.G, (int)blockIdx.x, 2};
          pg8::Gemm g{P_(const pg8::bf16_t, WS_ACT), (const pg8::bf16_t*)(unsigned char*)(w_ + WS_WT + WT_WD), T, DM, EFF};
          pg8::EpiDownF<1> E{P_(const SlotInfo, WS_SLOT), args.out, P_XA, P_PART};
          pg8::gemm_phase<pg8::EpiDownF<1>, pg8::MoeSched, true, true>(F.lds, g, S, E); }
        GRID_BAR();
        { PHASE_WS; pg8::EpiPleF E{P_PART, P_(bf16, WS_PLE), args.out, P_XB, P_PART2}; GEMM_PHASE(pg8::EpiPleF, P_XA, WT_WPG, DM, DM, E); }
        GRID_BAR();
    }
}

extern "C" void kernel_launch(void* const* d_in, const int* in_sizes, int n_in, void* d_out, int out_size, void* d_ws, size_t ws_size, hipStream_t stream) {
    static int grid = 0;
    if (grid == 0) {
        if (n_in != N_IN || in_sizes[0] != T * DM || out_size != T * DM || ws_size < WS_END) {
            fprintf(stderr, "kernel_launch: unexpected problem (n_in %d, in0 %d, out %d, ws %zu); nothing launched\n", n_in, n_in > 0 ? in_sizes[0] : -1, out_size, ws_size); grid = -1; return; }
        int dev = 0, cus = 0, per_cu = 0;
        if (hipGetDevice(&dev) != hipSuccess || hipDeviceGetAttribute(&cus, hipDeviceAttributeMultiprocessorCount, dev) != hipSuccess) { grid = -1; return; }
        if (hipFuncSetAttribute((const void*)mega_fwd, hipFuncAttributeMaxDynamicSharedMemorySize, LDS_BYTES) != hipSuccess) { fprintf(stderr, "kernel_launch: hipFuncSetAttribute failed\n"); grid = -1; return; }
        if (hipOccupancyMaxActiveBlocksPerMultiprocessor(&per_cu, (const void*)mega_fwd, NTHREADS, LDS_BYTES) != hipSuccess || per_cu < 1)
            fprintf(stderr, "kernel_launch: note: occupancy query reports %d workgroups per CU\n", per_cu);
        (void)hipGetLastError();
        grid = cus;
    }
    if (grid < 0) return;
    if (hipMemsetAsync((char*)d_ws + WS_CTL, 0, CTL_ZERO_BYTES, stream) != hipSuccess) { fprintf(stderr, "kernel_launch: memset failed\n"); return; }
    Args a{};
    for (int i = 0; i < N_IN; ++i) a.in[i] = (const float*)d_in[i];
    a.out = (float*)d_out; a.ws = (unsigned char*)d_ws;
    hipLaunchKernelGGL(mega_fwd, dim3(grid), dim3(NTHREADS), LDS_BYTES, stream, a);
    const hipError_t le = hipPeekAtLastError();
    if (le != hipSuccess) fprintf(stderr, "kernel_launch: launch failed: %s\n", hipGetErrorName(le));
}
```

```cpp
#include <hip/hip_runtime.h>
#include <cstdio>
#include <cstdint>
#include <cmath>
#include <hip/hip_bf16.h>

#define GAS __attribute__((address_space(1)))
#define LAS __attribute__((address_space(3)))
typedef unsigned short bf16;
typedef unsigned v4u __attribute__((ext_vector_type(4)));
typedef unsigned v2u __attribute__((ext_vector_type(2)));
typedef float f32x4 __attribute__((ext_vector_type(4)));

constexpr int DM = 1024, BATCH = 8, SEQ = 2048, T = BATCH * SEQ, DEPTH = 2;
constexpr int NH = 8, HD = 64, QKW = 1024, VW = 1024, SSMW = 512, SG = 16, NG = 32, SP = 64;
constexpr int INW = 5632, NGRP = 4, EPG = 8, NEXP = 32, EFF = 256, PLE = 256;
constexpr float EPS = 1e-6f;
constexpr float C2 = 0.125f * 1.4426950408889634f;
constexpr int NWAVES = 8, NTHREADS = 512;

enum { I_X = 0, I_P, I_ATTN_G, I_WIN, I_BGATE, I_QG, I_KG, I_LAMQK, I_SUBLN, I_WAU, I_LRE, I_LIM, I_LSTEP, I_BRE, I_BIM, I_CRE, I_CIM,
       I_SSMD, I_WGLU, I_BGLU, I_WSU, I_WOUT, I_FFN_G, I_WRG, I_BRG, I_WRE, I_BRE2, I_WEG, I_WEU, I_WED, I_PLE_G, I_WPG, I_WPLE, N_IN };

constexpr size_t MiB = 1u << 20;
constexpr size_t WS_CTL = 0, CTL_ZERO_BYTES = 1 * MiB;
constexpr size_t WS_PART = 1 * MiB;
constexpr size_t WS_MISC = 3 * MiB;
constexpr size_t WS_SLOT = 4 * MiB;
constexpr size_t WS_WT = 16 * MiB;
constexpr size_t WS_X0 = 84 * MiB, WS_X1 = 116 * MiB;
constexpr size_t WS_Q = 148 * MiB, WS_K = 180 * MiB, WS_V = 212 * MiB;
constexpr size_t WS_U = 244 * MiB, WS_Z = 260 * MiB;
constexpr size_t WS_GATES = 276 * MiB;
constexpr size_t WS_PB = 340 * MiB;
constexpr size_t WS_END = 356 * MiB;
constexpr size_t WS_Z2 = WS_K, WS_MIXED = WS_K, WS_PARTS = WS_V, WS_PLE = WS_GATES, WS_OTMP = WS_X0, WS_ACT = WS_V;
struct SlotInfo { int token; float w; };
constexpr int CW_BAR = 4096;
constexpr int CW_CNT = 8192, CNT_STRIDE = 64;

__device__ __forceinline__ unsigned f2bf(float f) { unsigned u = __builtin_bit_cast(unsigned, f); return (u + 0x7fffu + ((u >> 16) & 1u)) >> 16; }
__device__ __forceinline__ float bf2f(unsigned b) { return __builtin_bit_cast(float, b << 16); }
__device__ __forceinline__ float bflo(unsigned w) { return __builtin_bit_cast(float, w << 16); }
__device__ __forceinline__ float bfhi(unsigned w) { return __builtin_bit_cast(float, w & 0xffff0000u); }
__device__ __forceinline__ float wave_sum(float v) {
#pragma unroll
    for (int o = 1; o < 64; o <<= 1) v += __shfl_xor(v, o);
    return v;
}
__device__ __forceinline__ float sigmoidf_(float x) { return 1.f / (1.f + __expf(-x)); }
__device__ __forceinline__ float gelu_tanh(float x) { const float u = 0.7978845608028654f * (x + 0.044715f * x * x * x); return 0.5f * x * (1.f + tanhf(u)); }
__device__ __forceinline__ float rowscale(const float* part, int row) {
    const f32x4* p = (const f32x4*)(part + (size_t)row * 16);
    float s = 0.f;
#pragma unroll
    for (int i = 0; i < 4; ++i) { const f32x4 v = p[i]; s += v.x; s += v.y; s += v.z; s += v.w; }
    return rsqrtf(s * (1.f / DM) + EPS);
}
__host__ __device__ inline float lam_init_for(int i) { return 0.8f - 0.6f * expf(-0.3f * (float)i); }

#define XB_TMO      128
#define XB_XCNT(j)  (256  + 64 * (j))
#define XB_XSUB(j)  (1280 + 64 * (j))
#define XB_XGEN(j)  (2304 + 64 * (j))
#define XB_TOP      3328
#define XB_TOPGEN   3392
#define XCD_BAR_WORDS 3456
#define XB_SPIN_CAP (1u << 22)
__device__ __forceinline__ unsigned xb_ld(unsigned* p)              { return __hip_atomic_load(p, __ATOMIC_RELAXED, __HIP_MEMORY_SCOPE_AGENT); }
__device__ __forceinline__ unsigned xb_add(unsigned* p, unsigned v) { return __hip_atomic_fetch_add(p, v, __ATOMIC_RELAXED, __HIP_MEMORY_SCOPE_AGENT); }
__device__ __forceinline__ unsigned xb_xcc_id() { return (unsigned)__builtin_amdgcn_s_getreg((3 << 11) | 20) & 0xFu; }
#define XB_SPIN(cond, bar) do { unsigned _sp = 0; while (cond) { __builtin_amdgcn_s_sleep(1); \
    if ((++_sp & 255u) == 0u) { if (xb_ld(&(bar)[XB_TMO])) break; if (_sp > XB_SPIN_CAP) { atomicAdd(&(bar)[XB_TMO], 1u); break; } } } } while (0)
struct XcdBarrier { unsigned* bar; unsigned x; volatile LAS unsigned* st; };
__device__ __forceinline__ XcdBarrier xcd_barrier_post(unsigned* bar, volatile LAS unsigned* st) {
    XcdBarrier b; b.bar = bar; b.x = 0; b.st = st;
    if (threadIdx.x == 0) { const unsigned x = xb_xcc_id(); st[2] = x; (void)xb_add(&bar[XB_XCNT(x)], 1u); }
    return b;
}
__device__ __forceinline__ void xcd_barrier_complete(unsigned* bar, unsigned x, unsigned& nloc, unsigned& nx) {
    const unsigned G = gridDim.x * gridDim.y * gridDim.z;
    unsigned sum, cnt, mine, sp = 0u;
    for (;;) {
        sum = 0u; cnt = 0u; mine = 0u;
#pragma unroll
        for (unsigned j = 0; j < 16; ++j) { const unsigned c = xb_ld(&bar[XB_XCNT(j)]); sum += c; cnt += (c > 0u) ? 1u : 0u; mine = (j == x) ? c : mine; }
        if (sum == G) break;
        __builtin_amdgcn_s_sleep(1);
        if ((++sp & 255u) == 0u) { if (xb_ld(&bar[XB_TMO])) break; if (sp > XB_SPIN_CAP) { atomicAdd(&bar[XB_TMO], 1u); break; } }
    }
    nloc = mine > 0u ? mine : 1u; nx = cnt > 0u ? cnt : 1u;
}
__device__ __forceinline__ void xcd_barrier(const XcdBarrier& b) {
    asm volatile("s_waitcnt vmcnt(0)" ::: "memory");
    __syncthreads();
    if (threadIdx.x == 0) {
        unsigned* bar = b.bar;
        __builtin_amdgcn_s_waitcnt(0);
        unsigned nloc = b.st[0], nx = b.st[1]; const unsigned bx = b.st[2];
        if (nloc == 0u) { xcd_barrier_complete(bar, bx, nloc, nx); b.st[0] = nloc; b.st[1] = nx; }
        const unsigned old = xb_add(&bar[XB_XSUB(bx)], 1u);
        const unsigned gen = old / nloc;
        if (old + 1u == (gen + 1u) * nloc) {
            __builtin_amdgcn_fence(__ATOMIC_RELEASE, "agent");
            asm volatile("s_waitcnt vmcnt(0)" ::: "memory");
            const unsigned og = xb_add(&bar[XB_TOP], 1u);
            const unsigned tg = og / nx;
            if (og + 1u == (tg + 1u) * nx) xb_add(&bar[XB_TOPGEN], 1u);
            else XB_SPIN(xb_ld(&bar[XB_TOPGEN]) == tg, bar);
            __builtin_amdgcn_fence(__ATOMIC_ACQUIRE, "agent");
            xb_add(&bar[XB_XGEN(bx)], 1u);
            asm volatile("s_waitcnt vmcnt(0)" ::: "memory");
        } else {
            XB_SPIN(xb_ld(&bar[XB_XGEN(bx)]) == gen, bar);
            __builtin_amdgcn_fence(__ATOMIC_ACQUIRE, "agent");
            asm volatile("s_waitcnt vmcnt(0)" ::: "memory");
        }
    }
    __syncthreads();
}

constexpr int LDS_BYTES = 160 * 1024 - 1024;
constexpr int MISC_OFF = LDS_BYTES - 256;
constexpr int PTAB_OFF = LDS_BYTES - 1024;

struct Args { const float* in[N_IN]; float* out; unsigned char* ws; };

struct Frame {
    LAS unsigned char* lds;
    int tid, lane, wave, vcu, G;
};
__device__ __forceinline__ Frame refresh(const Frame& F0) {
    Frame F = F0; int t = F0.tid; asm volatile("" : "+v"(t)); F.tid = t; F.lane = t & 63; F.wave = __builtin_amdgcn_readfirstlane(t >> 6); return F;
}
__device__ __forceinline__ const float* inp(const Frame& F, int i) {
    const LAS unsigned* p = (const LAS unsigned*)(F.lds + PTAB_OFF) + 2 * i;
    const unsigned lo = __builtin_amdgcn_readfirstlane(p[0]), hi = __builtin_amdgcn_readfirstlane(p[1]);
    return (const float*)(const GAS float*)(((unsigned long long)hi << 32) | lo);
}

namespace pg8 {
#define PG8_LAS __attribute__((address_space(3)))
typedef unsigned short bf16_t;
typedef short bf16x8 __attribute__((ext_vector_type(8)));
typedef float f32x4 __attribute__((ext_vector_type(4)));
typedef unsigned u32x4 __attribute__((ext_vector_type(4)));
constexpr int BM = 256, BK = 64, HALF = 128, HTB = HALF * BK * 2  , STAGE_BYTES = 8 * HTB, NXCD = 8, WGM = 8;

__host__ __device__ __forceinline__ int lds_byte(int r, int c) { const int st = (r >> 4) * 2 + (c >> 5), rr = r & 15, cc = c & 31, ob = rr * 64 + cc * 2; return st * 1024 + (ob ^ (((ob >> 9) & 1) << 5)); }
__host__ __device__ __forceinline__ void stage_rc(int b, int& R, int& C) { const int st = b / 1024, sb = b % 1024, swz = sb ^ (((sb >> 9) & 1) << 5); R = (st >> 1) * 16 + swz / 64; C = (st & 1) * 32 + (swz % 64) / 2; }
__host__ __device__ __forceinline__ int perm32(int rho) { const int n = rho >> 4, i = rho & 15; return 8 * (i >> 2) + 4 * n + (i & 3); }

struct Unit { int pm, pn, e, mt, cnt, pl, k, slot; };
struct Gemm { const bf16_t* A; const bf16_t* Bt; int M, N, K; };

struct StaticOrder {
    int nM, nN, nwg, G, c;
    __host__ __device__ void init(int M, int N, int G_, int c_) { nM = M / BM; nN = N / BM; nwg = nM * nN; G = G_; c = c_; }
    __host__ __device__ bool next(int i, Unit& u) const {
        const long L = (long)i * G + c; if (L >= nwg) return false;
        int wgid = (int)L; { const int q = nwg / NXCD, r = nwg % NXCD, xcd = wgid % NXCD, off = wgid / NXCD; wgid = (xcd < r ? xcd * (q + 1) : r * (q + 1) + (xcd - r) * q) + off; }
        const int nig = WGM * nN, gid = wgid / nig, fm = gid * WGM, gsz = (nM - fm) < WGM ? (nM - fm) : WGM;
        u.pm = fm + ((wgid % nig) % gsz); u.pn = (wgid % nig) / gsz; u.slot = i; return true;
    }
    __device__ __forceinline__ void a_ready(const Unit&) const {}
    __device__ __forceinline__ void done(const Unit&) const {}
};
typedef float f32x2_t __attribute__((ext_vector_type(2))); typedef __bf16 bf16x2_t __attribute__((ext_vector_type(2)));
__device__ __forceinline__ unsigned cvt_pk_bf16(float lo, float hi) { f32x2_t v = {lo, hi}; bf16x2_t b = __builtin_convertvector(v, bf16x2_t); return __builtin_bit_cast(unsigned, b); }

__device__ __forceinline__ float rowscale16(const float* part, int row) {
    const f32x4* p = (const f32x4*)(part + (size_t)row * 16); float s = 0.f;
#pragma unroll
    for (int i = 0; i < 4; ++i) { const f32x4 v = p[i]; s += v[0]; s += v[1]; s += v[2]; s += v[3]; }
    return rsqrtf(s * (1.f / 1024.f) + EPS);
}
__device__ __forceinline__ u32x4 pack8(f32x4 a, f32x4 b) { u32x4 w; w.x = cvt_pk_bf16(a[0], a[1]); w.y = cvt_pk_bf16(a[2], a[3]); w.z = cvt_pk_bf16(b[0], b[1]); w.w = cvt_pk_bf16(b[2], b[3]); return w; }
__device__ __forceinline__ void unpack8(u32x4 w, f32x4& a, f32x4& b) {
    a = (f32x4){__builtin_bit_cast(float, w.x << 16), __builtin_bit_cast(float, w.x & 0xffff0000u), __builtin_bit_cast(float, w.y << 16), __builtin_bit_cast(float, w.y & 0xffff0000u)};
    b = (f32x4){__builtin_bit_cast(float, w.z << 16), __builtin_bit_cast(float, w.z & 0xffff0000u), __builtin_bit_cast(float, w.w << 16), __builtin_bit_cast(float, w.w & 0xffff0000u)};
}
__device__ __forceinline__ float sig1(float x) { return __builtin_amdgcn_rcpf(1.f + __builtin_amdgcn_exp2f(-1.4426950408889634f * x)); }
__device__ __forceinline__ f32x4 sig4(f32x4 x) { return (f32x4){sig1(x[0]), sig1(x[1]), sig1(x[2]), sig1(x[3])}; }
__device__ __forceinline__ float dot4(f32x4 x) { return (x[0] * x[0] + x[1] * x[1]) + (x[2] * x[2] + x[3] * x[3]); }

#define PG8_TOKOFF_OFF 131072
#define PG8_ROWINFO_OFF 135168
#define PG8_RS_OFF 144384
struct EpiWinF {
    static constexpr bool PERM = false, AFTER_DRAIN = false;
    PG8_LAS const unsigned char* lds; bf16_t *q, *k, *v, *u, *gates; const float *qg, *kg, *bgate;
    __device__ __forceinline__ void operator()(const f32x4 (&acc)[2][2][4][2], const Unit& un, int wr, int wc, int, int) const {
        int l_ = threadIdx.x; asm volatile("" : "+v"(l_)); const int fr = l_ & 15, fq = (l_ >> 4) & 3;
        const int pn = un.pn, rl0 = wr * 64 + fr; const size_t row0 = (size_t)un.pm * BM + rl0;
        PG8_LAS const float* rsl = (PG8_LAS const float*)(lds + PG8_RS_OFF) + un.slot * 256 + rl0;
        if (pn < 8) {
            const bool isq = pn < 4; bf16_t* dst = isq ? q : k; const int cb = (pn & 3) * 256 + wc * 64 + fq * 8;
            const float* gn = (isq ? qg : kg) + (wc & 1) * 64 + fq * 8; const float sc = isq ? C2 : 1.f;
            f32x4 gv[2][2];
#pragma unroll
            for (int bj = 0; bj < 2; ++bj)
#pragma unroll
                for (int n = 0; n < 2; ++n) gv[bj][n] = *(const f32x4*)(gn + bj * 32 + n * 4) * sc;
#pragma unroll
            for (int ai = 0; ai < 2; ++ai)
#pragma unroll
                for (int m = 0; m < 4; ++m) {
                    const float rs = rsl[ai * HALF + m * 16];
                    float ss = (dot4(acc[ai][0][m][0]) + dot4(acc[ai][0][m][1])) + (dot4(acc[ai][1][m][0]) + dot4(acc[ai][1][m][1]));
                    ss += __shfl_xor(ss, 16); ss += __shfl_xor(ss, 32);
                    const float inv = rsqrtf(ss * rs * rs * (1.f / 64.f) + EPS) * rs;
                    bf16_t* rowp = dst + (row0 + ai * HALF + m * 16) * 1024 + cb;
#pragma unroll
                    for (int bj = 0; bj < 2; ++bj) *(u32x4*)(rowp + bj * 32) = pack8(acc[ai][bj][m][0] * inv * gv[bj][0], acc[ai][bj][m][1] * inv * gv[bj][1]);
                }
        } else if (pn < 14) {
            bf16_t* dst; int ld, cb;
            if (pn < 12) { dst = v; ld = 1024; cb = (pn - 8) * 256; } else { dst = u; ld = 512; cb = (pn - 12) * 256; }
            cb += wc * 64 + fq * 8;
#pragma unroll
            for (int ai = 0; ai < 2; ++ai)
#pragma unroll
                for (int m = 0; m < 4; ++m) {
                    const float rs = rsl[ai * HALF + m * 16];
                    bf16_t* rowp = dst + (row0 + ai * HALF + m * 16) * ld + cb;
#pragma unroll
                    for (int bj = 0; bj < 2; ++bj) *(u32x4*)(rowp + bj * 32) = pack8(acc[ai][bj][m][0] * rs, acc[ai][bj][m][1] * rs);
                }
        } else {
            const int cb = (pn - 14) * 256 + wc * 64 + fq * 8;
            f32x4 bv[2][2];
#pragma unroll
            for (int bj = 0; bj < 2; ++bj)
#pragma unroll
                for (int n = 0; n < 2; ++n) bv[bj][n] = *(const f32x4*)(bgate + cb + bj * 32 + n * 4);
#pragma unroll
            for (int ai = 0; ai < 2; ++ai)
#pragma unroll
                for (int m = 0; m < 4; ++m) {
                    const float rs = rsl[ai * HALF + m * 16];
                    bf16_t* rowp = gates + (row0 + ai * HALF + m * 16) * 2048 + cb;
#pragma unroll
                    for (int bj = 0; bj < 2; ++bj) *(u32x4*)(rowp + bj * 32) = pack8(sig4(acc[ai][bj][m][0] * rs + bv[bj][0]), sig4(acc[ai][bj][m][1] * rs + bv[bj][1]));
                }
        }
    }
};
struct EpiGluF {
    static constexpr bool PERM = false, AFTER_DRAIN = false;
    const bf16_t* z; bf16_t* z2; const float* b;
    __device__ __forceinline__ void operator()(const f32x4 (&acc)[2][2][4][2], const Unit& un, int wr, int wc, int, int) const {
        int l_ = threadIdx.x; asm volatile("" : "+v"(l_)); const int fr = l_ & 15, fq = (l_ >> 4) & 3;
        const int cb = un.pn * 256 + wc * 64 + fq * 8; const size_t row0 = (size_t)un.pm * BM + wr * 64 + fr;
        f32x4 bv[2][2];
#pragma unroll
        for (int bj = 0; bj < 2; ++bj)
#pragma unroll
            for (int n = 0; n < 2; ++n) bv[bj][n] = *(const f32x4*)(b + cb + bj * 32 + n * 4);
#pragma unroll
        for (int ai = 0; ai < 2; ++ai) {
            u32x4 zw[4][2];
#pragma unroll
            for (int m = 0; m < 4; ++m)
#pragma unroll
                for (int bj = 0; bj < 2; ++bj) zw[m][bj] = *(const u32x4*)(z + (row0 + ai * HALF + m * 16) * 512 + cb + bj * 32);
#pragma unroll
            for (int m = 0; m < 4; ++m)
#pragma unroll
                for (int bj = 0; bj < 2; ++bj) { f32x4 z0, z1; unpack8(zw[m][bj], z0, z1);
                    *(u32x4*)(z2 + (row0 + ai * HALF + m * 16) * 512 + cb + bj * 32) = pack8(z0 * sig4(acc[ai][bj][m][0] + bv[bj][0]), z1 * sig4(acc[ai][bj][m][1] + bv[bj][1])); }
        }
    }
};
struct EpiPlainF {
    static constexpr bool PERM = false, AFTER_DRAIN = false;
    bf16_t* o; int ld;
    __device__ __forceinline__ void operator()(const f32x4 (&acc)[2][2][4][2], const Unit& un, int wr, int wc, int, int) const {
        int l_ = threadIdx.x; asm volatile("" : "+v"(l_)); const int fr = l_ & 15, fq = (l_ >> 4) & 3;
        const int row0 = un.pm * BM + wr * 64 + fr, cb = un.pn * 256 + wc * 64 + fq * 8;
#pragma unroll
        for (int ai = 0; ai < 2; ++ai)
#pragma unroll
            for (int m = 0; m < 4; ++m) {
                const int row = row0 + ai * HALF + m * 16;
#pragma unroll
                for (int bj = 0; bj < 2; ++bj) *(u32x4*)(o + (size_t)row * ld + cb + bj * 32) = pack8(acc[ai][bj][m][0], acc[ai][bj][m][1]);
            }
    }
};
struct EpiGateF {
    static constexpr bool PERM = false, AFTER_DRAIN = false;
    const bf16_t* gates; int goff; const bf16_t* add; bf16_t* o;
    __device__ __forceinline__ void operator()(const f32x4 (&acc)[2][2][4][2], const Unit& un, int wr, int wc, int, int) const {
        int l_ = threadIdx.x; asm volatile("" : "+v"(l_)); const int fr = l_ & 15, fq = (l_ >> 4) & 3;
        const int cb = un.pn * 256 + wc * 64 + fq * 8; const size_t row0 = (size_t)un.pm * BM + wr * 64 + fr;
#pragma unroll
        for (int ai = 0; ai < 2; ++ai) {
            u32x4 gw[4][2], aw[4][2];
#pragma unroll
            for (int m = 0; m < 4; ++m)
#pragma unroll
                for (int bj = 0; bj < 2; ++bj) { const size_t row = row0 + ai * HALF + m * 16; const int c = cb + bj * 32;
                    gw[m][bj] = *(const u32x4*)(gates + row * 2048 + goff + c); if (add) aw[m][bj] = *(const u32x4*)(add + row * 1024 + c); }
#pragma unroll
            for (int m = 0; m < 4; ++m)
#pragma unroll
                for (int bj = 0; bj < 2; ++bj) { const size_t row = row0 + ai * HALF + m * 16; const int c = cb + bj * 32; f32x4 g0, g1; unpack8(gw[m][bj], g0, g1);
                    f32x4 v0 = g0 * acc[ai][bj][m][0], v1 = g1 * acc[ai][bj][m][1];
                    if (add) { f32x4 a0, a1; unpack8(aw[m][bj], a0, a1); v0 += a0; v1 += a1; }
                    *(u32x4*)(o + row * 1024 + c) = pack8(v0, v1); }
        }
    }
};
struct EpiResF {
    static constexpr bool PERM = false, AFTER_DRAIN = false;
    const float* base; float* out; bf16_t* xb; float* part;
    __device__ __forceinline__ void operator()(const f32x4 (&acc)[2][2][4][2], const Unit& un, int wr, int wc, int, int) const {
        int l_ = threadIdx.x; asm volatile("" : "+v"(l_)); const int fr = l_ & 15, fq = (l_ >> 4) & 3;
        const int cb = un.pn * 256 + wc * 64 + fq * 8; const size_t row0 = (size_t)un.pm * BM + wr * 64 + fr;
#pragma unroll
        for (int ai = 0; ai < 2; ++ai) {
            f32x4 bl[4][2][2];
#pragma unroll
            for (int m = 0; m < 4; ++m)
#pragma unroll
                for (int bj = 0; bj < 2; ++bj) { const size_t o = (row0 + ai * HALF + m * 16) * 1024 + cb + bj * 32; bl[m][bj][0] = *(const f32x4*)(base + o); bl[m][bj][1] = *(const f32x4*)(base + o + 4); }
#pragma unroll
            for (int m = 0; m < 4; ++m) {
                const size_t row = row0 + ai * HALF + m * 16; float ss = 0.f;
#pragma unroll
                for (int bj = 0; bj < 2; ++bj) { const size_t o = row * 1024 + cb + bj * 32;
                    const f32x4 v0 = bl[m][bj][0] + acc[ai][bj][m][0], v1 = bl[m][bj][1] + acc[ai][bj][m][1];
                    *(f32x4*)(out + o) = v0; *(f32x4*)(out + o + 4) = v1; *(u32x4*)(xb + o) = pack8(v0, v1); ss += dot4(v0) + dot4(v1); }
                ss += __shfl_xor(ss, 16); ss += __shfl_xor(ss, 32);
                if (fq == 0) part[row * 16 + un.pn * 4 + wc] = ss;
            }
        }
    }
};
struct EpiPleF {
    static constexpr bool PERM = false, AFTER_DRAIN = false;
    PG8_LAS const unsigned char* lds; const bf16_t* ple; float* out; bf16_t* xb; float* part_out;
    __device__ __forceinline__ void operator()(const f32x4 (&acc)[2][2][4][2], const Unit& un, int wr, int wc, int, int) const {
        int l_ = threadIdx.x; asm volatile("" : "+v"(l_)); const int fr = l_ & 15, fq = (l_ >> 4) & 3;
        const int cb = un.pn * 256 + wc * 64 + fq * 8, rl0 = wr * 64 + fr; const size_t row0 = (size_t)un.pm * BM + rl0;
        PG8_LAS const float* rsl = (PG8_LAS const float*)(lds + PG8_RS_OFF) + un.slot * 256 + rl0;
#pragma unroll
        for (int ai = 0; ai < 2; ++ai)
#pragma unroll
            for (int mp = 0; mp < 2; ++mp) {
                u32x4 pw[2][2]; f32x4 xl[2][2][2];
#pragma unroll
                for (int mm = 0; mm < 2; ++mm)
#pragma unroll
                    for (int bj = 0; bj < 2; ++bj) { const size_t o = (row0 + ai * HALF + (2 * mp + mm) * 16) * 1024 + cb + bj * 32; pw[mm][bj] = *(const u32x4*)(ple + o); xl[mm][bj][0] = *(const f32x4*)(out + o); xl[mm][bj][1] = *(const f32x4*)(out + o + 4); }
#pragma unroll
                for (int mm = 0; mm < 2; ++mm) {
                    const int m = 2 * mp + mm; const size_t row = row0 + ai * HALF + m * 16; const float rs = rsl[ai * HALF + m * 16]; float ss = 0.f;
#pragma unroll
                    for (int bj = 0; bj < 2; ++bj) { const size_t o = row * 1024 + cb + bj * 32; f32x4 p0, p1; unpack8(pw[mm][bj], p0, p1);
                        const f32x4 v0 = xl[mm][bj][0] + sig4(acc[ai][bj][m][0] * rs) * p0, v1 = xl[mm][bj][1] + sig4(acc[ai][bj][m][1] * rs) * p1;
                        *(f32x4*)(out + o) = v0; *(f32x4*)(out + o + 4) = v1; *(u32x4*)(xb + o) = pack8(v0, v1); ss += dot4(v0) + dot4(v1); }
                    ss += __shfl_xor(ss, 16); ss += __shfl_xor(ss, 32);
                    if (fq == 0) part_out[row * 16 + un.pn * 4 + wc] = ss;
                }
            }
    }
};
template <class Epi, class Sched, bool ALIGN_EPI = false, bool SP2 = false>
__device__ __forceinline__ void gemm_phase(PG8_LAS unsigned char* lds, const Gemm g, const Sched& S, const Epi& E) {
    int tid_ = threadIdx.x; asm volatile("" : "+v"(tid_)); const int tid = tid_, wid = __builtin_amdgcn_readfirstlane(tid >> 6), lane = tid & 63, wr = wid >> 2, wc = wid & 3, fr = lane & 15, fq = lane >> 4;
    const int K = g.K, nt = K / BK;
    unsigned voffA[2], voffB[2];
#pragma unroll
    for (int i = 0; i < 2; ++i) { int R, C; stage_rc(tid * 16 + i * 8192, R, C); const int Rb = Epi::PERM ? ((R & ~31) + perm32(R & 31)) : R;
        voffA[i] = (unsigned)(R * K + C) * 2u; voffB[i] = (unsigned)(Rb * K + C) * 2u; }
    const size_t kstep = (size_t)(BK * 2);
    const size_t hstep = (size_t)HALF * K * 2;
    const size_t tstep = 2 * hstep;
    const unsigned ldsw = (unsigned)wid * 1024u;
    const int aoff = lds_byte(wr * 64 + fr, fq * 8), boff = lds_byte(wc * 32 + fr, fq * 8);
#define PG8_SA(b, h) (((b) * 2 + (h)) * HTB)
#define PG8_SB(b, h) ((4 + (b) * 2 + (h)) * HTB)
#define PG8_STAGE(bufoff, gbase, voff) do { _Pragma("unroll") for (int _i = 0; _i < 2; ++_i) \
        __builtin_amdgcn_global_load_lds((const unsigned*)((const char*)(gbase) + (voff)[_i]), (PG8_LAS unsigned*)(lds + (bufoff) + ldsw + _i * 8192), 16, 0, 0); } while (0)
#define PG8_LDA(dst, b, h) do { _Pragma("unroll") for (int m = 0; m < 4; ++m) _Pragma("unroll") for (int k = 0; k < 2; ++k) dst[m][k] = *(const PG8_LAS bf16x8*)(lds + PG8_SA(b, h) + aoff + m * 2048 + k * 1024); } while (0)
#define PG8_LDB(dst, b, h) do { _Pragma("unroll") for (int n = 0; n < 2; ++n) _Pragma("unroll") for (int k = 0; k < 2; ++k) dst[n][k] = *(const PG8_LAS bf16x8*)(lds + PG8_SB(b, h) + boff + n * 2048 + k * 1024); } while (0)
#define PG8_MMA(ai, bj, At, Bt) do { __builtin_amdgcn_s_setprio(1); _Pragma("unroll") for (int m = 0; m < 4; ++m) _Pragma("unroll") for (int n = 0; n < 2; ++n) _Pragma("unroll") for (int k = 0; k < 2; ++k) \
        acc[ai][bj][m][n] = __builtin_amdgcn_mfma_f32_16x16x32_bf16(Bt[n][k], At[m][k], acc[ai][bj][m][n], 0, 0, 0); __builtin_amdgcn_s_setprio(0); } while (0)
#define PG8_WAIT_V(n) asm volatile("s_waitcnt vmcnt(" #n ")" ::: "memory")
#define PG8_WAIT_L(n) asm volatile("s_waitcnt lgkmcnt(" #n ")" ::: "memory")
#define PG8_BAR __builtin_amdgcn_s_barrier()
#define PG8_SCHED __builtin_amdgcn_sched_barrier(0)
    Unit cur, nxt; int ui = 0;
    if (!S.next(0, cur)) return;
    f32x4 acc[2][2][4][2];
#pragma unroll
    for (int a = 0; a < 2; ++a)
#pragma unroll
        for (int b = 0; b < 2; ++b)
#pragma unroll
            for (int m = 0; m < 4; ++m)
#pragma unroll
                for (int n = 0; n < 2; ++n) acc[a][b][m][n] = (f32x4){0.f, 0.f, 0.f, 0.f};
    bf16x8 At[4][2], B0[2][2], B1[2][2];
    const char* cA = (const char*)g.A + (size_t)cur.pm * tstep; const char* cB = (const char*)g.Bt + (size_t)cur.pn * tstep;
    S.a_ready(cur);
    if constexpr (SP2) {
        PG8_STAGE(PG8_SB(0, 0), cB, voffB); PG8_STAGE(PG8_SB(0, 1), cB + hstep, voffB); PG8_STAGE(PG8_SA(0, 0), cA, voffA); PG8_STAGE(PG8_SA(0, 1), cA + hstep, voffA);
        if (wr == 1) PG8_BAR;
        PG8_WAIT_V(2); PG8_BAR;
        PG8_STAGE(PG8_SB(1, 0), cB + kstep, voffB); PG8_STAGE(PG8_SA(1, 0), cA + kstep, voffA); PG8_STAGE(PG8_SB(1, 1), cB + hstep + kstep, voffB);
        PG8_WAIT_V(6); PG8_BAR;
    } else {
        PG8_STAGE(PG8_SB(0, 0), cB, voffB); PG8_STAGE(PG8_SA(0, 0), cA, voffA); PG8_STAGE(PG8_SB(0, 1), cB + hstep, voffB); PG8_STAGE(PG8_SA(0, 1), cA + hstep, voffA);
        if (wr == 1) PG8_BAR;
        PG8_WAIT_V(4); PG8_BAR;
        PG8_STAGE(PG8_SB(1, 0), cB + kstep, voffB); PG8_STAGE(PG8_SA(1, 0), cA + kstep, voffA); PG8_STAGE(PG8_SB(1, 1), cB + hstep + kstep, voffB);
        PG8_WAIT_V(6); PG8_BAR;
    }
    for (;;) {
        const bool has_next = S.next(ui + 1, nxt);
        const char* nA = has_next ? (const char*)g.A + (size_t)nxt.pm * tstep : cA; const char* nB = has_next ? (const char*)g.Bt + (size_t)nxt.pn * tstep : cB;
#pragma unroll 1
        for (int t = 0; t < nt; t += 2) {
            const bool last = (t == nt - 2);
            const char* a1 = cA + (size_t)(t + 1) * kstep;
            const char* a2 = last ? nA : cA + (size_t)(t + 2) * kstep; const char* b2 = last ? nB : cB + (size_t)(t + 2) * kstep;
            const char* a3 = a2 + kstep; const char* b3 = b2 + kstep;
            if (last && has_next) S.a_ready(nxt);
            if constexpr (SP2) {
            PG8_LDB(B0, 0, 0); PG8_LDB(B1, 0, 1); PG8_SCHED; PG8_LDA(At, 0, 0); PG8_STAGE(PG8_SA(1, 1), a1 + hstep, voffA);
            PG8_WAIT_V(8); PG8_WAIT_L(0); PG8_BAR; PG8_MMA(0, 0, At, B0); PG8_MMA(0, 1, At, B1); PG8_BAR; PG8_SCHED;
            PG8_LDA(At, 0, 1); PG8_STAGE(PG8_SB(0, 0), b2, voffB); PG8_STAGE(PG8_SB(0, 1), b2 + hstep, voffB); PG8_STAGE(PG8_SA(0, 0), a2, voffA);
            PG8_WAIT_V(8); PG8_WAIT_L(0); PG8_BAR; PG8_MMA(1, 0, At, B0); PG8_MMA(1, 1, At, B1); PG8_BAR; PG8_SCHED;
            PG8_LDB(B0, 1, 0); PG8_LDB(B1, 1, 1); PG8_SCHED; PG8_LDA(At, 1, 0); PG8_STAGE(PG8_SA(0, 1), a2 + hstep, voffA);
            PG8_WAIT_V(8); PG8_WAIT_L(0); PG8_BAR; PG8_MMA(0, 0, At, B0); PG8_MMA(0, 1, At, B1); PG8_BAR; PG8_SCHED;
            PG8_LDA(At, 1, 1); PG8_STAGE(PG8_SB(1, 0), b3, voffB); PG8_STAGE(PG8_SB(1, 1), b3 + hstep, voffB); PG8_STAGE(PG8_SA(1, 0), a3, voffA);
            PG8_WAIT_V(8); PG8_WAIT_L(0); PG8_BAR; PG8_MMA(1, 0, At, B0); PG8_MMA(1, 1, At, B1); PG8_BAR; PG8_SCHED;
            } else {
            PG8_LDB(B0, 0, 0); PG8_SCHED; PG8_LDA(At, 0, 0); PG8_STAGE(PG8_SA(1, 1), a1 + hstep, voffA);
            PG8_WAIT_L(8); PG8_BAR; PG8_WAIT_L(0); PG8_MMA(0, 0, At, B0); PG8_BAR; PG8_SCHED;
            PG8_LDB(B1, 0, 1); PG8_STAGE(PG8_SB(0, 0), b2, voffB);
            PG8_BAR; PG8_WAIT_L(0); PG8_MMA(0, 1, At, B1); PG8_BAR;
            PG8_LDA(At, 0, 1); PG8_STAGE(PG8_SA(0, 0), a2, voffA);
            PG8_BAR; PG8_WAIT_L(0); PG8_MMA(1, 0, At, B0); PG8_BAR; PG8_SCHED;
            PG8_STAGE(PG8_SB(0, 1), b2 + hstep, voffB);
            PG8_WAIT_V(6); PG8_BAR; PG8_MMA(1, 1, At, B1); PG8_BAR;
            PG8_LDB(B0, 1, 0); PG8_SCHED; PG8_LDA(At, 1, 0); PG8_STAGE(PG8_SA(0, 1), a2 + hstep, voffA);
            PG8_WAIT_L(8); PG8_BAR; PG8_WAIT_L(0); PG8_MMA(0, 0, At, B0); PG8_BAR; PG8_SCHED;
            PG8_LDB(B1, 1, 1); PG8_STAGE(PG8_SB(1, 0), b3, voffB);
            PG8_BAR; PG8_WAIT_L(0); PG8_MMA(0, 1, At, B1); PG8_BAR;
            PG8_LDA(At, 1, 1); PG8_STAGE(PG8_SA(1, 0), a3, voffA);
            PG8_BAR; PG8_WAIT_L(0); PG8_MMA(1, 0, At, B0); PG8_BAR; PG8_SCHED;
            PG8_STAGE(PG8_SB(1, 1), b3 + hstep, voffB);
            PG8_WAIT_V(6); PG8_BAR; PG8_MMA(1, 1, At, B1); PG8_BAR;
            }
        }
        if constexpr (ALIGN_EPI) { if (wr == 0) PG8_BAR; }
        if constexpr (!Epi::AFTER_DRAIN) { E(acc, cur, wr, wc, fr, fq); S.done(cur); }
        if (!has_next) break;
#pragma unroll
        for (int a = 0; a < 2; ++a)
#pragma unroll
            for (int b = 0; b < 2; ++b)
#pragma unroll
                for (int m = 0; m < 4; ++m)
#pragma unroll
                    for (int n = 0; n < 2; ++n) acc[a][b][m][n] = (f32x4){0.f, 0.f, 0.f, 0.f};
        cur = nxt; cA = nA; cB = nB; ++ui;
        if constexpr (ALIGN_EPI) { if (wr == 1) PG8_BAR; }
    }
    PG8_WAIT_V(0);
    if constexpr (!ALIGN_EPI) { if (wr == 0) PG8_BAR; }
    PG8_BAR;
    if constexpr (Epi::AFTER_DRAIN) { E.fused(acc, cur, wr, wc, fr, fq, lds, wid, lane); S.done(cur); }
#undef PG8_SA
#undef PG8_SB
#undef PG8_STAGE
#undef PG8_LDA
#undef PG8_LDB
#undef PG8_MMA
#undef PG8_WAIT_V
#undef PG8_WAIT_L
#undef PG8_BAR
#undef PG8_SCHED
}

struct EpiActF {
    static constexpr bool PERM = false, AFTER_DRAIN = false;
    bf16_t* act; PG8_LAS const unsigned char* lds;
    __device__ __forceinline__ void operator()(const f32x4 (&acc)[2][2][4][2], const Unit& un, int wr, int wc, int, int) const {
        int l_ = threadIdx.x; asm volatile("" : "+v"(l_)); const int fr = l_ & 15, fq = (l_ >> 4) & 3;
        typedef float f32x2v __attribute__((ext_vector_type(2)));
        PG8_LAS const f32x2v* ri = (PG8_LAS const f32x2v*)(lds + PG8_ROWINFO_OFF) + un.slot * 256;
#pragma unroll
        for (int ai = 0; ai < 2; ++ai)
#pragma unroll
            for (int m = 0; m < 4; ++m) {
                const int r = ai * HALF + wr * 64 + m * 16 + fr; const f32x2v wi = ri[r]; const float w = wi.x, rs = wi.y;
                f32x4 a[2];
#pragma unroll
                for (int n = 0; n < 2; ++n) { const f32x4 g = acc[ai][0][m][n] * rs, u = acc[ai][1][m][n] * rs; a[n] = g * sig4(g) * u * w; }
                *(u32x4*)(act + ((size_t)un.pm * 256 + r) * 256 + un.pl * 128 + wc * 32 + fq * 8) = pack8(a[0], a[1]);
            }
    }
};
template <int KK> struct EpiDownF {
    static constexpr bool PERM = false, AFTER_DRAIN = false;
    PG8_LAS const unsigned char* lds; float* out; bf16_t* xb; float* part;
    __device__ __forceinline__ void operator()(const f32x4 (&acc)[2][2][4][2], const Unit& un, int wr, int wc, int, int) const {
        int l_ = threadIdx.x; asm volatile("" : "+v"(l_)); const int fr = l_ & 15, fq = (l_ >> 4) & 3;
        const int cb = un.pl * 256 + wc * 64 + fq * 8;
        PG8_LAS const int* tk = (PG8_LAS const int*)(lds + PG8_TOKOFF_OFF) + un.slot * 256 + wr * 64 + fr;
#pragma unroll
        for (int ai = 0; ai < 2; ++ai) {
            int tok[4]; f32x4 bl[4][2][2];
#pragma unroll
            for (int m = 0; m < 4; ++m) { tok[m] = tk[ai * HALF + m * 16]; const size_t rb = (size_t)(tok[m] < 0 ? 0 : tok[m]) * 1024 + cb;
#pragma unroll
                for (int bj = 0; bj < 2; ++bj) { bl[m][bj][0] = *(const f32x4*)(out + rb + bj * 32); bl[m][bj][1] = *(const f32x4*)(out + rb + bj * 32 + 4); } }
#pragma unroll
            for (int m = 0; m < 4; ++m) {
                const bool valid = tok[m] >= 0; const size_t rb = (size_t)(valid ? tok[m] : 0) * 1024 + cb; float ss = 0.f;
#pragma unroll
                for (int bj = 0; bj < 2; ++bj) { const size_t o = rb + bj * 32;
                    const f32x4 v0 = bl[m][bj][0] + acc[ai][bj][m][0], v1 = bl[m][bj][1] + acc[ai][bj][m][1];
                    if (valid) { *(f32x4*)(out + o) = v0; *(f32x4*)(out + o + 4) = v1; if (KK) *(u32x4*)(xb + o) = pack8(v0, v1); }
                    ss += dot4(v0) + dot4(v1); }
                if (KK) { ss += __shfl_xor(ss, 16); ss += __shfl_xor(ss, 32); if (valid && fq == 0) part[(size_t)tok[m] * 16 + un.pl * 4 + wc] = ss; }
            }
        }
    }
};
__device__ __forceinline__ int ldsu(PG8_LAS const int* p) { return __builtin_amdgcn_readfirstlane(*p); }
struct MoeSched {
    PG8_LAS const int* tb; PG8_LAS const int* tc; int G, c, mode;
    __device__ __forceinline__ bool next(int i, Unit& u) const {
        const int gi = i * G + c; int ti, pl;
        if (mode == 0) { ti = gi >> 1; pl = gi & 1; if (ti >= ldsu(tb + 64)) return false; }
        else { ti = gi >> 2; pl = gi & 3; const int n0 = ldsu(tb + 32); if (mode == 2) { ti += n0; if (ti >= ldsu(tb + 64)) return false; } else if (ti >= n0) return false; }
        int ke = 0;
        for (int j = 1; j < 64; ++j) if (ldsu(tb + j) <= ti) ke = j;
        u.pm = ti; u.e = ke & 31; u.k = ke >> 5; u.mt = ti - ldsu(tb + ke); u.cnt = ldsu(tc + ke); u.pl = pl; u.slot = i; u.pn = (ke & 31) * (mode == 0 ? 2 : 4) + pl;
        return true;
    }
    __device__ __forceinline__ void a_ready(const Unit&) const {}
    __device__ __forceinline__ void done(const Unit&) const {}
};
template <class Epi, class Sched>
__device__ __forceinline__ void gemm_phase_g(PG8_LAS unsigned char* lds, const Gemm g, const Sched& S, const Epi& E) {
    int tid_ = threadIdx.x; asm volatile("" : "+v"(tid_)); const int tid = tid_, wid = __builtin_amdgcn_readfirstlane(tid >> 6), lane = tid & 63, wr = wid >> 2, wc = wid & 3, fr = lane & 15, fq = lane >> 4;
    const int K = g.K, nt = K / BK;
    unsigned voffB[2]; int RA[2]; unsigned CA2[2];
#pragma unroll
    for (int i = 0; i < 2; ++i) { int R, C; stage_rc(tid * 16 + i * 8192, R, C); voffB[i] = (unsigned)(R * K + C) * 2u; RA[i] = R; CA2[i] = (unsigned)C * 2u; }
    const size_t kstep = (size_t)(BK * 2), hstep = (size_t)HALF * K * 2, tstep = 2 * hstep;
    const unsigned ldsw = (unsigned)wid * 1024u;
    const int aoff = lds_byte(wr * 64 + fr, fq * 8), boff = lds_byte(wc * 32 + fr, fq * 8);
    PG8_LAS const unsigned* tokoff = (PG8_LAS const unsigned*)(lds + PG8_TOKOFF_OFF);
#define PG8_SA(b, h) (((b) * 2 + (h)) * HTB)
#define PG8_SB(b, h) ((4 + (b) * 2 + (h)) * HTB)
#define PG8_STAGE(bufoff, gbase, voff) do { _Pragma("unroll") for (int _i = 0; _i < 2; ++_i) \
        __builtin_amdgcn_global_load_lds((const unsigned*)((const char*)(gbase) + (voff)[_i]), (PG8_LAS unsigned*)(lds + (bufoff) + ldsw + _i * 8192), 16, 0, 0); } while (0)
#define PG8_STAGE_A(bufoff, gbase, o0, o1) do { \
        __builtin_amdgcn_global_load_lds((const unsigned*)((const char*)(gbase) + (o0)), (PG8_LAS unsigned*)(lds + (bufoff) + ldsw), 16, 0, 0); \
        __builtin_amdgcn_global_load_lds((const unsigned*)((const char*)(gbase) + (o1)), (PG8_LAS unsigned*)(lds + (bufoff) + ldsw + 8192), 16, 0, 0); } while (0)
#define PG8_GOFF(slot, d00, d01, d10, d11) do { PG8_LAS const unsigned* t_ = tokoff + (slot) * 256; \
        d00 = t_[RA[0]] + CA2[0]; d01 = t_[RA[1]] + CA2[1]; d10 = t_[128 + RA[0]] + CA2[0]; d11 = t_[128 + RA[1]] + CA2[1]; } while (0)
#define PG8_LDA(dst, b, h) do { _Pragma("unroll") for (int m = 0; m < 4; ++m) _Pragma("unroll") for (int k = 0; k < 2; ++k) dst[m][k] = *(const PG8_LAS bf16x8*)(lds + PG8_SA(b, h) + aoff + m * 2048 + k * 1024); } while (0)
#define PG8_LDB(dst, b, h) do { _Pragma("unroll") for (int n = 0; n < 2; ++n) _Pragma("unroll") for (int k = 0; k < 2; ++k) dst[n][k] = *(const PG8_LAS bf16x8*)(lds + PG8_SB(b, h) + boff + n * 2048 + k * 1024); } while (0)
#define PG8_MMA(ai, bj, At, Bt) do { __builtin_amdgcn_s_setprio(1); _Pragma("unroll") for (int m = 0; m < 4; ++m) _Pragma("unroll") for (int n = 0; n < 2; ++n) _Pragma("unroll") for (int k = 0; k < 2; ++k) \
        acc[ai][bj][m][n] = __builtin_amdgcn_mfma_f32_16x16x32_bf16(Bt[n][k], At[m][k], acc[ai][bj][m][n], 0, 0, 0); __builtin_amdgcn_s_setprio(0); } while (0)
#define PG8_WAIT_V(n) asm volatile("s_waitcnt vmcnt(" #n ")" ::: "memory")
#define PG8_WAIT_L(n) asm volatile("s_waitcnt lgkmcnt(" #n ")" ::: "memory")
#define PG8_BAR __builtin_amdgcn_s_barrier()
#define PG8_SCHED __builtin_amdgcn_sched_barrier(0)
    Unit cur, nxt; int ui = 0;
    if (!S.next(0, cur)) return;
    f32x4 acc[2][2][4][2];
#pragma unroll
    for (int a = 0; a < 2; ++a)
#pragma unroll
        for (int b = 0; b < 2; ++b)
#pragma unroll
            for (int m = 0; m < 4; ++m)
#pragma unroll
                for (int n = 0; n < 2; ++n) acc[a][b][m][n] = (f32x4){0.f, 0.f, 0.f, 0.f};
    bf16x8 At[4][2], B0[2][2], B1[2][2];
    unsigned gc00, gc01, gc10, gc11;
    PG8_GOFF(0, gc00, gc01, gc10, gc11);
    const char* A0 = (const char*)g.A; const char* cB = (const char*)g.Bt + (size_t)cur.pn * tstep;
    PG8_STAGE(PG8_SB(0, 0), cB, voffB); PG8_STAGE(PG8_SB(0, 1), cB + hstep, voffB); PG8_STAGE_A(PG8_SA(0, 0), A0, gc00, gc01); PG8_STAGE_A(PG8_SA(0, 1), A0, gc10, gc11);
    if (wr == 1) PG8_BAR;
    PG8_WAIT_V(2); PG8_BAR;
    PG8_STAGE(PG8_SB(1, 0), cB + kstep, voffB); PG8_STAGE_A(PG8_SA(1, 0), A0 + kstep, gc00, gc01); PG8_STAGE(PG8_SB(1, 1), cB + hstep + kstep, voffB);
    PG8_WAIT_V(6); PG8_BAR;
    for (;;) {
        const bool has_next = S.next(ui + 1, nxt);
        const char* nB = has_next ? (const char*)g.Bt + (size_t)nxt.pn * tstep : cB;
#pragma unroll 1
        for (int t = 0; t < nt; t += 2) {
            const bool last = (t == nt - 2);
            const char* a1 = A0 + (size_t)(t + 1) * kstep;
            const char* a2 = last ? A0 : A0 + (size_t)(t + 2) * kstep; const char* b2 = last ? nB : cB + (size_t)(t + 2) * kstep;
            const char* a3 = a2 + kstep; const char* b3 = b2 + kstep;
            unsigned g200 = gc00, g201 = gc01, g210 = gc10, g211 = gc11;
            if (last && has_next) { PG8_GOFF(ui + 1, g200, g201, g210, g211); }
            PG8_LDB(B0, 0, 0); PG8_LDB(B1, 0, 1); PG8_SCHED; PG8_LDA(At, 0, 0); PG8_STAGE_A(PG8_SA(1, 1), a1, gc10, gc11);
            PG8_WAIT_V(8); PG8_WAIT_L(0); PG8_BAR; PG8_MMA(0, 0, At, B0); PG8_MMA(0, 1, At, B1); PG8_BAR; PG8_SCHED;
            PG8_LDA(At, 0, 1); PG8_STAGE(PG8_SB(0, 0), b2, voffB); PG8_STAGE(PG8_SB(0, 1), b2 + hstep, voffB); PG8_STAGE_A(PG8_SA(0, 0), a2, g200, g201);
            PG8_WAIT_V(8); PG8_WAIT_L(0); PG8_BAR; PG8_MMA(1, 0, At, B0); PG8_MMA(1, 1, At, B1); PG8_BAR; PG8_SCHED;
            PG8_LDB(B0, 1, 0); PG8_LDB(B1, 1, 1); PG8_SCHED; PG8_LDA(At, 1, 0); PG8_STAGE_A(PG8_SA(0, 1), a2, g210, g211);
            PG8_WAIT_V(8); PG8_WAIT_L(0); PG8_BAR; PG8_MMA(0, 0, At, B0); PG8_MMA(0, 1, At, B1); PG8_BAR; PG8_SCHED;
            PG8_LDA(At, 1, 1); PG8_STAGE(PG8_SB(1, 0), b3, voffB); PG8_STAGE(PG8_SB(1, 1), b3 + hstep, voffB); PG8_STAGE_A(PG8_SA(1, 0), a3, g200, g201);
            PG8_WAIT_V(8); PG8_WAIT_L(0); PG8_BAR; PG8_MMA(1, 0, At, B0); PG8_MMA(1, 1, At, B1); PG8_BAR; PG8_SCHED;
        }
        if (wr == 0) PG8_BAR;
        E(acc, cur, wr, wc, fr, fq);
        if (!has_next) break;
#pragma unroll
        for (int a = 0; a < 2; ++a)
#pragma unroll
            for (int b = 0; b < 2; ++b)
#pragma unroll
                for (int m = 0; m < 4; ++m)
#pragma unroll
                    for (int n = 0; n < 2; ++n) acc[a][b][m][n] = (f32x4){0.f, 0.f, 0.f, 0.f};
        cur = nxt; cB = nB; ++ui; PG8_GOFF(ui, gc00, gc01, gc10, gc11);
        if (wr == 1) PG8_BAR;
    }
    PG8_WAIT_V(0);
    PG8_BAR;
#undef PG8_SA
#undef PG8_SB
#undef PG8_STAGE
#undef PG8_STAGE_A
#undef PG8_GOFF
#undef PG8_LDA
#undef PG8_LDB
#undef PG8_MMA
#undef PG8_WAIT_V
#undef PG8_WAIT_L
#undef PG8_BAR
#undef PG8_SCHED
}

}

__device__ __forceinline__ int p64_row(int c) { const int cl = c & 255; return (c & ~255) + 128 * ((cl >> 5) & 1) + 32 * (cl >> 6) + 16 * ((cl >> 2) & 1) + 4 * ((cl >> 3) & 3) + (cl & 3); }
__device__ __forceinline__ unsigned pk2(float lo, float hi) { return f2bf(lo) | (f2bf(hi) << 16); }
__device__ __forceinline__ int gu_row(int ff, int isup) { const int fl = ff & 127; return 256 * (ff >> 7) + 128 * isup + 32 * (fl >> 5) + 16 * ((fl >> 2) & 1) + 4 * ((fl >> 3) & 3) + (fl & 3); }
template <int MODE>
__device__ __forceinline__ void transpose_item(const float* W, int K, int N, bf16* WT, const float* gain, LAS float* scr, int item, int lane) {
    const int nblk = N / 32, kb = item / nblk, nb = item % nblk, k0 = 64 * kb, n0 = 32 * nb;
    const float* wp = W + (size_t)(k0 + (lane >> 5)) * N + n0 + (lane & 31);
    float wv[32];
#pragma unroll
    for (int i = 0; i < 32; ++i) wv[i] = wp[(size_t)(2 * i) * N];
    const int c = lane & 7;
    f32x4 g0 = {1.f, 1.f, 1.f, 1.f}, g1 = {1.f, 1.f, 1.f, 1.f};
    if (gain) { g0 = *(const f32x4*)(gain + k0 + 8 * c); g1 = *(const f32x4*)(gain + k0 + 8 * c + 4); }
#pragma unroll
    for (int i = 0; i < 32; ++i) scr[(2 * i + (lane >> 5)) * 33 + (lane & 31)] = wv[i];
    asm volatile("s_waitcnt lgkmcnt(0)" ::: "memory");
#pragma unroll
    for (int j = 0; j < 4; ++j) { const int n = (lane >> 3) + 8 * j; const LAS float* s = scr + (8 * c) * 33 + n;
        v4u o; o.x = pk2(s[0 * 33] * g0[0], s[1 * 33] * g0[1]); o.y = pk2(s[2 * 33] * g0[2], s[3 * 33] * g0[3]); o.z = pk2(s[4 * 33] * g1[0], s[5 * 33] * g1[1]); o.w = pk2(s[6 * 33] * g1[2], s[7 * 33] * g1[3]);
        const int drow = MODE == 0 ? p64_row(n0 + n) : gu_row(n0 + n, MODE == 2);
        *(v4u*)(WT + (size_t)drow * K + k0 + 8 * c) = o; }
    asm volatile("s_waitcnt lgkmcnt(0)" ::: "memory");
}
constexpr size_t WT_WIN = 0, WT_WAU = 12 * MiB, WT_WOUT = 14 * MiB, WT_WPG = 16 * MiB, WT_WGLU = 18 * MiB, WT_WSU = 18 * MiB + 512 * 1024, WT_WPLE = 19 * MiB + 512 * 1024, WT_WGU = 20 * MiB, WT_WD = 52 * MiB;
__device__ __forceinline__ void convert_weights(const Frame& F0, int L, unsigned char* wt) {
    const Frame F = refresh(F0);
    LAS float* scr = (LAS float*)(F.lds + F.wave * 16384);
    const int gw = F.vcu * NWAVES + F.wave, NGW = F.G * NWAVES;
    constexpr int I_IN = (DM / 64) * (INW / 32), I_SQ = (DM / 64) * (DM / 32), I_GLU = (SSMW / 64) * (SSMW / 32), I_SU = (SSMW / 64) * (DM / 32), I_PL = (PLE / 64) * (DM / 32);
    constexpr int I_EX = NEXP * 128;
    constexpr int NIT = I_IN + 3 * I_SQ + I_GLU + I_SU + I_PL + 3 * I_EX;
    for (int it = gw; it < NIT; it += NGW) {
        int r = it;
        if (r < I_IN) { transpose_item<0>(inp(F, I_WIN) + (size_t)L * DM * INW, DM, INW, (bf16*)(wt + WT_WIN), inp(F, I_ATTN_G) + L * DM, scr, r, F.lane); continue; } r -= I_IN;
        if (r < I_SQ) { transpose_item<0>(inp(F, I_WAU) + (size_t)L * DM * DM, DM, DM, (bf16*)(wt + WT_WAU), nullptr, scr, r, F.lane); continue; } r -= I_SQ;
        if (r < I_SQ) { transpose_item<0>(inp(F, I_WOUT) + (size_t)L * DM * DM, DM, DM, (bf16*)(wt + WT_WOUT), nullptr, scr, r, F.lane); continue; } r -= I_SQ;
        if (r < I_SQ) { transpose_item<0>(inp(F, I_WPG) + (size_t)L * DM * DM, DM, DM, (bf16*)(wt + WT_WPG), inp(F, I_PLE_G) + L * DM, scr, r, F.lane); continue; } r -= I_SQ;
        if (r < I_GLU) { transpose_item<0>(inp(F, I_WGLU) + (size_t)L * SSMW * SSMW, SSMW, SSMW, (bf16*)(wt + WT_WGLU), nullptr, scr, r, F.lane); continue; } r -= I_GLU;
        if (r < I_SU) { transpose_item<0>(inp(F, I_WSU) + (size_t)L * SSMW * DM, SSMW, DM, (bf16*)(wt + WT_WSU), nullptr, scr, r, F.lane); continue; } r -= I_SU;
        if (r < I_PL) { transpose_item<0>(inp(F, I_WPLE) + (size_t)L * PLE * DM, PLE, DM, (bf16*)(wt + WT_WPLE), nullptr, scr, r, F.lane); continue; } r -= I_PL;
        if (r < I_EX) { const int e = r >> 7; transpose_item<1>(inp(F, I_WEG) + ((size_t)L * NEXP + e) * DM * EFF, DM, EFF, (bf16*)(wt + WT_WGU) + (size_t)e * 512 * DM, inp(F, I_FFN_G) + L * DM, scr, r & 127, F.lane); continue; } r -= I_EX;
        if (r < I_EX) { const int e = r >> 7; transpose_item<2>(inp(F, I_WEU) + ((size_t)L * NEXP + e) * DM * EFF, DM, EFF, (bf16*)(wt + WT_WGU) + (size_t)e * 512 * DM, inp(F, I_FFN_G) + L * DM, scr, r & 127, F.lane); continue; } r -= I_EX;
        { const int e = r >> 7; transpose_item<0>(inp(F, I_WED) + ((size_t)L * NEXP + e) * EFF * DM, EFF, DM, (bf16*)(wt + WT_WD) + (size_t)e * DM * EFF, nullptr, scr, r & 127, F.lane); }
    }
}
#include <hip/hip_bf16.h>
namespace attn_body {
using bf16=__hip_bfloat16;
using bf16x8=__attribute__((ext_vector_type(8)))short;
using s16x4=__attribute__((ext_vector_type(4)))short;
using f32x16=__attribute__((ext_vector_type(16)))float;
using u32x4=__attribute__((ext_vector_type(4)))unsigned;
constexpr int BATCH=8,NHEAD=16,SEQ=2048,D=64,DM=NHEAD*D;
constexpr int NW=8,QBLK=32,QB=QBLK*NW,KVBLK=64,NQB=SEQ/QB;
constexpr int ATTN_PITCH=DM, ATTN_UNIT_ROWS=QB;
__device__ __forceinline__ int crow(int r,int hi){return (r&3)+8*(r>>2)+4*hi;}
#define SBAR() __builtin_amdgcn_sched_barrier(0)
__device__ __forceinline__ void cmask(f32x16&p0,f32x16&p1,int jb,int qrel,int hi){
  const float NEG=-INFINITY; int kb=64*jb+4*hi;
  #pragma unroll
  for(int r=0;r<16;++r){int kv=kb+(r&3)+8*(r>>2); if(kv>qrel)p0[r]=NEG; if(kv+32>qrel)p1[r]=NEG;}
}

constexpr int NSLOT=3, SLOTB=8192;
constexpr int LDS_K=0, LDS_V=NSLOT*SLOTB, LDS_WS=2*NSLOT*SLOTB, LDS_OST=LDS_WS+NW*64*4, LDS_BYTES=LDS_OST+NW*4096;
constexpr float C2=0.125f*1.4426950408889634f;
__device__ __forceinline__ void glds16(const void*gsrc,unsigned lds_dst){unsigned keep;
  asm volatile("s_mov_b32 %0, m0\n\ts_mov_b32 m0, %2\n\ts_nop 0\n\tglobal_load_lds_dwordx4 %1, off\n\ts_mov_b32 m0, %0":"=&s"(keep):"v"(gsrc),"s"(lds_dst):"memory");}
__device__ __forceinline__ float max3f(float a,float b,float c){float r;asm("v_max3_f32 %0, %1, %2, %3":"=v"(r):"v"(a),"v"(b),"v"(c));return r;}
__device__ __forceinline__ float max2f(float a,float b){float r;asm("v_max_f32_e32 %0, %1, %2":"=v"(r):"v"(a),"v"(b));return r;}
__device__ __forceinline__ float fadd_s(float a,float b){float r;asm("v_add_f32_e32 %0, %1, %2":"=v"(r):"v"(a),"v"(b));return r;}
__device__ __forceinline__ float fsub_s(float a,float b){float r;asm("v_sub_f32_e32 %0, %1, %2":"=v"(r):"v"(a),"v"(b));return r;}
typedef float f32x2_t __attribute__((ext_vector_type(2))); typedef __bf16 bf16x2_t __attribute__((ext_vector_type(2)));
__device__ __forceinline__ unsigned cvtpk_s(float lo,float hi){f32x2_t v={lo,hi};bf16x2_t b=__builtin_convertvector(v,bf16x2_t);return __builtin_bit_cast(unsigned,b);}
#define WAIT_BAR(N) asm volatile("s_waitcnt vmcnt(" #N ") lgkmcnt(0)\n\ts_barrier":::"memory")

__device__ __forceinline__ void qkt(f32x16&p0,f32x16&p1,const char*Kslot,const bf16x8*qr,const f32x16&negm,int r32,int hi){
  const char*kb=Kslot+hi*1024+r32*16;
  #pragma unroll
  for(int d0=0;d0<4;++d0){
    const bf16x8 b0=*reinterpret_cast<const bf16x8*>(kb+d0*2048);
    const bf16x8 b1=*reinterpret_cast<const bf16x8*>(kb+d0*2048+512);
    if(d0==0){p0=__builtin_amdgcn_mfma_f32_32x32x16_bf16(b0,qr[0],negm,0,0,0);p1=__builtin_amdgcn_mfma_f32_32x32x16_bf16(b1,qr[0],negm,0,0,0);}
    else{p0=__builtin_amdgcn_mfma_f32_32x32x16_bf16(b0,qr[d0],p0,0,0,0);p1=__builtin_amdgcn_mfma_f32_32x32x16_bf16(b1,qr[d0],p1,0,0,0);}}
}
typedef __attribute__((address_space(3))) const char* lds_cptr;
typedef short v4i16_t __attribute__((ext_vector_type(4)));
__device__ __forceinline__ void kload8(bf16x8*kf,lds_cptr kp){
  kf[0]=*(const __attribute__((address_space(3))) bf16x8*)(kp);      kf[1]=*(const __attribute__((address_space(3))) bf16x8*)(kp+512);
  kf[2]=*(const __attribute__((address_space(3))) bf16x8*)(kp+2048); kf[3]=*(const __attribute__((address_space(3))) bf16x8*)(kp+2560);
  kf[4]=*(const __attribute__((address_space(3))) bf16x8*)(kp+4096); kf[5]=*(const __attribute__((address_space(3))) bf16x8*)(kp+4608);
  kf[6]=*(const __attribute__((address_space(3))) bf16x8*)(kp+6144); kf[7]=*(const __attribute__((address_space(3))) bf16x8*)(kp+6656);
}
__device__ __forceinline__ void kload2(bf16x8*kf,lds_cptr kp,int j){ kf[2*j]=*(const __attribute__((address_space(3))) bf16x8*)(kp+j*2048); kf[2*j+1]=*(const __attribute__((address_space(3))) bf16x8*)(kp+j*2048+512); }
__device__ __forceinline__ s16x4 vtr(lds_cptr p){ return __builtin_bit_cast(s16x4,__builtin_amdgcn_ds_read_tr16_b64_v4i16((__attribute__((address_space(3))) v4i16_t*)p)); }
__device__ __forceinline__ float rowmax(const f32x16&p0,const f32x16&p1){
  float a=max3f(p0[0],p0[1],p1[0]),b=max3f(p0[2],p0[3],p1[1]);a=max3f(a,p1[2],p1[3]);
  #pragma unroll
  for(int r=4;r<16;r+=4){a=max3f(a,p0[r],p0[r+1]);b=max3f(b,p0[r+2],p0[r+3]);a=max3f(a,p1[r],p1[r+1]);b=max3f(b,p1[r+2],p1[r+3]);}
  const float m=max2f(a,b);
  auto rr=__builtin_amdgcn_permlane32_swap(__float_as_uint(m),__float_as_uint(m),false,false);
  return max2f(__uint_as_float(rr[0]),__uint_as_float(rr[1]));
}
__device__ __forceinline__ void pv(f32x16*o,int vb,bf16x8 pa0,bf16x8 pa1,bf16x8 pa2,bf16x8 pa3){
  #pragma unroll
  for(int d0=0;d0<2;++d0){s16x4 lo[4],hi[4];
    #pragma unroll
    for(int ks=0;ks<4;++ks){
      asm volatile("ds_read_b64_tr_b16 %0,%1 offset:%c2":"=&v"(lo[ks]):"v"(vb),"i"(d0*4096+ks*1024):"memory");
      asm volatile("ds_read_b64_tr_b16 %0,%1 offset:%c2":"=&v"(hi[ks]):"v"(vb),"i"(d0*4096+ks*1024+512):"memory");}
    asm volatile("s_waitcnt lgkmcnt(0)":::"memory");SBAR();
    #define PK(k) (bf16x8){lo[k][0],lo[k][1],lo[k][2],lo[k][3],hi[k][0],hi[k][1],hi[k][2],hi[k][3]}
    o[d0]=__builtin_amdgcn_mfma_f32_32x32x16_bf16(pa0,PK(0),o[d0],0,0,0);
    o[d0]=__builtin_amdgcn_mfma_f32_32x32x16_bf16(pa1,PK(1),o[d0],0,0,0);
    o[d0]=__builtin_amdgcn_mfma_f32_32x32x16_bf16(pa2,PK(2),o[d0],0,0,0);
    o[d0]=__builtin_amdgcn_mfma_f32_32x32x16_bf16(pa3,PK(3),o[d0],0,0,0);
    #undef PK
  }
}

#ifndef ATTN_STORE16
#define ATTN_STORE16(p,v) (*(u32x4*)(p)=(v))
#endif
template<int THRL> __device__ __forceinline__ void attn_pass(int b,int hq,int hv,int qb,const bf16*Q,const bf16*K,const bf16*V,char*shm,f32x16 (&o)[2],float (&rli)[16]){
  int tid_=threadIdx.x; asm volatile("":"+v"(tid_)); const int tid=tid_,lane=tid&63,r32=lane&31,hi=lane>>5; const int wid=__builtin_amdgcn_readfirstlane(tid>>6);
  const long rowbase=(long)b*SEQ; const int q0=qb*QB;
  const bf16*Qw=Q+(rowbase+q0+wid*QBLK)*DM+hq*D;
  const bf16*Kh=K+rowbase*DM+hq*D,*Vh=V+rowbase*DM+hv*D;
  const unsigned lds0=(unsigned)(uintptr_t)shm;
  float*wsf=(float*)(shm+LDS_WS)+wid*64;
  const bf16*ksrc=Kh+(long)lane*DM+wid*8;
  const bf16*vsrc=Vh+(long)(16*(wid&3)+(lane>>2))*DM+(wid>>2)*32+(lane&3)*8;
  const unsigned kdst=lds0+LDS_K+wid*1024, vdst=lds0+LDS_V+wid*1024;
  #define DMA_K(t,slot) glds16(ksrc+(long)(t)*KVBLK*DM,(unsigned)__builtin_amdgcn_readfirstlane(kdst+(slot)))
  #define DMA_V(t,slot) glds16(vsrc+(long)(t)*KVBLK*DM,(unsigned)__builtin_amdgcn_readfirstlane(vdst+(slot)))
  const int vb0=(int)(lds0+LDS_V)+((lane>>4)&1)*32+(lane&3)*8+(4*hi+((lane&15)>>2))*64;
  const char*Kbase=shm+LDS_K; bf16x8 kf[8];
  const lds_cptr shm3=(lds_cptr)shm; const lds_cptr kp0=shm3+LDS_K+hi*1024+r32*16; const lds_cptr vp0=shm3+LDS_V+((lane>>4)&1)*32+(lane&3)*8+(4*hi+((lane&15)>>2))*64;
  const int NT=(q0+QB)/KVBLK;
  DMA_K(0,0);DMA_V(0,0);DMA_K(1,SLOTB);
  bf16x8 qr[4];
  #pragma unroll
  for(int d0=0;d0<4;++d0)qr[d0]=*reinterpret_cast<const bf16x8*>(&Qw[(long)r32*DM+d0*16+hi*8]);
  float mhat=0.f,l_reg=0.f;o[0]=f32x16{};o[1]=f32x16{};f32x16 negm=f32x16{};asm volatile("":"+v"(negm));
  const int qrel=wid*QBLK+r32;
  #define CMASK(P0,P1,t) do{int jb_=(t)-(NT-4); if(jb_>=0)cmask(P0,P1,jb_,qrel,hi);}while(0)
  bool resc=false;
  #define START(P0,P1) do{ const float rm=rowmax(P0,P1); resc=false; \
    { const float dl=rm; mhat=fadd_s(mhat,dl); \
      _Pragma("unroll") for(int r=0;r<16;++r){P0[r]=fsub_s(P0[r],dl);P1[r]=fsub_s(P1[r],dl);} \
      _Pragma("unroll") for(int r=0;r<16;++r)negm[r]=-mhat; asm volatile("":"+v"(negm)); } \
    _Pragma("unroll") for(int r=0;r<16;++r)P0[r]=__builtin_amdgcn_exp2f(P0[r]); }while(0)
  #define RESC() do{ if(resc){ asm volatile("s_waitcnt lgkmcnt(0)":::"memory"); \
      _Pragma("unroll") for(int d_=0;d_<2;++d_) _Pragma("unroll") for(int r=0;r<16;++r)o[d_][r]*=wsf[crow(r,hi)]; } }while(0)
  f32x16 pA0,pA1,pB0,pB1;
  int sl_prev=0,sl_cur=0,sl_next=SLOTB;
  #define ROT() do{sl_prev=sl_cur;sl_cur=sl_next;sl_next=(sl_next==(NSLOT-1)*SLOTB)?0:sl_next+SLOTB;}while(0)
  DMA_K(2,2*SLOTB);
  WAIT_BAR(3);
  qkt(pA0,pA1,Kbase,qr,negm,r32,hi);asm volatile("s_nop 15\n\ts_nop 7":"+v"(pA0),"+v"(pA1));CMASK(pA0,pA1,0);
  START(pA0,pA1);
  _Pragma("unroll") for(int r=0;r<16;++r)pA1[r]=__builtin_amdgcn_exp2f(pA1[r]);
  WAIT_BAR(0);
  DMA_K(3,0);DMA_V(1,SLOTB);
  ROT();
  kload8(kf,kp0+sl_cur);
  WAIT_BAR(2);
  s16x4 vlo[8],vhi[8]; u32x4 pw0,pw1,pw2,pw3;
  #define PKW(P,B) cvtpk_s(P[B],P[B+1])
  #define PAF(k) __builtin_bit_cast(bf16x8,pw##k)
  #define VFR(i) (bf16x8){vlo[i][0],vlo[i][1],vlo[i][2],vlo[i][3],vhi[i][0],vhi[i][1],vhi[i][2],vhi[i][3]}
  #define PIN(x) asm volatile("":"+v"(x))
  #define MX3(a,b,c) __builtin_fmaxf(__builtin_fmaxf((a),(b)),(c))
  #define GAPA(MF,A0,A1,A2,A3,W0,W1,PW) do{ MF; sacc+=A0; sacc+=A1; sacc+=A2; sacc+=A3; PIN(sacc); W0; W1; PIN(PW); SBAR(); }while(0)
  #define EX(v) __builtin_amdgcn_exp2f(v)
  #define GAPB(MF,X,B) do{ MF; X[B]=EX(X[B]); X[B+1]=EX(X[B+1]); X[B+2]=EX(X[B+2]); X[B+3]=EX(X[B+3]); PIN(X); SBAR(); }while(0)
  #define VRD(i) do{ vlo[i]=vtr(vp_+(((i)>>2)*4096+((i)&3)*1024)); vhi[i]=vtr(vp_+(((i)>>2)*4096+((i)&3)*1024+512)); }while(0)
  #define KRD(G,j) do{ if(G){ kload2(kf,kp0+sl_next,j); SBAR(); } }while(0)
  #define STEP(C0,C1,P0,P1,t,GK,GV,GL) do{ SBAR(); \
    const lds_cptr vp_=vp0+sl_prev; \
    VRD(0); SBAR(); float sacc=(P0[0]+P0[1]); \
    GAPA(C0=__builtin_amdgcn_mfma_f32_32x32x16_bf16(kf[0],qr[0],negm,0,0,0), P0[2],P0[3],P0[4],P0[5],     pw0[0]=PKW(P0,0), pw0[1]=PKW(P0,2), pw0); \
    VRD(4); SBAR(); GAPA(C1=__builtin_amdgcn_mfma_f32_32x32x16_bf16(kf[1],qr[0],negm,0,0,0), P0[6],P0[7],P0[8],P0[9],     pw0[2]=PKW(P0,4), pw0[3]=PKW(P0,6), pw0); \
    VRD(1); SBAR(); GAPA(C0=__builtin_amdgcn_mfma_f32_32x32x16_bf16(kf[2],qr[1],C0,0,0,0),   P0[10],P0[11],P0[12],P0[13], pw1[0]=PKW(P0,8), pw1[1]=PKW(P0,10), pw1); \
    VRD(5); SBAR(); GAPA(C1=__builtin_amdgcn_mfma_f32_32x32x16_bf16(kf[3],qr[1],C1,0,0,0),   P0[14],P0[15],P1[0],P1[1],   pw1[2]=PKW(P0,12),pw1[3]=PKW(P0,14), pw1); \
    VRD(2); SBAR(); GAPA(C0=__builtin_amdgcn_mfma_f32_32x32x16_bf16(kf[4],qr[2],C0,0,0,0),   P1[2],P1[3],P1[4],P1[5],     pw2[0]=PKW(P1,0), pw2[1]=PKW(P1,2), pw2); \
    VRD(6); SBAR(); GAPA(C1=__builtin_amdgcn_mfma_f32_32x32x16_bf16(kf[5],qr[2],C1,0,0,0),   P1[6],P1[7],P1[8],P1[9],     pw2[2]=PKW(P1,4), pw2[3]=PKW(P1,6), pw2); \
    VRD(3); SBAR(); GAPA(C0=__builtin_amdgcn_mfma_f32_32x32x16_bf16(kf[6],qr[3],C0,0,0,0),   P1[10],P1[11],P1[12],P1[13], pw3[0]=PKW(P1,8), pw3[1]=PKW(P1,10), pw3); \
    VRD(7); SBAR(); GAPA(C1=__builtin_amdgcn_mfma_f32_32x32x16_bf16(kf[7],qr[3],C1,0,0,0),   P1[14],P1[15],0.f,0.f,       pw3[2]=PKW(P1,12),pw3[3]=PKW(P1,14), pw3); \
    l_reg+=sacc; \
    if(GK){DMA_K((t)+3,sl_cur);} if(GV){DMA_V((t)+1,sl_next);} \
    CMASK(C0,C1,t); \
    { float a=MX3(C0[0],C0[1],C1[0]),b=MX3(C0[2],C0[3],C1[1]); a=MX3(a,C1[2],C1[3]); \
      _Pragma("unroll") for(int r=4;r<16;r+=4){a=MX3(a,C0[r],C0[r+1]);b=MX3(b,C0[r+2],C0[r+3]);a=MX3(a,C1[r],C1[r+1]);b=MX3(b,C1[r+2],C1[r+3]);} \
      float rm=__builtin_fmaxf(a,b); { auto rr=__builtin_amdgcn_permlane32_swap(__float_as_uint(rm),__float_as_uint(rm),false,false); rm=__builtin_fmaxf(__uint_as_float(rr[0]),__uint_as_float(rr[1])); } \
      resc=false; \
      if(__builtin_expect(__any(rm>(float)THRL),0)){ const float dl=__builtin_fmaxf(rm,0.f); mhat+=dl; \
        _Pragma("unroll") for(int r=0;r<16;++r){C0[r]-=dl;C1[r]-=dl;} \
        _Pragma("unroll") for(int r=0;r<16;++r)negm[r]=-mhat; asm volatile("":"+v"(negm)); \
        const float f=__builtin_amdgcn_exp2f(-dl); l_reg*=f; if(hi==0)wsf[r32]=f; resc=true; } } \
    SBAR(); \
    GAPB(o[0]=__builtin_amdgcn_mfma_f32_32x32x16_bf16(PAF(0),VFR(0),o[0],0,0,0), C0,0); \
    GAPB(o[1]=__builtin_amdgcn_mfma_f32_32x32x16_bf16(PAF(0),VFR(4),o[1],0,0,0), C0,4); \
    KRD(GL,0); GAPB(o[0]=__builtin_amdgcn_mfma_f32_32x32x16_bf16(PAF(1),VFR(1),o[0],0,0,0), C0,8); \
    KRD(GL,1); GAPB(o[1]=__builtin_amdgcn_mfma_f32_32x32x16_bf16(PAF(1),VFR(5),o[1],0,0,0), C0,12); \
    KRD(GL,2); GAPB(o[0]=__builtin_amdgcn_mfma_f32_32x32x16_bf16(PAF(2),VFR(2),o[0],0,0,0), C1,0); \
    KRD(GL,3); GAPB(o[1]=__builtin_amdgcn_mfma_f32_32x32x16_bf16(PAF(2),VFR(6),o[1],0,0,0), C1,4); \
    GAPB(o[0]=__builtin_amdgcn_mfma_f32_32x32x16_bf16(PAF(3),VFR(3),o[0],0,0,0), C1,8); \
    GAPB(o[1]=__builtin_amdgcn_mfma_f32_32x32x16_bf16(PAF(3),VFR(7),o[1],0,0,0), C1,12); \
    }while(0)
  int t=1;
  #undef CMASK
  #define CMASK(P0,P1,t) do{}while(0)
  for(;t+5<NT;t+=2){
    STEP(pB0,pB1,pA0,pA1,t,true,true,true);     WAIT_BAR(2); RESC(); ROT();
    STEP(pA0,pA1,pB0,pB1,t+1,true,true,true);   WAIT_BAR(2); RESC(); ROT();
  }
  #undef CMASK
  #define CMASK(P0,P1,t) do{int jb_=(t)-(NT-4); if(jb_>=0)cmask(P0,P1,jb_,qrel,hi);}while(0)
  #define ENDW(tt) do{ if((tt)+3<NT){WAIT_BAR(2);} else if((tt)+2<NT){WAIT_BAR(1);} else {WAIT_BAR(0);} }while(0)
  for(;t+1<NT;t+=2){
    STEP(pB0,pB1,pA0,pA1,t,(t+3<NT),(t+1<NT),(t+1<NT));       ENDW(t);   RESC(); ROT();
    STEP(pA0,pA1,pB0,pB1,t+1,(t+4<NT),(t+2<NT),(t+2<NT));     ENDW(t+1); RESC(); ROT();
  }
  STEP(pB0,pB1,pA0,pA1,NT-1,false,false,false); RESC();
  { float sacc=pB0[0]+pB0[1]; _Pragma("unroll") for(int r=2;r<16;++r)sacc+=pB0[r]; _Pragma("unroll") for(int r=0;r<16;++r)sacc+=pB1[r]; l_reg+=sacc;
    pw0=(u32x4){PKW(pB0,0),PKW(pB0,2),PKW(pB0,4),PKW(pB0,6)};pw1=(u32x4){PKW(pB0,8),PKW(pB0,10),PKW(pB0,12),PKW(pB0,14)};pw2=(u32x4){PKW(pB1,0),PKW(pB1,2),PKW(pB1,4),PKW(pB1,6)};pw3=(u32x4){PKW(pB1,8),PKW(pB1,10),PKW(pB1,12),PKW(pB1,14)};
    SBAR(); pv(o,vb0+sl_cur,PAF(0),PAF(1),PAF(2),PAF(3)); }
  #undef PKW
  #undef PAF
  #undef VFR
  #undef PIN
  #undef MX3
  #undef GAPA
  #undef GAPB
  #undef EX
  #undef VRD
  #undef KRD
  #undef STEP
  #undef ENDW
  {auto rr=__builtin_amdgcn_permlane32_swap(__float_as_uint(l_reg),__float_as_uint(l_reg),false,false);l_reg=__uint_as_float(rr[0])+__uint_as_float(rr[1]);}
  if(hi==0)wsf[32+r32]=l_reg;asm volatile("s_waitcnt lgkmcnt(0)":::"memory");
  #pragma unroll
  for(int r=0;r<16;++r)rli[r]=__builtin_amdgcn_rcpf(wsf[32+crow(r,hi)]);
  asm volatile("s_waitcnt lgkmcnt(0)\n\ts_barrier":::"memory");
  #undef DMA_K
  #undef DMA_V
  #undef CMASK
  #undef START
  #undef RESC
  #undef ROT
}
constexpr int LDS_STASH=LDS_BYTES, LDS_SSQ=LDS_STASH+NW*8192, ATTN_LDS_BYTES=LDS_SSQ+NW*128;
template<int THRL> __device__ __forceinline__ void dattn_unit(int b,int h,int qb,const bf16*Q,const bf16*K,const bf16*V,bf16*O,char*shm,float lam,const float*subln,float oml){
  #pragma unroll 1
  for(int pass=0;pass<4;++pass){
    const int m=pass&1,vh=pass>>1;
    f32x16 o[2]; float rli[16];
    attn_pass<THRL>(b,2*h+m,2*h+vh,qb,Q,K,V,shm,o,rli);
    int tid_=threadIdx.x; asm volatile("":"+v"(tid_)); const int tid=tid_,lane=tid&63,r32=lane&31,hi=lane>>5; const int wid=__builtin_amdgcn_readfirstlane(tid>>6);
    float*stash=(float*)(shm+LDS_STASH)+wid*2048; float*ssq0=(float*)(shm+LDS_SSQ)+wid*32; float*wsf=(float*)(shm+LDS_WS)+wid*64;
    unsigned short*stg=(unsigned short*)(shm+LDS_OST)+wid*2048;
    const long orow0=((long)b*SEQ+(long)qb*QB+wid*QBLK)*DM+h*128;
    if(m==0){
      #pragma unroll
      for(int d0=0;d0<2;++d0)
        #pragma unroll
        for(int r=0;r<16;++r)stash[(d0*16+r)*64+lane]=o[d0][r]*rli[r];
    }else{
      float sq[16];
      #pragma unroll
      for(int r=0;r<16;++r){ const float a0=stash[r*64+lane]-lam*o[0][r]*rli[r], a1=stash[(16+r)*64+lane]-lam*o[1][r]*rli[r]; o[0][r]=a0;o[1][r]=a1;sq[r]=a0*a0+a1*a1; }
      #pragma unroll
      for(int r=0;r<16;++r){ float s=sq[r]; s+=__shfl_xor(s,1);s+=__shfl_xor(s,2);s+=__shfl_xor(s,4);s+=__shfl_xor(s,8);s+=__shfl_xor(s,16); sq[r]=s; }
      if(vh==0){
        if(r32==0){
          #pragma unroll
          for(int r=0;r<16;++r)ssq0[crow(r,hi)]=sq[r]; }
        #pragma unroll
        for(int r=0;r<16;++r){const int orow=crow(r,hi); stg[orow*64+r32]=(unsigned short)(cvtpk_s(o[0][r],0.f)&0xffffu); stg[orow*64+32+r32]=(unsigned short)(cvtpk_s(o[1][r],0.f)&0xffffu);}
      }else{
        float rsc[16];
        #pragma unroll
        for(int r=0;r<16;++r)rsc[r]=__builtin_amdgcn_rsqf((sq[r]+ssq0[crow(r,hi)])*(1.f/128.f)+1e-6f)*oml;
        if(r32==0){
          #pragma unroll
          for(int r=0;r<16;++r)wsf[32+crow(r,hi)]=rsc[r]; }
        asm volatile("s_waitcnt lgkmcnt(0)":::"memory");
        { const int ch=lane&7; const float4 g0=*(const float4*)(subln+ch*8),g1=*(const float4*)(subln+ch*8+4);
          #pragma unroll
          for(int i=0;i<4;++i){const int row=i*8+(lane>>3); const u32x4 v=*(const u32x4*)(stg+row*64+ch*8); const float rs_=wsf[32+row];
            u32x4 w;
            w.x=cvtpk_s(__uint_as_float(v.x<<16)*rs_*g0.x,__uint_as_float(v.x&0xffff0000u)*rs_*g0.y); w.y=cvtpk_s(__uint_as_float(v.y<<16)*rs_*g0.z,__uint_as_float(v.y&0xffff0000u)*rs_*g0.w);
            w.z=cvtpk_s(__uint_as_float(v.z<<16)*rs_*g1.x,__uint_as_float(v.z&0xffff0000u)*rs_*g1.y); w.w=cvtpk_s(__uint_as_float(v.w<<16)*rs_*g1.z,__uint_as_float(v.w&0xffff0000u)*rs_*g1.w);
            *(u32x4*)((unsigned short*)O+orow0+(long)row*DM+ch*8)=w; } }
        asm volatile("s_waitcnt lgkmcnt(0)":::"memory");
        { const float ga=subln[64+r32],gb=subln[96+r32];
          #pragma unroll
          for(int r=0;r<16;++r){const int orow=crow(r,hi); stg[orow*64+r32]=(unsigned short)(cvtpk_s(o[0][r]*rsc[r]*ga,0.f)&0xffffu); stg[orow*64+32+r32]=(unsigned short)(cvtpk_s(o[1][r]*rsc[r]*gb,0.f)&0xffffu);}
          asm volatile("s_waitcnt lgkmcnt(0)":::"memory");
          #pragma unroll
          for(int i=0;i<4;++i){const int row=i*8+(lane>>3),ch=lane&7; const u32x4 v=*(const u32x4*)(stg+row*64+ch*8); *(u32x4*)((unsigned short*)O+orow0+(long)row*DM+64+ch*8)=v;} }
        asm volatile("s_waitcnt lgkmcnt(0)":::"memory");
      }
    }
  }
}
#undef SBAR
#undef WAIT_BAR
}

constexpr size_t SSM_F16_OFF = 0, SSM_TG_OFF = 2 * MiB, SSM_V_OFF = 8 * MiB;
constexpr int SSM_XLD = 392;
typedef short bf16x8_t __attribute__((ext_vector_type(8)));
__device__ __forceinline__ void ssm_tables(const Frame& F0, int L, unsigned char* base) {
    const Frame F = refresh(F0);
    LAS float* ap_re = (LAS float*)F.lds; LAS float* ap_im = ap_re + 17 * 64;
    LAS float* bb_re = ap_im + 17 * 64;   LAS float* bb_im = bb_re + 1024;
    LAS float* cc_re = bb_im + 1024;      LAS float* cc_im = cc_re + 1024;
    LAS float* kt = cc_im + 1024;         LAS float* dd = kt + 4096;
    const int tid = F.tid;
    for (int item = F.vcu; item < NG * 8; item += F.G) {
        const int g = item >> 3, part = item & 7;
        __syncthreads();
        if (tid < 64) {
            const int p = tid; const float dt = expf(inp(F, I_LSTEP)[L * NG + g]);
            const float lr = inp(F, I_LRE)[(L * NG + g) * SP + p], li = inp(F, I_LIM)[(L * NG + g) * SP + p];
            for (int tau = 0; tau <= 16; ++tau) { const float mg = expf(lr * dt * (float)tau); float sn, cs; sincosf(li * dt * (float)tau, &sn, &cs); ap_re[tau * 64 + p] = mg * cs; ap_im[tau * 64 + p] = mg * sn; }
            const float ab_re = ap_re[64 + p], ab_im = ap_im[64 + p];
            const float den = lr * lr + li * li, nr = ab_re - 1.f;
            const float coef_re = (nr * lr + ab_im * li) / den, coef_im = (ab_im * lr - nr * li) / den;
            const float* br = inp(F, I_BRE) + ((size_t)(L * NG + g) * SP + p) * SG; const float* bi = inp(F, I_BIM) + ((size_t)(L * NG + g) * SP + p) * SG;
            for (int h = 0; h < 16; ++h) { bb_re[p * 16 + h] = coef_re * br[h] - coef_im * bi[h]; bb_im[p * 16 + h] = coef_re * bi[h] + coef_im * br[h]; }
        }
        for (int i = tid; i < 1024; i += NTHREADS) { cc_re[i] = inp(F, I_CRE)[(size_t)(L * NG + g) * SG * SP + i]; cc_im[i] = inp(F, I_CIM)[(size_t)(L * NG + g) * SG * SP + i]; }
        if (tid < 16) dd[tid] = inp(F, I_SSMD)[(L * NG + g) * SG + tid];
        __syncthreads();
        unsigned* F16 = (unsigned*)(base + SSM_F16_OFF) + (size_t)g * 128 * 128;
        for (int i3 = tid; i3 < 16 * 128; i3 += NTHREADS) {
            const int i2 = part * 16 * 128 + i3, row = i2 >> 7, col = (i2 & 127) * 2, p = row & 63, j = col >> 4, h0 = col & 15;
            const float ar = ap_re[(15 - j) * 64 + p], ai = ap_im[(15 - j) * 64 + p];
            float v[2];
#pragma unroll
            for (int q = 0; q < 2; ++q) { const float br = bb_re[p * 16 + h0 + q], bi = bb_im[p * 16 + h0 + q]; v[q] = row < 64 ? (ar * br - ai * bi) : (ar * bi + ai * br); }
            F16[i2] = f2bf(v[0]) | (f2bf(v[1]) << 16);
        }
        for (int i = tid; i < (2 * part + 2) * 256; i += NTHREADS) {
            const int tau = i >> 8, h = (i >> 4) & 15, hp = i & 15; float acc = 0.f;
            for (int p = 0; p < 64; ++p) { const float ar = ap_re[tau * 64 + p], ai = ap_im[tau * 64 + p], br = bb_re[p * 16 + hp], bi = bb_im[p * 16 + hp];
                const float er = ar * br - ai * bi, ei = ar * bi + ai * br; acc += cc_re[h * 64 + p] * er - cc_im[h * 64 + p] * ei; }
            kt[i] = acc;
        }
        __syncthreads();
        unsigned* TG = (unsigned*)(base + SSM_TG_OFF) + (size_t)g * 256 * 192;
        for (int i3 = tid; i3 < 32 * 128; i3 += NTHREADS) {
            const int i2 = part * 32 * 128 + i3, row = i2 >> 7, col = (i2 & 127) * 2, i = row >> 4, h = row & 15, j = col >> 4, h0 = col & 15;
            float v[2] = {0.f, 0.f};
            if (j <= i) {
#pragma unroll
                for (int q = 0; q < 2; ++q) { v[q] = kt[((i - j) * 16 + h) * 16 + h0 + q]; if (i == j && h == h0 + q) v[q] += dd[h]; } }
            TG[row * 192 + (i2 & 127)] = f2bf(v[0]) | (f2bf(v[1]) << 16);
        }
        for (int i3 = tid; i3 < 32 * 64; i3 += NTHREADS) {
            const int i2 = part * 32 * 64 + i3, row = i2 >> 6, c = (i2 & 63) * 2, i = row >> 4, h = row & 15;
            float v[2];
#pragma unroll
            for (int q = 0; q < 2; ++q) { const int p = (c + q) & 63; const float ar = ap_re[(i + 1) * 64 + p], ai = ap_im[(i + 1) * 64 + p], cr = cc_re[h * 64 + p], ci = cc_im[h * 64 + p];
                v[q] = (c + q) < 64 ? (cr * ar - ci * ai) : -(cr * ai + ci * ar); }
            TG[row * 192 + 128 + (i2 & 63)] = f2bf(v[0]) | (f2bf(v[1]) << 16);
        }
    }
    __syncthreads();
}
__device__ __forceinline__ float gelu_fast(float x) { const float u = 1.5957691216057308f * (x + 0.044715f * x * x * x); return x - x * __builtin_amdgcn_rcpf(1.f + __expf(u)); }
__device__ __forceinline__ void ssm_item_mfma(const Frame& F0, int L, int it, const bf16* U, bf16* Z, const unsigned char* tbase, float* vscr) {
    const Frame F = refresh(F0);
    const int g = it & 31, b = it >> 5, tid = F.tid, lane = F.lane, w = F.wave, lr16 = lane & 15, q = lane >> 4;
    LAS unsigned char* X = F.lds;
    { const bf16* ub = U + (size_t)b * SEQ * SSMW + g * 16;
#pragma unroll
      for (int r = 0; r < 4; ++r) { const int t = tid + r * NTHREADS; const v4u* sp = (const v4u*)(ub + (size_t)t * SSMW); const v4u a = sp[0], c = sp[1];
          LAS v4u* dp = (LAS v4u*)(X + (t >> 4) * (SSM_XLD * 2) + (t & 15) * 32); dp[0] = a; dp[1] = c; } }
    __syncthreads();
    { const bf16* F16 = (const bf16*)(tbase + SSM_F16_OFF) + (size_t)g * 128 * 256 + (size_t)(16 * w + lr16) * 256 + 8 * q;
      bf16x8_t af[8];
#pragma unroll
      for (int ks = 0; ks < 8; ++ks) af[ks] = *(const bf16x8_t*)(F16 + ks * 32);
#pragma unroll 1
      for (int nt = 0; nt < 8; ++nt) {
          f32x4 acc = {0.f, 0.f, 0.f, 0.f};
          LAS const unsigned char* xr = X + (16 * nt + lr16) * (SSM_XLD * 2) + 16 * q;
#pragma unroll
          for (int ks = 0; ks < 8; ++ks) { const bf16x8_t bf = *(LAS const bf16x8_t*)(xr + ks * 64); acc = __builtin_amdgcn_mfma_f32_16x16x32_bf16(af[ks], bf, acc, 0, 0, 0); }
          *(f32x4*)(vscr + (size_t)(16 * nt + lr16) * 128 + 16 * w + 4 * q) = acc;
      } }
    asm volatile("s_waitcnt vmcnt(0)" ::: "memory");
    __syncthreads();
    if (w == 0) {
        __builtin_amdgcn_fence(__ATOMIC_ACQUIRE, "agent");
        const int p = lane; const float dt = expf(inp(F, I_LSTEP)[L * NG + g]);
        const float lr = inp(F, I_LRE)[(L * NG + g) * SP + p], li = inp(F, I_LIM)[(L * NG + g) * SP + p];
        const float mg = expf(lr * dt * 16.f); float sn, cs; sincosf(li * dt * 16.f, &sn, &cs); const float a_re = mg * cs, a_im = mg * sn;
        float s_re = 0.f, s_im = 0.f;
        LAS unsigned short* xs = (LAS unsigned short*)X + 256 + p;
        float vr = vscr[p], vi = vscr[64 + p];
#pragma unroll 4
        for (int sc = 0; sc < 128; ++sc) {
            const int nx = sc < 127 ? sc + 1 : sc; const float nvr = vscr[nx * 128 + p], nvi = vscr[nx * 128 + 64 + p];
            xs[sc * SSM_XLD] = (unsigned short)f2bf(s_re); xs[sc * SSM_XLD + 64] = (unsigned short)f2bf(s_im);
            const float t_re = a_re * s_re - a_im * s_im + vr, t_im = a_re * s_im + a_im * s_re + vi; s_re = t_re; s_im = t_im; vr = nvr; vi = nvi;
        }
    }
    __syncthreads();
    { const int mA = w, mB = 15 - w, limA = mA >> 1, limB = mB >> 1;
      const bf16* TGa = (const bf16*)(tbase + SSM_TG_OFF) + (size_t)g * 256 * 384 + (size_t)(16 * mA + lr16) * 384 + 8 * q;
      const bf16* TGb = (const bf16*)(tbase + SSM_TG_OFF) + (size_t)g * 256 * 384 + (size_t)(16 * mB + lr16) * 384 + 8 * q;
      bf16x8_t fa[12], fb[12];
#pragma unroll
      for (int ks = 0; ks < 12; ++ks) { const bf16x8_t zz = {0, 0, 0, 0, 0, 0, 0, 0}; fa[ks] = (ks >= 8 || ks <= limA) ? *(const bf16x8_t*)(TGa + ks * 32) : zz; fb[ks] = (ks >= 8 || ks <= limB) ? *(const bf16x8_t*)(TGb + ks * 32) : zz; }
      bf16* zb = Z + (size_t)b * SEQ * SSMW + g * 16 + 4 * q;
#pragma unroll 1
      for (int nt = 0; nt < 8; ++nt) {
          f32x4 accA = {0.f, 0.f, 0.f, 0.f}, accB = {0.f, 0.f, 0.f, 0.f};
          LAS const unsigned char* xr = X + (16 * nt + lr16) * (SSM_XLD * 2) + 16 * q;
#pragma unroll
          for (int ks = 0; ks < 12; ++ks) { const bf16x8_t bf = *(LAS const bf16x8_t*)(xr + ks * 64);
              if (ks >= 8 || ks <= limA) accA = __builtin_amdgcn_mfma_f32_16x16x32_bf16(fa[ks], bf, accA, 0, 0, 0);
              if (ks >= 8 || ks <= limB) accB = __builtin_amdgcn_mfma_f32_16x16x32_bf16(fb[ks], bf, accB, 0, 0, 0); }
          const int sc = 16 * nt + lr16;
          { v2u o; o.x = f2bf(gelu_fast(accA[0])) | (f2bf(gelu_fast(accA[1])) << 16); o.y = f2bf(gelu_fast(accA[2])) | (f2bf(gelu_fast(accA[3])) << 16); *(v2u*)(zb + (size_t)(16 * sc + mA) * SSMW) = o; }
          { v2u o; o.x = f2bf(gelu_fast(accB[0])) | (f2bf(gelu_fast(accB[1])) << 16); o.y = f2bf(gelu_fast(accB[2])) | (f2bf(gelu_fast(accB[3])) << 16); *(v2u*)(zb + (size_t)(16 * sc + mB) * SSMW) = o; }
      } }
    __syncthreads();
}

__device__ __forceinline__ void router_phase(const Frame& F0, int L, const float* xio, unsigned* ctl, unsigned char* ws) {
    const Frame F = refresh(F0);
    LAS f32x4* Wg = (LAS f32x4*)F.lds; LAS f32x4* Wl = (LAS f32x4*)(F.lds + 16384); LAS f32x4* Wh = (LAS f32x4*)(F.lds + 81920);
    const float* gf = inp(F, I_FFN_G) + L * DM; const float* wrg = inp(F, I_WRG) + (size_t)L * DM * NGRP; const float* wre = inp(F, I_WRE) + (size_t)L * NGRP * DM * EPG;
    for (int k = F.tid; k < DM; k += NTHREADS) Wg[k] = *(const f32x4*)(wrg + (size_t)k * 4) * gf[k];
    for (int idx = F.tid; idx < NGRP * DM; idx += NTHREADS) { const float g = gf[idx & (DM - 1)]; const f32x4* s = (const f32x4*)(wre + (size_t)idx * 8); Wl[idx] = s[0] * g; Wh[idx] = s[1] * g; }
    __syncthreads();
    const float* brg = inp(F, I_BRG) + L * NGRP; const float* bre = inp(F, I_BRE2) + L * NGRP * EPG;
    unsigned* cnt = ctl + CW_CNT + L * 64 * CNT_STRIDE; SlotInfo* slots = (SlotInfo*)(ws + WS_SLOT);
    const int gw = F.vcu * NWAVES + F.wave, NGW = F.G * NWAVES;
    int my_t = -1, my_e0 = 0, my_e1 = 0; float my_w0 = 0.f, my_w1 = 0.f; int nr = 0;
    for (int t = gw; t < T; t += NGW, ++nr) {
        const float* xr = xio + (size_t)t * DM + F.lane;
        float xv[16]; float ss = 0.f;
#pragma unroll
        for (int j = 0; j < 16; ++j) { xv[j] = xr[64 * j]; ss += xv[j] * xv[j]; }
        const float rs = rsqrtf(wave_sum(ss) * (1.f / DM) + EPS);
        f32x4 ag = {0.f, 0.f, 0.f, 0.f};
#pragma unroll
        for (int j = 0; j < 16; ++j) ag += Wg[F.lane + 64 * j] * xv[j];
        float lg[4];
#pragma unroll
        for (int c = 0; c < 4; ++c) lg[c] = wave_sum(ag[c]) * rs + brg[c];
        int grp = 0; float gmax = lg[0];
#pragma unroll
        for (int c = 1; c < 4; ++c) if (lg[c] > gmax) { gmax = lg[c]; grp = c; }
        float gden = 0.f;
#pragma unroll
        for (int c = 0; c < 4; ++c) gden += __expf(lg[c] - gmax);
        const float p_grp = 1.f / gden;
        grp = __builtin_amdgcn_readfirstlane(grp);
        f32x4 al = {0.f, 0.f, 0.f, 0.f}, ah = {0.f, 0.f, 0.f, 0.f};
#pragma unroll
        for (int j = 0; j < 16; ++j) { const int idx = grp * DM + F.lane + 64 * j; al += Wl[idx] * xv[j]; ah += Wh[idx] * xv[j]; }
        float le[8];
#pragma unroll
        for (int c = 0; c < 4; ++c) { le[c] = wave_sum(al[c]) * rs + bre[grp * EPG + c]; le[4 + c] = wave_sum(ah[c]) * rs + bre[grp * EPG + 4 + c]; }
        int i0 = 0; float v0 = le[0];
#pragma unroll
        for (int c = 1; c < 8; ++c) if (le[c] > v0) { v0 = le[c]; i0 = c; }
        int i1 = -1; float v1 = -3.0e38f;
#pragma unroll
        for (int c = 0; c < 8; ++c) if (c != i0 && le[c] > v1) { v1 = le[c]; i1 = c; }
        const float e1 = __expf(v1 - v0);
        const float w0 = p_grp / (1.f + e1), w1 = p_grp * e1 / (1.f + e1);
        if (F.lane == (nr & 63)) { my_t = t; my_e0 = grp * EPG + i0; my_e1 = grp * EPG + i1; my_w0 = w0; my_w1 = w1; }
        if ((nr & 63) == 63 || t + NGW >= T) {
            if (my_t >= 0) {
                const unsigned p0 = atomicAdd(cnt + my_e0 * CNT_STRIDE, 1u), p1 = atomicAdd(cnt + (32 + my_e1) * CNT_STRIDE, 1u);
                slots[(size_t)my_e0 * T + p0] = SlotInfo{my_t, my_w0}; slots[(size_t)(32 + my_e1) * T + p1] = SlotInfo{my_t, my_w1};
            }
            my_t = -1;
        }
    }
}
constexpr int LDS_TB_OFF = 143360;
__device__ __forceinline__ void moe_tables(const Frame& F0, int L, unsigned* ctl) {
    const Frame F = refresh(F0);
    LAS int* tb = (LAS int*)(F.lds + LDS_TB_OFF); LAS int* tc = tb + 80;
    if (F.tid < 64) tc[F.tid] = (int)__hip_atomic_load(ctl + CW_CNT + (L * 64 + F.tid) * CNT_STRIDE, __ATOMIC_RELAXED, __HIP_MEMORY_SCOPE_AGENT);
    __syncthreads();
    if (F.tid == 0) { int s = 0; for (int i = 0; i < 64; ++i) { tb[i] = s; s += (tc[i] + 255) >> 8; } tb[64] = s; }
    __syncthreads();
}
__device__ __forceinline__ void moe_gather_tables(const Frame& F0, const pg8::MoeSched& S, const SlotInfo* slots, const float* part) {
    const Frame F = refresh(F0);
    LAS unsigned* tokoff = (LAS unsigned*)(F.lds + PG8_TOKOFF_OFF); LAS float* ri = (LAS float*)(F.lds + PG8_ROWINFO_OFF);
    pg8::Unit u;
    for (int i = 0; i < 4 && S.next(i, u); ++i) {
        if (F.tid < 256) { const int p = u.mt * 256 + F.tid; SlotInfo si = SlotInfo{0, 0.f};
            if (p < u.cnt) si = slots[(size_t)(u.k * 32 + u.e) * T + p];
            const float rs = pg8::rowscale16(part, si.token);
            tokoff[i * 256 + F.tid] = (unsigned)si.token * (unsigned)(DM * 2); ri[(i * 256 + F.tid) * 2] = si.w; ri[(i * 256 + F.tid) * 2 + 1] = rs; }
    }
    __syncthreads();
}
__device__ __forceinline__ void moe_down_tables(const Frame& F0, const pg8::MoeSched& S, const SlotInfo* slots) {
    const Frame F = refresh(F0);
    LAS int* tk = (LAS int*)(F.lds + PG8_TOKOFF_OFF);
    pg8::Unit u;
    for (int i = 0; i < 4 && S.next(i, u); ++i) {
        if (F.tid < 256) { const int p = u.mt * 256 + F.tid; tk[i * 256 + F.tid] = (p < u.cnt) ? slots[(size_t)(u.k * 32 + u.e) * T + p].token : -1; }
    }
    __syncthreads();
}
__device__ __forceinline__ void fill_rowscales(const Frame& F0, const pg8::StaticOrder& S, const float* part) {
    const Frame F = refresh(F0);
    LAS float* rsl = (LAS float*)(F.lds + PG8_RS_OFF);
    pg8::Unit u; const int half = F.tid >> 8, r = F.tid & 255;
    for (int i = 0; i < 8; i += 2) { if (S.next(i + half, u)) rsl[(i + half) * 256 + r] = pg8::rowscale16(part, u.pm * 256 + r); }
    __syncthreads();
}

__global__ void __launch_bounds__(NTHREADS, 2) mega_fwd(Args args) {
    extern __shared__ __attribute__((aligned(16))) unsigned char lds_raw[];
    Frame Fk;
    Fk.lds = (LAS unsigned char*)lds_raw;
    Fk.tid = threadIdx.x; Fk.lane = Fk.tid & 63; Fk.wave = __builtin_amdgcn_readfirstlane(Fk.tid >> 6);
    Fk.G = gridDim.x; { const int bx = blockIdx.x; Fk.vcu = (Fk.G % 8 == 0) ? (bx % 8) * (Fk.G / 8) + bx / 8 : bx; }
    const Frame& F = Fk;
    volatile LAS unsigned* MISC = (volatile LAS unsigned*)(F.lds + MISC_OFF);
    if (F.tid < 64) MISC[F.tid] = 0u;
    if (F.tid < N_IN) ((LAS unsigned long long*)(F.lds + PTAB_OFF))[F.tid] = (unsigned long long)args.in[F.tid];
    __syncthreads();
    unsigned char* const ws = args.ws;
    XcdBarrier bar = xcd_barrier_post((unsigned*)(ws + WS_CTL) + CW_BAR, MISC + 8);
#define GRID_BAR() xcd_barrier(bar)
#define PHASE_WS unsigned long long wv_ = (unsigned long long)ws; asm volatile("" : "+s"(wv_)); GAS unsigned char* const w_ = (GAS unsigned char*)wv_
    constexpr size_t PARTSZ = (size_t)T * 16 * 4;
    const int NGW = F.G * NWAVES;

    { PHASE_WS; const Frame F = refresh(Fk); const int gw = F.vcu * NWAVES + F.wave;
      float* part = (float*)(w_ + WS_PART); bf16* X0 = (bf16*)(w_ + WS_X0); bf16* PB = (bf16*)(w_ + WS_PB); float* lamv = (float*)(w_ + WS_MISC);
    for (int m = gw; m < T; m += NGW) {
        const f32x4* xr = (const f32x4*)(inp(F, I_X) + (size_t)m * DM) + F.lane; float s = 0.f;
        v2u* o8 = (v2u*)(X0 + (size_t)m * DM) + F.lane;
#pragma unroll
        for (int j = 0; j < 4; ++j) { const f32x4 v = xr[64 * j]; s += v.x * v.x + v.y * v.y + v.z * v.z + v.w * v.w;
            v2u w; w.x = f2bf(v.x) | (f2bf(v.y) << 16); w.y = f2bf(v.z) | (f2bf(v.w) << 16); o8[64 * j] = w; }
        s = wave_sum(s);
        if (F.lane < 16) part[(size_t)m * 16 + F.lane] = (F.lane == 0) ? s : 0.f;
    }
    for (size_t i = (size_t)(blockIdx.x * NTHREADS + F.tid) * 4; i < (size_t)DEPTH * T * PLE; i += (size_t)F.G * NTHREADS * 4) {
        const f32x4 v = *(const f32x4*)(inp(F, I_P) + i); v2u w; w.x = f2bf(v.x) | (f2bf(v.y) << 16); w.y = f2bf(v.z) | (f2bf(v.w) << 16); *(v2u*)(PB + i) = w; }
    if (blockIdx.x == 0 && F.tid < DEPTH) {
        const float* lq = inp(F, I_LAMQK) + F.tid * 4 * HD; float s1 = 0.f, s2 = 0.f;
        for (int j = 0; j < HD; ++j) { s1 += lq[j] * lq[HD + j]; s2 += lq[2 * HD + j] * lq[3 * HD + j]; }
        lamv[F.tid] = expf(s1) - expf(s2) + lam_init_for(F.tid);
    }
    convert_weights(Fk, 0, (unsigned char*)(w_ + WS_WT));
    ssm_tables(Fk, 0, (unsigned char*)(w_ + WS_X1));
    }
    GRID_BAR();

#define GEMM_PHASE(EPI, Aptr, WOFF, N_, K_, E_) do { pg8::Gemm g_{(const pg8::bf16_t*)(Aptr), (const pg8::bf16_t*)(unsigned char*)(w_ + WS_WT + (WOFF)), T, (N_), (K_)}; pg8::StaticOrder S_; S_.init(T, (N_), F.G, (int)blockIdx.x); \
        pg8::gemm_phase<EPI, pg8::StaticOrder, true, true>(F.lds, g_, S_, E_); } while (0)
#define P_XA ((bf16*)(unsigned char*)(w_ + ((L & 1) ? WS_X1 : WS_X0)))
#define P_XB ((bf16*)(unsigned char*)(w_ + ((L & 1) ? WS_X0 : WS_X1)))
#define P_PART ((float*)(unsigned char*)(w_ + WS_PART + (size_t)(L & 1) * PARTSZ))
#define P_PART2 ((float*)(unsigned char*)(w_ + WS_PART + (size_t)((L & 1) ^ 1) * PARTSZ))
#define P_(T_, OFF) ((T_*)(unsigned char*)(w_ + (OFF)))
#pragma unroll 1
    for (int L = 0; L < DEPTH; ++L) {
        if (L > 0) { { PHASE_WS; convert_weights(Fk, L, (unsigned char*)(w_ + WS_WT)); ssm_tables(Fk, L, (unsigned char*)P_XB); } GRID_BAR(); }
        { PHASE_WS; pg8::EpiWinF E{F.lds, P_(bf16, WS_Q), P_(bf16, WS_K), P_(bf16, WS_V), P_(bf16, WS_U), P_(bf16, WS_GATES), inp(F, I_QG) + L * 2 * HD, inp(F, I_KG) + L * 2 * HD, inp(F, I_BGATE) + L * 2 * DM};
          { pg8::StaticOrder S0; S0.init(T, INW, F.G, (int)blockIdx.x); fill_rowscales(Fk, S0, P_PART); }
          GEMM_PHASE(pg8::EpiWinF, P_XA, WT_WIN, INW, DM, E); }
        GRID_BAR();
        { PHASE_WS;
          for (int it = F.vcu; it < BATCH * NG; it += F.G)
              ssm_item_mfma(Fk, L, it, P_(const bf16, WS_U), P_(bf16, WS_Z), (const unsigned char*)P_XB, (float*)((unsigned char*)P_XB + SSM_V_OFF) + (size_t)F.vcu * 16384); }
        { PHASE_WS; const Frame F = refresh(Fk);
          const float lam = P_(float, WS_MISC)[L]; const float oml = 1.f - lam_init_for(L); const float* subln = inp(F, I_SUBLN) + L * 2 * HD;
          static_assert(attn_body::ATTN_LDS_BYTES <= PTAB_OFF, "attention LDS");
          for (int v = F.vcu; v < BATCH * NH * 4; v += F.G) {
              const int bh = v >> 2, s = v & 3;
#pragma unroll 1
              for (int i = 0; i < 2; ++i)
                  attn_body::dattn_unit<8>(bh >> 3, bh & 7, i ? s : 7 - s, P_(const attn_body::bf16, WS_Q), P_(const attn_body::bf16, WS_K), P_(const attn_body::bf16, WS_V), P_(attn_body::bf16, WS_Q), (char*)lds_raw, lam, subln, oml);
          } }
        GRID_BAR();
        { PHASE_WS; pg8::EpiGluF E{P_(bf16, WS_Z), P_(bf16, WS_Z2), inp(F, I_BGLU) + L * SSMW}; GEMM_PHASE(pg8::EpiGluF, P_(bf16, WS_Z), WT_WGLU, SSMW, SSMW, E); }
        GRID_BAR();
        { PHASE_WS; pg8::EpiGateF E{P_(bf16, WS_GATES), DM, nullptr, P_(bf16, WS_PARTS)}; GEMM_PHASE(pg8::EpiGateF, P_(bf16, WS_Z2), WT_WSU, DM, SSMW, E); }
        GRID_BAR();
        { PHASE_WS; pg8::EpiGateF E{P_(bf16, WS_GATES), 0, P_(bf16, WS_PARTS), P_(bf16, WS_MIXED)}; GEMM_PHASE(pg8::EpiGateF, P_(bf16, WS_Q), WT_WAU, DM, VW, E); }
        GRID_BAR();
        { PHASE_WS; const float* xbase = (L == 0) ? inp(F, I_X) : args.out;
          pg8::EpiResF E{xbase, args.out, P_XB, P_PART2}; GEMM_PHASE(pg8::EpiResF, P_(bf16, WS_MIXED), WT_WOUT, DM, DM, E); }
        GRID_BAR();
        { PHASE_WS; pg8::EpiPlainF E{P_(bf16, WS_PLE), DM}; GEMM_PHASE(pg8::EpiPlainF, P_(bf16, WS_PB) + (size_t)L * T * PLE, WT_WPLE, DM, PLE, E);
          router_phase(Fk, L, args.out, P_(unsigned, WS_CTL), (unsigned char*)w_); }
        GRID_BAR();
        { PHASE_WS; moe_tables(Fk, L, P_(unsigned, WS_CTL));
          pg8::MoeSched S{(LAS const int*)(F.lds + LDS_TB_OFF), (LAS const int*)(F.lds + LDS_TB_OFF) + 80, F.G, (int)blockIdx.x, 0};
          moe_gather_tables(Fk, S, P_(const SlotInfo, WS_SLOT), P_PART2);
          pg8::Gemm g{(const pg8::bf16_t*)P_XB, (const pg8::bf16_t*)(unsigned char*)(w_ + WS_WT + WT_WGU), T, 512, DM};
          pg8::EpiActF E{P_(pg8::bf16_t, WS_ACT), F.lds};
          pg8::gemm_phase_g<pg8::EpiActF, pg8::MoeSched>(F.lds, g, S, E); }
        GRID_BAR();
        { PHASE_WS; moe_tables(Fk, L, P_(unsigned, WS_CTL));
          pg8::MoeSched S{(LAS const int*)(F.lds + LDS_TB_OFF), (LAS const int*)(F.lds + LDS_TB_OFF) + 80, F.G, (int)blockIdx.x, 1};
          pg8::Gemm g{P_(const pg8::bf16_t, WS_ACT), (const pg8::bf16_t*)(unsigned char*)(w_ + WS_WT + WT_WD), T, DM, EFF};
          moe_down_tables(Fk, S, P_(const SlotInfo, WS_SLOT));
          pg8::EpiDownF<0> E{F.lds, args.out, P_XA, P_PART};
          pg8::gemm_phase<pg8::EpiDownF<0>, pg8::MoeSched, true, true>(F.lds, g, S, E); }
        GRID_BAR();
        { PHASE_WS; moe_tables(Fk, L, P_(unsigned, WS_CTL));
          pg8::MoeSched S{(LAS const int*)(F.lds + LDS_TB_OFF), (LAS const int*)(F.lds + LDS_TB_OFF) + 80, F.G, (int)blockIdx.x, 2};
          pg8::Gemm g{P_(const pg8::bf16_t, WS_ACT), (const pg8::bf16_t*)(unsigned char*)(w_ + WS_WT + WT_WD), T, DM, EFF};
          moe_down_tables(Fk, S, P_(const SlotInfo, WS_SLOT));
          pg8::EpiDownF<1> E{F.lds, args.out, P_XA, P_PART};
          pg8::gemm_phase<pg8::EpiDownF<1>, pg8::MoeSched, true, true>(F.lds, g, S, E); }
        GRID_BAR();
        { PHASE_WS; pg8::EpiPleF E{F.lds, P_(bf16, WS_PLE), args.out, P_XB, P_PART2};
          { pg8::StaticOrder S0; S0.init(T, DM, F.G, (int)blockIdx.x); fill_rowscales(Fk, S0, P_PART); }
          GEMM_PHASE(pg8::EpiPleF, P_XA, WT_WPG, DM, DM, E); }
        GRID_BAR();
    }
}

extern "C" void kernel_launch(void* const* d_in, const int* in_sizes, int n_in, void* d_out, int out_size, void* d_ws, size_t ws_size, hipStream_t stream) {
    static int grid = 0;
    if (grid == 0) {
        if (n_in != N_IN || in_sizes[0] != T * DM || out_size != T * DM || ws_size < WS_END) {
            fprintf(stderr, "kernel_launch: unexpected problem (n_in %d, in0 %d, out %d, ws %zu); nothing launched\n", n_in, n_in > 0 ? in_sizes[0] : -1, out_size, ws_size); grid = -1; return; }
        int dev = 0, cus = 0, per_cu = 0;
        if (hipGetDevice(&dev) != hipSuccess || hipDeviceGetAttribute(&cus, hipDeviceAttributeMultiprocessorCount, dev) != hipSuccess) { grid = -1; return; }
        if (hipFuncSetAttribute((const void*)mega_fwd, hipFuncAttributeMaxDynamicSharedMemorySize, LDS_BYTES) != hipSuccess) { fprintf(stderr, "kernel_launch: hipFuncSetAttribute failed\n"); grid = -1; return; }
        if (hipOccupancyMaxActiveBlocksPerMultiprocessor(&per_cu, (const void*)mega_fwd, NTHREADS, LDS_BYTES) != hipSuccess || per_cu < 1)
            fprintf(stderr, "kernel_launch: note: occupancy query reports %d workgroups per CU\n", per_cu);
        (void)hipGetLastError();
        grid = cus;
    }
    if (grid < 0) return;
    if (hipMemsetAsync((char*)d_ws + WS_CTL, 0, CTL_ZERO_BYTES, stream) != hipSuccess) { fprintf(stderr, "kernel_launch: memset failed\n"); return; }
    Args a{};
    for (int i = 0; i < N_IN; ++i) a.in[i] = (const float*)d_in[i];
    a.out = (float*)d_out; a.ws = (unsigned char*)d_ws;
    hipLaunchKernelGGL(mega_fwd, dim3(grid), dim3(NTHREADS), LDS_BYTES, stream, a);
    const hipError_t le = hipPeekAtLastError();
    if (le != hipSuccess) fprintf(stderr, "kernel_launch: launch failed: %s\n", hipGetErrorName(le));
}
```

```cpp
#include <hip/hip_runtime.h>
#include <cstdio>
#include <cstdint>
#include <cmath>
#include <hip/hip_bf16.h>

#define GAS __attribute__((address_space(1)))
#define LAS __attribute__((address_space(3)))
typedef unsigned short bf16;
typedef unsigned v4u __attribute__((ext_vector_type(4)));
typedef unsigned v2u __attribute__((ext_vector_type(2)));
typedef float f32x4 __attribute__((ext_vector_type(4)));

constexpr int DM = 1024, BATCH = 8, SEQ = 2048, T = BATCH * SEQ, DEPTH = 2;
constexpr int NH = 8, HD = 64, QKW = 1024, VW = 1024, SSMW = 512, SG = 16, NG = 32, SP = 64;
constexpr int INW = 5632, NGRP = 4, EPG = 8, NEXP = 32, EFF = 256, PLE = 256;
constexpr float EPS = 1e-6f;
constexpr float C2 = 0.125f * 1.4426950408889634f;
constexpr int NWAVES = 8, NTHREADS = 512;

enum { I_X = 0, I_P, I_ATTN_G, I_WIN, I_BGATE, I_QG, I_KG, I_LAMQK, I_SUBLN, I_WAU, I_LRE, I_LIM, I_LSTEP, I_BRE, I_BIM, I_CRE, I_CIM,
       I_SSMD, I_WGLU, I_BGLU, I_WSU, I_WOUT, I_FFN_G, I_WRG, I_BRG, I_WRE, I_BRE2, I_WEG, I_WEU, I_WED, I_PLE_G, I_WPG, I_WPLE, N_IN };

constexpr size_t MiB = 1u << 20;
constexpr size_t WS_CTL = 0, CTL_ZERO_BYTES = 1 * MiB;
constexpr size_t WS_PART = 1 * MiB;
constexpr size_t WS_MISC = 3 * MiB;
constexpr size_t WS_SLOT = 4 * MiB;
constexpr size_t WS_WT = 16 * MiB;
constexpr size_t WS_X0 = 84 * MiB, WS_X1 = 116 * MiB;
constexpr size_t WS_Q = 148 * MiB, WS_K = 180 * MiB, WS_V = 212 * MiB;
constexpr size_t WS_U = 244 * MiB, WS_Z = 260 * MiB;
constexpr size_t WS_GATES = 276 * MiB;
constexpr size_t WS_PB = 340 * MiB;
constexpr size_t WS_END = 356 * MiB;
constexpr size_t WS_Z2 = WS_K, WS_MIXED = WS_K, WS_PARTS = WS_V, WS_PLE = WS_GATES, WS_OTMP = WS_X0, WS_ACT = WS_V;
struct SlotInfo { int token; float w; };
constexpr int CW_BAR = 4096;
constexpr int CW_CNT = 8192, CNT_STRIDE = 64;

__device__ __forceinline__ unsigned f2bf(float f) { unsigned u = __builtin_bit_cast(unsigned, f); return (u + 0x7fffu + ((u >> 16) & 1u)) >> 16; }
__device__ __forceinline__ float bf2f(unsigned b) { return __builtin_bit_cast(float, b << 16); }
__device__ __forceinline__ float bflo(unsigned w) { return __builtin_bit_cast(float, w << 16); }
__device__ __forceinline__ float bfhi(unsigned w) { return __builtin_bit_cast(float, w & 0xffff0000u); }
__device__ __forceinline__ float wave_sum(float v) {
#pragma unroll
    for (int o = 1; o < 64; o <<= 1) v += __shfl_xor(v, o);
    return v;
}
__device__ __forceinline__ float sigmoidf_(float x) { return 1.f / (1.f + __expf(-x)); }
__device__ __forceinline__ float gelu_tanh(float x) { const float u = 0.7978845608028654f * (x + 0.044715f * x * x * x); return 0.5f * x * (1.f + tanhf(u)); }
__device__ __forceinline__ float rowscale(const float* part, int row) {
    const f32x4* p = (const f32x4*)(part + (size_t)row * 16);
    float s = 0.f;
#pragma unroll
    for (int i = 0; i < 4; ++i) { const f32x4 v = p[i]; s += v.x; s += v.y; s += v.z; s += v.w; }
    return rsqrtf(s * (1.f / DM) + EPS);
}
__host__ __device__ inline float lam_init_for(int i) { return 0.8f - 0.6f * expf(-0.3f * (float)i); }

#define XB_TMO      128
#define XB_XCNT(j)  (256  + 64 * (j))
#define XB_XSUB(j)  (1280 + 64 * (j))
#define XB_XGEN(j)  (2304 + 64 * (j))
#define XB_TOP      3328
#define XB_TOPGEN   3392
#define XCD_BAR_WORDS 3456
#define XB_SPIN_CAP (1u << 22)
__device__ __forceinline__ unsigned xb_ld(unsigned* p)              { return __hip_atomic_load(p, __ATOMIC_RELAXED, __HIP_MEMORY_SCOPE_AGENT); }
__device__ __forceinline__ unsigned xb_add(unsigned* p, unsigned v) { return __hip_atomic_fetch_add(p, v, __ATOMIC_RELAXED, __HIP_MEMORY_SCOPE_AGENT); }
__device__ __forceinline__ unsigned xb_xcc_id() { return (unsigned)__builtin_amdgcn_s_getreg((3 << 11) | 20) & 0xFu; }
#define XB_SPIN(cond, bar) do { unsigned _sp = 0; while (cond) { __builtin_amdgcn_s_sleep(1); \
    if ((++_sp & 255u) == 0u) { if (xb_ld(&(bar)[XB_TMO])) break; if (_sp > XB_SPIN_CAP) { atomicAdd(&(bar)[XB_TMO], 1u); break; } } } } while (0)
struct XcdBarrier { unsigned* bar; unsigned x; volatile LAS unsigned* st; };
__device__ __forceinline__ XcdBarrier xcd_barrier_post(unsigned* bar, volatile LAS unsigned* st) {
    XcdBarrier b; b.bar = bar; b.x = 0; b.st = st;
    if (threadIdx.x == 0) { const unsigned x = xb_xcc_id(); st[2] = x; (void)xb_add(&bar[XB_XCNT(x)], 1u); }
    return b;
}
__device__ __forceinline__ void xcd_barrier_complete(unsigned* bar, unsigned x, unsigned& nloc, unsigned& nx) {
    const unsigned G = gridDim.x * gridDim.y * gridDim.z;
    unsigned sum, cnt, mine, sp = 0u;
    for (;;) {
        sum = 0u; cnt = 0u; mine = 0u;
#pragma unroll
        for (unsigned j = 0; j < 16; ++j) { const unsigned c = xb_ld(&bar[XB_XCNT(j)]); sum += c; cnt += (c > 0u) ? 1u : 0u; mine = (j == x) ? c : mine; }
        if (sum == G) break;
        __builtin_amdgcn_s_sleep(1);
        if ((++sp & 255u) == 0u) { if (xb_ld(&bar[XB_TMO])) break; if (sp > XB_SPIN_CAP) { atomicAdd(&bar[XB_TMO], 1u); break; } }
    }
    nloc = mine > 0u ? mine : 1u; nx = cnt > 0u ? cnt : 1u;
}
__device__ __forceinline__ void xcd_barrier(const XcdBarrier& b) {
    asm volatile("s_waitcnt vmcnt(0)" ::: "memory");
    __syncthreads();
    if (threadIdx.x == 0) {
        unsigned* bar = b.bar;
        __builtin_amdgcn_s_waitcnt(0);
        unsigned nloc = b.st[0], nx = b.st[1]; const unsigned bx = b.st[2];
        if (nloc == 0u) { xcd_barrier_complete(bar, bx, nloc, nx); b.st[0] = nloc; b.st[1] = nx; }
        const unsigned old = xb_add(&bar[XB_XSUB(bx)], 1u);
        const unsigned gen = old / nloc;
        if (old + 1u == (gen + 1u) * nloc) {
            __builtin_amdgcn_fence(__ATOMIC_RELEASE, "agent");
            asm volatile("s_waitcnt vmcnt(0)" ::: "memory");
            const unsigned og = xb_add(&bar[XB_TOP], 1u);
            const unsigned tg = og / nx;
            if (og + 1u == (tg + 1u) * nx) xb_add(&bar[XB_TOPGEN], 1u);
            else XB_SPIN(xb_ld(&bar[XB_TOPGEN]) == tg, bar);
            __builtin_amdgcn_fence(__ATOMIC_ACQUIRE, "agent");
            xb_add(&bar[XB_XGEN(bx)], 1u);
            asm volatile("s_waitcnt vmcnt(0)" ::: "memory");
        } else {
            XB_SPIN(xb_ld(&bar[XB_XGEN(bx)]) == gen, bar);
            __builtin_amdgcn_fence(__ATOMIC_ACQUIRE, "agent");
            asm volatile("s_waitcnt vmcnt(0)" ::: "memory");
        }
    }
    __syncthreads();
}

constexpr int LDS_BYTES = 160 * 1024 - 1024;
constexpr int MISC_OFF = LDS_BYTES - 256;
constexpr int PTAB_OFF = LDS_BYTES - 1024;

struct Args { const float* in[N_IN]; float* out; unsigned char* ws; };

struct Frame {
    LAS unsigned char* lds;
    int tid, lane, wave, vcu, G;
};
__device__ __forceinline__ Frame refresh(const Frame& F0) {
    Frame F = F0; int t = F0.tid; asm volatile("" : "+v"(t)); F.tid = t; F.lane = t & 63; F.wave = __builtin_amdgcn_readfirstlane(t >> 6); return F;
}
__device__ __forceinline__ const float* inp(const Frame& F, int i) {
    const LAS unsigned* p = (const LAS unsigned*)(F.lds + PTAB_OFF) + 2 * i;
    const unsigned lo = __builtin_amdgcn_readfirstlane(p[0]), hi = __builtin_amdgcn_readfirstlane(p[1]);
    return (const float*)(const GAS float*)(((unsigned long long)hi << 32) | lo);
}

namespace pg8 {
#define PG8_LAS __attribute__((address_space(3)))
typedef unsigned short bf16_t;
typedef short bf16x8 __attribute__((ext_vector_type(8)));
typedef float f32x4 __attribute__((ext_vector_type(4)));
typedef unsigned u32x4 __attribute__((ext_vector_type(4)));
constexpr int BM = 256, BK = 64, HALF = 128, HTB = HALF * BK * 2  , STAGE_BYTES = 8 * HTB, NXCD = 8, WGM = 8;

__host__ __device__ __forceinline__ int lds_byte(int r, int c) { const int st = (r >> 4) * 2 + (c >> 5), rr = r & 15, cc = c & 31, ob = rr * 64 + cc * 2; return st * 1024 + (ob ^ (((ob >> 9) & 1) << 5)); }
__host__ __device__ __forceinline__ void stage_rc(int b, int& R, int& C) { const int st = b / 1024, sb = b % 1024, swz = sb ^ (((sb >> 9) & 1) << 5); R = (st >> 1) * 16 + swz / 64; C = (st & 1) * 32 + (swz % 64) / 2; }
__host__ __device__ __forceinline__ int perm32(int rho) { const int n = rho >> 4, i = rho & 15; return 8 * (i >> 2) + 4 * n + (i & 3); }

struct Unit { int pm, pn, e, mt, cnt, pl, k, slot; };
struct Gemm { const bf16_t* A; const bf16_t* Bt; int M, N, K; };

struct StaticOrder {
    int nM, nN, nwg, G, c;
    __host__ __device__ void init(int M, int N, int G_, int c_) { nM = M / BM; nN = N / BM; nwg = nM * nN; G = G_; c = c_; }
    __host__ __device__ bool next(int i, Unit& u) const {
        const long L = (long)i * G + c; if (L >= nwg) return false;
        int wgid = (int)L; { const int q = nwg / NXCD, r = nwg % NXCD, xcd = wgid % NXCD, off = wgid / NXCD; wgid = (xcd < r ? xcd * (q + 1) : r * (q + 1) + (xcd - r) * q) + off; }
        const int nig = WGM * nN, gid = wgid / nig, fm = gid * WGM, gsz = (nM - fm) < WGM ? (nM - fm) : WGM;
        u.pm = fm + ((wgid % nig) % gsz); u.pn = (wgid % nig) / gsz; u.slot = i; return true;
    }
    __device__ __forceinline__ void a_ready(const Unit&) const {}
    __device__ __forceinline__ void done(const Unit&) const {}
};
typedef float f32x2_t __attribute__((ext_vector_type(2))); typedef __bf16 bf16x2_t __attribute__((ext_vector_type(2)));
__device__ __forceinline__ unsigned cvt_pk_bf16(float lo, float hi) { f32x2_t v = {lo, hi}; bf16x2_t b = __builtin_convertvector(v, bf16x2_t); return __builtin_bit_cast(unsigned, b); }

__device__ __forceinline__ float rowscale16(const float* part, int row) {
    const f32x4* p = (const f32x4*)(part + (size_t)row * 16); float s = 0.f;
#pragma unroll
    for (int i = 0; i < 4; ++i) { const f32x4 v = p[i]; s += v[0]; s += v[1]; s += v[2]; s += v[3]; }
    return rsqrtf(s * (1.f / 1024.f) + EPS);
}
__device__ __forceinline__ u32x4 pack8(f32x4 a, f32x4 b) { u32x4 w; w.x = cvt_pk_bf16(a[0], a[1]); w.y = cvt_pk_bf16(a[2], a[3]); w.z = cvt_pk_bf16(b[0], b[1]); w.w = cvt_pk_bf16(b[2], b[3]); return w; }
__device__ __forceinline__ void unpack8(u32x4 w, f32x4& a, f32x4& b) {
    a = (f32x4){__builtin_bit_cast(float, w.x << 16), __builtin_bit_cast(float, w.x & 0xffff0000u), __builtin_bit_cast(float, w.y << 16), __builtin_bit_cast(float, w.y & 0xffff0000u)};
    b = (f32x4){__builtin_bit_cast(float, w.z << 16), __builtin_bit_cast(float, w.z & 0xffff0000u), __builtin_bit_cast(float, w.w << 16), __builtin_bit_cast(float, w.w & 0xffff0000u)};
}
__device__ __forceinline__ float sig1(float x) { return __builtin_amdgcn_rcpf(1.f + __builtin_amdgcn_exp2f(-1.4426950408889634f * x)); }
__device__ __forceinline__ f32x4 sig4(f32x4 x) { return (f32x4){sig1(x[0]), sig1(x[1]), sig1(x[2]), sig1(x[3])}; }
__device__ __forceinline__ float dot4(f32x4 x) { return (x[0] * x[0] + x[1] * x[1]) + (x[2] * x[2] + x[3] * x[3]); }

#define PG8_TOKOFF_OFF 131072
#define PG8_ROWINFO_OFF 135168
#define PG8_RS_OFF 144384
struct EpiWinF {
    static constexpr bool PERM = false, AFTER_DRAIN = false;
    PG8_LAS const unsigned char* lds; bf16_t *q, *k, *v, *u, *gates; const float *qg, *kg, *bgate;
    __device__ __forceinline__ void operator()(const f32x4 (&acc)[2][2][4][2], const Unit& un, int wr, int wc, int, int) const {
        int l_ = threadIdx.x; asm volatile("" : "+v"(l_)); const int fr = l_ & 15, fq = (l_ >> 4) & 3;
        const int pn = un.pn, rl0 = wr * 64 + fr; const size_t row0 = (size_t)un.pm * BM + rl0;
        PG8_LAS const float* rsl = (PG8_LAS const float*)(lds + PG8_RS_OFF) + un.slot * 256 + rl0;
        if (pn < 8) {
            const bool isq = pn < 4; bf16_t* dst = isq ? q : k; const int cb = (pn & 3) * 256 + wc * 64 + fq * 8;
            const float* gn = (isq ? qg : kg) + (wc & 1) * 64 + fq * 8; const float sc = isq ? C2 : 1.f;
            f32x4 gv[2][2];
#pragma unroll
            for (int bj = 0; bj < 2; ++bj)
#pragma unroll
                for (int n = 0; n < 2; ++n) gv[bj][n] = *(const f32x4*)(gn + bj * 32 + n * 4) * sc;
#pragma unroll
            for (int ai = 0; ai < 2; ++ai)
#pragma unroll
                for (int m = 0; m < 4; ++m) {
                    const float rs = rsl[ai * HALF + m * 16];
                    float ss = (dot4(acc[ai][0][m][0]) + dot4(acc[ai][0][m][1])) + (dot4(acc[ai][1][m][0]) + dot4(acc[ai][1][m][1]));
                    ss += __shfl_xor(ss, 16); ss += __shfl_xor(ss, 32);
                    const float inv = rsqrtf(ss * rs * rs * (1.f / 64.f) + EPS) * rs;
                    bf16_t* rowp = dst + (row0 + ai * HALF + m * 16) * 1024 + cb;
#pragma unroll
                    for (int bj = 0; bj < 2; ++bj) *(u32x4*)(rowp + bj * 32) = pack8(acc[ai][bj][m][0] * inv * gv[bj][0], acc[ai][bj][m][1] * inv * gv[bj][1]);
                }
        } else if (pn < 14) {
            bf16_t* dst; int ld, cb;
            if (pn < 12) { dst = v; ld = 1024; cb = (pn - 8) * 256; } else { dst = u; ld = 512; cb = (pn - 12) * 256; }
            cb += wc * 64 + fq * 8;
#pragma unroll
            for (int ai = 0; ai < 2; ++ai)
#pragma unroll
                for (int m = 0; m < 4; ++m) {
                    const float rs = rsl[ai * HALF + m * 16];
                    bf16_t* rowp = dst + (row0 + ai * HALF + m * 16) * ld + cb;
#pragma unroll
                    for (int bj = 0; bj < 2; ++bj) *(u32x4*)(rowp + bj * 32) = pack8(acc[ai][bj][m][0] * rs, acc[ai][bj][m][1] * rs);
                }
        } else {
            const int cb = (pn - 14) * 256 + wc * 64 + fq * 8;
            f32x4 bv[2][2];
#pragma unroll
            for (int bj = 0; bj < 2; ++bj)
#pragma unroll
                for (int n = 0; n < 2; ++n) bv[bj][n] = *(const f32x4*)(bgate + cb + bj * 32 + n * 4);
#pragma unroll
            for (int ai = 0; ai < 2; ++ai)
#pragma unroll
                for (int m = 0; m < 4; ++m) {
                    const float rs = rsl[ai * HALF + m * 16];
                    bf16_t* rowp = gates + (row0 + ai * HALF + m * 16) * 2048 + cb;
#pragma unroll
                    for (int bj = 0; bj < 2; ++bj) *(u32x4*)(rowp + bj * 32) = pack8(sig4(acc[ai][bj][m][0] * rs + bv[bj][0]), sig4(acc[ai][bj][m][1] * rs + bv[bj][1]));
                }
        }
    }
};
struct EpiGluF {
    static constexpr bool PERM = false, AFTER_DRAIN = false;
    const bf16_t* z; bf16_t* z2; const float* b;
    __device__ __forceinline__ void operator()(const f32x4 (&acc)[2][2][4][2], const Unit& un, int wr, int wc, int, int) const {
        int l_ = threadIdx.x; asm volatile("" : "+v"(l_)); const int fr = l_ & 15, fq = (l_ >> 4) & 3;
        const int cb = un.pn * 256 + wc * 64 + fq * 8; const size_t row0 = (size_t)un.pm * BM + wr * 64 + fr;
        f32x4 bv[2][2];
#pragma unroll
        for (int bj = 0; bj < 2; ++bj)
#pragma unroll
            for (int n = 0; n < 2; ++n) bv[bj][n] = *(const f32x4*)(b + cb + bj * 32 + n * 4);
#pragma unroll
        for (int ai = 0; ai < 2; ++ai) {
            u32x4 zw[4][2];
#pragma unroll
            for (int m = 0; m < 4; ++m)
#pragma unroll
                for (int bj = 0; bj < 2; ++bj) zw[m][bj] = *(const u32x4*)(z + (row0 + ai * HALF + m * 16) * 512 + cb + bj * 32);
#pragma unroll
            for (int m = 0; m < 4; ++m)
#pragma unroll
                for (int bj = 0; bj < 2; ++bj) { f32x4 z0, z1; unpack8(zw[m][bj], z0, z1);
                    *(u32x4*)(z2 + (row0 + ai * HALF + m * 16) * 512 + cb + bj * 32) = pack8(z0 * sig4(acc[ai][bj][m][0] + bv[bj][0]), z1 * sig4(acc[ai][bj][m][1] + bv[bj][1])); }
        }
    }
};
struct EpiPlainF {
    static constexpr bool PERM = false, AFTER_DRAIN = false;
    bf16_t* o; int ld;
    __device__ __forceinline__ void operator()(const f32x4 (&acc)[2][2][4][2], const Unit& un, int wr, int wc, int, int) const {
        int l_ = threadIdx.x; asm volatile("" : "+v"(l_)); const int fr = l_ & 15, fq = (l_ >> 4) & 3;
        const int row0 = un.pm * BM + wr * 64 + fr, cb = un.pn * 256 + wc * 64 + fq * 8;
#pragma unroll
        for (int ai = 0; ai < 2; ++ai)
#pragma unroll
            for (int m = 0; m < 4; ++m) {
                const int row = row0 + ai * HALF + m * 16;
#pragma unroll
                for (int bj = 0; bj < 2; ++bj) *(u32x4*)(o + (size_t)row * ld + cb + bj * 32) = pack8(acc[ai][bj][m][0], acc[ai][bj][m][1]);
            }
    }
};
struct EpiGateF {
    static constexpr bool PERM = false, AFTER_DRAIN = false;
    const bf16_t* gates; int goff; const bf16_t* add; bf16_t* o;
    __device__ __forceinline__ void operator()(const f32x4 (&acc)[2][2][4][2], const Unit& un, int wr, int wc, int, int) const {
        int l_ = threadIdx.x; asm volatile("" : "+v"(l_)); const int fr = l_ & 15, fq = (l_ >> 4) & 3;
        const int cb = un.pn * 256 + wc * 64 + fq * 8; const size_t row0 = (size_t)un.pm * BM + wr * 64 + fr;
#pragma unroll
        for (int ai = 0; ai < 2; ++ai) {
            u32x4 gw[4][2], aw[4][2];
#pragma unroll
            for (int m = 0; m < 4; ++m)
#pragma unroll
                for (int bj = 0; bj < 2; ++bj) { const size_t row = row0 + ai * HALF + m * 16; const int c = cb + bj * 32;
                    gw[m][bj] = *(const u32x4*)(gates + row * 2048 + goff + c); if (add) aw[m][bj] = *(const u32x4*)(add + row * 1024 + c); }
#pragma unroll
            for (int m = 0; m < 4; ++m)
#pragma unroll
                for (int bj = 0; bj < 2; ++bj) { const size_t row = row0 + ai * HALF + m * 16; const int c = cb + bj * 32; f32x4 g0, g1; unpack8(gw[m][bj], g0, g1);
                    f32x4 v0 = g0 * acc[ai][bj][m][0], v1 = g1 * acc[ai][bj][m][1];
                    if (add) { f32x4 a0, a1; unpack8(aw[m][bj], a0, a1); v0 += a0; v1 += a1; }
                    *(u32x4*)(o + row * 1024 + c) = pack8(v0, v1); }
        }
    }
};
struct EpiResF {
    static constexpr bool PERM = false, AFTER_DRAIN = false;
    const float* base; float* out; bf16_t* xb; float* part;
    __device__ __forceinline__ void operator()(const f32x4 (&acc)[2][2][4][2], const Unit& un, int wr, int wc, int, int) const {
        int l_ = threadIdx.x; asm volatile("" : "+v"(l_)); const int fr = l_ & 15, fq = (l_ >> 4) & 3;
        const int cb = un.pn * 256 + wc * 64 + fq * 8; const size_t row0 = (size_t)un.pm * BM + wr * 64 + fr;
#pragma unroll
        for (int ai = 0; ai < 2; ++ai) {
            f32x4 bl[4][2][2];
#pragma unroll
            for (int m = 0; m < 4; ++m)
#pragma unroll
                for (int bj = 0; bj < 2; ++bj) { const size_t o = (row0 + ai * HALF + m * 16) * 1024 + cb + bj * 32; bl[m][bj][0] = *(const f32x4*)(base + o); bl[m][bj][1] = *(const f32x4*)(base + o + 4); }
#pragma unroll
            for (int m = 0; m < 4; ++m) {
                const size_t row = row0 + ai * HALF + m * 16; float ss = 0.f;
#pragma unroll
                for (int bj = 0; bj < 2; ++bj) { const size_t o = row * 1024 + cb + bj * 32;
                    const f32x4 v0 = bl[m][bj][0] + acc[ai][bj][m][0], v1 = bl[m][bj][1] + acc[ai][bj][m][1];
                    *(f32x4*)(out + o) = v0; *(f32x4*)(out + o + 4) = v1; *(u32x4*)(xb + o) = pack8(v0, v1); ss += dot4(v0) + dot4(v1); }
                ss += __shfl_xor(ss, 16); ss += __shfl_xor(ss, 32);
                if (fq == 0) part[row * 16 + un.pn * 4 + wc] = ss;
            }
        }
    }
};
struct EpiPleF {
    static constexpr bool PERM = false, AFTER_DRAIN = false;
    PG8_LAS const unsigned char* lds; const bf16_t* ple; float* out; bf16_t* xb; float* part_out;
    __device__ __forceinline__ void operator()(const f32x4 (&acc)[2][2][4][2], const Unit& un, int wr, int wc, int, int) const {
        int l_ = threadIdx.x; asm volatile("" : "+v"(l_)); const int fr = l_ & 15, fq = (l_ >> 4) & 3;
        const int cb = un.pn * 256 + wc * 64 + fq * 8, rl0 = wr * 64 + fr; const size_t row0 = (size_t)un.pm * BM + rl0;
        PG8_LAS const float* rsl = (PG8_LAS const float*)(lds + PG8_RS_OFF) + un.slot * 256 + rl0;
#pragma unroll
        for (int ai = 0; ai < 2; ++ai)
#pragma unroll
            for (int mp = 0; mp < 2; ++mp) {
                u32x4 pw[2][2]; f32x4 xl[2][2][2];
#pragma unroll
                for (int mm = 0; mm < 2; ++mm)
#pragma unroll
                    for (int bj = 0; bj < 2; ++bj) { const size_t o = (row0 + ai * HALF + (2 * mp + mm) * 16) * 1024 + cb + bj * 32; pw[mm][bj] = *(const u32x4*)(ple + o); xl[mm][bj][0] = *(const f32x4*)(out + o); xl[mm][bj][1] = *(const f32x4*)(out + o + 4); }
#pragma unroll
                for (int mm = 0; mm < 2; ++mm) {
                    const int m = 2 * mp + mm; const size_t row = row0 + ai * HALF + m * 16; const float rs = rsl[ai * HALF + m * 16]; float ss = 0.f;
#pragma unroll
                    for (int bj = 0; bj < 2; ++bj) { const size_t o = row * 1024 + cb + bj * 32; f32x4 p0, p1; unpack8(pw[mm][bj], p0, p1);
                        const f32x4 v0 = xl[mm][bj][0] + sig4(acc[ai][bj][m][0] * rs) * p0, v1 = xl[mm][bj][1] + sig4(acc[ai][bj][m][1] * rs) * p1;
                        *(f32x4*)(out + o) = v0; *(f32x4*)(out + o + 4) = v1; *(u32x4*)(xb + o) = pack8(v0, v1); ss += dot4(v0) + dot4(v1); }
                    ss += __shfl_xor(ss, 16); ss += __shfl_xor(ss, 32);
                    if (fq == 0) part_out[row * 16 + un.pn * 4 + wc] = ss;
                }
            }
    }
};
template <class Epi, class Sched, bool ALIGN_EPI = false, bool SP2 = false>
__device__ __forceinline__ void gemm_phase(PG8_LAS unsigned char* lds, const Gemm g, const Sched& S, const Epi& E) {
    int tid_ = threadIdx.x; asm volatile("" : "+v"(tid_)); const int tid = tid_, wid = __builtin_amdgcn_readfirstlane(tid >> 6), lane = tid & 63, wr = wid >> 2, wc = wid & 3, fr = lane & 15, fq = lane >> 4;
    const int K = g.K, nt = K / BK;
    unsigned voffA[2], voffB[2];
#pragma unroll
    for (int i = 0; i < 2; ++i) { int R, C; stage_rc(tid * 16 + i * 8192, R, C); const int Rb = Epi::PERM ? ((R & ~31) + perm32(R & 31)) : R;
        voffA[i] = (unsigned)(R * K + C) * 2u; voffB[i] = (unsigned)(Rb * K + C) * 2u; }
    const size_t kstep = (size_t)(BK * 2);
    const size_t hstep = (size_t)HALF * K * 2;
    const size_t tstep = 2 * hstep;
    const unsigned ldsw = (unsigned)wid * 1024u;
    const int aoff = lds_byte(wr * 64 + fr, fq * 8), boff = lds_byte(wc * 32 + fr, fq * 8);
#define PG8_SA(b, h) (((b) * 2 + (h)) * HTB)
#define PG8_SB(b, h) ((4 + (b) * 2 + (h)) * HTB)
#define PG8_STAGE(bufoff, gbase, voff) do { _Pragma("unroll") for (int _i = 0; _i < 2; ++_i) \
        __builtin_amdgcn_global_load_lds((const unsigned*)((const char*)(gbase) + (voff)[_i]), (PG8_LAS unsigned*)(lds + (bufoff) + ldsw + _i * 8192), 16, 0, 0); } while (0)
#define PG8_LDA(dst, b, h) do { _Pragma("unroll") for (int m = 0; m < 4; ++m) _Pragma("unroll") for (int k = 0; k < 2; ++k) dst[m][k] = *(const PG8_LAS bf16x8*)(lds + PG8_SA(b, h) + aoff + m * 2048 + k * 1024); } while (0)
#define PG8_LDB(dst, b, h) do { _Pragma("unroll") for (int n = 0; n < 2; ++n) _Pragma("unroll") for (int k = 0; k < 2; ++k) dst[n][k] = *(const PG8_LAS bf16x8*)(lds + PG8_SB(b, h) + boff + n * 2048 + k * 1024); } while (0)
#define PG8_MMA(ai, bj, At, Bt) do { __builtin_amdgcn_s_setprio(1); _Pragma("unroll") for (int m = 0; m < 4; ++m) _Pragma("unroll") for (int n = 0; n < 2; ++n) _Pragma("unroll") for (int k = 0; k < 2; ++k) \
        acc[ai][bj][m][n] = __builtin_amdgcn_mfma_f32_16x16x32_bf16(Bt[n][k], At[m][k], acc[ai][bj][m][n], 0, 0, 0); __builtin_amdgcn_s_setprio(0); } while (0)
#define PG8_WAIT_V(n) asm volatile("s_waitcnt vmcnt(" #n ")" ::: "memory")
#define PG8_WAIT_L(n) asm volatile("s_waitcnt lgkmcnt(" #n ")" ::: "memory")
#define PG8_BAR __builtin_amdgcn_s_barrier()
#define PG8_SCHED __builtin_amdgcn_sched_barrier(0)
    Unit cur, nxt; int ui = 0;
    if (!S.next(0, cur)) return;
    f32x4 acc[2][2][4][2];
#pragma unroll
    for (int a = 0; a < 2; ++a)
#pragma unroll
        for (int b = 0; b < 2; ++b)
#pragma unroll
            for (int m = 0; m < 4; ++m)
#pragma unroll
                for (int n = 0; n < 2; ++n) acc[a][b][m][n] = (f32x4){0.f, 0.f, 0.f, 0.f};
    bf16x8 At[4][2], B0[2][2], B1[2][2];
    const char* cA = (const char*)g.A + (size_t)cur.pm * tstep; const char* cB = (const char*)g.Bt + (size_t)cur.pn * tstep;
    S.a_ready(cur);
    if constexpr (SP2) {
        PG8_STAGE(PG8_SB(0, 0), cB, voffB); PG8_STAGE(PG8_SB(0, 1), cB + hstep, voffB); PG8_STAGE(PG8_SA(0, 0), cA, voffA); PG8_STAGE(PG8_SA(0, 1), cA + hstep, voffA);
        if (wr == 1) PG8_BAR;
        PG8_WAIT_V(2); PG8_BAR;
        PG8_STAGE(PG8_SB(1, 0), cB + kstep, voffB); PG8_STAGE(PG8_SA(1, 0), cA + kstep, voffA); PG8_STAGE(PG8_SB(1, 1), cB + hstep + kstep, voffB);
        PG8_WAIT_V(6); PG8_BAR;
    } else {
        PG8_STAGE(PG8_SB(0, 0), cB, voffB); PG8_STAGE(PG8_SA(0, 0), cA, voffA); PG8_STAGE(PG8_SB(0, 1), cB + hstep, voffB); PG8_STAGE(PG8_SA(0, 1), cA + hstep, voffA);
        if (wr == 1) PG8_BAR;
        PG8_WAIT_V(4); PG8_BAR;
        PG8_STAGE(PG8_SB(1, 0), cB + kstep, voffB); PG8_STAGE(PG8_SA(1, 0), cA + kstep, voffA); PG8_STAGE(PG8_SB(1, 1), cB + hstep + kstep, voffB);
        PG8_WAIT_V(6); PG8_BAR;
    }
    for (;;) {
        const bool has_next = S.next(ui + 1, nxt);
        const char* nA = has_next ? (const char*)g.A + (size_t)nxt.pm * tstep : cA; const char* nB = has_next ? (const char*)g.Bt + (size_t)nxt.pn * tstep : cB;
#pragma unroll 1
        for (int t = 0; t < nt; t += 2) {
            const bool last = (t == nt - 2);
            const char* a1 = cA + (size_t)(t + 1) * kstep;
            const char* a2 = last ? nA : cA + (size_t)(t + 2) * kstep; const char* b2 = last ? nB : cB + (size_t)(t + 2) * kstep;
            const char* a3 = a2 + kstep; const char* b3 = b2 + kstep;
            if (last && has_next) S.a_ready(nxt);
            if constexpr (SP2) {
            PG8_LDB(B0, 0, 0); PG8_LDB(B1, 0, 1); PG8_SCHED; PG8_LDA(At, 0, 0); PG8_STAGE(PG8_SA(1, 1), a1 + hstep, voffA);
            PG8_WAIT_V(8); PG8_WAIT_L(0); PG8_BAR; PG8_MMA(0, 0, At, B0); PG8_MMA(0, 1, At, B1); PG8_BAR; PG8_SCHED;
            PG8_LDA(At, 0, 1); PG8_STAGE(PG8_SB(0, 0), b2, voffB); PG8_STAGE(PG8_SB(0, 1), b2 + hstep, voffB); PG8_STAGE(PG8_SA(0, 0), a2, voffA);
            PG8_WAIT_V(8); PG8_WAIT_L(0); PG8_BAR; PG8_MMA(1, 0, At, B0); PG8_MMA(1, 1, At, B1); PG8_BAR; PG8_SCHED;
            PG8_LDB(B0, 1, 0); PG8_LDB(B1, 1, 1); PG8_SCHED; PG8_LDA(At, 1, 0); PG8_STAGE(PG8_SA(0, 1), a2 + hstep, voffA);
            PG8_WAIT_V(8); PG8_WAIT_L(0); PG8_BAR; PG8_MMA(0, 0, At, B0); PG8_MMA(0, 1, At, B1); PG8_BAR; PG8_SCHED;
            PG8_LDA(At, 1, 1); PG8_STAGE(PG8_SB(1, 0), b3, voffB); PG8_STAGE(PG8_SB(1, 1), b3 + hstep, voffB); PG8_STAGE(PG8_SA(1, 0), a3, voffA);
            PG8_WAIT_V(8); PG8_WAIT_L(0); PG8_BAR; PG8_MMA(1, 0, At, B0); PG8_MMA(1, 1, At, B1); PG8_BAR; PG8_SCHED;
            } else {
            PG8_LDB(B0, 0, 0); PG8_SCHED; PG8_LDA(At, 0, 0); PG8_STAGE(PG8_SA(1, 1), a1 + hstep, voffA);
            PG8_WAIT_L(8); PG8_BAR; PG8_WAIT_L(0); PG8_MMA(0, 0, At, B0); PG8_BAR; PG8_SCHED;
            PG8_LDB(B1, 0, 1); PG8_STAGE(PG8_SB(0, 0), b2, voffB);
            PG8_BAR; PG8_WAIT_L(0); PG8_MMA(0, 1, At, B1); PG8_BAR;
            PG8_LDA(At, 0, 1); PG8_STAGE(PG8_SA(0, 0), a2, voffA);
            PG8_BAR; PG8_WAIT_L(0); PG8_MMA(1, 0, At, B0); PG8_BAR; PG8_SCHED;
            PG8_STAGE(PG8_SB(0, 1), b2 + hstep, voffB);
            PG8_WAIT_V(6); PG8_BAR; PG8_MMA(1, 1, At, B1); PG8_BAR;
            PG8_LDB(B0, 1, 0); PG8_SCHED; PG8_LDA(At, 1, 0); PG8_STAGE(PG8_SA(0, 1), a2 + hstep, voffA);
            PG8_WAIT_L(8); PG8_BAR; PG8_WAIT_L(0); PG8_MMA(0, 0, At, B0); PG8_BAR; PG8_SCHED;
            PG8_LDB(B1, 1, 1); PG8_STAGE(PG8_SB(1, 0), b3, voffB);
            PG8_BAR; PG8_WAIT_L(0); PG8_MMA(0, 1, At, B1); PG8_BAR;
            PG8_LDA(At, 1, 1); PG8_STAGE(PG8_SA(1, 0), a3, voffA);
            PG8_BAR; PG8_WAIT_L(0); PG8_MMA(1, 0, At, B0); PG8_BAR; PG8_SCHED;
            PG8_STAGE(PG8_SB(1, 1), b3 + hstep, voffB);
            PG8_WAIT_V(6); PG8_BAR; PG8_MMA(1, 1, At, B1); PG8_BAR;
            }
        }
        if constexpr (ALIGN_EPI) { if (wr == 0) PG8_BAR; }
        if constexpr (!Epi::AFTER_DRAIN) { E(acc, cur, wr, wc, fr, fq); S.done(cur); }
        if (!has_next) break;
#pragma unroll
        for (int a = 0; a < 2; ++a)
#pragma unroll
            for (int b = 0; b < 2; ++b)
#pragma unroll
                for (int m = 0; m < 4; ++m)
#pragma unroll
                    for (int n = 0; n < 2; ++n) acc[a][b][m][n] = (f32x4){0.f, 0.f, 0.f, 0.f};
        cur = nxt; cA = nA; cB = nB; ++ui;
        if constexpr (ALIGN_EPI) { if (wr == 1) PG8_BAR; }
    }
    PG8_WAIT_V(0);
    if constexpr (!ALIGN_EPI) { if (wr == 0) PG8_BAR; }
    PG8_BAR;
    if constexpr (Epi::AFTER_DRAIN) { E.fused(acc, cur, wr, wc, fr, fq, lds, wid, lane); S.done(cur); }
#undef PG8_SA
#undef PG8_SB
#undef PG8_STAGE
#undef PG8_LDA
#undef PG8_LDB
#undef PG8_MMA
#undef PG8_WAIT_V
#undef PG8_WAIT_L
#undef PG8_BAR
#undef PG8_SCHED
}

struct EpiActF {
    static constexpr bool PERM = false, AFTER_DRAIN = false;
    bf16_t* act; PG8_LAS const unsigned char* lds;
    __device__ __forceinline__ void operator()(const f32x4 (&acc)[2][2][4][2], const Unit& un, int wr, int wc, int, int) const {
        int l_ = threadIdx.x; asm volatile("" : "+v"(l_)); const int fr = l_ & 15, fq = (l_ >> 4) & 3;
        typedef float f32x2v __attribute__((ext_vector_type(2)));
        PG8_LAS const f32x2v* ri = (PG8_LAS const f32x2v*)(lds + PG8_ROWINFO_OFF) + un.slot * 256;
#pragma unroll
        for (int ai = 0; ai < 2; ++ai)
#pragma unroll
            for (int m = 0; m < 4; ++m) {
                const int r = ai * HALF + wr * 64 + m * 16 + fr; const f32x2v wi = ri[r]; const float w = wi.x, rs = wi.y;
                f32x4 a[2];
#pragma unroll
                for (int n = 0; n < 2; ++n) { const f32x4 g = acc[ai][0][m][n] * rs, u = acc[ai][1][m][n] * rs; a[n] = g * sig4(g) * u * w; }
                *(u32x4*)(act + ((size_t)un.pm * 256 + r) * 256 + un.pl * 128 + wc * 32 + fq * 8) = pack8(a[0], a[1]);
            }
    }
};
template <int KK> struct EpiDownF {
    static constexpr bool PERM = false, AFTER_DRAIN = false;
    PG8_LAS const unsigned char* lds; float* out; bf16_t* xb; float* part;
    __device__ __forceinline__ void operator()(const f32x4 (&acc)[2][2][4][2], const Unit& un, int wr, int wc, int, int) const {
        int l_ = threadIdx.x; asm volatile("" : "+v"(l_)); const int fr = l_ & 15, fq = (l_ >> 4) & 3;
        const int cb = un.pl * 256 + wc * 64 + fq * 8;
        PG8_LAS const int* tk = (PG8_LAS const int*)(lds + PG8_TOKOFF_OFF) + un.slot * 256 + wr * 64 + fr;
#pragma unroll
        for (int ai = 0; ai < 2; ++ai) {
            int tok[4]; f32x4 bl[4][2][2];
#pragma unroll
            for (int m = 0; m < 4; ++m) { tok[m] = tk[ai * HALF + m * 16]; const size_t rb = (size_t)(tok[m] < 0 ? 0 : tok[m]) * 1024 + cb;
#pragma unroll
                for (int bj = 0; bj < 2; ++bj) { bl[m][bj][0] = *(const f32x4*)(out + rb + bj * 32); bl[m][bj][1] = *(const f32x4*)(out + rb + bj * 32 + 4); } }
#pragma unroll
            for (int m = 0; m < 4; ++m) {
                const bool valid = tok[m] >= 0; const size_t rb = (size_t)(valid ? tok[m] : 0) * 1024 + cb; float ss = 0.f;
#pragma unroll
                for (int bj = 0; bj < 2; ++bj) { const size_t o = rb + bj * 32;
                    const f32x4 v0 = bl[m][bj][0] + acc[ai][bj][m][0], v1 = bl[m][bj][1] + acc[ai][bj][m][1];
                    if (valid) { *(f32x4*)(out + o) = v0; *(f32x4*)(out + o + 4) = v1; if (KK) *(u32x4*)(xb + o) = pack8(v0, v1); }
                    ss += dot4(v0) + dot4(v1); }
                if (KK) { ss += __shfl_xor(ss, 16); ss += __shfl_xor(ss, 32); if (valid && fq == 0) part[(size_t)tok[m] * 16 + un.pl * 4 + wc] = ss; }
            }
        }
    }
};
__device__ __forceinline__ int ldsu(PG8_LAS const int* p) { return __builtin_amdgcn_readfirstlane(*p); }
struct MoeSched {
    PG8_LAS const int* tb; PG8_LAS const int* tc; int G, c, mode;
    __device__ __forceinline__ bool next(int i, Unit& u) const {
        const int gi = i * G + c; int ti, pl;
        if (mode == 0) { ti = gi >> 1; pl = gi & 1; if (ti >= ldsu(tb + 64)) return false; }
        else { ti = gi >> 2; pl = gi & 3; const int n0 = ldsu(tb + 32); if (mode == 2) { ti += n0; if (ti >= ldsu(tb + 64)) return false; } else if (ti >= n0) return false; }
        const int ke = ldsu(tb + 160 + ti);
        u.pm = ti; u.e = ke & 31; u.k = ke >> 5; u.mt = ti - ldsu(tb + ke); u.cnt = ldsu(tc + ke); u.pl = pl; u.slot = i; u.pn = (ke & 31) * (mode == 0 ? 2 : 4) + pl;
        return true;
    }
    __device__ __forceinline__ void a_ready(const Unit&) const {}
    __device__ __forceinline__ void done(const Unit&) const {}
};
template <class Epi, class Sched>
__device__ __forceinline__ void gemm_phase_g(PG8_LAS unsigned char* lds, const Gemm g, const Sched& S, const Epi& E) {
    int tid_ = threadIdx.x; asm volatile("" : "+v"(tid_)); const int tid = tid_, wid = __builtin_amdgcn_readfirstlane(tid >> 6), lane = tid & 63, wr = wid >> 2, wc = wid & 3, fr = lane & 15, fq = lane >> 4;
    const int K = g.K, nt = K / BK;
    unsigned voffB[2]; int RA[2]; unsigned CA2[2];
#pragma unroll
    for (int i = 0; i < 2; ++i) { int R, C; stage_rc(tid * 16 + i * 8192, R, C); voffB[i] = (unsigned)(R * K + C) * 2u; RA[i] = R; CA2[i] = (unsigned)C * 2u; }
    const size_t kstep = (size_t)(BK * 2), hstep = (size_t)HALF * K * 2, tstep = 2 * hstep;
    const unsigned ldsw = (unsigned)wid * 1024u;
    const int aoff = lds_byte(wr * 64 + fr, fq * 8), boff = lds_byte(wc * 32 + fr, fq * 8);
    PG8_LAS const unsigned* tokoff = (PG8_LAS const unsigned*)(lds + PG8_TOKOFF_OFF);
#define PG8_SA(b, h) (((b) * 2 + (h)) * HTB)
#define PG8_SB(b, h) ((4 + (b) * 2 + (h)) * HTB)
#define PG8_STAGE(bufoff, gbase, voff) do { _Pragma("unroll") for (int _i = 0; _i < 2; ++_i) \
        __builtin_amdgcn_global_load_lds((const unsigned*)((const char*)(gbase) + (voff)[_i]), (PG8_LAS unsigned*)(lds + (bufoff) + ldsw + _i * 8192), 16, 0, 0); } while (0)
#define PG8_STAGE_A(bufoff, gbase, o0, o1) do { \
        __builtin_amdgcn_global_load_lds((const unsigned*)((const char*)(gbase) + (o0)), (PG8_LAS unsigned*)(lds + (bufoff) + ldsw), 16, 0, 0); \
        __builtin_amdgcn_global_load_lds((const unsigned*)((const char*)(gbase) + (o1)), (PG8_LAS unsigned*)(lds + (bufoff) + ldsw + 8192), 16, 0, 0); } while (0)
#define PG8_GOFF(slot, d00, d01, d10, d11) do { PG8_LAS const unsigned* t_ = tokoff + (slot) * 256; \
        d00 = t_[RA[0]] + CA2[0]; d01 = t_[RA[1]] + CA2[1]; d10 = t_[128 + RA[0]] + CA2[0]; d11 = t_[128 + RA[1]] + CA2[1]; } while (0)
#define PG8_LDA(dst, b, h) do { _Pragma("unroll") for (int m = 0; m < 4; ++m) _Pragma("unroll") for (int k = 0; k < 2; ++k) dst[m][k] = *(const PG8_LAS bf16x8*)(lds + PG8_SA(b, h) + aoff + m * 2048 + k * 1024); } while (0)
#define PG8_LDB(dst, b, h) do { _Pragma("unroll") for (int n = 0; n < 2; ++n) _Pragma("unroll") for (int k = 0; k < 2; ++k) dst[n][k] = *(const PG8_LAS bf16x8*)(lds + PG8_SB(b, h) + boff + n * 2048 + k * 1024); } while (0)
#define PG8_MMA(ai, bj, At, Bt) do { __builtin_amdgcn_s_setprio(1); _Pragma("unroll") for (int m = 0; m < 4; ++m) _Pragma("unroll") for (int n = 0; n < 2; ++n) _Pragma("unroll") for (int k = 0; k < 2; ++k) \
        acc[ai][bj][m][n] = __builtin_amdgcn_mfma_f32_16x16x32_bf16(Bt[n][k], At[m][k], acc[ai][bj][m][n], 0, 0, 0); __builtin_amdgcn_s_setprio(0); } while (0)
#define PG8_WAIT_V(n) asm volatile("s_waitcnt vmcnt(" #n ")" ::: "memory")
#define PG8_WAIT_L(n) asm volatile("s_waitcnt lgkmcnt(" #n ")" ::: "memory")
#define PG8_BAR __builtin_amdgcn_s_barrier()
#define PG8_SCHED __builtin_amdgcn_sched_barrier(0)
    Unit cur, nxt; int ui = 0;
    if (!S.next(0, cur)) return;
    f32x4 acc[2][2][4][2];
#pragma unroll
    for (int a = 0; a < 2; ++a)
#pragma unroll
        for (int b = 0; b < 2; ++b)
#pragma unroll
            for (int m = 0; m < 4; ++m)
#pragma unroll
                for (int n = 0; n < 2; ++n) acc[a][b][m][n] = (f32x4){0.f, 0.f, 0.f, 0.f};
    bf16x8 At[4][2], B0[2][2], B1[2][2];
    unsigned gc00, gc01, gc10, gc11;
    PG8_GOFF(0, gc00, gc01, gc10, gc11);
    const char* A0 = (const char*)g.A; const char* cB = (const char*)g.Bt + (size_t)cur.pn * tstep;
    PG8_STAGE(PG8_SB(0, 0), cB, voffB); PG8_STAGE(PG8_SB(0, 1), cB + hstep, voffB); PG8_STAGE_A(PG8_SA(0, 0), A0, gc00, gc01); PG8_STAGE_A(PG8_SA(0, 1), A0, gc10, gc11);
    if (wr == 1) PG8_BAR;
    PG8_WAIT_V(2); PG8_BAR;
    PG8_STAGE(PG8_SB(1, 0), cB + kstep, voffB); PG8_STAGE_A(PG8_SA(1, 0), A0 + kstep, gc00, gc01); PG8_STAGE(PG8_SB(1, 1), cB + hstep + kstep, voffB);
    PG8_WAIT_V(6); PG8_BAR;
    for (;;) {
        const bool has_next = S.next(ui + 1, nxt);
        const char* nB = has_next ? (const char*)g.Bt + (size_t)nxt.pn * tstep : cB;
#pragma unroll 1
        for (int t = 0; t < nt; t += 2) {
            const bool last = (t == nt - 2);
            const char* a1 = A0 + (size_t)(t + 1) * kstep;
            const char* a2 = last ? A0 : A0 + (size_t)(t + 2) * kstep; const char* b2 = last ? nB : cB + (size_t)(t + 2) * kstep;
            const char* a3 = a2 + kstep; const char* b3 = b2 + kstep;
            unsigned g200 = gc00, g201 = gc01, g210 = gc10, g211 = gc11;
            if (last && has_next) { PG8_GOFF(ui + 1, g200, g201, g210, g211); }
            PG8_LDB(B0, 0, 0); PG8_LDB(B1, 0, 1); PG8_SCHED; PG8_LDA(At, 0, 0); PG8_STAGE_A(PG8_SA(1, 1), a1, gc10, gc11);
            PG8_WAIT_V(8); PG8_WAIT_L(0); PG8_BAR; PG8_MMA(0, 0, At, B0); PG8_MMA(0, 1, At, B1); PG8_BAR; PG8_SCHED;
            PG8_LDA(At, 0, 1); PG8_STAGE(PG8_SB(0, 0), b2, voffB); PG8_STAGE(PG8_SB(0, 1), b2 + hstep, voffB); PG8_STAGE_A(PG8_SA(0, 0), a2, g200, g201);
            PG8_WAIT_V(8); PG8_WAIT_L(0); PG8_BAR; PG8_MMA(1, 0, At, B0); PG8_MMA(1, 1, At, B1); PG8_BAR; PG8_SCHED;
            PG8_LDB(B0, 1, 0); PG8_LDB(B1, 1, 1); PG8_SCHED; PG8_LDA(At, 1, 0); PG8_STAGE_A(PG8_SA(0, 1), a2, g210, g211);
            PG8_WAIT_V(8); PG8_WAIT_L(0); PG8_BAR; PG8_MMA(0, 0, At, B0); PG8_MMA(0, 1, At, B1); PG8_BAR; PG8_SCHED;
            PG8_LDA(At, 1, 1); PG8_STAGE(PG8_SB(1, 0), b3, voffB); PG8_STAGE(PG8_SB(1, 1), b3 + hstep, voffB); PG8_STAGE_A(PG8_SA(1, 0), a3, g200, g201);
            PG8_WAIT_V(8); PG8_WAIT_L(0); PG8_BAR; PG8_MMA(1, 0, At, B0); PG8_MMA(1, 1, At, B1); PG8_BAR; PG8_SCHED;
        }
        if (wr == 0) PG8_BAR;
        E(acc, cur, wr, wc, fr, fq);
        if (!has_next) break;
#pragma unroll
        for (int a = 0; a < 2; ++a)
#pragma unroll
            for (int b = 0; b < 2; ++b)
#pragma unroll
                for (int m = 0; m < 4; ++m)
#pragma unroll
                    for (int n = 0; n < 2; ++n) acc[a][b][m][n] = (f32x4){0.f, 0.f, 0.f, 0.f};
        cur = nxt; cB = nB; ++ui; PG8_GOFF(ui, gc00, gc01, gc10, gc11);
        if (wr == 1) PG8_BAR;
    }
    PG8_WAIT_V(0);
    PG8_BAR;
#undef PG8_SA
#undef PG8_SB
#undef PG8_STAGE
#undef PG8_STAGE_A
#undef PG8_GOFF
#undef PG8_LDA
#undef PG8_LDB
#undef PG8_MMA
#undef PG8_WAIT_V
#undef PG8_WAIT_L
#undef PG8_BAR
#undef PG8_SCHED
}

}

__device__ __forceinline__ int p64_row(int c) { const int cl = c & 255; return (c & ~255) + 128 * ((cl >> 5) & 1) + 32 * (cl >> 6) + 16 * ((cl >> 2) & 1) + 4 * ((cl >> 3) & 3) + (cl & 3); }
__device__ __forceinline__ unsigned pk2(float lo, float hi) { return f2bf(lo) | (f2bf(hi) << 16); }
__device__ __forceinline__ int gu_row(int ff, int isup) { const int fl = ff & 127; return 256 * (ff >> 7) + 128 * isup + 32 * (fl >> 5) + 16 * ((fl >> 2) & 1) + 4 * ((fl >> 3) & 3) + (fl & 3); }
template <int MODE>
__device__ __forceinline__ void transpose_item(const float* W, int K, int N, bf16* WT, const float* gain, LAS float* scr, int item, int lane) {
    const int nblk = N / 32, kb = item / nblk, nb = item % nblk, k0 = 64 * kb, n0 = 32 * nb;
    const float* wp = W + (size_t)(k0 + (lane >> 5)) * N + n0 + (lane & 31);
    float wv[32];
#pragma unroll
    for (int i = 0; i < 32; ++i) wv[i] = wp[(size_t)(2 * i) * N];
    const int c = lane & 7;
    f32x4 g0 = {1.f, 1.f, 1.f, 1.f}, g1 = {1.f, 1.f, 1.f, 1.f};
    if (gain) { g0 = *(const f32x4*)(gain + k0 + 8 * c); g1 = *(const f32x4*)(gain + k0 + 8 * c + 4); }
#pragma unroll
    for (int i = 0; i < 32; ++i) scr[(2 * i + (lane >> 5)) * 33 + (lane & 31)] = wv[i];
    asm volatile("s_waitcnt lgkmcnt(0)" ::: "memory");
#pragma unroll
    for (int j = 0; j < 4; ++j) { const int n = (lane >> 3) + 8 * j; const LAS float* s = scr + (8 * c) * 33 + n;
        v4u o; o.x = pk2(s[0 * 33] * g0[0], s[1 * 33] * g0[1]); o.y = pk2(s[2 * 33] * g0[2], s[3 * 33] * g0[3]); o.z = pk2(s[4 * 33] * g1[0], s[5 * 33] * g1[1]); o.w = pk2(s[6 * 33] * g1[2], s[7 * 33] * g1[3]);
        const int drow = MODE == 0 ? p64_row(n0 + n) : gu_row(n0 + n, MODE == 2);
        *(v4u*)(WT + (size_t)drow * K + k0 + 8 * c) = o; }
    asm volatile("s_waitcnt lgkmcnt(0)" ::: "memory");
}
constexpr size_t WT_WIN = 0, WT_WAU = 12 * MiB, WT_WOUT = 14 * MiB, WT_WPG = 16 * MiB, WT_WGLU = 18 * MiB, WT_WSU = 18 * MiB + 512 * 1024, WT_WPLE = 19 * MiB + 512 * 1024, WT_WGU = 20 * MiB, WT_WD = 52 * MiB;
__device__ __forceinline__ void convert_weights(const Frame& F0, int L, unsigned char* wt) {
    const Frame F = refresh(F0);
    LAS float* scr = (LAS float*)(F.lds + F.wave * 16384);
    const int gw = F.vcu * NWAVES + F.wave, NGW = F.G * NWAVES;
    constexpr int I_IN = (DM / 64) * (INW / 32), I_SQ = (DM / 64) * (DM / 32), I_GLU = (SSMW / 64) * (SSMW / 32), I_SU = (SSMW / 64) * (DM / 32), I_PL = (PLE / 64) * (DM / 32);
    constexpr int I_EX = NEXP * 128;
    constexpr int NIT = I_IN + 3 * I_SQ + I_GLU + I_SU + I_PL + 3 * I_EX;
    for (int it = gw; it < NIT; it += NGW) {
        int r = it;
        if (r < I_IN) { transpose_item<0>(inp(F, I_WIN) + (size_t)L * DM * INW, DM, INW, (bf16*)(wt + WT_WIN), inp(F, I_ATTN_G) + L * DM, scr, r, F.lane); continue; } r -= I_IN;
        if (r < I_SQ) { transpose_item<0>(inp(F, I_WAU) + (size_t)L * DM * DM, DM, DM, (bf16*)(wt + WT_WAU), nullptr, scr, r, F.lane); continue; } r -= I_SQ;
        if (r < I_SQ) { transpose_item<0>(inp(F, I_WOUT) + (size_t)L * DM * DM, DM, DM, (bf16*)(wt + WT_WOUT), nullptr, scr, r, F.lane); continue; } r -= I_SQ;
        if (r < I_SQ) { transpose_item<0>(inp(F, I_WPG) + (size_t)L * DM * DM, DM, DM, (bf16*)(wt + WT_WPG), inp(F, I_PLE_G) + L * DM, scr, r, F.lane); continue; } r -= I_SQ;
        if (r < I_GLU) { transpose_item<0>(inp(F, I_WGLU) + (size_t)L * SSMW * SSMW, SSMW, SSMW, (bf16*)(wt + WT_WGLU), nullptr, scr, r, F.lane); continue; } r -= I_GLU;
        if (r < I_SU) { transpose_item<0>(inp(F, I_WSU) + (size_t)L * SSMW * DM, SSMW, DM, (bf16*)(wt + WT_WSU), nullptr, scr, r, F.lane); continue; } r -= I_SU;
        if (r < I_PL) { transpose_item<0>(inp(F, I_WPLE) + (size_t)L * PLE * DM, PLE, DM, (bf16*)(wt + WT_WPLE), nullptr, scr, r, F.lane); continue; } r -= I_PL;
        if (r < I_EX) { const int e = r >> 7; transpose_item<1>(inp(F, I_WEG) + ((size_t)L * NEXP + e) * DM * EFF, DM, EFF, (bf16*)(wt + WT_WGU) + (size_t)e * 512 * DM, inp(F, I_FFN_G) + L * DM, scr, r & 127, F.lane); continue; } r -= I_EX;
        if (r < I_EX) { const int e = r >> 7; transpose_item<2>(inp(F, I_WEU) + ((size_t)L * NEXP + e) * DM * EFF, DM, EFF, (bf16*)(wt + WT_WGU) + (size_t)e * 512 * DM, inp(F, I_FFN_G) + L * DM, scr, r & 127, F.lane); continue; } r -= I_EX;
        { const int e = r >> 7; transpose_item<0>(inp(F, I_WED) + ((size_t)L * NEXP + e) * EFF * DM, EFF, DM, (bf16*)(wt + WT_WD) + (size_t)e * DM * EFF, nullptr, scr, r & 127, F.lane); }
    }
}
#include <hip/hip_bf16.h>
namespace attn_body {
using bf16=__hip_bfloat16;
using bf16x8=__attribute__((ext_vector_type(8)))short;
using s16x4=__attribute__((ext_vector_type(4)))short;
using f32x16=__attribute__((ext_vector_type(16)))float;
using u32x4=__attribute__((ext_vector_type(4)))unsigned;
constexpr int BATCH=8,NHEAD=16,SEQ=2048,D=64,DM=NHEAD*D;
constexpr int NW=8,QBLK=32,QB=QBLK*NW,KVBLK=64,NQB=SEQ/QB;
constexpr int ATTN_PITCH=DM, ATTN_UNIT_ROWS=QB;
__device__ __forceinline__ int crow(int r,int hi){return (r&3)+8*(r>>2)+4*hi;}
#define SBAR() __builtin_amdgcn_sched_barrier(0)
__device__ __forceinline__ void cmask(f32x16&p0,f32x16&p1,int jb,int qrel,int hi){
  const float NEG=-INFINITY; int kb=64*jb+4*hi;
  #pragma unroll
  for(int r=0;r<16;++r){int kv=kb+(r&3)+8*(r>>2); if(kv>qrel)p0[r]=NEG; if(kv+32>qrel)p1[r]=NEG;}
}

constexpr int NSLOT=3, SLOTB=8192;
constexpr int LDS_K=0, LDS_V=NSLOT*SLOTB, LDS_WS=2*NSLOT*SLOTB, LDS_OST=LDS_WS+NW*64*4, LDS_BYTES=LDS_OST+NW*4096;
constexpr float C2=0.125f*1.4426950408889634f;
__device__ __forceinline__ void glds16(const void*gsrc,unsigned lds_dst){unsigned keep;
  asm volatile("s_mov_b32 %0, m0\n\ts_mov_b32 m0, %2\n\ts_nop 0\n\tglobal_load_lds_dwordx4 %1, off\n\ts_mov_b32 m0, %0":"=&s"(keep):"v"(gsrc),"s"(lds_dst):"memory");}
__device__ __forceinline__ float max3f(float a,float b,float c){float r;asm("v_max3_f32 %0, %1, %2, %3":"=v"(r):"v"(a),"v"(b),"v"(c));return r;}
__device__ __forceinline__ float max2f(float a,float b){float r;asm("v_max_f32_e32 %0, %1, %2":"=v"(r):"v"(a),"v"(b));return r;}
__device__ __forceinline__ float fadd_s(float a,float b){float r;asm("v_add_f32_e32 %0, %1, %2":"=v"(r):"v"(a),"v"(b));return r;}
__device__ __forceinline__ float fsub_s(float a,float b){float r;asm("v_sub_f32_e32 %0, %1, %2":"=v"(r):"v"(a),"v"(b));return r;}
typedef float f32x2_t __attribute__((ext_vector_type(2))); typedef __bf16 bf16x2_t __attribute__((ext_vector_type(2)));
__device__ __forceinline__ unsigned cvtpk_s(float lo,float hi){f32x2_t v={lo,hi};bf16x2_t b=__builtin_convertvector(v,bf16x2_t);return __builtin_bit_cast(unsigned,b);}
#define WAIT_BAR(N) asm volatile("s_waitcnt vmcnt(" #N ") lgkmcnt(0)\n\ts_barrier":::"memory")

__device__ __forceinline__ void qkt(f32x16&p0,f32x16&p1,const char*Kslot,const bf16x8*qr,const f32x16&negm,int r32,int hi){
  const char*kb=Kslot+hi*1024+r32*16;
  #pragma unroll
  for(int d0=0;d0<4;++d0){
    const bf16x8 b0=*reinterpret_cast<const bf16x8*>(kb+d0*2048);
    const bf16x8 b1=*reinterpret_cast<const bf16x8*>(kb+d0*2048+512);
    if(d0==0){p0=__builtin_amdgcn_mfma_f32_32x32x16_bf16(b0,qr[0],negm,0,0,0);p1=__builtin_amdgcn_mfma_f32_32x32x16_bf16(b1,qr[0],negm,0,0,0);}
    else{p0=__builtin_amdgcn_mfma_f32_32x32x16_bf16(b0,qr[d0],p0,0,0,0);p1=__builtin_amdgcn_mfma_f32_32x32x16_bf16(b1,qr[d0],p1,0,0,0);}}
}
typedef __attribute__((address_space(3))) const char* lds_cptr;
typedef short v4i16_t __attribute__((ext_vector_type(4)));
__device__ __forceinline__ void kload8(bf16x8*kf,lds_cptr kp){
  kf[0]=*(const __attribute__((address_space(3))) bf16x8*)(kp);      kf[1]=*(const __attribute__((address_space(3))) bf16x8*)(kp+512);
  kf[2]=*(const __attribute__((address_space(3))) bf16x8*)(kp+2048); kf[3]=*(const __attribute__((address_space(3))) bf16x8*)(kp+2560);
  kf[4]=*(const __attribute__((address_space(3))) bf16x8*)(kp+4096); kf[5]=*(const __attribute__((address_space(3))) bf16x8*)(kp+4608);
  kf[6]=*(const __attribute__((address_space(3))) bf16x8*)(kp+6144); kf[7]=*(const __attribute__((address_space(3))) bf16x8*)(kp+6656);
}
__device__ __forceinline__ void kload2(bf16x8*kf,lds_cptr kp,int j){ kf[2*j]=*(const __attribute__((address_space(3))) bf16x8*)(kp+j*2048); kf[2*j+1]=*(const __attribute__((address_space(3))) bf16x8*)(kp+j*2048+512); }
__device__ __forceinline__ s16x4 vtr(lds_cptr p){ return __builtin_bit_cast(s16x4,__builtin_amdgcn_ds_read_tr16_b64_v4i16((__attribute__((address_space(3))) v4i16_t*)p)); }
__device__ __forceinline__ float rowmax(const f32x16&p0,const f32x16&p1){
  float a=max3f(p0[0],p0[1],p1[0]),b=max3f(p0[2],p0[3],p1[1]);a=max3f(a,p1[2],p1[3]);
  #pragma unroll
  for(int r=4;r<16;r+=4){a=max3f(a,p0[r],p0[r+1]);b=max3f(b,p0[r+2],p0[r+3]);a=max3f(a,p1[r],p1[r+1]);b=max3f(b,p1[r+2],p1[r+3]);}
  const float m=max2f(a,b);
  auto rr=__builtin_amdgcn_permlane32_swap(__float_as_uint(m),__float_as_uint(m),false,false);
  return max2f(__uint_as_float(rr[0]),__uint_as_float(rr[1]));
}
__device__ __forceinline__ void pv(f32x16*o,int vb,bf16x8 pa0,bf16x8 pa1,bf16x8 pa2,bf16x8 pa3){
  #pragma unroll
  for(int d0=0;d0<2;++d0){s16x4 lo[4],hi[4];
    #pragma unroll
    for(int ks=0;ks<4;++ks){
      asm volatile("ds_read_b64_tr_b16 %0,%1 offset:%c2":"=&v"(lo[ks]):"v"(vb),"i"(d0*4096+ks*1024):"memory");
      asm volatile("ds_read_b64_tr_b16 %0,%1 offset:%c2":"=&v"(hi[ks]):"v"(vb),"i"(d0*4096+ks*1024+512):"memory");}
    asm volatile("s_waitcnt lgkmcnt(0)":::"memory");SBAR();
    #define PK(k) (bf16x8){lo[k][0],lo[k][1],lo[k][2],lo[k][3],hi[k][0],hi[k][1],hi[k][2],hi[k][3]}
    o[d0]=__builtin_amdgcn_mfma_f32_32x32x16_bf16(pa0,PK(0),o[d0],0,0,0);
    o[d0]=__builtin_amdgcn_mfma_f32_32x32x16_bf16(pa1,PK(1),o[d0],0,0,0);
    o[d0]=__builtin_amdgcn_mfma_f32_32x32x16_bf16(pa2,PK(2),o[d0],0,0,0);
    o[d0]=__builtin_amdgcn_mfma_f32_32x32x16_bf16(pa3,PK(3),o[d0],0,0,0);
    #undef PK
  }
}

#ifndef ATTN_STORE16
#define ATTN_STORE16(p,v) (*(u32x4*)(p)=(v))
#endif
template<int THRL> __device__ __forceinline__ void attn_pass(int b,int hq,int hv,int qb,const bf16*Q,const bf16*K,const bf16*V,char*shm,f32x16 (&o)[2],float (&rli)[16]){
  int tid_=threadIdx.x; asm volatile("":"+v"(tid_)); const int tid=tid_,lane=tid&63,r32=lane&31,hi=lane>>5; const int wid=__builtin_amdgcn_readfirstlane(tid>>6);
  const long rowbase=(long)b*SEQ; const int q0=qb*QB;
  const bf16*Qw=Q+(rowbase+q0+wid*QBLK)*DM+hq*D;
  const bf16*Kh=K+rowbase*DM+hq*D,*Vh=V+rowbase*DM+hv*D;
  const unsigned lds0=(unsigned)(uintptr_t)shm;
  float*wsf=(float*)(shm+LDS_WS)+wid*64;
  const bf16*ksrc=Kh+(long)lane*DM+wid*8;
  const bf16*vsrc=Vh+(long)(16*(wid&3)+(lane>>2))*DM+(wid>>2)*32+(lane&3)*8;
  const unsigned kdst=lds0+LDS_K+wid*1024, vdst=lds0+LDS_V+wid*1024;
  #define DMA_K(t,slot) glds16(ksrc+(long)(t)*KVBLK*DM,(unsigned)__builtin_amdgcn_readfirstlane(kdst+(slot)))
  #define DMA_V(t,slot) glds16(vsrc+(long)(t)*KVBLK*DM,(unsigned)__builtin_amdgcn_readfirstlane(vdst+(slot)))
  const int vb0=(int)(lds0+LDS_V)+((lane>>4)&1)*32+(lane&3)*8+(4*hi+((lane&15)>>2))*64;
  const char*Kbase=shm+LDS_K; bf16x8 kf[8];
  const lds_cptr shm3=(lds_cptr)shm; const lds_cptr kp0=shm3+LDS_K+hi*1024+r32*16; const lds_cptr vp0=shm3+LDS_V+((lane>>4)&1)*32+(lane&3)*8+(4*hi+((lane&15)>>2))*64;
  const int NT=(q0+QB)/KVBLK;
  DMA_K(0,0);DMA_V(0,0);DMA_K(1,SLOTB);
  bf16x8 qr[4];
  #pragma unroll
  for(int d0=0;d0<4;++d0)qr[d0]=*reinterpret_cast<const bf16x8*>(&Qw[(long)r32*DM+d0*16+hi*8]);
  float mhat=0.f,l_reg=0.f;o[0]=f32x16{};o[1]=f32x16{};f32x16 negm=f32x16{};asm volatile("":"+v"(negm));
  const int qrel=wid*QBLK+r32;
  #define CMASK(P0,P1,t) do{int jb_=(t)-(NT-4); if(jb_>=0)cmask(P0,P1,jb_,qrel,hi);}while(0)
  bool resc=false;
  #define START(P0,P1) do{ const float rm=rowmax(P0,P1); resc=false; \
    { const float dl=rm; mhat=fadd_s(mhat,dl); \
      _Pragma("unroll") for(int r=0;r<16;++r){P0[r]=fsub_s(P0[r],dl);P1[r]=fsub_s(P1[r],dl);} \
      _Pragma("unroll") for(int r=0;r<16;++r)negm[r]=-mhat; asm volatile("":"+v"(negm)); } \
    _Pragma("unroll") for(int r=0;r<16;++r)P0[r]=__builtin_amdgcn_exp2f(P0[r]); }while(0)
  #define RESC() do{ if(resc){ asm volatile("s_waitcnt lgkmcnt(0)":::"memory"); \
      _Pragma("unroll") for(int d_=0;d_<2;++d_) _Pragma("unroll") for(int r=0;r<16;++r)o[d_][r]*=wsf[crow(r,hi)]; } }while(0)
  f32x16 pA0,pA1,pB0,pB1;
  int sl_prev=0,sl_cur=0,sl_next=SLOTB;
  #define ROT() do{sl_prev=sl_cur;sl_cur=sl_next;sl_next=(sl_next==(NSLOT-1)*SLOTB)?0:sl_next+SLOTB;}while(0)
  DMA_K(2,2*SLOTB);
  WAIT_BAR(3);
  qkt(pA0,pA1,Kbase,qr,negm,r32,hi);asm volatile("s_nop 15\n\ts_nop 7":"+v"(pA0),"+v"(pA1));CMASK(pA0,pA1,0);
  START(pA0,pA1);
  _Pragma("unroll") for(int r=0;r<16;++r)pA1[r]=__builtin_amdgcn_exp2f(pA1[r]);
  WAIT_BAR(0);
  DMA_K(3,0);DMA_V(1,SLOTB);
  ROT();
  kload8(kf,kp0+sl_cur);
  WAIT_BAR(2);
  s16x4 vlo[8],vhi[8]; u32x4 pw0,pw1,pw2,pw3;
  #define PKW(P,B) cvtpk_s(P[B],P[B+1])
  #define PAF(k) __builtin_bit_cast(bf16x8,pw##k)
  #define VFR(i) (bf16x8){vlo[i][0],vlo[i][1],vlo[i][2],vlo[i][3],vhi[i][0],vhi[i][1],vhi[i][2],vhi[i][3]}
  #define PIN(x) asm volatile("":"+v"(x))
  #define MX3(a,b,c) __builtin_fmaxf(__builtin_fmaxf((a),(b)),(c))
  #define GAPA(MF,A0,A1,A2,A3,W0,W1,PW) do{ MF; sacc+=A0; sacc+=A1; sacc+=A2; sacc+=A3; PIN(sacc); W0; W1; PIN(PW); SBAR(); }while(0)
  #define EX(v) __builtin_amdgcn_exp2f(v)
  #define GAPB(MF,X,B) do{ MF; X[B]=EX(X[B]); X[B+1]=EX(X[B+1]); X[B+2]=EX(X[B+2]); X[B+3]=EX(X[B+3]); PIN(X); SBAR(); }while(0)
  #define VRD(i) do{ vlo[i]=vtr(vp_+(((i)>>2)*4096+((i)&3)*1024)); vhi[i]=vtr(vp_+(((i)>>2)*4096+((i)&3)*1024+512)); }while(0)
  #define KRD(G,j) do{ if(G){ kload2(kf,kp0+sl_next,j); SBAR(); } }while(0)
  #define STEP(C0,C1,P0,P1,t,GK,GV,GL) do{ SBAR(); \
    const lds_cptr vp_=vp0+sl_prev; \
    VRD(0); SBAR(); float sacc=(P0[0]+P0[1]); \
    GAPA(C0=__builtin_amdgcn_mfma_f32_32x32x16_bf16(kf[0],qr[0],negm,0,0,0), P0[2],P0[3],P0[4],P0[5],     pw0[0]=PKW(P0,0), pw0[1]=PKW(P0,2), pw0); \
    VRD(4); SBAR(); GAPA(C1=__builtin_amdgcn_mfma_f32_32x32x16_bf16(kf[1],qr[0],negm,0,0,0), P0[6],P0[7],P0[8],P0[9],     pw0[2]=PKW(P0,4), pw0[3]=PKW(P0,6), pw0); \
    VRD(1); SBAR(); GAPA(C0=__builtin_amdgcn_mfma_f32_32x32x16_bf16(kf[2],qr[1],C0,0,0,0),   P0[10],P0[11],P0[12],P0[13], pw1[0]=PKW(P0,8), pw1[1]=PKW(P0,10), pw1); \
    VRD(5); SBAR(); GAPA(C1=__builtin_amdgcn_mfma_f32_32x32x16_bf16(kf[3],qr[1],C1,0,0,0),   P0[14],P0[15],P1[0],P1[1],   pw1[2]=PKW(P0,12),pw1[3]=PKW(P0,14), pw1); \
    VRD(2); SBAR(); GAPA(C0=__builtin_amdgcn_mfma_f32_32x32x16_bf16(kf[4],qr[2],C0,0,0,0),   P1[2],P1[3],P1[4],P1[5],     pw2[0]=PKW(P1,0), pw2[1]=PKW(P1,2), pw2); \
    VRD(6); SBAR(); GAPA(C1=__builtin_amdgcn_mfma_f32_32x32x16_bf16(kf[5],qr[2],C1,0,0,0),   P1[6],P1[7],P1[8],P1[9],     pw2[2]=PKW(P1,4), pw2[3]=PKW(P1,6), pw2); \
    VRD(3); SBAR(); GAPA(C0=__builtin_amdgcn_mfma_f32_32x32x16_bf16(kf[6],qr[3],C0,0,0,0),   P1[10],P1[11],P1[12],P1[13], pw3[0]=PKW(P1,8), pw3[1]=PKW(P1,10), pw3); \
    VRD(7); SBAR(); GAPA(C1=__builtin_amdgcn_mfma_f32_32x32x16_bf16(kf[7],qr[3],C1,0,0,0),   P1[14],P1[15],0.f,0.f,       pw3[2]=PKW(P1,12),pw3[3]=PKW(P1,14), pw3); \
    l_reg+=sacc; \
    if(GK){DMA_K((t)+3,sl_cur);} if(GV){DMA_V((t)+1,sl_next);} \
    CMASK(C0,C1,t); \
    { float a=MX3(C0[0],C0[1],C1[0]),b=MX3(C0[2],C0[3],C1[1]); a=MX3(a,C1[2],C1[3]); \
      _Pragma("unroll") for(int r=4;r<16;r+=4){a=MX3(a,C0[r],C0[r+1]);b=MX3(b,C0[r+2],C0[r+3]);a=MX3(a,C1[r],C1[r+1]);b=MX3(b,C1[r+2],C1[r+3]);} \
      float rm=__builtin_fmaxf(a,b); { auto rr=__builtin_amdgcn_permlane32_swap(__float_as_uint(rm),__float_as_uint(rm),false,false); rm=__builtin_fmaxf(__uint_as_float(rr[0]),__uint_as_float(rr[1])); } \
      resc=false; \
      if(__builtin_expect(__any(rm>(float)THRL),0)){ const float dl=__builtin_fmaxf(rm,0.f); mhat+=dl; \
        _Pragma("unroll") for(int r=0;r<16;++r){C0[r]-=dl;C1[r]-=dl;} \
        _Pragma("unroll") for(int r=0;r<16;++r)negm[r]=-mhat; asm volatile("":"+v"(negm)); \
        const float f=__builtin_amdgcn_exp2f(-dl); l_reg*=f; if(hi==0)wsf[r32]=f; resc=true; } } \
    SBAR(); \
    GAPB(o[0]=__builtin_amdgcn_mfma_f32_32x32x16_bf16(PAF(0),VFR(0),o[0],0,0,0), C0,0); \
    GAPB(o[1]=__builtin_amdgcn_mfma_f32_32x32x16_bf16(PAF(0),VFR(4),o[1],0,0,0), C0,4); \
    KRD(GL,0); GAPB(o[0]=__builtin_amdgcn_mfma_f32_32x32x16_bf16(PAF(1),VFR(1),o[0],0,0,0), C0,8); \
    KRD(GL,1); GAPB(o[1]=__builtin_amdgcn_mfma_f32_32x32x16_bf16(PAF(1),VFR(5),o[1],0,0,0), C0,12); \
    KRD(GL,2); GAPB(o[0]=__builtin_amdgcn_mfma_f32_32x32x16_bf16(PAF(2),VFR(2),o[0],0,0,0), C1,0); \
    KRD(GL,3); GAPB(o[1]=__builtin_amdgcn_mfma_f32_32x32x16_bf16(PAF(2),VFR(6),o[1],0,0,0), C1,4); \
    GAPB(o[0]=__builtin_amdgcn_mfma_f32_32x32x16_bf16(PAF(3),VFR(3),o[0],0,0,0), C1,8); \
    GAPB(o[1]=__builtin_amdgcn_mfma_f32_32x32x16_bf16(PAF(3),VFR(7),o[1],0,0,0), C1,12); \
    }while(0)
  int t=1;
  #undef CMASK
  #define CMASK(P0,P1,t) do{}while(0)
  for(;t+5<NT;t+=2){
    STEP(pB0,pB1,pA0,pA1,t,true,true,true);     WAIT_BAR(2); RESC(); ROT();
    STEP(pA0,pA1,pB0,pB1,t+1,true,true,true);   WAIT_BAR(2); RESC(); ROT();
  }
  #undef CMASK
  #define CMASK(P0,P1,t) do{int jb_=(t)-(NT-4); if(jb_>=0)cmask(P0,P1,jb_,qrel,hi);}while(0)
  #define ENDW(tt) do{ if((tt)+3<NT){WAIT_BAR(2);} else if((tt)+2<NT){WAIT_BAR(1);} else {WAIT_BAR(0);} }while(0)
  for(;t+1<NT;t+=2){
    STEP(pB0,pB1,pA0,pA1,t,(t+3<NT),(t+1<NT),(t+1<NT));       ENDW(t);   RESC(); ROT();
    STEP(pA0,pA1,pB0,pB1,t+1,(t+4<NT),(t+2<NT),(t+2<NT));     ENDW(t+1); RESC(); ROT();
  }
  STEP(pB0,pB1,pA0,pA1,NT-1,false,false,false); RESC();
  { float sacc=pB0[0]+pB0[1]; _Pragma("unroll") for(int r=2;r<16;++r)sacc+=pB0[r]; _Pragma("unroll") for(int r=0;r<16;++r)sacc+=pB1[r]; l_reg+=sacc;
    pw0=(u32x4){PKW(pB0,0),PKW(pB0,2),PKW(pB0,4),PKW(pB0,6)};pw1=(u32x4){PKW(pB0,8),PKW(pB0,10),PKW(pB0,12),PKW(pB0,14)};pw2=(u32x4){PKW(pB1,0),PKW(pB1,2),PKW(pB1,4),PKW(pB1,6)};pw3=(u32x4){PKW(pB1,8),PKW(pB1,10),PKW(pB1,12),PKW(pB1,14)};
    SBAR(); pv(o,vb0+sl_cur,PAF(0),PAF(1),PAF(2),PAF(3)); }
  #undef PKW
  #undef PAF
  #undef VFR
  #undef PIN
  #undef MX3
  #undef GAPA
  #undef GAPB
  #undef EX
  #undef VRD
  #undef KRD
  #undef STEP
  #undef ENDW
  {auto rr=__builtin_amdgcn_permlane32_swap(__float_as_uint(l_reg),__float_as_uint(l_reg),false,false);l_reg=__uint_as_float(rr[0])+__uint_as_float(rr[1]);}
  if(hi==0)wsf[32+r32]=l_reg;asm volatile("s_waitcnt lgkmcnt(0)":::"memory");
  #pragma unroll
  for(int r=0;r<16;++r)rli[r]=__builtin_amdgcn_rcpf(wsf[32+crow(r,hi)]);
  asm volatile("s_waitcnt lgkmcnt(0)\n\ts_barrier":::"memory");
  #undef DMA_K
  #undef DMA_V
  #undef CMASK
  #undef START
  #undef RESC
  #undef ROT
}
constexpr int LDS_STASH=LDS_BYTES, LDS_SSQ=LDS_STASH+NW*8192, ATTN_LDS_BYTES=LDS_SSQ+NW*128;
template<int THRL> __device__ __forceinline__ void dattn_unit(int b,int h,int qb,const bf16*Q,const bf16*K,const bf16*V,bf16*O,char*shm,float lam,const float*subln,float oml){
  #pragma unroll 1
  for(int pass=0;pass<4;++pass){
    const int m=pass&1,vh=pass>>1;
    f32x16 o[2]; float rli[16];
    attn_pass<THRL>(b,2*h+m,2*h+vh,qb,Q,K,V,shm,o,rli);
    int tid_=threadIdx.x; asm volatile("":"+v"(tid_)); const int tid=tid_,lane=tid&63,r32=lane&31,hi=lane>>5; const int wid=__builtin_amdgcn_readfirstlane(tid>>6);
    float*stash=(float*)(shm+LDS_STASH)+wid*2048; float*ssq0=(float*)(shm+LDS_SSQ)+wid*32; float*wsf=(float*)(shm+LDS_WS)+wid*64;
    unsigned short*stg=(unsigned short*)(shm+LDS_OST)+wid*2048;
    const long orow0=((long)b*SEQ+(long)qb*QB+wid*QBLK)*DM+h*128;
    if(m==0){
      #pragma unroll
      for(int d0=0;d0<2;++d0)
        #pragma unroll
        for(int r=0;r<16;++r)stash[(d0*16+r)*64+lane]=o[d0][r]*rli[r];
    }else{
      float sq[16];
      #pragma unroll
      for(int r=0;r<16;++r){ const float a0=stash[r*64+lane]-lam*o[0][r]*rli[r], a1=stash[(16+r)*64+lane]-lam*o[1][r]*rli[r]; o[0][r]=a0;o[1][r]=a1;sq[r]=a0*a0+a1*a1; }
      #pragma unroll
      for(int r=0;r<16;++r){ float s=sq[r]; s+=__shfl_xor(s,1);s+=__shfl_xor(s,2);s+=__shfl_xor(s,4);s+=__shfl_xor(s,8);s+=__shfl_xor(s,16); sq[r]=s; }
      if(vh==0){
        if(r32==0){
          #pragma unroll
          for(int r=0;r<16;++r)ssq0[crow(r,hi)]=sq[r]; }
        #pragma unroll
        for(int r=0;r<16;++r){const int orow=crow(r,hi); stg[orow*64+r32]=(unsigned short)(cvtpk_s(o[0][r],0.f)&0xffffu); stg[orow*64+32+r32]=(unsigned short)(cvtpk_s(o[1][r],0.f)&0xffffu);}
      }else{
        float rsc[16];
        #pragma unroll
        for(int r=0;r<16;++r)rsc[r]=__builtin_amdgcn_rsqf((sq[r]+ssq0[crow(r,hi)])*(1.f/128.f)+1e-6f)*oml;
        if(r32==0){
          #pragma unroll
          for(int r=0;r<16;++r)wsf[32+crow(r,hi)]=rsc[r]; }
        asm volatile("s_waitcnt lgkmcnt(0)":::"memory");
        { const int ch=lane&7; const float4 g0=*(const float4*)(subln+ch*8),g1=*(const float4*)(subln+ch*8+4);
          #pragma unroll
          for(int i=0;i<4;++i){const int row=i*8+(lane>>3); const u32x4 v=*(const u32x4*)(stg+row*64+ch*8); const float rs_=wsf[32+row];
            u32x4 w;
            w.x=cvtpk_s(__uint_as_float(v.x<<16)*rs_*g0.x,__uint_as_float(v.x&0xffff0000u)*rs_*g0.y); w.y=cvtpk_s(__uint_as_float(v.y<<16)*rs_*g0.z,__uint_as_float(v.y&0xffff0000u)*rs_*g0.w);
            w.z=cvtpk_s(__uint_as_float(v.z<<16)*rs_*g1.x,__uint_as_float(v.z&0xffff0000u)*rs_*g1.y); w.w=cvtpk_s(__uint_as_float(v.w<<16)*rs_*g1.z,__uint_as_float(v.w&0xffff0000u)*rs_*g1.w);
            *(u32x4*)((unsigned short*)O+orow0+(long)row*DM+ch*8)=w; } }
        asm volatile("s_waitcnt lgkmcnt(0)":::"memory");
        { const float ga=subln[64+r32],gb=subln[96+r32];
          #pragma unroll
          for(int r=0;r<16;++r){const int orow=crow(r,hi); stg[orow*64+r32]=(unsigned short)(cvtpk_s(o[0][r]*rsc[r]*ga,0.f)&0xffffu); stg[orow*64+32+r32]=(unsigned short)(cvtpk_s(o[1][r]*rsc[r]*gb,0.f)&0xffffu);}
          asm volatile("s_waitcnt lgkmcnt(0)":::"memory");
          #pragma unroll
          for(int i=0;i<4;++i){const int row=i*8+(lane>>3),ch=lane&7; const u32x4 v=*(const u32x4*)(stg+row*64+ch*8); *(u32x4*)((unsigned short*)O+orow0+(long)row*DM+64+ch*8)=v;} }
        asm volatile("s_waitcnt lgkmcnt(0)":::"memory");
      }
    }
  }
}
#undef SBAR
#undef WAIT_BAR
}

constexpr size_t SSM_F16_OFF = 0, SSM_TG_OFF = 2 * MiB, SSM_V_OFF = 8 * MiB;
constexpr int SSM_XLD = 392;
typedef short bf16x8_t __attribute__((ext_vector_type(8)));
__device__ __forceinline__ void ssm_tables(const Frame& F0, int L, unsigned char* base) {
    const Frame F = refresh(F0);
    LAS float* ap_re = (LAS float*)F.lds; LAS float* ap_im = ap_re + 17 * 64;
    LAS float* bb_re = ap_im + 17 * 64;   LAS float* bb_im = bb_re + 1024;
    LAS float* cc_re = bb_im + 1024;      LAS float* cc_im = cc_re + 1024;
    LAS float* kt = cc_im + 1024;         LAS float* dd = kt + 4096;
    const int tid = F.tid;
    for (int item = F.vcu; item < NG * 8; item += F.G) {
        const int g = item >> 3, part = item & 7;
        __syncthreads();
        if (tid < 64) {
            const int p = tid; const float dt = expf(inp(F, I_LSTEP)[L * NG + g]);
            const float lr = inp(F, I_LRE)[(L * NG + g) * SP + p], li = inp(F, I_LIM)[(L * NG + g) * SP + p];
            for (int tau = 0; tau <= 16; ++tau) { const float mg = expf(lr * dt * (float)tau); float sn, cs; sincosf(li * dt * (float)tau, &sn, &cs); ap_re[tau * 64 + p] = mg * cs; ap_im[tau * 64 + p] = mg * sn; }
            const float ab_re = ap_re[64 + p], ab_im = ap_im[64 + p];
            const float den = lr * lr + li * li, nr = ab_re - 1.f;
            const float coef_re = (nr * lr + ab_im * li) / den, coef_im = (ab_im * lr - nr * li) / den;
            const float* br = inp(F, I_BRE) + ((size_t)(L * NG + g) * SP + p) * SG; const float* bi = inp(F, I_BIM) + ((size_t)(L * NG + g) * SP + p) * SG;
            for (int h = 0; h < 16; ++h) { bb_re[p * 16 + h] = coef_re * br[h] - coef_im * bi[h]; bb_im[p * 16 + h] = coef_re * bi[h] + coef_im * br[h]; }
        }
        for (int i = tid; i < 1024; i += NTHREADS) { cc_re[i] = inp(F, I_CRE)[(size_t)(L * NG + g) * SG * SP + i]; cc_im[i] = inp(F, I_CIM)[(size_t)(L * NG + g) * SG * SP + i]; }
        if (tid < 16) dd[tid] = inp(F, I_SSMD)[(L * NG + g) * SG + tid];
        __syncthreads();
        unsigned* F16 = (unsigned*)(base + SSM_F16_OFF) + (size_t)g * 128 * 128;
        for (int i3 = tid; i3 < 16 * 128; i3 += NTHREADS) {
            const int i2 = part * 16 * 128 + i3, row = i2 >> 7, col = (i2 & 127) * 2, p = row & 63, j = col >> 4, h0 = col & 15;
            const float ar = ap_re[(15 - j) * 64 + p], ai = ap_im[(15 - j) * 64 + p];
            float v[2];
#pragma unroll
            for (int q = 0; q < 2; ++q) { const float br = bb_re[p * 16 + h0 + q], bi = bb_im[p * 16 + h0 + q]; v[q] = row < 64 ? (ar * br - ai * bi) : (ar * bi + ai * br); }
            F16[i2] = f2bf(v[0]) | (f2bf(v[1]) << 16);
        }
        for (int i = tid; i < (2 * part + 2) * 256; i += NTHREADS) {
            const int tau = i >> 8, h = (i >> 4) & 15, hp = i & 15; float acc = 0.f;
            for (int p = 0; p < 64; ++p) { const float ar = ap_re[tau * 64 + p], ai = ap_im[tau * 64 + p], br = bb_re[p * 16 + hp], bi = bb_im[p * 16 + hp];
                const float er = ar * br - ai * bi, ei = ar * bi + ai * br; acc += cc_re[h * 64 + p] * er - cc_im[h * 64 + p] * ei; }
            kt[i] = acc;
        }
        __syncthreads();
        unsigned* TG = (unsigned*)(base + SSM_TG_OFF) + (size_t)g * 256 * 192;
        for (int i3 = tid; i3 < 32 * 128; i3 += NTHREADS) {
            const int i2 = part * 32 * 128 + i3, row = i2 >> 7, col = (i2 & 127) * 2, i = row >> 4, h = row & 15, j = col >> 4, h0 = col & 15;
            float v[2] = {0.f, 0.f};
            if (j <= i) {
#pragma unroll
                for (int q = 0; q < 2; ++q) { v[q] = kt[((i - j) * 16 + h) * 16 + h0 + q]; if (i == j && h == h0 + q) v[q] += dd[h]; } }
            TG[row * 192 + (i2 & 127)] = f2bf(v[0]) | (f2bf(v[1]) << 16);
        }
        for (int i3 = tid; i3 < 32 * 64; i3 += NTHREADS) {
            const int i2 = part * 32 * 64 + i3, row = i2 >> 6, c = (i2 & 63) * 2, i = row >> 4, h = row & 15;
            float v[2];
#pragma unroll
            for (int q = 0; q < 2; ++q) { const int p = (c + q) & 63; const float ar = ap_re[(i + 1) * 64 + p], ai = ap_im[(i + 1) * 64 + p], cr = cc_re[h * 64 + p], ci = cc_im[h * 64 + p];
                v[q] = (c + q) < 64 ? (cr * ar - ci * ai) : -(cr * ai + ci * ar); }
            TG[row * 192 + 128 + (i2 & 63)] = f2bf(v[0]) | (f2bf(v[1]) << 16);
        }
    }
    __syncthreads();
}
__device__ __forceinline__ float gelu_fast(float x) { const float u = 1.5957691216057308f * (x + 0.044715f * x * x * x); return x - x * __builtin_amdgcn_rcpf(1.f + __expf(u)); }
__device__ __forceinline__ void ssm_item_mfma(const Frame& F0, int L, int it, const bf16* U, bf16* Z, const unsigned char* tbase, float* vscr) {
    const Frame F = refresh(F0);
    const int g = it & 31, b = it >> 5, tid = F.tid, lane = F.lane, w = F.wave, lr16 = lane & 15, q = lane >> 4;
    LAS unsigned char* X = F.lds;
    { const bf16* ub = U + (size_t)b * SEQ * SSMW + g * 16;
#pragma unroll
      for (int r = 0; r < 4; ++r) { const int t = tid + r * NTHREADS; const v4u* sp = (const v4u*)(ub + (size_t)t * SSMW); const v4u a = sp[0], c = sp[1];
          LAS v4u* dp = (LAS v4u*)(X + (t >> 4) * (SSM_XLD * 2) + (t & 15) * 32); dp[0] = a; dp[1] = c; } }
    __syncthreads();
    { const bf16* F16 = (const bf16*)(tbase + SSM_F16_OFF) + (size_t)g * 128 * 256 + (size_t)(16 * w + lr16) * 256 + 8 * q;
      bf16x8_t af[8];
#pragma unroll
      for (int ks = 0; ks < 8; ++ks) af[ks] = *(const bf16x8_t*)(F16 + ks * 32);
#pragma unroll 1
      for (int nt = 0; nt < 8; ++nt) {
          f32x4 acc = {0.f, 0.f, 0.f, 0.f};
          LAS const unsigned char* xr = X + (16 * nt + lr16) * (SSM_XLD * 2) + 16 * q;
#pragma unroll
          for (int ks = 0; ks < 8; ++ks) { const bf16x8_t bf = *(LAS const bf16x8_t*)(xr + ks * 64); acc = __builtin_amdgcn_mfma_f32_16x16x32_bf16(af[ks], bf, acc, 0, 0, 0); }
          *(f32x4*)(vscr + (size_t)(16 * nt + lr16) * 128 + 16 * w + 4 * q) = acc;
      } }
    asm volatile("s_waitcnt vmcnt(0)" ::: "memory");
    __syncthreads();
    if (w == 0) {
        __builtin_amdgcn_fence(__ATOMIC_ACQUIRE, "agent");
        const int p = lane; const float dt = expf(inp(F, I_LSTEP)[L * NG + g]);
        const float lr = inp(F, I_LRE)[(L * NG + g) * SP + p], li = inp(F, I_LIM)[(L * NG + g) * SP + p];
        const float mg = expf(lr * dt * 16.f); float sn, cs; sincosf(li * dt * 16.f, &sn, &cs); const float a_re = mg * cs, a_im = mg * sn;
        float s_re = 0.f, s_im = 0.f;
        LAS unsigned short* xs = (LAS unsigned short*)X + 256 + p;
#pragma unroll 1
        for (int c0 = 0; c0 < 128; c0 += 16) {
            float vr[16], vi[16];
#pragma unroll
            for (int j = 0; j < 16; ++j) { vr[j] = vscr[(c0 + j) * 128 + p]; vi[j] = vscr[(c0 + j) * 128 + 64 + p]; }
#pragma unroll
            for (int j = 0; j < 16; ++j) {
                xs[(c0 + j) * SSM_XLD] = (unsigned short)f2bf(s_re); xs[(c0 + j) * SSM_XLD + 64] = (unsigned short)f2bf(s_im);
                const float t_re = a_re * s_re - a_im * s_im + vr[j], t_im = a_re * s_im + a_im * s_re + vi[j]; s_re = t_re; s_im = t_im;
            }
        }
    }
    __syncthreads();
    { const int mA = w, mB = 15 - w, limA = mA >> 1, limB = mB >> 1;
      const bf16* TGa = (const bf16*)(tbase + SSM_TG_OFF) + (size_t)g * 256 * 384 + (size_t)(16 * mA + lr16) * 384 + 8 * q;
      const bf16* TGb = (const bf16*)(tbase + SSM_TG_OFF) + (size_t)g * 256 * 384 + (size_t)(16 * mB + lr16) * 384 + 8 * q;
      bf16x8_t fa[12], fb[12];
#pragma unroll
      for (int ks = 0; ks < 12; ++ks) { const bf16x8_t zz = {0, 0, 0, 0, 0, 0, 0, 0}; fa[ks] = (ks >= 8 || ks <= limA) ? *(const bf16x8_t*)(TGa + ks * 32) : zz; fb[ks] = (ks >= 8 || ks <= limB) ? *(const bf16x8_t*)(TGb + ks * 32) : zz; }
      bf16* zb = Z + (size_t)b * SEQ * SSMW + g * 16 + 4 * q;
#pragma unroll 1
      for (int nt = 0; nt < 8; ++nt) {
          f32x4 accA = {0.f, 0.f, 0.f, 0.f}, accB = {0.f, 0.f, 0.f, 0.f};
          LAS const unsigned char* xr = X + (16 * nt + lr16) * (SSM_XLD * 2) + 16 * q;
#pragma unroll
          for (int ks = 0; ks < 12; ++ks) { const bf16x8_t bf = *(LAS const bf16x8_t*)(xr + ks * 64);
              if (ks >= 8 || ks <= limA) accA = __builtin_amdgcn_mfma_f32_16x16x32_bf16(fa[ks], bf, accA, 0, 0, 0);
              if (ks >= 8 || ks <= limB) accB = __builtin_amdgcn_mfma_f32_16x16x32_bf16(fb[ks], bf, accB, 0, 0, 0); }
          const int sc = 16 * nt + lr16;
          { v2u o; o.x = f2bf(gelu_fast(accA[0])) | (f2bf(gelu_fast(accA[1])) << 16); o.y = f2bf(gelu_fast(accA[2])) | (f2bf(gelu_fast(accA[3])) << 16); *(v2u*)(zb + (size_t)(16 * sc + mA) * SSMW) = o; }
          { v2u o; o.x = f2bf(gelu_fast(accB[0])) | (f2bf(gelu_fast(accB[1])) << 16); o.y = f2bf(gelu_fast(accB[2])) | (f2bf(gelu_fast(accB[3])) << 16); *(v2u*)(zb + (size_t)(16 * sc + mB) * SSMW) = o; }
      } }
    __syncthreads();
}

__device__ __forceinline__ void router_phase(const Frame& F0, int L, const float* xio, unsigned* ctl, unsigned char* ws) {
    const Frame F = refresh(F0);
    LAS f32x4* Wg = (LAS f32x4*)F.lds; LAS f32x4* Wl = (LAS f32x4*)(F.lds + 16384); LAS f32x4* Wh = (LAS f32x4*)(F.lds + 81920);
    const float* gf = inp(F, I_FFN_G) + L * DM; const float* wrg = inp(F, I_WRG) + (size_t)L * DM * NGRP; const float* wre = inp(F, I_WRE) + (size_t)L * NGRP * DM * EPG;
    for (int k = F.tid; k < DM; k += NTHREADS) Wg[k] = *(const f32x4*)(wrg + (size_t)k * 4) * gf[k];
    for (int idx = F.tid; idx < NGRP * DM; idx += NTHREADS) { const float g = gf[idx & (DM - 1)]; const f32x4* s = (const f32x4*)(wre + (size_t)idx * 8); Wl[idx] = s[0] * g; Wh[idx] = s[1] * g; }
    __syncthreads();
    const float* brg = inp(F, I_BRG) + L * NGRP; const float* bre = inp(F, I_BRE2) + L * NGRP * EPG;
    unsigned* cnt = ctl + CW_CNT + L * 64 * CNT_STRIDE; SlotInfo* slots = (SlotInfo*)(ws + WS_SLOT);
    const int gw = F.vcu * NWAVES + F.wave, NGW = F.G * NWAVES;
    int my_t = -1, my_e0 = 0, my_e1 = 0; float my_w0 = 0.f, my_w1 = 0.f; int nr = 0;
    for (int t = gw; t < T; t += NGW, ++nr) {
        const float* xr = xio + (size_t)t * DM + F.lane;
        float xv[16]; float ss = 0.f;
#pragma unroll
        for (int j = 0; j < 16; ++j) { xv[j] = xr[64 * j]; ss += xv[j] * xv[j]; }
        const float rs = rsqrtf(wave_sum(ss) * (1.f / DM) + EPS);
        f32x4 ag = {0.f, 0.f, 0.f, 0.f};
#pragma unroll
        for (int j = 0; j < 16; ++j) ag += Wg[F.lane + 64 * j] * xv[j];
        float lg[4];
#pragma unroll
        for (int c = 0; c < 4; ++c) lg[c] = wave_sum(ag[c]) * rs + brg[c];
        int grp = 0; float gmax = lg[0];
#pragma unroll
        for (int c = 1; c < 4; ++c) if (lg[c] > gmax) { gmax = lg[c]; grp = c; }
        float gden = 0.f;
#pragma unroll
        for (int c = 0; c < 4; ++c) gden += __expf(lg[c] - gmax);
        const float p_grp = 1.f / gden;
        grp = __builtin_amdgcn_readfirstlane(grp);
        f32x4 al = {0.f, 0.f, 0.f, 0.f}, ah = {0.f, 0.f, 0.f, 0.f};
#pragma unroll
        for (int j = 0; j < 16; ++j) { const int idx = grp * DM + F.lane + 64 * j; al += Wl[idx] * xv[j]; ah += Wh[idx] * xv[j]; }
        float le[8];
#pragma unroll
        for (int c = 0; c < 4; ++c) { le[c] = wave_sum(al[c]) * rs + bre[grp * EPG + c]; le[4 + c] = wave_sum(ah[c]) * rs + bre[grp * EPG + 4 + c]; }
        int i0 = 0; float v0 = le[0];
#pragma unroll
        for (int c = 1; c < 8; ++c) if (le[c] > v0) { v0 = le[c]; i0 = c; }
        int i1 = -1; float v1 = -3.0e38f;
#pragma unroll
        for (int c = 0; c < 8; ++c) if (c != i0 && le[c] > v1) { v1 = le[c]; i1 = c; }
        const float e1 = __expf(v1 - v0);
        const float w0 = p_grp / (1.f + e1), w1 = p_grp * e1 / (1.f + e1);
        if (F.lane == (nr & 63)) { my_t = t; my_e0 = grp * EPG + i0; my_e1 = grp * EPG + i1; my_w0 = w0; my_w1 = w1; }
        if ((nr & 63) == 63 || t + NGW >= T) {
            if (my_t >= 0) {
                const unsigned p0 = atomicAdd(cnt + my_e0 * CNT_STRIDE, 1u), p1 = atomicAdd(cnt + (32 + my_e1) * CNT_STRIDE, 1u);
                slots[(size_t)my_e0 * T + p0] = SlotInfo{my_t, my_w0}; slots[(size_t)(32 + my_e1) * T + p1] = SlotInfo{my_t, my_w1};
            }
            my_t = -1;
        }
    }
}
constexpr int LDS_TB_OFF = 143360;
__device__ __forceinline__ void moe_tables(const Frame& F0, int L, unsigned* ctl) {
    const Frame F = refresh(F0);
    LAS int* tb = (LAS int*)(F.lds + LDS_TB_OFF); LAS int* tc = tb + 80;
    if (F.tid < 64) tc[F.tid] = (int)__hip_atomic_load(ctl + CW_CNT + (L * 64 + F.tid) * CNT_STRIDE, __ATOMIC_RELAXED, __HIP_MEMORY_SCOPE_AGENT);
    __syncthreads();
    if (F.tid == 0) { int s = 0; for (int i = 0; i < 64; ++i) { tb[i] = s; s += (tc[i] + 255) >> 8; } tb[64] = s; }
    __syncthreads();
    if (F.tid < 64) { const int t0 = tb[F.tid], t1 = tb[F.tid + 1]; for (int t = t0; t < t1; ++t) tb[160 + t] = F.tid; }
    __syncthreads();
}
__device__ __forceinline__ void moe_gather_tables(const Frame& F0, const pg8::MoeSched& S, const SlotInfo* slots, const float* part) {
    const Frame F = refresh(F0);
    LAS unsigned* tokoff = (LAS unsigned*)(F.lds + PG8_TOKOFF_OFF); LAS float* ri = (LAS float*)(F.lds + PG8_ROWINFO_OFF);
    pg8::Unit u;
    for (int i = 0; i < 4 && S.next(i, u); ++i) {
        if (F.tid < 256) { const int p = u.mt * 256 + F.tid; SlotInfo si = SlotInfo{0, 0.f};
            if (p < u.cnt) si = slots[(size_t)(u.k * 32 + u.e) * T + p];
            const float rs = pg8::rowscale16(part, si.token);
            tokoff[i * 256 + F.tid] = (unsigned)si.token * (unsigned)(DM * 2); ri[(i * 256 + F.tid) * 2] = si.w; ri[(i * 256 + F.tid) * 2 + 1] = rs; }
    }
    __syncthreads();
}
__device__ __forceinline__ void moe_down_tables(const Frame& F0, const pg8::MoeSched& S, const SlotInfo* slots) {
    const Frame F = refresh(F0);
    LAS int* tk = (LAS int*)(F.lds + PG8_TOKOFF_OFF);
    pg8::Unit u;
    for (int i = 0; i < 4 && S.next(i, u); ++i) {
        if (F.tid < 256) { const int p = u.mt * 256 + F.tid; tk[i * 256 + F.tid] = (p < u.cnt) ? slots[(size_t)(u.k * 32 + u.e) * T + p].token : -1; }
    }
    __syncthreads();
}
__device__ __forceinline__ void fill_rowscales(const Frame& F0, const pg8::StaticOrder& S, const float* part) {
    const Frame F = refresh(F0);
    LAS float* rsl = (LAS float*)(F.lds + PG8_RS_OFF);
    pg8::Unit u; const int half = F.tid >> 8, r = F.tid & 255;
    for (int i = 0; i < 8; i += 2) { if (S.next(i + half, u)) rsl[(i + half) * 256 + r] = pg8::rowscale16(part, u.pm * 256 + r); }
    __syncthreads();
}

__global__ void __launch_bounds__(NTHREADS, 2) mega_fwd(Args args) {
    extern __shared__ __attribute__((aligned(16))) unsigned char lds_raw[];
    Frame Fk;
    Fk.lds = (LAS unsigned char*)lds_raw;
    Fk.tid = threadIdx.x; Fk.lane = Fk.tid & 63; Fk.wave = __builtin_amdgcn_readfirstlane(Fk.tid >> 6);
    Fk.G = gridDim.x; { const int bx = blockIdx.x; Fk.vcu = (Fk.G % 8 == 0) ? (bx % 8) * (Fk.G / 8) + bx / 8 : bx; }
    const Frame& F = Fk;
    volatile LAS unsigned* MISC = (volatile LAS unsigned*)(F.lds + MISC_OFF);
    if (F.tid < 64) MISC[F.tid] = 0u;
    if (F.tid < N_IN) ((LAS unsigned long long*)(F.lds + PTAB_OFF))[F.tid] = (unsigned long long)args.in[F.tid];
    __syncthreads();
    unsigned char* const ws = args.ws;
    XcdBarrier bar = xcd_barrier_post((unsigned*)(ws + WS_CTL) + CW_BAR, MISC + 8);
#define GRID_BAR() xcd_barrier(bar)
#define PHASE_WS unsigned long long wv_ = (unsigned long long)ws; asm volatile("" : "+s"(wv_)); GAS unsigned char* const w_ = (GAS unsigned char*)wv_
    constexpr size_t PARTSZ = (size_t)T * 16 * 4;
    const int NGW = F.G * NWAVES;

    { PHASE_WS; const Frame F = refresh(Fk); const int gw = F.vcu * NWAVES + F.wave;
      float* part = (float*)(w_ + WS_PART); bf16* X0 = (bf16*)(w_ + WS_X0); bf16* PB = (bf16*)(w_ + WS_PB); float* lamv = (float*)(w_ + WS_MISC);
    for (int m = gw; m < T; m += NGW) {
        const f32x4* xr = (const f32x4*)(inp(F, I_X) + (size_t)m * DM) + F.lane; float s = 0.f;
        v2u* o8 = (v2u*)(X0 + (size_t)m * DM) + F.lane;
#pragma unroll
        for (int j = 0; j < 4; ++j) { const f32x4 v = xr[64 * j]; s += v.x * v.x + v.y * v.y + v.z * v.z + v.w * v.w;
            v2u w; w.x = f2bf(v.x) | (f2bf(v.y) << 16); w.y = f2bf(v.z) | (f2bf(v.w) << 16); o8[64 * j] = w; }
        s = wave_sum(s);
        if (F.lane < 16) part[(size_t)m * 16 + F.lane] = (F.lane == 0) ? s : 0.f;
    }
    for (size_t i = (size_t)(blockIdx.x * NTHREADS + F.tid) * 4; i < (size_t)DEPTH * T * PLE; i += (size_t)F.G * NTHREADS * 4) {
        const f32x4 v = *(const f32x4*)(inp(F, I_P) + i); v2u w; w.x = f2bf(v.x) | (f2bf(v.y) << 16); w.y = f2bf(v.z) | (f2bf(v.w) << 16); *(v2u*)(PB + i) = w; }
    if (blockIdx.x == 0 && F.tid < DEPTH) {
        const float* lq = inp(F, I_LAMQK) + F.tid * 4 * HD; float s1 = 0.f, s2 = 0.f;
        for (int j = 0; j < HD; ++j) { s1 += lq[j] * lq[HD + j]; s2 += lq[2 * HD + j] * lq[3 * HD + j]; }
        lamv[F.tid] = expf(s1) - expf(s2) + lam_init_for(F.tid);
    }
    convert_weights(Fk, 0, (unsigned char*)(w_ + WS_WT));
    ssm_tables(Fk, 0, (unsigned char*)(w_ + WS_X1));
    }
    GRID_BAR();

#define GEMM_PHASE(EPI, Aptr, WOFF, N_, K_, E_) do { pg8::Gemm g_{(const pg8::bf16_t*)(Aptr), (const pg8::bf16_t*)(unsigned char*)(w_ + WS_WT + (WOFF)), T, (N_), (K_)}; pg8::StaticOrder S_; S_.init(T, (N_), F.G, (int)blockIdx.x); \
        pg8::gemm_phase<EPI, pg8::StaticOrder, true, true>(F.lds, g_, S_, E_); } while (0)
#define P_XA ((bf16*)(unsigned char*)(w_ + ((L & 1) ? WS_X1 : WS_X0)))
#define P_XB ((bf16*)(unsigned char*)(w_ + ((L & 1) ? WS_X0 : WS_X1)))
#define P_PART ((float*)(unsigned char*)(w_ + WS_PART + (size_t)(L & 1) * PARTSZ))
#define P_PART2 ((float*)(unsigned char*)(w_ + WS_PART + (size_t)((L & 1) ^ 1) * PARTSZ))
#define P_(T_, OFF) ((T_*)(unsigned char*)(w_ + (OFF)))
#pragma unroll 1
    for (int L = 0; L < DEPTH; ++L) {
        if (L > 0) { { PHASE_WS; convert_weights(Fk, L, (unsigned char*)(w_ + WS_WT)); ssm_tables(Fk, L, (unsigned char*)P_XB); } GRID_BAR(); }
        { PHASE_WS; pg8::EpiWinF E{F.lds, P_(bf16, WS_Q), P_(bf16, WS_K), P_(bf16, WS_V), P_(bf16, WS_U), P_(bf16, WS_GATES), inp(F, I_QG) + L * 2 * HD, inp(F, I_KG) + L * 2 * HD, inp(F, I_BGATE) + L * 2 * DM};
          { pg8::StaticOrder S0; S0.init(T, INW, F.G, (int)blockIdx.x); fill_rowscales(Fk, S0, P_PART); }
          GEMM_PHASE(pg8::EpiWinF, P_XA, WT_WIN, INW, DM, E); }
        GRID_BAR();
        { PHASE_WS;
          for (int it = F.vcu; it < BATCH * NG; it += F.G)
              ssm_item_mfma(Fk, L, it, P_(const bf16, WS_U), P_(bf16, WS_Z), (const unsigned char*)P_XB, (float*)((unsigned char*)P_XB + SSM_V_OFF) + (size_t)F.vcu * 16384); }
        { PHASE_WS; const Frame F = refresh(Fk);
          const float lam = P_(float, WS_MISC)[L]; const float oml = 1.f - lam_init_for(L); const float* subln = inp(F, I_SUBLN) + L * 2 * HD;
          static_assert(attn_body::ATTN_LDS_BYTES <= PTAB_OFF, "attention LDS");
          for (int v = F.vcu; v < BATCH * NH * 4; v += F.G) {
              const int bh = v >> 2, s = v & 3;
#pragma unroll 1
              for (int i = 0; i < 2; ++i)
                  attn_body::dattn_unit<8>(bh >> 3, bh & 7, i ? s : 7 - s, P_(const attn_body::bf16, WS_Q), P_(const attn_body::bf16, WS_K), P_(const attn_body::bf16, WS_V), P_(attn_body::bf16, WS_Q), (char*)lds_raw, lam, subln, oml);
          } }
        GRID_BAR();
        { PHASE_WS; pg8::EpiGluF E{P_(bf16, WS_Z), P_(bf16, WS_Z2), inp(F, I_BGLU) + L * SSMW}; GEMM_PHASE(pg8::EpiGluF, P_(bf16, WS_Z), WT_WGLU, SSMW, SSMW, E); }
        GRID_BAR();
        { PHASE_WS; pg8::EpiGateF E{P_(bf16, WS_GATES), DM, nullptr, P_(bf16, WS_PARTS)}; GEMM_PHASE(pg8::EpiGateF, P_(bf16, WS_Z2), WT_WSU, DM, SSMW, E); }
        GRID_BAR();
        { PHASE_WS; pg8::EpiGateF E{P_(bf16, WS_GATES), 0, P_(bf16, WS_PARTS), P_(bf16, WS_MIXED)}; GEMM_PHASE(pg8::EpiGateF, P_(bf16, WS_Q), WT_WAU, DM, VW, E); }
        GRID_BAR();
        { PHASE_WS; const float* xbase = (L == 0) ? inp(F, I_X) : args.out;
          pg8::EpiResF E{xbase, args.out, P_XB, P_PART2}; GEMM_PHASE(pg8::EpiResF, P_(bf16, WS_MIXED), WT_WOUT, DM, DM, E); }
        GRID_BAR();
        { PHASE_WS; pg8::EpiPlainF E{P_(bf16, WS_PLE), DM}; GEMM_PHASE(pg8::EpiPlainF, P_(bf16, WS_PB) + (size_t)L * T * PLE, WT_WPLE, DM, PLE, E);
          router_phase(Fk, L, args.out, P_(unsigned, WS_CTL), (unsigned char*)w_); }
        GRID_BAR();
        { PHASE_WS; moe_tables(Fk, L, P_(unsigned, WS_CTL));
          pg8::MoeSched S{(LAS const int*)(F.lds + LDS_TB_OFF), (LAS const int*)(F.lds + LDS_TB_OFF) + 80, F.G, (int)blockIdx.x, 0};
          moe_gather_tables(Fk, S, P_(const SlotInfo, WS_SLOT), P_PART2);
          pg8::Gemm g{(const pg8::bf16_t*)P_XB, (const pg8::bf16_t*)(unsigned char*)(w_ + WS_WT + WT_WGU), T, 512, DM};
          pg8::EpiActF E{P_(pg8::bf16_t, WS_ACT), F.lds};
          pg8::gemm_phase_g<pg8::EpiActF, pg8::MoeSched>(F.lds, g, S, E); }
        GRID_BAR();
        { PHASE_WS; moe_tables(Fk, L, P_(unsigned, WS_CTL));
          pg8::MoeSched S{(LAS const int*)(F.lds + LDS_TB_OFF), (LAS const int*)(F.lds + LDS_TB_OFF) + 80, F.G, (int)blockIdx.x, 1};
          pg8::Gemm g{P_(const pg8::bf16_t, WS_ACT), (const pg8::bf16_t*)(unsigned char*)(w_ + WS_WT + WT_WD), T, DM, EFF};
          moe_down_tables(Fk, S, P_(const SlotInfo, WS_SLOT));
          pg8::EpiDownF<0> E{F.lds, args.out, P_XA, P_PART};
          pg8::gemm_phase<pg8::EpiDownF<0>, pg8::MoeSched, true, true>(F.lds, g, S, E); }
        GRID_BAR();
        { PHASE_WS; moe_tables(Fk, L, P_(unsigned, WS_CTL));
          pg8::MoeSched S{(LAS const int*)(F.lds + LDS_TB_OFF), (LAS const int*)(F.lds + LDS_TB_OFF) + 80, F.G, (int)blockIdx.x, 2};
          pg8::Gemm g{P_(const pg8::bf16_t, WS_ACT), (const pg8::bf16_t*)(unsigned char*)(w_ + WS_WT + WT_WD), T, DM, EFF};
          moe_down_tables(Fk, S, P_(const SlotInfo, WS_SLOT));
          pg8::EpiDownF<1> E{F.lds, args.out, P_XA, P_PART};
          pg8::gemm_phase<pg8::EpiDownF<1>, pg8::MoeSched, true, true>(F.lds, g, S, E); }
        GRID_BAR();
        { PHASE_WS; pg8::EpiPleF E{F.lds, P_(bf16, WS_PLE), args.out, P_XB, P_PART2};
          { pg8::StaticOrder S0; S0.init(T, DM, F.G, (int)blockIdx.x); fill_rowscales(Fk, S0, P_PART); }
          GEMM_PHASE(pg8::EpiPleF, P_XA, WT_WPG, DM, DM, E); }
        GRID_BAR();
    }
}

extern "C" void kernel_launch(void* const* d_in, const int* in_sizes, int n_in, void* d_out, int out_size, void* d_ws, size_t ws_size, hipStream_t stream) {
    static int grid = 0;
    if (grid == 0) {
        if (n_in != N_IN || in_sizes[0] != T * DM || out_size != T * DM || ws_size < WS_END) {
            fprintf(stderr, "kernel_launch: unexpected problem (n_in %d, in0 %d, out %d, ws %zu); nothing launched\n", n_in, n_in > 0 ? in_sizes[0] : -1, out_size, ws_size); grid = -1; return; }
        int dev = 0, cus = 0, per_cu = 0;
        if (hipGetDevice(&dev) != hipSuccess || hipDeviceGetAttribute(&cus, hipDeviceAttributeMultiprocessorCount, dev) != hipSuccess) { grid = -1; return; }
        if (hipFuncSetAttribute((const void*)mega_fwd, hipFuncAttributeMaxDynamicSharedMemorySize, LDS_BYTES) != hipSuccess) { fprintf(stderr, "kernel_launch: hipFuncSetAttribute failed\n"); grid = -1; return; }
        if (hipOccupancyMaxActiveBlocksPerMultiprocessor(&per_cu, (const void*)mega_fwd, NTHREADS, LDS_BYTES) != hipSuccess || per_cu < 1)
            fprintf(stderr, "kernel_launch: note: occupancy query reports %d workgroups per CU\n", per_cu);
        (void)hipGetLastError();
        grid = cus;
    }
    if (grid < 0) return;
    if (hipMemsetAsync((char*)d_ws + WS_CTL, 0, CTL_ZERO_BYTES, stream) != hipSuccess) { fprintf(stderr, "kernel_launch: memset failed\n"); return; }
    Args a{};
    for (int i = 0; i < N_IN; ++i) a.in[i] = (const float*)d_in[i];
    a.out = (float*)d_out; a.ws = (unsigned char*)d_ws;
    hipLaunchKernelGGL(mega_fwd, dim3(grid), dim3(NTHREADS), LDS_BYTES, stream, a);
    const hipError_t le = hipPeekAtLastError();
    if (le != hipSuccess) fprintf(stderr, "kernel_launch: launch failed: %s\n", hipGetErrorName(le));
}
```

```cpp
#include <hip/hip_runtime.h>
#include <cstdio>
#include <cstdint>
#include <cmath>
#include <hip/hip_bf16.h>

#define GAS __attribute__((address_space(1)))
#define LAS __attribute__((address_space(3)))
typedef unsigned short bf16;
typedef unsigned v4u __attribute__((ext_vector_type(4)));
typedef unsigned v2u __attribute__((ext_vector_type(2)));
typedef float f32x4 __attribute__((ext_vector_type(4)));

constexpr int DM = 1024, BATCH = 8, SEQ = 2048, T = BATCH * SEQ, DEPTH = 2;
constexpr int NH = 8, HD = 64, QKW = 1024, VW = 1024, SSMW = 512, SG = 16, NG = 32, SP = 64;
constexpr int INW = 5632, NGRP = 4, EPG = 8, NEXP = 32, EFF = 256, PLE = 256;
constexpr float EPS = 1e-6f;
constexpr float C2 = 0.125f * 1.4426950408889634f;
constexpr int NWAVES = 8, NTHREADS = 512;

enum { I_X = 0, I_P, I_ATTN_G, I_WIN, I_BGATE, I_QG, I_KG, I_LAMQK, I_SUBLN, I_WAU, I_LRE, I_LIM, I_LSTEP, I_BRE, I_BIM, I_CRE, I_CIM,
       I_SSMD, I_WGLU, I_BGLU, I_WSU, I_WOUT, I_FFN_G, I_WRG, I_BRG, I_WRE, I_BRE2, I_WEG, I_WEU, I_WED, I_PLE_G, I_WPG, I_WPLE, N_IN };

constexpr size_t MiB = 1u << 20;
constexpr size_t WS_CTL = 0, CTL_ZERO_BYTES = 1 * MiB;
constexpr size_t WS_PART = 1 * MiB;
constexpr size_t WS_MISC = 3 * MiB;
constexpr size_t WS_SLOT = 4 * MiB;
constexpr size_t WS_WT = 16 * MiB;
constexpr size_t WS_X0 = 84 * MiB, WS_X1 = 116 * MiB;
constexpr size_t WS_Q = 148 * MiB, WS_K = 180 * MiB, WS_V = 212 * MiB;
constexpr size_t WS_U = 244 * MiB, WS_Z = 260 * MiB;
constexpr size_t WS_GATES = 276 * MiB;
constexpr size_t WS_PB = 340 * MiB;
constexpr size_t WS_SSMT = 356 * MiB;
constexpr size_t WS_END = 364 * MiB;
constexpr size_t WS_Z2 = WS_U, WS_MIXED = WS_K, WS_PARTS = WS_V, WS_PLE = WS_GATES, WS_OTMP = WS_X0, WS_ACT = WS_V;
struct SlotInfo { int token; float w; };
constexpr int CW_BAR = 4096;
constexpr int CW_CNT = 16384, CNT_STRIDE = 64;

__device__ __forceinline__ unsigned f2bf(float f) { unsigned u = __builtin_bit_cast(unsigned, f); return (u + 0x7fffu + ((u >> 16) & 1u)) >> 16; }
__device__ __forceinline__ float bf2f(unsigned b) { return __builtin_bit_cast(float, b << 16); }
__device__ __forceinline__ float bflo(unsigned w) { return __builtin_bit_cast(float, w << 16); }
__device__ __forceinline__ float bfhi(unsigned w) { return __builtin_bit_cast(float, w & 0xffff0000u); }
__device__ __forceinline__ float wave_sum(float v) {
#pragma unroll
    for (int o = 1; o < 64; o <<= 1) v += __shfl_xor(v, o);
    return v;
}
__device__ __forceinline__ float sigmoidf_(float x) { return 1.f / (1.f + __expf(-x)); }
__device__ __forceinline__ float gelu_tanh(float x) { const float u = 0.7978845608028654f * (x + 0.044715f * x * x * x); return 0.5f * x * (1.f + tanhf(u)); }
__device__ __forceinline__ float rowscale(const float* part, int row) {
    const f32x4* p = (const f32x4*)(part + (size_t)row * 16);
    float s = 0.f;
#pragma unroll
    for (int i = 0; i < 4; ++i) { const f32x4 v = p[i]; s += v.x; s += v.y; s += v.z; s += v.w; }
    return rsqrtf(s * (1.f / DM) + EPS);
}
__host__ __device__ inline float lam_init_for(int i) { return 0.8f - 0.6f * expf(-0.3f * (float)i); }

#define XB_TMO      128
#define XB_XCNT(j)  (256  + 64 * (j))
#define XB_XSUB(j)  (1280 + 64 * (j))
#define XB_XGEN(j)  (2304 + 64 * (j))
#define XB_TOP      3328
#define XB_TOPGEN   3392
#define XB_LSUB(j)  (3456 + 64 * (j))
#define XB_LGEN(j)  (4480 + 64 * (j))
#define XCD_BAR_WORDS 5504
#define XB_SPIN_CAP (1u << 22)
__device__ __forceinline__ unsigned xb_ld(unsigned* p)              { return __hip_atomic_load(p, __ATOMIC_RELAXED, __HIP_MEMORY_SCOPE_AGENT); }
__device__ __forceinline__ unsigned xb_add(unsigned* p, unsigned v) { return __hip_atomic_fetch_add(p, v, __ATOMIC_RELAXED, __HIP_MEMORY_SCOPE_AGENT); }
__device__ __forceinline__ unsigned xb_xcc_id() { return (unsigned)__builtin_amdgcn_s_getreg((3 << 11) | 20) & 0xFu; }
#define XB_SPIN(cond, bar) do { unsigned _sp = 0; while (cond) { __builtin_amdgcn_s_sleep(1); \
    if ((++_sp & 255u) == 0u) { if (xb_ld(&(bar)[XB_TMO])) break; if (_sp > XB_SPIN_CAP) { atomicAdd(&(bar)[XB_TMO], 1u); break; } } } } while (0)
struct XcdBarrier { unsigned* bar; unsigned x; volatile LAS unsigned* st; };
__device__ __forceinline__ XcdBarrier xcd_barrier_post(unsigned* bar, volatile LAS unsigned* st) {
    XcdBarrier b; b.bar = bar; b.x = 0; b.st = st;
    if (threadIdx.x == 0) { const unsigned x = xb_xcc_id(); st[2] = x; st[4] = xb_add(&bar[XB_XCNT(x)], 1u); }
    return b;
}
__device__ __forceinline__ void xcd_barrier_complete(unsigned* bar, unsigned x, unsigned& nloc, unsigned& nx) {
    const unsigned G = gridDim.x * gridDim.y * gridDim.z;
    unsigned sum, cnt, mine, sp = 0u;
    for (;;) {
        sum = 0u; cnt = 0u; mine = 0u;
#pragma unroll
        for (unsigned j = 0; j < 16; ++j) { const unsigned c = xb_ld(&bar[XB_XCNT(j)]); sum += c; cnt += (c > 0u) ? 1u : 0u; mine = (j == x) ? c : mine; }
        if (sum == G) break;
        __builtin_amdgcn_s_sleep(1);
        if ((++sp & 255u) == 0u) { if (xb_ld(&bar[XB_TMO])) break; if (sp > XB_SPIN_CAP) { atomicAdd(&bar[XB_TMO], 1u); break; } }
    }
    nloc = mine > 0u ? mine : 1u; nx = cnt > 0u ? cnt : 1u;
}
__device__ __forceinline__ unsigned xcd_census_even(unsigned* bar) {
    const unsigned G = gridDim.x; unsigned ok = (G % 8u == 0u) ? 1u : 0u;
#pragma unroll
    for (unsigned j = 0; j < 16; ++j) { const unsigned c = xb_ld(&bar[XB_XCNT(j)]); if (c != (j < 8u ? G / 8u : 0u)) ok = 0u; }
    return ok;
}
__device__ __forceinline__ void xcd_barrier(const XcdBarrier& b) {
    asm volatile("s_waitcnt vmcnt(0)" ::: "memory");
    __syncthreads();
    if (threadIdx.x == 0) {
        unsigned* bar = b.bar;
        __builtin_amdgcn_s_waitcnt(0);
        unsigned nloc = b.st[0], nx = b.st[1]; const unsigned bx = b.st[2];
        if (nloc == 0u) { xcd_barrier_complete(bar, bx, nloc, nx); b.st[0] = nloc; b.st[1] = nx; b.st[3] = xcd_census_even(bar); }
        const unsigned old = xb_add(&bar[XB_XSUB(bx)], 1u);
        const unsigned gen = old / nloc;
        if (old + 1u == (gen + 1u) * nloc) {
            __builtin_amdgcn_fence(__ATOMIC_RELEASE, "agent");
            asm volatile("s_waitcnt vmcnt(0)" ::: "memory");
            const unsigned og = xb_add(&bar[XB_TOP], 1u);
            const unsigned tg = og / nx;
            if (og + 1u == (tg + 1u) * nx) xb_add(&bar[XB_TOPGEN], 1u);
            else XB_SPIN(xb_ld(&bar[XB_TOPGEN]) == tg, bar);
            __builtin_amdgcn_fence(__ATOMIC_ACQUIRE, "agent");
            xb_add(&bar[XB_XGEN(bx)], 1u);
            asm volatile("s_waitcnt vmcnt(0)" ::: "memory");
        } else {
            XB_SPIN(xb_ld(&bar[XB_XGEN(bx)]) == gen, bar);
            __builtin_amdgcn_fence(__ATOMIC_ACQUIRE, "agent");
            asm volatile("s_waitcnt vmcnt(0)" ::: "memory");
        }
    }
    __syncthreads();
}

__device__ __forceinline__ void xcc_barrier(const XcdBarrier& b) {
    asm volatile("s_waitcnt vmcnt(0)" ::: "memory");
    __syncthreads();
    if (threadIdx.x == 0) {
        unsigned* bar = b.bar;
        __builtin_amdgcn_s_waitcnt(0);
        const unsigned nloc = b.st[0], bx = b.st[2];
        const unsigned old = xb_add(&bar[XB_LSUB(bx)], 1u);
        const unsigned gen = old / nloc;
        if (old + 1u == (gen + 1u) * nloc) xb_add(&bar[XB_LGEN(bx)], 1u);
        else XB_SPIN(xb_ld(&bar[XB_LGEN(bx)]) == gen, bar);
        __builtin_amdgcn_fence(__ATOMIC_ACQUIRE, "agent");
        asm volatile("s_waitcnt vmcnt(0)" ::: "memory");
    }
    __syncthreads();
}

constexpr int LDS_BYTES = 160 * 1024 - 1024;
constexpr int MISC_OFF = LDS_BYTES - 256;
constexpr int PTAB_OFF = LDS_BYTES - 1024;

struct Args { const float* in[N_IN]; float* out; unsigned char* ws; };

struct Frame {
    LAS unsigned char* lds;
    int tid, lane, wave, vcu, G, cid, even;
};
__device__ __forceinline__ Frame refresh(const Frame& F0) {
    Frame F = F0; int t = F0.tid; asm volatile("" : "+v"(t)); F.tid = t; F.lane = t & 63; F.wave = __builtin_amdgcn_readfirstlane(t >> 6); return F;
}
__device__ __forceinline__ const float* inp(const Frame& F, int i) {
    const LAS unsigned* p = (const LAS unsigned*)(F.lds + PTAB_OFF) + 2 * i;
    const unsigned lo = __builtin_amdgcn_readfirstlane(p[0]), hi = __builtin_amdgcn_readfirstlane(p[1]);
    return (const float*)(const GAS float*)(((unsigned long long)hi << 32) | lo);
}

namespace pg8 {
#define PG8_LAS __attribute__((address_space(3)))
typedef unsigned short bf16_t;
typedef short bf16x8 __attribute__((ext_vector_type(8)));
typedef float f32x4 __attribute__((ext_vector_type(4)));
typedef unsigned u32x4 __attribute__((ext_vector_type(4)));
constexpr int BM = 256, BK = 64, HALF = 128, HTB = HALF * BK * 2  , STAGE_BYTES = 8 * HTB, NXCD = 8, WGM = 8;

__host__ __device__ __forceinline__ int lds_byte(int r, int c) { const int st = (r >> 4) * 2 + (c >> 5), rr = r & 15, cc = c & 31, ob = rr * 64 + cc * 2; return st * 1024 + (ob ^ (((ob >> 9) & 1) << 5)); }
__host__ __device__ __forceinline__ void stage_rc(int b, int& R, int& C) { const int st = b / 1024, sb = b % 1024, swz = sb ^ (((sb >> 9) & 1) << 5); R = (st >> 1) * 16 + swz / 64; C = (st & 1) * 32 + (swz % 64) / 2; }
__host__ __device__ __forceinline__ int perm32(int rho) { const int n = rho >> 4, i = rho & 15; return 8 * (i >> 2) + 4 * n + (i & 3); }

struct Unit { int pm, pn, e, mt, cnt, pl, k, slot; };
struct Gemm { const bf16_t* A; const bf16_t* Bt; int M, N, K; };

struct StaticOrder {
    int nM, nN, nwg, G, c;
    __host__ __device__ void init(int M, int N, int G_, int c_) { nM = M / BM; nN = N / BM; nwg = nM * nN; G = G_; c = c_; }
    __host__ __device__ bool next(int i, Unit& u) const {
        const long L = (long)i * G + c; if (L >= nwg) return false;
        int wgid = (int)L; { const int q = nwg / NXCD, r = nwg % NXCD, xcd = wgid % NXCD, off = wgid / NXCD; wgid = (xcd < r ? xcd * (q + 1) : r * (q + 1) + (xcd - r) * q) + off; }
        const int nig = WGM * nN, gid = wgid / nig, fm = gid * WGM, gsz = (nM - fm) < WGM ? (nM - fm) : WGM;
        u.pm = fm + ((wgid % nig) % gsz); u.pn = (wgid % nig) / gsz; u.slot = i; return true;
    }
    __device__ __forceinline__ void a_ready(const Unit&) const {}
    __device__ __forceinline__ void done(const Unit&) const {}
};
typedef float f32x2_t __attribute__((ext_vector_type(2))); typedef __bf16 bf16x2_t __attribute__((ext_vector_type(2)));
__device__ __forceinline__ unsigned cvt_pk_bf16(float lo, float hi) { f32x2_t v = {lo, hi}; bf16x2_t b = __builtin_convertvector(v, bf16x2_t); return __builtin_bit_cast(unsigned, b); }

__device__ __forceinline__ float rowscale16(const float* part, int row) {
    const f32x4* p = (const f32x4*)(part + (size_t)row * 16); float s = 0.f;
#pragma unroll
    for (int i = 0; i < 4; ++i) { const f32x4 v = p[i]; s += v[0]; s += v[1]; s += v[2]; s += v[3]; }
    return rsqrtf(s * (1.f / 1024.f) + EPS);
}
__device__ __forceinline__ u32x4 pack8(f32x4 a, f32x4 b) { u32x4 w; w.x = cvt_pk_bf16(a[0], a[1]); w.y = cvt_pk_bf16(a[2], a[3]); w.z = cvt_pk_bf16(b[0], b[1]); w.w = cvt_pk_bf16(b[2], b[3]); return w; }
__device__ __forceinline__ void unpack8(u32x4 w, f32x4& a, f32x4& b) {
    a = (f32x4){__builtin_bit_cast(float, w.x << 16), __builtin_bit_cast(float, w.x & 0xffff0000u), __builtin_bit_cast(float, w.y << 16), __builtin_bit_cast(float, w.y & 0xffff0000u)};
    b = (f32x4){__builtin_bit_cast(float, w.z << 16), __builtin_bit_cast(float, w.z & 0xffff0000u), __builtin_bit_cast(float, w.w << 16), __builtin_bit_cast(float, w.w & 0xffff0000u)};
}
__device__ __forceinline__ float sig1(float x) { return __builtin_amdgcn_rcpf(1.f + __builtin_amdgcn_exp2f(-1.4426950408889634f * x)); }
__device__ __forceinline__ f32x4 sig4(f32x4 x) { return (f32x4){sig1(x[0]), sig1(x[1]), sig1(x[2]), sig1(x[3])}; }
__device__ __forceinline__ float dot4(f32x4 x) { return (x[0] * x[0] + x[1] * x[1]) + (x[2] * x[2] + x[3] * x[3]); }

#define PG8_TOKOFF_OFF 131072
#define PG8_ROWINFO_OFF 135168
#define PG8_RS_OFF 144384
struct EpiWinF {
    static constexpr bool PERM = false, AFTER_DRAIN = false;
    PG8_LAS const unsigned char* lds; bf16_t *q, *k, *v, *u, *gates; const float *qg, *kg, *bgate;
    __device__ __forceinline__ void operator()(const f32x4 (&acc)[2][2][4][2], const Unit& un, int wr, int wc, int, int) const {
        int l_ = threadIdx.x; asm volatile("" : "+v"(l_)); const int fr = l_ & 15, fq = (l_ >> 4) & 3;
        const int pn = un.pn, rl0 = wr * 64 + fr; const size_t row0 = (size_t)un.pm * BM + rl0;
        PG8_LAS const float* rsl = (PG8_LAS const float*)(lds + PG8_RS_OFF) + un.slot * 256 + rl0;
        if (pn < 8) {
            const bool isq = pn < 4; bf16_t* dst = isq ? q : k; const int cb = (pn & 3) * 256 + wc * 64 + fq * 8;
            const float* gn = (isq ? qg : kg) + (wc & 1) * 64 + fq * 8; const float sc = isq ? C2 : 1.f;
            f32x4 gv[2][2];
#pragma unroll
            for (int bj = 0; bj < 2; ++bj)
#pragma unroll
                for (int n = 0; n < 2; ++n) gv[bj][n] = *(const f32x4*)(gn + bj * 32 + n * 4) * sc;
#pragma unroll
            for (int ai = 0; ai < 2; ++ai)
#pragma unroll
                for (int m = 0; m < 4; ++m) {
                    const float rs = rsl[ai * HALF + m * 16];
                    float ss = (dot4(acc[ai][0][m][0]) + dot4(acc[ai][0][m][1])) + (dot4(acc[ai][1][m][0]) + dot4(acc[ai][1][m][1]));
                    ss += __shfl_xor(ss, 16); ss += __shfl_xor(ss, 32);
                    const float inv = rsqrtf(ss * rs * rs * (1.f / 64.f) + EPS) * rs;
                    bf16_t* rowp = dst + (row0 + ai * HALF + m * 16) * 1024 + cb;
#pragma unroll
                    for (int bj = 0; bj < 2; ++bj) *(u32x4*)(rowp + bj * 32) = pack8(acc[ai][bj][m][0] * inv * gv[bj][0], acc[ai][bj][m][1] * inv * gv[bj][1]);
                }
        } else if (pn < 14) {
            bf16_t* dst; int ld, cb;
            if (pn < 12) { dst = v; ld = 1024; cb = (pn - 8) * 256; } else { dst = u; ld = 512; cb = (pn - 12) * 256; }
            cb += wc * 64 + fq * 8;
#pragma unroll
            for (int ai = 0; ai < 2; ++ai)
#pragma unroll
                for (int m = 0; m < 4; ++m) {
                    const float rs = rsl[ai * HALF + m * 16];
                    bf16_t* rowp = dst + (row0 + ai * HALF + m * 16) * ld + cb;
#pragma unroll
                    for (int bj = 0; bj < 2; ++bj) *(u32x4*)(rowp + bj * 32) = pack8(acc[ai][bj][m][0] * rs, acc[ai][bj][m][1] * rs);
                }
        } else {
            const int cb = (pn - 14) * 256 + wc * 64 + fq * 8;
            f32x4 bv[2][2];
#pragma unroll
            for (int bj = 0; bj < 2; ++bj)
#pragma unroll
                for (int n = 0; n < 2; ++n) bv[bj][n] = *(const f32x4*)(bgate + cb + bj * 32 + n * 4);
#pragma unroll
            for (int ai = 0; ai < 2; ++ai)
#pragma unroll
                for (int m = 0; m < 4; ++m) {
                    const float rs = rsl[ai * HALF + m * 16];
                    bf16_t* rowp = gates + (row0 + ai * HALF + m * 16) * 2048 + cb;
#pragma unroll
                    for (int bj = 0; bj < 2; ++bj) *(u32x4*)(rowp + bj * 32) = pack8(sig4(acc[ai][bj][m][0] * rs + bv[bj][0]), sig4(acc[ai][bj][m][1] * rs + bv[bj][1]));
                }
        }
    }
};
struct EpiGluF {
    static constexpr bool PERM = false, AFTER_DRAIN = false;
    const bf16_t* z; bf16_t* z2; const float* b;
    __device__ __forceinline__ void operator()(const f32x4 (&acc)[2][2][4][2], const Unit& un, int wr, int wc, int, int) const {
        int l_ = threadIdx.x; asm volatile("" : "+v"(l_)); const int fr = l_ & 15, fq = (l_ >> 4) & 3;
        const int cb = un.pn * 256 + wc * 64 + fq * 8; const size_t row0 = (size_t)un.pm * BM + wr * 64 + fr;
        f32x4 bv[2][2];
#pragma unroll
        for (int bj = 0; bj < 2; ++bj)
#pragma unroll
            for (int n = 0; n < 2; ++n) bv[bj][n] = *(const f32x4*)(b + cb + bj * 32 + n * 4);
#pragma unroll
        for (int ai = 0; ai < 2; ++ai) {
            u32x4 zw[4][2];
#pragma unroll
            for (int m = 0; m < 4; ++m)
#pragma unroll
                for (int bj = 0; bj < 2; ++bj) zw[m][bj] = *(const u32x4*)(z + (row0 + ai * HALF + m * 16) * 512 + cb + bj * 32);
#pragma unroll
            for (int m = 0; m < 4; ++m)
#pragma unroll
                for (int bj = 0; bj < 2; ++bj) { f32x4 z0, z1; unpack8(zw[m][bj], z0, z1);
                    *(u32x4*)(z2 + (row0 + ai * HALF + m * 16) * 512 + cb + bj * 32) = pack8(z0 * sig4(acc[ai][bj][m][0] + bv[bj][0]), z1 * sig4(acc[ai][bj][m][1] + bv[bj][1])); }
        }
    }
};
struct EpiPlainF {
    static constexpr bool PERM = false, AFTER_DRAIN = false;
    bf16_t* o; int ld;
    __device__ __forceinline__ void operator()(const f32x4 (&acc)[2][2][4][2], const Unit& un, int wr, int wc, int, int) const {
        int l_ = threadIdx.x; asm volatile("" : "+v"(l_)); const int fr = l_ & 15, fq = (l_ >> 4) & 3;
        const int row0 = un.pm * BM + wr * 64 + fr, cb = un.pn * 256 + wc * 64 + fq * 8;
#pragma unroll
        for (int ai = 0; ai < 2; ++ai)
#pragma unroll
            for (int m = 0; m < 4; ++m) {
                const int row = row0 + ai * HALF + m * 16;
#pragma unroll
                for (int bj = 0; bj < 2; ++bj) *(u32x4*)(o + (size_t)row * ld + cb + bj * 32) = pack8(acc[ai][bj][m][0], acc[ai][bj][m][1]);
            }
    }
};
struct EpiGateF {
    static constexpr bool PERM = false, AFTER_DRAIN = false;
    const bf16_t* gates; int goff; const bf16_t* add; bf16_t* o;
    __device__ __forceinline__ void operator()(const f32x4 (&acc)[2][2][4][2], const Unit& un, int wr, int wc, int, int) const {
        int l_ = threadIdx.x; asm volatile("" : "+v"(l_)); const int fr = l_ & 15, fq = (l_ >> 4) & 3;
        const int cb = un.pn * 256 + wc * 64 + fq * 8; const size_t row0 = (size_t)un.pm * BM + wr * 64 + fr;
#pragma unroll
        for (int ai = 0; ai < 2; ++ai) {
            u32x4 gw[4][2], aw[4][2];
#pragma unroll
            for (int m = 0; m < 4; ++m)
#pragma unroll
                for (int bj = 0; bj < 2; ++bj) { const size_t row = row0 + ai * HALF + m * 16; const int c = cb + bj * 32;
                    gw[m][bj] = *(const u32x4*)(gates + row * 2048 + goff + c); if (add) aw[m][bj] = *(const u32x4*)(add + row * 1024 + c); }
#pragma unroll
            for (int m = 0; m < 4; ++m)
#pragma unroll
                for (int bj = 0; bj < 2; ++bj) { const size_t row = row0 + ai * HALF + m * 16; const int c = cb + bj * 32; f32x4 g0, g1; unpack8(gw[m][bj], g0, g1);
                    f32x4 v0 = g0 * acc[ai][bj][m][0], v1 = g1 * acc[ai][bj][m][1];
                    if (add) { f32x4 a0, a1; unpack8(aw[m][bj], a0, a1); v0 += a0; v1 += a1; }
                    *(u32x4*)(o + row * 1024 + c) = pack8(v0, v1); }
        }
    }
};
struct EpiResF {
    static constexpr bool PERM = false, AFTER_DRAIN = false;
    const float* base; float* out; bf16_t* xb; float* part;
    __device__ __forceinline__ void operator()(const f32x4 (&acc)[2][2][4][2], const Unit& un, int wr, int wc, int, int) const {
        int l_ = threadIdx.x; asm volatile("" : "+v"(l_)); const int fr = l_ & 15, fq = (l_ >> 4) & 3;
        const int cb = un.pn * 256 + wc * 64 + fq * 8; const size_t row0 = (size_t)un.pm * BM + wr * 64 + fr;
#pragma unroll
        for (int ai = 0; ai < 2; ++ai) {
            f32x4 bl[4][2][2];
#pragma unroll
            for (int m = 0; m < 4; ++m)
#pragma unroll
                for (int bj = 0; bj < 2; ++bj) { const size_t o = (row0 + ai * HALF + m * 16) * 1024 + cb + bj * 32; bl[m][bj][0] = *(const f32x4*)(base + o); bl[m][bj][1] = *(const f32x4*)(base + o + 4); }
#pragma unroll
            for (int m = 0; m < 4; ++m) {
                const size_t row = row0 + ai * HALF + m * 16; float ss = 0.f;
#pragma unroll
                for (int bj = 0; bj < 2; ++bj) { const size_t o = row * 1024 + cb + bj * 32;
                    const f32x4 v0 = bl[m][bj][0] + acc[ai][bj][m][0], v1 = bl[m][bj][1] + acc[ai][bj][m][1];
                    *(f32x4*)(out + o) = v0; *(f32x4*)(out + o + 4) = v1; *(u32x4*)(xb + o) = pack8(v0, v1); ss += dot4(v0) + dot4(v1); }
                ss += __shfl_xor(ss, 16); ss += __shfl_xor(ss, 32);
                if (fq == 0) part[row * 16 + un.pn * 4 + wc] = ss;
            }
        }
    }
};
struct EpiPleF {
    static constexpr bool PERM = false, AFTER_DRAIN = false;
    PG8_LAS const unsigned char* lds; const bf16_t* ple; float* out; bf16_t* xb; float* part_out;
    __device__ __forceinline__ void operator()(const f32x4 (&acc)[2][2][4][2], const Unit& un, int wr, int wc, int, int) const {
        int l_ = threadIdx.x; asm volatile("" : "+v"(l_)); const int fr = l_ & 15, fq = (l_ >> 4) & 3;
        const int cb = un.pn * 256 + wc * 64 + fq * 8, rl0 = wr * 64 + fr; const size_t row0 = (size_t)un.pm * BM + rl0;
        PG8_LAS const float* rsl = (PG8_LAS const float*)(lds + PG8_RS_OFF) + un.slot * 256 + rl0;
#pragma unroll
        for (int ai = 0; ai < 2; ++ai)
#pragma unroll
            for (int mp = 0; mp < 2; ++mp) {
                u32x4 pw[2][2]; f32x4 xl[2][2][2];
#pragma unroll
                for (int mm = 0; mm < 2; ++mm)
#pragma unroll
                    for (int bj = 0; bj < 2; ++bj) { const size_t o = (row0 + ai * HALF + (2 * mp + mm) * 16) * 1024 + cb + bj * 32; pw[mm][bj] = *(const u32x4*)(ple + 2 * o - (cb + bj * 32)); xl[mm][bj][0] = *(const f32x4*)(out + o); xl[mm][bj][1] = *(const f32x4*)(out + o + 4); }
#pragma unroll
                for (int mm = 0; mm < 2; ++mm) {
                    const int m = 2 * mp + mm; const size_t row = row0 + ai * HALF + m * 16; const float rs = rsl[ai * HALF + m * 16]; float ss = 0.f;
#pragma unroll
                    for (int bj = 0; bj < 2; ++bj) { const size_t o = row * 1024 + cb + bj * 32; f32x4 p0, p1; unpack8(pw[mm][bj], p0, p1);
                        const f32x4 v0 = xl[mm][bj][0] + sig4(acc[ai][bj][m][0] * rs) * p0, v1 = xl[mm][bj][1] + sig4(acc[ai][bj][m][1] * rs) * p1;
                        *(f32x4*)(out + o) = v0; *(f32x4*)(out + o + 4) = v1; *(u32x4*)(xb + o) = pack8(v0, v1); ss += dot4(v0) + dot4(v1); }
                    ss += __shfl_xor(ss, 16); ss += __shfl_xor(ss, 32);
                    if (fq == 0) part_out[row * 16 + un.pn * 4 + wc] = ss;
                }
            }
    }
};
template <class Epi, class Sched, bool ALIGN_EPI = false, bool SP2 = false>
__device__ __forceinline__ void gemm_phase(PG8_LAS unsigned char* lds, const Gemm g, const Sched& S, const Epi& E) {
    int tid_ = threadIdx.x; asm volatile("" : "+v"(tid_)); const int tid = tid_, wid = __builtin_amdgcn_readfirstlane(tid >> 6), lane = tid & 63, wr = wid >> 2, wc = wid & 3, fr = lane & 15, fq = lane >> 4;
    const int K = g.K, nt = K / BK;
    unsigned voffA[2], voffB[2];
#pragma unroll
    for (int i = 0; i < 2; ++i) { int R, C; stage_rc(tid * 16 + i * 8192, R, C); const int Rb = Epi::PERM ? ((R & ~31) + perm32(R & 31)) : R;
        voffA[i] = (unsigned)(R * K + C) * 2u; voffB[i] = (unsigned)(Rb * K + C) * 2u; }
    const size_t kstep = (size_t)(BK * 2);
    const size_t hstep = (size_t)HALF * K * 2;
    const size_t tstep = 2 * hstep;
    const unsigned ldsw = (unsigned)wid * 1024u;
    const int aoff = lds_byte(wr * 64 + fr, fq * 8), boff = lds_byte(wc * 32 + fr, fq * 8);
#define PG8_SA(b, h) (((b) * 2 + (h)) * HTB)
#define PG8_SB(b, h) ((4 + (b) * 2 + (h)) * HTB)
#define PG8_STAGE(bufoff, gbase, voff) do { _Pragma("unroll") for (int _i = 0; _i < 2; ++_i) \
        __builtin_amdgcn_global_load_lds((const unsigned*)((const char*)(gbase) + (voff)[_i]), (PG8_LAS unsigned*)(lds + (bufoff) + ldsw + _i * 8192), 16, 0, 0); } while (0)
#define PG8_LDA(dst, b, h) do { _Pragma("unroll") for (int m = 0; m < 4; ++m) _Pragma("unroll") for (int k = 0; k < 2; ++k) dst[m][k] = *(const PG8_LAS bf16x8*)(lds + PG8_SA(b, h) + aoff + m * 2048 + k * 1024); } while (0)
#define PG8_LDB(dst, b, h) do { _Pragma("unroll") for (int n = 0; n < 2; ++n) _Pragma("unroll") for (int k = 0; k < 2; ++k) dst[n][k] = *(const PG8_LAS bf16x8*)(lds + PG8_SB(b, h) + boff + n * 2048 + k * 1024); } while (0)
#define PG8_MMA(ai, bj, At, Bt) do { __builtin_amdgcn_s_setprio(1); _Pragma("unroll") for (int m = 0; m < 4; ++m) _Pragma("unroll") for (int n = 0; n < 2; ++n) _Pragma("unroll") for (int k = 0; k < 2; ++k) \
        acc[ai][bj][m][n] = __builtin_amdgcn_mfma_f32_16x16x32_bf16(Bt[n][k], At[m][k], acc[ai][bj][m][n], 0, 0, 0); __builtin_amdgcn_s_setprio(0); } while (0)
#define PG8_WAIT_V(n) asm volatile("s_waitcnt vmcnt(" #n ")" ::: "memory")
#define PG8_WAIT_L(n) asm volatile("s_waitcnt lgkmcnt(" #n ")" ::: "memory")
#define PG8_BAR __builtin_amdgcn_s_barrier()
#define PG8_SCHED __builtin_amdgcn_sched_barrier(0)
    Unit cur, nxt; int ui = 0;
    if (!S.next(0, cur)) return;
    f32x4 acc[2][2][4][2];
#pragma unroll
    for (int a = 0; a < 2; ++a)
#pragma unroll
        for (int b = 0; b < 2; ++b)
#pragma unroll
            for (int m = 0; m < 4; ++m)
#pragma unroll
                for (int n = 0; n < 2; ++n) acc[a][b][m][n] = (f32x4){0.f, 0.f, 0.f, 0.f};
    bf16x8 At[4][2], B0[2][2], B1[2][2];
    const char* cA = (const char*)g.A + (size_t)cur.pm * tstep; const char* cB = (const char*)g.Bt + (size_t)cur.pn * tstep;
    S.a_ready(cur);
    if constexpr (SP2) {
        PG8_STAGE(PG8_SB(0, 0), cB, voffB); PG8_STAGE(PG8_SB(0, 1), cB + hstep, voffB); PG8_STAGE(PG8_SA(0, 0), cA, voffA); PG8_STAGE(PG8_SA(0, 1), cA + hstep, voffA);
        if (wr == 1) PG8_BAR;
        PG8_WAIT_V(2); PG8_BAR;
        PG8_STAGE(PG8_SB(1, 0), cB + kstep, voffB); PG8_STAGE(PG8_SA(1, 0), cA + kstep, voffA); PG8_STAGE(PG8_SB(1, 1), cB + hstep + kstep, voffB);
        PG8_WAIT_V(6); PG8_BAR;
    } else {
        PG8_STAGE(PG8_SB(0, 0), cB, voffB); PG8_STAGE(PG8_SA(0, 0), cA, voffA); PG8_STAGE(PG8_SB(0, 1), cB + hstep, voffB); PG8_STAGE(PG8_SA(0, 1), cA + hstep, voffA);
        if (wr == 1) PG8_BAR;
        PG8_WAIT_V(4); PG8_BAR;
        PG8_STAGE(PG8_SB(1, 0), cB + kstep, voffB); PG8_STAGE(PG8_SA(1, 0), cA + kstep, voffA); PG8_STAGE(PG8_SB(1, 1), cB + hstep + kstep, voffB);
        PG8_WAIT_V(6); PG8_BAR;
    }
    for (;;) {
        const bool has_next = S.next(ui + 1, nxt);
        const char* nA = has_next ? (const char*)g.A + (size_t)nxt.pm * tstep : cA; const char* nB = has_next ? (const char*)g.Bt + (size_t)nxt.pn * tstep : cB;
#pragma unroll 1
        for (int t = 0; t < nt; t += 2) {
            const bool last = (t == nt - 2);
            const char* a1 = cA + (size_t)(t + 1) * kstep;
            const char* a2 = last ? nA : cA + (size_t)(t + 2) * kstep; const char* b2 = last ? nB : cB + (size_t)(t + 2) * kstep;
            const char* a3 = a2 + kstep; const char* b3 = b2 + kstep;
            if (last && has_next) S.a_ready(nxt);
            if constexpr (SP2) {
            PG8_LDB(B0, 0, 0); PG8_LDB(B1, 0, 1); PG8_SCHED; PG8_LDA(At, 0, 0); PG8_STAGE(PG8_SA(1, 1), a1 + hstep, voffA);
            PG8_WAIT_V(8); PG8_WAIT_L(0); PG8_BAR; PG8_MMA(0, 0, At, B0); PG8_MMA(0, 1, At, B1); PG8_BAR; PG8_SCHED;
            PG8_LDA(At, 0, 1); PG8_STAGE(PG8_SB(0, 0), b2, voffB); PG8_STAGE(PG8_SB(0, 1), b2 + hstep, voffB); PG8_STAGE(PG8_SA(0, 0), a2, voffA);
            PG8_WAIT_V(8); PG8_WAIT_L(0); PG8_BAR; PG8_MMA(1, 0, At, B0); PG8_MMA(1, 1, At, B1); PG8_BAR; PG8_SCHED;
            PG8_LDB(B0, 1, 0); PG8_LDB(B1, 1, 1); PG8_SCHED; PG8_LDA(At, 1, 0); PG8_STAGE(PG8_SA(0, 1), a2 + hstep, voffA);
            PG8_WAIT_V(8); PG8_WAIT_L(0); PG8_BAR; PG8_MMA(0, 0, At, B0); PG8_MMA(0, 1, At, B1); PG8_BAR; PG8_SCHED;
            PG8_LDA(At, 1, 1); PG8_STAGE(PG8_SB(1, 0), b3, voffB); PG8_STAGE(PG8_SB(1, 1), b3 + hstep, voffB); PG8_STAGE(PG8_SA(1, 0), a3, voffA);
            PG8_WAIT_V(8); PG8_WAIT_L(0); PG8_BAR; PG8_MMA(1, 0, At, B0); PG8_MMA(1, 1, At, B1); PG8_BAR; PG8_SCHED;
            } else {
            PG8_LDB(B0, 0, 0); PG8_SCHED; PG8_LDA(At, 0, 0); PG8_STAGE(PG8_SA(1, 1), a1 + hstep, voffA);
            PG8_WAIT_L(8); PG8_BAR; PG8_WAIT_L(0); PG8_MMA(0, 0, At, B0); PG8_BAR; PG8_SCHED;
            PG8_LDB(B1, 0, 1); PG8_STAGE(PG8_SB(0, 0), b2, voffB);
            PG8_BAR; PG8_WAIT_L(0); PG8_MMA(0, 1, At, B1); PG8_BAR;
            PG8_LDA(At, 0, 1); PG8_STAGE(PG8_SA(0, 0), a2, voffA);
            PG8_BAR; PG8_WAIT_L(0); PG8_MMA(1, 0, At, B0); PG8_BAR; PG8_SCHED;
            PG8_STAGE(PG8_SB(0, 1), b2 + hstep, voffB);
            PG8_WAIT_V(6); PG8_BAR; PG8_MMA(1, 1, At, B1); PG8_BAR;
            PG8_LDB(B0, 1, 0); PG8_SCHED; PG8_LDA(At, 1, 0); PG8_STAGE(PG8_SA(0, 1), a2 + hstep, voffA);
            PG8_WAIT_L(8); PG8_BAR; PG8_WAIT_L(0); PG8_MMA(0, 0, At, B0); PG8_BAR; PG8_SCHED;
            PG8_LDB(B1, 1, 1); PG8_STAGE(PG8_SB(1, 0), b3, voffB);
            PG8_BAR; PG8_WAIT_L(0); PG8_MMA(0, 1, At, B1); PG8_BAR;
            PG8_LDA(At, 1, 1); PG8_STAGE(PG8_SA(1, 0), a3, voffA);
            PG8_BAR; PG8_WAIT_L(0); PG8_MMA(1, 0, At, B0); PG8_BAR; PG8_SCHED;
            PG8_STAGE(PG8_SB(1, 1), b3 + hstep, voffB);
            PG8_WAIT_V(6); PG8_BAR; PG8_MMA(1, 1, At, B1); PG8_BAR;
            }
        }
        if constexpr (ALIGN_EPI) { if (wr == 0) PG8_BAR; }
        if constexpr (!Epi::AFTER_DRAIN) { E(acc, cur, wr, wc, fr, fq); S.done(cur); }
        if (!has_next) break;
#pragma unroll
        for (int a = 0; a < 2; ++a)
#pragma unroll
            for (int b = 0; b < 2; ++b)
#pragma unroll
                for (int m = 0; m < 4; ++m)
#pragma unroll
                    for (int n = 0; n < 2; ++n) acc[a][b][m][n] = (f32x4){0.f, 0.f, 0.f, 0.f};
        cur = nxt; cA = nA; cB = nB; ++ui;
        if constexpr (ALIGN_EPI) { if (wr == 1) PG8_BAR; }
    }
    PG8_WAIT_V(0);
    if constexpr (!ALIGN_EPI) { if (wr == 0) PG8_BAR; }
    PG8_BAR;
    if constexpr (Epi::AFTER_DRAIN) { E.fused(acc, cur, wr, wc, fr, fq, lds, wid, lane); S.done(cur); }
#undef PG8_SA
#undef PG8_SB
#undef PG8_STAGE
#undef PG8_LDA
#undef PG8_LDB
#undef PG8_MMA
#undef PG8_WAIT_V
#undef PG8_WAIT_L
#undef PG8_BAR
#undef PG8_SCHED
}

struct EpiActF {
    static constexpr bool PERM = false, AFTER_DRAIN = false;
    bf16_t* act; PG8_LAS const unsigned char* lds;
    __device__ __forceinline__ void operator()(const f32x4 (&acc)[2][2][4][2], const Unit& un, int wr, int wc, int, int) const {
        int l_ = threadIdx.x; asm volatile("" : "+v"(l_)); const int fr = l_ & 15, fq = (l_ >> 4) & 3;
        typedef float f32x2v __attribute__((ext_vector_type(2)));
        PG8_LAS const f32x2v* ri = (PG8_LAS const f32x2v*)(lds + PG8_ROWINFO_OFF) + un.slot * 256;
#pragma unroll
        for (int ai = 0; ai < 2; ++ai)
#pragma unroll
            for (int m = 0; m < 4; ++m) {
                const int r = ai * HALF + wr * 64 + m * 16 + fr; const f32x2v wi = ri[r]; const float w = wi.x, rs = wi.y;
                f32x4 a[2];
#pragma unroll
                for (int n = 0; n < 2; ++n) { const f32x4 g = acc[ai][0][m][n] * rs, u = acc[ai][1][m][n] * rs; a[n] = g * sig4(g) * u * w; }
                *(u32x4*)(act + ((size_t)un.pm * 256 + r) * 256 + un.pl * 128 + wc * 32 + fq * 8) = pack8(a[0], a[1]);
            }
    }
};
template <int KK> struct EpiDownF {
    static constexpr bool PERM = false, AFTER_DRAIN = false;
    PG8_LAS const unsigned char* lds; float* out; bf16_t* xb; float* part;
    __device__ __forceinline__ void operator()(const f32x4 (&acc)[2][2][4][2], const Unit& un, int wr, int wc, int, int) const {
        int l_ = threadIdx.x; asm volatile("" : "+v"(l_)); const int fr = l_ & 15, fq = (l_ >> 4) & 3;
        const int cb = un.pl * 256 + wc * 64 + fq * 8;
        PG8_LAS const int* tk = (PG8_LAS const int*)(lds + PG8_TOKOFF_OFF) + un.slot * 256 + wr * 64 + fr;
#pragma unroll
        for (int ai = 0; ai < 2; ++ai) {
            int tok[4]; f32x4 bl[4][2][2];
#pragma unroll
            for (int m = 0; m < 4; ++m) { tok[m] = tk[ai * HALF + m * 16]; const size_t rb = (size_t)(tok[m] < 0 ? 0 : tok[m]) * 1024 + cb;
#pragma unroll
                for (int bj = 0; bj < 2; ++bj) { bl[m][bj][0] = *(const f32x4*)(out + rb + bj * 32); bl[m][bj][1] = *(const f32x4*)(out + rb + bj * 32 + 4); } }
#pragma unroll
            for (int m = 0; m < 4; ++m) {
                const bool valid = tok[m] >= 0; const size_t rb = (size_t)(valid ? tok[m] : 0) * 1024 + cb; float ss = 0.f;
#pragma unroll
                for (int bj = 0; bj < 2; ++bj) { const size_t o = rb + bj * 32;
                    const f32x4 v0 = bl[m][bj][0] + acc[ai][bj][m][0], v1 = bl[m][bj][1] + acc[ai][bj][m][1];
                    if (valid) { *(f32x4*)(out + o) = v0; *(f32x4*)(out + o + 4) = v1; if (KK) *(u32x4*)(xb + o) = pack8(v0, v1); }
                    ss += dot4(v0) + dot4(v1); }
                if (KK) { ss += __shfl_xor(ss, 16); ss += __shfl_xor(ss, 32); if (valid && fq == 0) part[(size_t)tok[m] * 16 + un.pl * 4 + wc] = ss; }
            }
        }
    }
};
__device__ __forceinline__ int ldsu(PG8_LAS const int* p) { return __builtin_amdgcn_readfirstlane(*p); }
struct MoeSched {
    PG8_LAS const int* tb; PG8_LAS const int* tc; int G, c, mode;
    __device__ __forceinline__ bool next(int i, Unit& u) const {
        const int gi = i * G + c; int ti, pl;
        if (mode == 0) { ti = gi >> 1; pl = gi & 1; if (ti >= ldsu(tb + 64)) return false; }
        else { ti = gi >> 2; pl = gi & 3; const int n0 = ldsu(tb + 32); if (mode == 2) { ti += n0; if (ti >= ldsu(tb + 64)) return false; } else if (ti >= n0) return false; }
        const int ke = ldsu(tb + 160 + ti);
        u.pm = ti; u.e = ke & 31; u.k = ke >> 5; u.mt = ti - ldsu(tb + ke); u.cnt = ldsu(tc + ke); u.pl = pl; u.slot = i; u.pn = (ke & 31) * (mode == 0 ? 2 : 4) + pl;
        return true;
    }
    __device__ __forceinline__ void a_ready(const Unit&) const {}
    __device__ __forceinline__ void done(const Unit&) const {}
};
template <class Epi, class Sched>
__device__ __forceinline__ void gemm_phase_g(PG8_LAS unsigned char* lds, const Gemm g, const Sched& S, const Epi& E) {
    int tid_ = threadIdx.x; asm volatile("" : "+v"(tid_)); const int tid = tid_, wid = __builtin_amdgcn_readfirstlane(tid >> 6), lane = tid & 63, wr = wid >> 2, wc = wid & 3, fr = lane & 15, fq = lane >> 4;
    const int K = g.K, nt = K / BK;
    unsigned voffB[2]; int RA[2]; unsigned CA2[2];
#pragma unroll
    for (int i = 0; i < 2; ++i) { int R, C; stage_rc(tid * 16 + i * 8192, R, C); voffB[i] = (unsigned)(R * K + C) * 2u; RA[i] = R; CA2[i] = (unsigned)C * 2u; }
    const size_t kstep = (size_t)(BK * 2), hstep = (size_t)HALF * K * 2, tstep = 2 * hstep;
    const unsigned ldsw = (unsigned)wid * 1024u;
    const int aoff = lds_byte(wr * 64 + fr, fq * 8), boff = lds_byte(wc * 32 + fr, fq * 8);
    PG8_LAS const unsigned* tokoff = (PG8_LAS const unsigned*)(lds + PG8_TOKOFF_OFF);
#define PG8_SA(b, h) (((b) * 2 + (h)) * HTB)
#define PG8_SB(b, h) ((4 + (b) * 2 + (h)) * HTB)
#define PG8_STAGE(bufoff, gbase, voff) do { _Pragma("unroll") for (int _i = 0; _i < 2; ++_i) \
        __builtin_amdgcn_global_load_lds((const unsigned*)((const char*)(gbase) + (voff)[_i]), (PG8_LAS unsigned*)(lds + (bufoff) + ldsw + _i * 8192), 16, 0, 0); } while (0)
#define PG8_STAGE_A(bufoff, gbase, o0, o1) do { \
        __builtin_amdgcn_global_load_lds((const unsigned*)((const char*)(gbase) + (o0)), (PG8_LAS unsigned*)(lds + (bufoff) + ldsw), 16, 0, 0); \
        __builtin_amdgcn_global_load_lds((const unsigned*)((const char*)(gbase) + (o1)), (PG8_LAS unsigned*)(lds + (bufoff) + ldsw + 8192), 16, 0, 0); } while (0)
#define PG8_GOFF(slot, d00, d01, d10, d11) do { PG8_LAS const unsigned* t_ = tokoff + (slot) * 256; \
        d00 = t_[RA[0]] + CA2[0]; d01 = t_[RA[1]] + CA2[1]; d10 = t_[128 + RA[0]] + CA2[0]; d11 = t_[128 + RA[1]] + CA2[1]; } while (0)
#define PG8_LDA(dst, b, h) do { _Pragma("unroll") for (int m = 0; m < 4; ++m) _Pragma("unroll") for (int k = 0; k < 2; ++k) dst[m][k] = *(const PG8_LAS bf16x8*)(lds + PG8_SA(b, h) + aoff + m * 2048 + k * 1024); } while (0)
#define PG8_LDB(dst, b, h) do { _Pragma("unroll") for (int n = 0; n < 2; ++n) _Pragma("unroll") for (int k = 0; k < 2; ++k) dst[n][k] = *(const PG8_LAS bf16x8*)(lds + PG8_SB(b, h) + boff + n * 2048 + k * 1024); } while (0)
#define PG8_MMA(ai, bj, At, Bt) do { __builtin_amdgcn_s_setprio(1); _Pragma("unroll") for (int m = 0; m < 4; ++m) _Pragma("unroll") for (int n = 0; n < 2; ++n) _Pragma("unroll") for (int k = 0; k < 2; ++k) \
        acc[ai][bj][m][n] = __builtin_amdgcn_mfma_f32_16x16x32_bf16(Bt[n][k], At[m][k], acc[ai][bj][m][n], 0, 0, 0); __builtin_amdgcn_s_setprio(0); } while (0)
#define PG8_WAIT_V(n) asm volatile("s_waitcnt vmcnt(" #n ")" ::: "memory")
#define PG8_WAIT_L(n) asm volatile("s_waitcnt lgkmcnt(" #n ")" ::: "memory")
#define PG8_BAR __builtin_amdgcn_s_barrier()
#define PG8_SCHED __builtin_amdgcn_sched_barrier(0)
    Unit cur, nxt; int ui = 0;
    if (!S.next(0, cur)) return;
    f32x4 acc[2][2][4][2];
#pragma unroll
    for (int a = 0; a < 2; ++a)
#pragma unroll
        for (int b = 0; b < 2; ++b)
#pragma unroll
            for (int m = 0; m < 4; ++m)
#pragma unroll
                for (int n = 0; n < 2; ++n) acc[a][b][m][n] = (f32x4){0.f, 0.f, 0.f, 0.f};
    bf16x8 At[4][2], B0[2][2], B1[2][2];
    unsigned gc00, gc01, gc10, gc11;
    PG8_GOFF(0, gc00, gc01, gc10, gc11);
    const char* A0 = (const char*)g.A; const char* cB = (const char*)g.Bt + (size_t)cur.pn * tstep;
    PG8_STAGE(PG8_SB(0, 0), cB, voffB); PG8_STAGE(PG8_SB(0, 1), cB + hstep, voffB); PG8_STAGE_A(PG8_SA(0, 0), A0, gc00, gc01); PG8_STAGE_A(PG8_SA(0, 1), A0, gc10, gc11);
    if (wr == 1) PG8_BAR;
    PG8_WAIT_V(2); PG8_BAR;
    PG8_STAGE(PG8_SB(1, 0), cB + kstep, voffB); PG8_STAGE_A(PG8_SA(1, 0), A0 + kstep, gc00, gc01); PG8_STAGE(PG8_SB(1, 1), cB + hstep + kstep, voffB);
    PG8_WAIT_V(6); PG8_BAR;
    for (;;) {
        const bool has_next = S.next(ui + 1, nxt);
        const char* nB = has_next ? (const char*)g.Bt + (size_t)nxt.pn * tstep : cB;
#pragma unroll 1
        for (int t = 0; t < nt; t += 2) {
            const bool last = (t == nt - 2);
            const char* a1 = A0 + (size_t)(t + 1) * kstep;
            const char* a2 = last ? A0 : A0 + (size_t)(t + 2) * kstep; const char* b2 = last ? nB : cB + (size_t)(t + 2) * kstep;
            const char* a3 = a2 + kstep; const char* b3 = b2 + kstep;
            unsigned g200 = gc00, g201 = gc01, g210 = gc10, g211 = gc11;
            if (last && has_next) { PG8_GOFF(ui + 1, g200, g201, g210, g211); }
            PG8_LDB(B0, 0, 0); PG8_LDB(B1, 0, 1); PG8_SCHED; PG8_LDA(At, 0, 0); PG8_STAGE_A(PG8_SA(1, 1), a1, gc10, gc11);
            PG8_WAIT_V(8); PG8_WAIT_L(0); PG8_BAR; PG8_MMA(0, 0, At, B0); PG8_MMA(0, 1, At, B1); PG8_BAR; PG8_SCHED;
            PG8_LDA(At, 0, 1); PG8_STAGE(PG8_SB(0, 0), b2, voffB); PG8_STAGE(PG8_SB(0, 1), b2 + hstep, voffB); PG8_STAGE_A(PG8_SA(0, 0), a2, g200, g201);
            PG8_WAIT_V(8); PG8_WAIT_L(0); PG8_BAR; PG8_MMA(1, 0, At, B0); PG8_MMA(1, 1, At, B1); PG8_BAR; PG8_SCHED;
            PG8_LDB(B0, 1, 0); PG8_LDB(B1, 1, 1); PG8_SCHED; PG8_LDA(At, 1, 0); PG8_STAGE_A(PG8_SA(0, 1), a2, g210, g211);
            PG8_WAIT_V(8); PG8_WAIT_L(0); PG8_BAR; PG8_MMA(0, 0, At, B0); PG8_MMA(0, 1, At, B1); PG8_BAR; PG8_SCHED;
            PG8_LDA(At, 1, 1); PG8_STAGE(PG8_SB(1, 0), b3, voffB); PG8_STAGE(PG8_SB(1, 1), b3 + hstep, voffB); PG8_STAGE_A(PG8_SA(1, 0), a3, g200, g201);
            PG8_WAIT_V(8); PG8_WAIT_L(0); PG8_BAR; PG8_MMA(1, 0, At, B0); PG8_MMA(1, 1, At, B1); PG8_BAR; PG8_SCHED;
        }
        if (wr == 0) PG8_BAR;
        E(acc, cur, wr, wc, fr, fq);
        if (!has_next) break;
#pragma unroll
        for (int a = 0; a < 2; ++a)
#pragma unroll
            for (int b = 0; b < 2; ++b)
#pragma unroll
                for (int m = 0; m < 4; ++m)
#pragma unroll
                    for (int n = 0; n < 2; ++n) acc[a][b][m][n] = (f32x4){0.f, 0.f, 0.f, 0.f};
        cur = nxt; cB = nB; ++ui; PG8_GOFF(ui, gc00, gc01, gc10, gc11);
        if (wr == 1) PG8_BAR;
    }
    PG8_WAIT_V(0);
    PG8_BAR;
#undef PG8_SA
#undef PG8_SB
#undef PG8_STAGE
#undef PG8_STAGE_A
#undef PG8_GOFF
#undef PG8_LDA
#undef PG8_LDB
#undef PG8_MMA
#undef PG8_WAIT_V
#undef PG8_WAIT_L
#undef PG8_BAR
#undef PG8_SCHED
}

}

__device__ __forceinline__ int p64_row(int c) { const int cl = c & 255; return (c & ~255) + 128 * ((cl >> 5) & 1) + 32 * (cl >> 6) + 16 * ((cl >> 2) & 1) + 4 * ((cl >> 3) & 3) + (cl & 3); }
__device__ __forceinline__ unsigned pk2(float lo, float hi) { return f2bf(lo) | (f2bf(hi) << 16); }
__device__ __forceinline__ int gu_row(int ff, int isup) { const int fl = ff & 127; return 256 * (ff >> 7) + 128 * isup + 32 * (fl >> 5) + 16 * ((fl >> 2) & 1) + 4 * ((fl >> 3) & 3) + (fl & 3); }
template <int MODE>
__device__ __forceinline__ void transpose_item(const float* W, int K, int N, bf16* WT, const float* gain, LAS float* scr, int item, int lane) {
    const int nblk = N / 32, kb = item / nblk, nb = item % nblk, k0 = 64 * kb, n0 = 32 * nb;
    const float* wp = W + (size_t)(k0 + (lane >> 5)) * N + n0 + (lane & 31);
    float wv[32];
#pragma unroll
    for (int i = 0; i < 32; ++i) wv[i] = wp[(size_t)(2 * i) * N];
    const int c = lane & 7;
    f32x4 g0 = {1.f, 1.f, 1.f, 1.f}, g1 = {1.f, 1.f, 1.f, 1.f};
    if (gain) { g0 = *(const f32x4*)(gain + k0 + 8 * c); g1 = *(const f32x4*)(gain + k0 + 8 * c + 4); }
#pragma unroll
    for (int i = 0; i < 32; ++i) scr[(2 * i + (lane >> 5)) * 33 + (lane & 31)] = wv[i];
    asm volatile("s_waitcnt lgkmcnt(0)" ::: "memory");
#pragma unroll
    for (int j = 0; j < 4; ++j) { const int n = (lane >> 3) + 8 * j; const LAS float* s = scr + (8 * c) * 33 + n;
        v4u o; o.x = pk2(s[0 * 33] * g0[0], s[1 * 33] * g0[1]); o.y = pk2(s[2 * 33] * g0[2], s[3 * 33] * g0[3]); o.z = pk2(s[4 * 33] * g1[0], s[5 * 33] * g1[1]); o.w = pk2(s[6 * 33] * g1[2], s[7 * 33] * g1[3]);
        const int drow = MODE == 0 ? p64_row(n0 + n) : gu_row(n0 + n, MODE == 2);
        *(v4u*)(WT + (size_t)drow * K + k0 + 8 * c) = o; }
    asm volatile("s_waitcnt lgkmcnt(0)" ::: "memory");
}
constexpr size_t WT_WIN = 0, WT_WAU = 12 * MiB, WT_WOUT = 14 * MiB, WT_WPG = 16 * MiB, WT_WGLU = 18 * MiB, WT_WSU = 18 * MiB + 512 * 1024, WT_WPLE = 19 * MiB + 512 * 1024, WT_WGU = 20 * MiB, WT_WD = 52 * MiB;
__device__ __forceinline__ void convert_weights(const Frame& F0, int L, unsigned char* wt) {
    const Frame F = refresh(F0);
    LAS float* scr = (LAS float*)(F.lds + F.wave * 16384);
    const int gw = F.vcu * NWAVES + F.wave, NGW = F.G * NWAVES;
    constexpr int I_IN = (DM / 64) * (INW / 32), I_SQ = (DM / 64) * (DM / 32), I_GLU = (SSMW / 64) * (SSMW / 32), I_SU = (SSMW / 64) * (DM / 32), I_PL = (PLE / 64) * (DM / 32);
    constexpr int I_EX = NEXP * 128;
    constexpr int NIT = I_IN + 3 * I_SQ + I_GLU + I_SU + I_PL + 3 * I_EX;
    for (int it = gw; it < NIT; it += NGW) {
        int r = it;
        if (r < I_IN) { transpose_item<0>(inp(F, I_WIN) + (size_t)L * DM * INW, DM, INW, (bf16*)(wt + WT_WIN), inp(F, I_ATTN_G) + L * DM, scr, r, F.lane); continue; } r -= I_IN;
        if (r < I_SQ) { transpose_item<0>(inp(F, I_WAU) + (size_t)L * DM * DM, DM, DM, (bf16*)(wt + WT_WAU), nullptr, scr, r, F.lane); continue; } r -= I_SQ;
        if (r < I_SQ) { transpose_item<0>(inp(F, I_WOUT) + (size_t)L * DM * DM, DM, DM, (bf16*)(wt + WT_WOUT), nullptr, scr, r, F.lane); continue; } r -= I_SQ;
        if (r < I_SQ) { transpose_item<0>(inp(F, I_WPG) + (size_t)L * DM * DM, DM, DM, (bf16*)(wt + WT_WPG), inp(F, I_PLE_G) + L * DM, scr, r, F.lane); continue; } r -= I_SQ;
        if (r < I_GLU) { transpose_item<0>(inp(F, I_WGLU) + (size_t)L * SSMW * SSMW, SSMW, SSMW, (bf16*)(wt + WT_WGLU), nullptr, scr, r, F.lane); continue; } r -= I_GLU;
        if (r < I_SU) { transpose_item<0>(inp(F, I_WSU) + (size_t)L * SSMW * DM, SSMW, DM, (bf16*)(wt + WT_WSU), nullptr, scr, r, F.lane); continue; } r -= I_SU;
        if (r < I_PL) { transpose_item<0>(inp(F, I_WPLE) + (size_t)L * PLE * DM, PLE, DM, (bf16*)(wt + WT_WPLE), nullptr, scr, r, F.lane); continue; } r -= I_PL;
        if (r < I_EX) { const int e = r >> 7; transpose_item<1>(inp(F, I_WEG) + ((size_t)L * NEXP + e) * DM * EFF, DM, EFF, (bf16*)(wt + WT_WGU) + (size_t)e * 512 * DM, inp(F, I_FFN_G) + L * DM, scr, r & 127, F.lane); continue; } r -= I_EX;
        if (r < I_EX) { const int e = r >> 7; transpose_item<2>(inp(F, I_WEU) + ((size_t)L * NEXP + e) * DM * EFF, DM, EFF, (bf16*)(wt + WT_WGU) + (size_t)e * 512 * DM, inp(F, I_FFN_G) + L * DM, scr, r & 127, F.lane); continue; } r -= I_EX;
        { const int e = r >> 7; transpose_item<0>(inp(F, I_WED) + ((size_t)L * NEXP + e) * EFF * DM, EFF, DM, (bf16*)(wt + WT_WD) + (size_t)e * DM * EFF, nullptr, scr, r & 127, F.lane); }
    }
}
#include <hip/hip_bf16.h>
namespace attn_body {
using bf16=__hip_bfloat16;
using bf16x8=__attribute__((ext_vector_type(8)))short;
using s16x4=__attribute__((ext_vector_type(4)))short;
using f32x16=__attribute__((ext_vector_type(16)))float;
using u32x4=__attribute__((ext_vector_type(4)))unsigned;
constexpr int BATCH=8,NHEAD=16,SEQ=2048,D=64,DM=NHEAD*D;
constexpr int NW=8,QBLK=32,QB=QBLK*NW,KVBLK=64,NQB=SEQ/QB;
constexpr int ATTN_PITCH=DM, ATTN_UNIT_ROWS=QB;
__device__ __forceinline__ int crow(int r,int hi){return (r&3)+8*(r>>2)+4*hi;}
#define SBAR() __builtin_amdgcn_sched_barrier(0)
__device__ __forceinline__ void cmask(f32x16&p0,f32x16&p1,int jb,int qrel,int hi){
  const float NEG=-INFINITY; int kb=64*jb+4*hi;
  #pragma unroll
  for(int r=0;r<16;++r){int kv=kb+(r&3)+8*(r>>2); if(kv>qrel)p0[r]=NEG; if(kv+32>qrel)p1[r]=NEG;}
}

constexpr int NSLOT=3, SLOTB=8192;
constexpr int LDS_K=0, LDS_V=NSLOT*SLOTB, LDS_WS=2*NSLOT*SLOTB, LDS_OST=LDS_WS+NW*64*4, LDS_BYTES=LDS_OST+NW*4096;
constexpr float C2=0.125f*1.4426950408889634f;
__device__ __forceinline__ void glds16(const void*gsrc,unsigned lds_dst){unsigned keep;
  asm volatile("s_mov_b32 %0, m0\n\ts_mov_b32 m0, %2\n\ts_nop 0\n\tglobal_load_lds_dwordx4 %1, off\n\ts_mov_b32 m0, %0":"=&s"(keep):"v"(gsrc),"s"(lds_dst):"memory");}
__device__ __forceinline__ float max3f(float a,float b,float c){float r;asm("v_max3_f32 %0, %1, %2, %3":"=v"(r):"v"(a),"v"(b),"v"(c));return r;}
__device__ __forceinline__ float max2f(float a,float b){float r;asm("v_max_f32_e32 %0, %1, %2":"=v"(r):"v"(a),"v"(b));return r;}
__device__ __forceinline__ float fadd_s(float a,float b){float r;asm("v_add_f32_e32 %0, %1, %2":"=v"(r):"v"(a),"v"(b));return r;}
__device__ __forceinline__ float fsub_s(float a,float b){float r;asm("v_sub_f32_e32 %0, %1, %2":"=v"(r):"v"(a),"v"(b));return r;}
typedef float f32x2_t __attribute__((ext_vector_type(2))); typedef __bf16 bf16x2_t __attribute__((ext_vector_type(2)));
__device__ __forceinline__ unsigned cvtpk_s(float lo,float hi){f32x2_t v={lo,hi};bf16x2_t b=__builtin_convertvector(v,bf16x2_t);return __builtin_bit_cast(unsigned,b);}
#define WAIT_BAR(N) asm volatile("s_waitcnt vmcnt(" #N ") lgkmcnt(0)\n\ts_barrier":::"memory")

__device__ __forceinline__ void qkt(f32x16&p0,f32x16&p1,const char*Kslot,const bf16x8*qr,const f32x16&negm,int r32,int hi){
  const char*kb=Kslot+hi*1024+r32*16;
  #pragma unroll
  for(int d0=0;d0<4;++d0){
    const bf16x8 b0=*reinterpret_cast<const bf16x8*>(kb+d0*2048);
    const bf16x8 b1=*reinterpret_cast<const bf16x8*>(kb+d0*2048+512);
    if(d0==0){p0=__builtin_amdgcn_mfma_f32_32x32x16_bf16(b0,qr[0],negm,0,0,0);p1=__builtin_amdgcn_mfma_f32_32x32x16_bf16(b1,qr[0],negm,0,0,0);}
    else{p0=__builtin_amdgcn_mfma_f32_32x32x16_bf16(b0,qr[d0],p0,0,0,0);p1=__builtin_amdgcn_mfma_f32_32x32x16_bf16(b1,qr[d0],p1,0,0,0);}}
}
typedef __attribute__((address_space(3))) const char* lds_cptr;
typedef short v4i16_t __attribute__((ext_vector_type(4)));
__device__ __forceinline__ void kload8(bf16x8*kf,lds_cptr kp){
  kf[0]=*(const __attribute__((address_space(3))) bf16x8*)(kp);      kf[1]=*(const __attribute__((address_space(3))) bf16x8*)(kp+512);
  kf[2]=*(const __attribute__((address_space(3))) bf16x8*)(kp+2048); kf[3]=*(const __attribute__((address_space(3))) bf16x8*)(kp+2560);
  kf[4]=*(const __attribute__((address_space(3))) bf16x8*)(kp+4096); kf[5]=*(const __attribute__((address_space(3))) bf16x8*)(kp+4608);
  kf[6]=*(const __attribute__((address_space(3))) bf16x8*)(kp+6144); kf[7]=*(const __attribute__((address_space(3))) bf16x8*)(kp+6656);
}
__device__ __forceinline__ void kload2(bf16x8*kf,lds_cptr kp,int j){ kf[2*j]=*(const __attribute__((address_space(3))) bf16x8*)(kp+j*2048); kf[2*j+1]=*(const __attribute__((address_space(3))) bf16x8*)(kp+j*2048+512); }
__device__ __forceinline__ s16x4 vtr(lds_cptr p){ return __builtin_bit_cast(s16x4,__builtin_amdgcn_ds_read_tr16_b64_v4i16((__attribute__((address_space(3))) v4i16_t*)p)); }
__device__ __forceinline__ float rowmax(const f32x16&p0,const f32x16&p1){
  float a=max3f(p0[0],p0[1],p1[0]),b=max3f(p0[2],p0[3],p1[1]);a=max3f(a,p1[2],p1[3]);
  #pragma unroll
  for(int r=4;r<16;r+=4){a=max3f(a,p0[r],p0[r+1]);b=max3f(b,p0[r+2],p0[r+3]);a=max3f(a,p1[r],p1[r+1]);b=max3f(b,p1[r+2],p1[r+3]);}
  const float m=max2f(a,b);
  auto rr=__builtin_amdgcn_permlane32_swap(__float_as_uint(m),__float_as_uint(m),false,false);
  return max2f(__uint_as_float(rr[0]),__uint_as_float(rr[1]));
}
__device__ __forceinline__ void pv(f32x16*o,int vb,bf16x8 pa0,bf16x8 pa1,bf16x8 pa2,bf16x8 pa3){
  #pragma unroll
  for(int d0=0;d0<2;++d0){s16x4 lo[4],hi[4];
    #pragma unroll
    for(int ks=0;ks<4;++ks){
      asm volatile("ds_read_b64_tr_b16 %0,%1 offset:%c2":"=&v"(lo[ks]):"v"(vb),"i"(d0*4096+ks*1024):"memory");
      asm volatile("ds_read_b64_tr_b16 %0,%1 offset:%c2":"=&v"(hi[ks]):"v"(vb),"i"(d0*4096+ks*1024+512):"memory");}
    asm volatile("s_waitcnt lgkmcnt(0)":::"memory");SBAR();
    #define PK(k) (bf16x8){lo[k][0],lo[k][1],lo[k][2],lo[k][3],hi[k][0],hi[k][1],hi[k][2],hi[k][3]}
    o[d0]=__builtin_amdgcn_mfma_f32_32x32x16_bf16(pa0,PK(0),o[d0],0,0,0);
    o[d0]=__builtin_amdgcn_mfma_f32_32x32x16_bf16(pa1,PK(1),o[d0],0,0,0);
    o[d0]=__builtin_amdgcn_mfma_f32_32x32x16_bf16(pa2,PK(2),o[d0],0,0,0);
    o[d0]=__builtin_amdgcn_mfma_f32_32x32x16_bf16(pa3,PK(3),o[d0],0,0,0);
    #undef PK
  }
}

#ifndef ATTN_STORE16
#define ATTN_STORE16(p,v) (*(u32x4*)(p)=(v))
#endif
template<int THRL> __device__ __forceinline__ void attn_pass(int b,int hq,int hv,int qb,const bf16*Q,const bf16*K,const bf16*V,char*shm,f32x16 (&o)[2],float (&rli)[16]){
  int tid_=threadIdx.x; asm volatile("":"+v"(tid_)); const int tid=tid_,lane=tid&63,r32=lane&31,hi=lane>>5; const int wid=__builtin_amdgcn_readfirstlane(tid>>6);
  const long rowbase=(long)b*SEQ; const int q0=qb*QB;
  const bf16*Qw=Q+(rowbase+q0+wid*QBLK)*DM+hq*D;
  const bf16*Kh=K+rowbase*DM+hq*D,*Vh=V+rowbase*DM+hv*D;
  const unsigned lds0=(unsigned)(uintptr_t)shm;
  float*wsf=(float*)(shm+LDS_WS)+wid*64;
  const bf16*ksrc=Kh+(long)lane*DM+wid*8;
  const bf16*vsrc=Vh+(long)(16*(wid&3)+(lane>>2))*DM+(wid>>2)*32+(lane&3)*8;
  const unsigned kdst=lds0+LDS_K+wid*1024, vdst=lds0+LDS_V+wid*1024;
  #define DMA_K(t,slot) glds16(ksrc+(long)(t)*KVBLK*DM,(unsigned)__builtin_amdgcn_readfirstlane(kdst+(slot)))
  #define DMA_V(t,slot) glds16(vsrc+(long)(t)*KVBLK*DM,(unsigned)__builtin_amdgcn_readfirstlane(vdst+(slot)))
  const int vb0=(int)(lds0+LDS_V)+((lane>>4)&1)*32+(lane&3)*8+(4*hi+((lane&15)>>2))*64;
  const char*Kbase=shm+LDS_K; bf16x8 kf[8];
  const lds_cptr shm3=(lds_cptr)shm; const lds_cptr kp0=shm3+LDS_K+hi*1024+r32*16; const lds_cptr vp0=shm3+LDS_V+((lane>>4)&1)*32+(lane&3)*8+(4*hi+((lane&15)>>2))*64;
  const int NT=(q0+QB)/KVBLK;
  DMA_K(0,0);DMA_V(0,0);DMA_K(1,SLOTB);
  bf16x8 qr[4];
  #pragma unroll
  for(int d0=0;d0<4;++d0)qr[d0]=*reinterpret_cast<const bf16x8*>(&Qw[(long)r32*DM+d0*16+hi*8]);
  float mhat=0.f,l_reg=0.f;o[0]=f32x16{};o[1]=f32x16{};f32x16 negm=f32x16{};asm volatile("":"+v"(negm));
  const int qrel=wid*QBLK+r32;
  #define CMASK(P0,P1,t) do{int jb_=(t)-(NT-4); if(jb_>=0)cmask(P0,P1,jb_,qrel,hi);}while(0)
  bool resc=false;
  #define START(P0,P1) do{ const float rm=rowmax(P0,P1); resc=false; \
    { const float dl=rm; mhat=fadd_s(mhat,dl); \
      _Pragma("unroll") for(int r=0;r<16;++r){P0[r]=fsub_s(P0[r],dl);P1[r]=fsub_s(P1[r],dl);} \
      _Pragma("unroll") for(int r=0;r<16;++r)negm[r]=-mhat; asm volatile("":"+v"(negm)); } \
    _Pragma("unroll") for(int r=0;r<16;++r)P0[r]=__builtin_amdgcn_exp2f(P0[r]); }while(0)
  #define RESC() do{ if(resc){ asm volatile("s_waitcnt lgkmcnt(0)":::"memory"); \
      _Pragma("unroll") for(int d_=0;d_<2;++d_) _Pragma("unroll") for(int r=0;r<16;++r)o[d_][r]*=wsf[crow(r,hi)]; } }while(0)
  f32x16 pA0,pA1,pB0,pB1;
  int sl_prev=0,sl_cur=0,sl_next=SLOTB;
  #define ROT() do{sl_prev=sl_cur;sl_cur=sl_next;sl_next=(sl_next==(NSLOT-1)*SLOTB)?0:sl_next+SLOTB;}while(0)
  DMA_K(2,2*SLOTB);
  WAIT_BAR(3);
  qkt(pA0,pA1,Kbase,qr,negm,r32,hi);asm volatile("s_nop 15\n\ts_nop 7":"+v"(pA0),"+v"(pA1));CMASK(pA0,pA1,0);
  START(pA0,pA1);
  _Pragma("unroll") for(int r=0;r<16;++r)pA1[r]=__builtin_amdgcn_exp2f(pA1[r]);
  WAIT_BAR(0);
  DMA_K(3,0);DMA_V(1,SLOTB);
  ROT();
  kload8(kf,kp0+sl_cur);
  WAIT_BAR(2);
  s16x4 vlo[8],vhi[8]; u32x4 pw0,pw1,pw2,pw3;
  #define PKW(P,B) cvtpk_s(P[B],P[B+1])
  #define PAF(k) __builtin_bit_cast(bf16x8,pw##k)
  #define VFR(i) (bf16x8){vlo[i][0],vlo[i][1],vlo[i][2],vlo[i][3],vhi[i][0],vhi[i][1],vhi[i][2],vhi[i][3]}
  #define PIN(x) asm volatile("":"+v"(x))
  #define MX3(a,b,c) __builtin_fmaxf(__builtin_fmaxf((a),(b)),(c))
  #define GAPA(MF,A0,A1,A2,A3,W0,W1,PW) do{ MF; sacc+=A0; sacc+=A1; sacc+=A2; sacc+=A3; PIN(sacc); W0; W1; PIN(PW); SBAR(); }while(0)
  #define EX(v) __builtin_amdgcn_exp2f(v)
  #define GAPB(MF,X,B) do{ MF; X[B]=EX(X[B]); X[B+1]=EX(X[B+1]); X[B+2]=EX(X[B+2]); X[B+3]=EX(X[B+3]); PIN(X); SBAR(); }while(0)
  #define VRD(i) do{ vlo[i]=vtr(vp_+(((i)>>2)*4096+((i)&3)*1024)); vhi[i]=vtr(vp_+(((i)>>2)*4096+((i)&3)*1024+512)); }while(0)
  #define KRD(G,j) do{ if(G){ kload2(kf,kp0+sl_next,j); SBAR(); } }while(0)
  #define STEP(C0,C1,P0,P1,t,GK,GV,GL) do{ SBAR(); \
    const lds_cptr vp_=vp0+sl_prev; \
    VRD(0); SBAR(); float sacc=(P0[0]+P0[1]); \
    GAPA(C0=__builtin_amdgcn_mfma_f32_32x32x16_bf16(kf[0],qr[0],negm,0,0,0), P0[2],P0[3],P0[4],P0[5],     pw0[0]=PKW(P0,0), pw0[1]=PKW(P0,2), pw0); \
    VRD(4); SBAR(); GAPA(C1=__builtin_amdgcn_mfma_f32_32x32x16_bf16(kf[1],qr[0],negm,0,0,0), P0[6],P0[7],P0[8],P0[9],     pw0[2]=PKW(P0,4), pw0[3]=PKW(P0,6), pw0); \
    VRD(1); SBAR(); GAPA(C0=__builtin_amdgcn_mfma_f32_32x32x16_bf16(kf[2],qr[1],C0,0,0,0),   P0[10],P0[11],P0[12],P0[13], pw1[0]=PKW(P0,8), pw1[1]=PKW(P0,10), pw1); \
    VRD(5); SBAR(); GAPA(C1=__builtin_amdgcn_mfma_f32_32x32x16_bf16(kf[3],qr[1],C1,0,0,0),   P0[14],P0[15],P1[0],P1[1],   pw1[2]=PKW(P0,12),pw1[3]=PKW(P0,14), pw1); \
    VRD(2); SBAR(); GAPA(C0=__builtin_amdgcn_mfma_f32_32x32x16_bf16(kf[4],qr[2],C0,0,0,0),   P1[2],P1[3],P1[4],P1[5],     pw2[0]=PKW(P1,0), pw2[1]=PKW(P1,2), pw2); \
    VRD(6); SBAR(); GAPA(C1=__builtin_amdgcn_mfma_f32_32x32x16_bf16(kf[5],qr[2],C1,0,0,0),   P1[6],P1[7],P1[8],P1[9],     pw2[2]=PKW(P1,4), pw2[3]=PKW(P1,6), pw2); \
    VRD(3); SBAR(); GAPA(C0=__builtin_amdgcn_mfma_f32_32x32x16_bf16(kf[6],qr[3],C0,0,0,0),   P1[10],P1[11],P1[12],P1[13], pw3[0]=PKW(P1,8), pw3[1]=PKW(P1,10), pw3); \
    VRD(7); SBAR(); GAPA(C1=__builtin_amdgcn_mfma_f32_32x32x16_bf16(kf[7],qr[3],C1,0,0,0),   P1[14],P1[15],0.f,0.f,       pw3[2]=PKW(P1,12),pw3[3]=PKW(P1,14), pw3); \
    l_reg+=sacc; \
    if(GK){DMA_K((t)+3,sl_cur);} if(GV){DMA_V((t)+1,sl_next);} \
    CMASK(C0,C1,t); \
    { float a=MX3(C0[0],C0[1],C1[0]),b=MX3(C0[2],C0[3],C1[1]); a=MX3(a,C1[2],C1[3]); \
      _Pragma("unroll") for(int r=4;r<16;r+=4){a=MX3(a,C0[r],C0[r+1]);b=MX3(b,C0[r+2],C0[r+3]);a=MX3(a,C1[r],C1[r+1]);b=MX3(b,C1[r+2],C1[r+3]);} \
      float rm=__builtin_fmaxf(a,b); { auto rr=__builtin_amdgcn_permlane32_swap(__float_as_uint(rm),__float_as_uint(rm),false,false); rm=__builtin_fmaxf(__uint_as_float(rr[0]),__uint_as_float(rr[1])); } \
      resc=false; \
      if(__builtin_expect(__any(rm>(float)THRL),0)){ const float dl=__builtin_fmaxf(rm,0.f); mhat+=dl; \
        _Pragma("unroll") for(int r=0;r<16;++r){C0[r]-=dl;C1[r]-=dl;} \
        _Pragma("unroll") for(int r=0;r<16;++r)negm[r]=-mhat; asm volatile("":"+v"(negm)); \
        const float f=__builtin_amdgcn_exp2f(-dl); l_reg*=f; if(hi==0)wsf[r32]=f; resc=true; } } \
    SBAR(); \
    GAPB(o[0]=__builtin_amdgcn_mfma_f32_32x32x16_bf16(PAF(0),VFR(0),o[0],0,0,0), C0,0); \
    GAPB(o[1]=__builtin_amdgcn_mfma_f32_32x32x16_bf16(PAF(0),VFR(4),o[1],0,0,0), C0,4); \
    KRD(GL,0); GAPB(o[0]=__builtin_amdgcn_mfma_f32_32x32x16_bf16(PAF(1),VFR(1),o[0],0,0,0), C0,8); \
    KRD(GL,1); GAPB(o[1]=__builtin_amdgcn_mfma_f32_32x32x16_bf16(PAF(1),VFR(5),o[1],0,0,0), C0,12); \
    KRD(GL,2); GAPB(o[0]=__builtin_amdgcn_mfma_f32_32x32x16_bf16(PAF(2),VFR(2),o[0],0,0,0), C1,0); \
    KRD(GL,3); GAPB(o[1]=__builtin_amdgcn_mfma_f32_32x32x16_bf16(PAF(2),VFR(6),o[1],0,0,0), C1,4); \
    GAPB(o[0]=__builtin_amdgcn_mfma_f32_32x32x16_bf16(PAF(3),VFR(3),o[0],0,0,0), C1,8); \
    GAPB(o[1]=__builtin_amdgcn_mfma_f32_32x32x16_bf16(PAF(3),VFR(7),o[1],0,0,0), C1,12); \
    }while(0)
  int t=1;
  #undef CMASK
  #define CMASK(P0,P1,t) do{}while(0)
  for(;t+5<NT;t+=2){
    STEP(pB0,pB1,pA0,pA1,t,true,true,true);     WAIT_BAR(2); RESC(); ROT();
    STEP(pA0,pA1,pB0,pB1,t+1,true,true,true);   WAIT_BAR(2); RESC(); ROT();
  }
  #undef CMASK
  #define CMASK(P0,P1,t) do{int jb_=(t)-(NT-4); if(jb_>=0)cmask(P0,P1,jb_,qrel,hi);}while(0)
  #define ENDW(tt) do{ if((tt)+3<NT){WAIT_BAR(2);} else if((tt)+2<NT){WAIT_BAR(1);} else {WAIT_BAR(0);} }while(0)
  for(;t+1<NT;t+=2){
    STEP(pB0,pB1,pA0,pA1,t,(t+3<NT),(t+1<NT),(t+1<NT));       ENDW(t);   RESC(); ROT();
    STEP(pA0,pA1,pB0,pB1,t+1,(t+4<NT),(t+2<NT),(t+2<NT));     ENDW(t+1); RESC(); ROT();
  }
  STEP(pB0,pB1,pA0,pA1,NT-1,false,false,false); RESC();
  { float sacc=pB0[0]+pB0[1]; _Pragma("unroll") for(int r=2;r<16;++r)sacc+=pB0[r]; _Pragma("unroll") for(int r=0;r<16;++r)sacc+=pB1[r]; l_reg+=sacc;
    pw0=(u32x4){PKW(pB0,0),PKW(pB0,2),PKW(pB0,4),PKW(pB0,6)};pw1=(u32x4){PKW(pB0,8),PKW(pB0,10),PKW(pB0,12),PKW(pB0,14)};pw2=(u32x4){PKW(pB1,0),PKW(pB1,2),PKW(pB1,4),PKW(pB1,6)};pw3=(u32x4){PKW(pB1,8),PKW(pB1,10),PKW(pB1,12),PKW(pB1,14)};
    SBAR(); pv(o,vb0+sl_cur,PAF(0),PAF(1),PAF(2),PAF(3)); }
  #undef PKW
  #undef PAF
  #undef VFR
  #undef PIN
  #undef MX3
  #undef GAPA
  #undef GAPB
  #undef EX
  #undef VRD
  #undef KRD
  #undef STEP
  #undef ENDW
  {auto rr=__builtin_amdgcn_permlane32_swap(__float_as_uint(l_reg),__float_as_uint(l_reg),false,false);l_reg=__uint_as_float(rr[0])+__uint_as_float(rr[1]);}
  if(hi==0)wsf[32+r32]=l_reg;asm volatile("s_waitcnt lgkmcnt(0)":::"memory");
  #pragma unroll
  for(int r=0;r<16;++r)rli[r]=__builtin_amdgcn_rcpf(wsf[32+crow(r,hi)]);
  asm volatile("s_waitcnt lgkmcnt(0)\n\ts_barrier":::"memory");
  #undef DMA_K
  #undef DMA_V
  #undef CMASK
  #undef START
  #undef RESC
  #undef ROT
}
constexpr int LDS_STASH=LDS_BYTES, LDS_SSQ=LDS_STASH+NW*8192, ATTN_LDS_BYTES=LDS_SSQ+NW*128;
template<int THRL> __device__ __forceinline__ void dattn_unit(int b,int h,int qb,const bf16*Q,const bf16*K,const bf16*V,bf16*O,char*shm,float lam,const float*subln,float oml){
  #pragma unroll 1
  for(int pass=0;pass<4;++pass){
    const int m=pass&1,vh=pass>>1;
    f32x16 o[2]; float rli[16];
    attn_pass<THRL>(b,2*h+m,2*h+vh,qb,Q,K,V,shm,o,rli);
    int tid_=threadIdx.x; asm volatile("":"+v"(tid_)); const int tid=tid_,lane=tid&63,r32=lane&31,hi=lane>>5; const int wid=__builtin_amdgcn_readfirstlane(tid>>6);
    float*stash=(float*)(shm+LDS_STASH)+wid*2048; float*ssq0=(float*)(shm+LDS_SSQ)+wid*32; float*wsf=(float*)(shm+LDS_WS)+wid*64;
    unsigned short*stg=(unsigned short*)(shm+LDS_OST)+wid*2048;
    const long orow0=((long)b*SEQ+(long)qb*QB+wid*QBLK)*DM+h*128;
    if(m==0){
      #pragma unroll
      for(int d0=0;d0<2;++d0)
        #pragma unroll
        for(int r=0;r<16;++r)stash[(d0*16+r)*64+lane]=o[d0][r]*rli[r];
    }else{
      float sq[16];
      #pragma unroll
      for(int r=0;r<16;++r){ const float a0=stash[r*64+lane]-lam*o[0][r]*rli[r], a1=stash[(16+r)*64+lane]-lam*o[1][r]*rli[r]; o[0][r]=a0;o[1][r]=a1;sq[r]=a0*a0+a1*a1; }
      #pragma unroll
      for(int r=0;r<16;++r){ float s=sq[r]; s+=__shfl_xor(s,1);s+=__shfl_xor(s,2);s+=__shfl_xor(s,4);s+=__shfl_xor(s,8);s+=__shfl_xor(s,16); sq[r]=s; }
      if(vh==0){
        if(r32==0){
          #pragma unroll
          for(int r=0;r<16;++r)ssq0[crow(r,hi)]=sq[r]; }
        #pragma unroll
        for(int r=0;r<16;++r){const int orow=crow(r,hi); stg[orow*64+r32]=(unsigned short)(cvtpk_s(o[0][r],0.f)&0xffffu); stg[orow*64+32+r32]=(unsigned short)(cvtpk_s(o[1][r],0.f)&0xffffu);}
      }else{
        float rsc[16];
        #pragma unroll
        for(int r=0;r<16;++r)rsc[r]=__builtin_amdgcn_rsqf((sq[r]+ssq0[crow(r,hi)])*(1.f/128.f)+1e-6f)*oml;
        if(r32==0){
          #pragma unroll
          for(int r=0;r<16;++r)wsf[32+crow(r,hi)]=rsc[r]; }
        asm volatile("s_waitcnt lgkmcnt(0)":::"memory");
        { const int ch=lane&7; const float4 g0=*(const float4*)(subln+ch*8),g1=*(const float4*)(subln+ch*8+4);
          #pragma unroll
          for(int i=0;i<4;++i){const int row=i*8+(lane>>3); const u32x4 v=*(const u32x4*)(stg+row*64+ch*8); const float rs_=wsf[32+row];
            u32x4 w;
            w.x=cvtpk_s(__uint_as_float(v.x<<16)*rs_*g0.x,__uint_as_float(v.x&0xffff0000u)*rs_*g0.y); w.y=cvtpk_s(__uint_as_float(v.y<<16)*rs_*g0.z,__uint_as_float(v.y&0xffff0000u)*rs_*g0.w);
            w.z=cvtpk_s(__uint_as_float(v.z<<16)*rs_*g1.x,__uint_as_float(v.z&0xffff0000u)*rs_*g1.y); w.w=cvtpk_s(__uint_as_float(v.w<<16)*rs_*g1.z,__uint_as_float(v.w&0xffff0000u)*rs_*g1.w);
            *(u32x4*)((unsigned short*)O+orow0+(long)row*DM+ch*8)=w; } }
        asm volatile("s_waitcnt lgkmcnt(0)":::"memory");
        { const float ga=subln[64+r32],gb=subln[96+r32];
          #pragma unroll
          for(int r=0;r<16;++r){const int orow=crow(r,hi); stg[orow*64+r32]=(unsigned short)(cvtpk_s(o[0][r]*rsc[r]*ga,0.f)&0xffffu); stg[orow*64+32+r32]=(unsigned short)(cvtpk_s(o[1][r]*rsc[r]*gb,0.f)&0xffffu);}
          asm volatile("s_waitcnt lgkmcnt(0)":::"memory");
          #pragma unroll
          for(int i=0;i<4;++i){const int row=i*8+(lane>>3),ch=lane&7; const u32x4 v=*(const u32x4*)(stg+row*64+ch*8); *(u32x4*)((unsigned short*)O+orow0+(long)row*DM+64+ch*8)=v;} }
        asm volatile("s_waitcnt lgkmcnt(0)":::"memory");
      }
    }
  }
}
#undef SBAR
#undef WAIT_BAR
}

constexpr size_t SSM_F16_OFF = 0, SSM_TG_OFF = 2 * MiB;
constexpr int SSM_XLD = 392;
typedef short bf16x8_t __attribute__((ext_vector_type(8)));
__device__ __forceinline__ void ssm_tables(const Frame& F0, int L, unsigned char* base) {
    const Frame F = refresh(F0);
    LAS float* ap_re = (LAS float*)F.lds; LAS float* ap_im = ap_re + 17 * 64;
    LAS float* bb_re = ap_im + 17 * 64;   LAS float* bb_im = bb_re + 1024;
    LAS float* cc_re = bb_im + 1024;      LAS float* cc_im = cc_re + 1024;
    LAS float* kt = cc_im + 1024;         LAS float* dd = kt + 4096;
    const int tid = F.tid;
    for (int item = F.vcu; item < NG * 8; item += F.G) {
        const int g = item >> 3, part = item & 7;
        __syncthreads();
        if (tid < 64) {
            const int p = tid; const float dt = expf(inp(F, I_LSTEP)[L * NG + g]);
            const float lr = inp(F, I_LRE)[(L * NG + g) * SP + p], li = inp(F, I_LIM)[(L * NG + g) * SP + p];
            for (int tau = 0; tau <= 16; ++tau) { const float mg = expf(lr * dt * (float)tau); float sn, cs; sincosf(li * dt * (float)tau, &sn, &cs); ap_re[tau * 64 + p] = mg * cs; ap_im[tau * 64 + p] = mg * sn; }
            const float ab_re = ap_re[64 + p], ab_im = ap_im[64 + p];
            const float den = lr * lr + li * li, nr = ab_re - 1.f;
            const float coef_re = (nr * lr + ab_im * li) / den, coef_im = (ab_im * lr - nr * li) / den;
            const float* br = inp(F, I_BRE) + ((size_t)(L * NG + g) * SP + p) * SG; const float* bi = inp(F, I_BIM) + ((size_t)(L * NG + g) * SP + p) * SG;
            for (int h = 0; h < 16; ++h) { bb_re[p * 16 + h] = coef_re * br[h] - coef_im * bi[h]; bb_im[p * 16 + h] = coef_re * bi[h] + coef_im * br[h]; }
        }
        for (int i = tid; i < 1024; i += NTHREADS) { cc_re[i] = inp(F, I_CRE)[(size_t)(L * NG + g) * SG * SP + i]; cc_im[i] = inp(F, I_CIM)[(size_t)(L * NG + g) * SG * SP + i]; }
        if (tid < 16) dd[tid] = inp(F, I_SSMD)[(L * NG + g) * SG + tid];
        __syncthreads();
        unsigned* F16 = (unsigned*)(base + SSM_F16_OFF) + (size_t)g * 128 * 128;
        for (int i3 = tid; i3 < 16 * 128; i3 += NTHREADS) {
            const int i2 = part * 16 * 128 + i3, row = i2 >> 7, col = (i2 & 127) * 2, p = row & 63, j = col >> 4, h0 = col & 15;
            const float ar = ap_re[(15 - j) * 64 + p], ai = ap_im[(15 - j) * 64 + p];
            float v[2];
#pragma unroll
            for (int q = 0; q < 2; ++q) { const float br = bb_re[p * 16 + h0 + q], bi = bb_im[p * 16 + h0 + q]; v[q] = row < 64 ? (ar * br - ai * bi) : (ar * bi + ai * br); }
            F16[i2] = f2bf(v[0]) | (f2bf(v[1]) << 16);
        }
        for (int i = tid; i < (2 * part + 2) * 256; i += NTHREADS) {
            const int tau = i >> 8, h = (i >> 4) & 15, hp = i & 15; float acc = 0.f;
            for (int p = 0; p < 64; ++p) { const float ar = ap_re[tau * 64 + p], ai = ap_im[tau * 64 + p], br = bb_re[p * 16 + hp], bi = bb_im[p * 16 + hp];
                const float er = ar * br - ai * bi, ei = ar * bi + ai * br; acc += cc_re[h * 64 + p] * er - cc_im[h * 64 + p] * ei; }
            kt[i] = acc;
        }
        __syncthreads();
        unsigned* TG = (unsigned*)(base + SSM_TG_OFF) + (size_t)g * 256 * 192;
        for (int i3 = tid; i3 < 32 * 128; i3 += NTHREADS) {
            const int i2 = part * 32 * 128 + i3, row = i2 >> 7, col = (i2 & 127) * 2, i = row >> 4, h = row & 15, j = col >> 4, h0 = col & 15;
            float v[2] = {0.f, 0.f};
            if (j <= i) {
#pragma unroll
                for (int q = 0; q < 2; ++q) { v[q] = kt[((i - j) * 16 + h) * 16 + h0 + q]; if (i == j && h == h0 + q) v[q] += dd[h]; } }
            TG[row * 192 + (i2 & 127)] = f2bf(v[0]) | (f2bf(v[1]) << 16);
        }
        for (int i3 = tid; i3 < 32 * 64; i3 += NTHREADS) {
            const int i2 = part * 32 * 64 + i3, row = i2 >> 6, c = (i2 & 63) * 2, i = row >> 4, h = row & 15;
            float v[2];
#pragma unroll
            for (int q = 0; q < 2; ++q) { const int p = (c + q) & 63; const float ar = ap_re[(i + 1) * 64 + p], ai = ap_im[(i + 1) * 64 + p], cr = cc_re[h * 64 + p], ci = cc_im[h * 64 + p];
                v[q] = (c + q) < 64 ? (cr * ar - ci * ai) : -(cr * ai + ci * ar); }
            TG[row * 192 + 128 + (i2 & 63)] = f2bf(v[0]) | (f2bf(v[1]) << 16);
        }
    }
    __syncthreads();
}
__device__ __forceinline__ float gelu_fast(float x) { const float u = 1.5957691216057308f * (x + 0.044715f * x * x * x); return x - x * __builtin_amdgcn_rcpf(1.f + __expf(u)); }
__device__ __forceinline__ void ssm_item_mfma(const Frame& F0, int L, int it, const bf16* U, bf16* Z, const unsigned char* tbase, float* vscr) {
    const Frame F = refresh(F0);
    const int g = it & 31, b = it >> 5, tid = F.tid, lane = F.lane, w = F.wave, lr16 = lane & 15, q = lane >> 4;
    LAS unsigned char* X = F.lds;
    { const bf16* ub = U + (size_t)b * SEQ * SSMW + g * 16;
#pragma unroll
      for (int r = 0; r < 4; ++r) { const int t = tid + r * NTHREADS; const v4u* sp = (const v4u*)(ub + (size_t)t * SSMW); const v4u a = sp[0], c = sp[1];
          LAS v4u* dp = (LAS v4u*)(X + (t >> 4) * (SSM_XLD * 2) + (t & 15) * 32); dp[0] = a; dp[1] = c; } }
    __syncthreads();
    { const bf16* F16 = (const bf16*)(tbase + SSM_F16_OFF) + (size_t)g * 128 * 256 + (size_t)(16 * w + lr16) * 256 + 8 * q;
      bf16x8_t af[8];
#pragma unroll
      for (int ks = 0; ks < 8; ++ks) af[ks] = *(const bf16x8_t*)(F16 + ks * 32);
#pragma unroll 1
      for (int nt = 0; nt < 8; ++nt) {
          f32x4 acc = {0.f, 0.f, 0.f, 0.f};
          LAS const unsigned char* xr = X + (16 * nt + lr16) * (SSM_XLD * 2) + 16 * q;
#pragma unroll
          for (int ks = 0; ks < 8; ++ks) { const bf16x8_t bf = *(LAS const bf16x8_t*)(xr + ks * 64); acc = __builtin_amdgcn_mfma_f32_16x16x32_bf16(af[ks], bf, acc, 0, 0, 0); }
          *(f32x4*)(vscr + (size_t)(16 * nt + lr16) * 128 + 16 * w + 4 * q) = acc;
      } }
    asm volatile("s_waitcnt vmcnt(0)" ::: "memory");
    __syncthreads();
    if (w == 0) {
        __builtin_amdgcn_fence(__ATOMIC_ACQUIRE, "agent");
        const int p = lane; const float dt = expf(inp(F, I_LSTEP)[L * NG + g]);
        const float lr = inp(F, I_LRE)[(L * NG + g) * SP + p], li = inp(F, I_LIM)[(L * NG + g) * SP + p];
        const float mg = expf(lr * dt * 16.f); float sn, cs; sincosf(li * dt * 16.f, &sn, &cs); const float a_re = mg * cs, a_im = mg * sn;
        float s_re = 0.f, s_im = 0.f;
        LAS unsigned short* xs = (LAS unsigned short*)X + 256 + p;
#pragma unroll 1
        for (int c0 = 0; c0 < 128; c0 += 16) {
            float vr[16], vi[16];
#pragma unroll
            for (int j = 0; j < 16; ++j) { vr[j] = vscr[(c0 + j) * 128 + p]; vi[j] = vscr[(c0 + j) * 128 + 64 + p]; }
#pragma unroll
            for (int j = 0; j < 16; ++j) {
                xs[(c0 + j) * SSM_XLD] = (unsigned short)f2bf(s_re); xs[(c0 + j) * SSM_XLD + 64] = (unsigned short)f2bf(s_im);
                const float t_re = a_re * s_re - a_im * s_im + vr[j], t_im = a_re * s_im + a_im * s_re + vi[j]; s_re = t_re; s_im = t_im;
            }
        }
    }
    __syncthreads();
    { const int mA = w, mB = 15 - w, limA = mA >> 1, limB = mB >> 1;
      const bf16* TGa = (const bf16*)(tbase + SSM_TG_OFF) + (size_t)g * 256 * 384 + (size_t)(16 * mA + lr16) * 384 + 8 * q;
      const bf16* TGb = (const bf16*)(tbase + SSM_TG_OFF) + (size_t)g * 256 * 384 + (size_t)(16 * mB + lr16) * 384 + 8 * q;
      bf16x8_t fa[12], fb[12];
#pragma unroll
      for (int ks = 0; ks < 12; ++ks) { const bf16x8_t zz = {0, 0, 0, 0, 0, 0, 0, 0}; fa[ks] = (ks >= 8 || ks <= limA) ? *(const bf16x8_t*)(TGa + ks * 32) : zz; fb[ks] = (ks >= 8 || ks <= limB) ? *(const bf16x8_t*)(TGb + ks * 32) : zz; }
      bf16* zb = Z + (size_t)b * SEQ * SSMW + g * 16 + 4 * q;
#pragma unroll 1
      for (int nt = 0; nt < 8; ++nt) {
          f32x4 accA = {0.f, 0.f, 0.f, 0.f}, accB = {0.f, 0.f, 0.f, 0.f};
          LAS const unsigned char* xr = X + (16 * nt + lr16) * (SSM_XLD * 2) + 16 * q;
#pragma unroll
          for (int ks = 0; ks < 12; ++ks) { const bf16x8_t bf = *(LAS const bf16x8_t*)(xr + ks * 64);
              if (ks >= 8 || ks <= limA) accA = __builtin_amdgcn_mfma_f32_16x16x32_bf16(fa[ks], bf, accA, 0, 0, 0);
              if (ks >= 8 || ks <= limB) accB = __builtin_amdgcn_mfma_f32_16x16x32_bf16(fb[ks], bf, accB, 0, 0, 0); }
          const int sc = 16 * nt + lr16;
          { v2u o; o.x = f2bf(gelu_fast(accA[0])) | (f2bf(gelu_fast(accA[1])) << 16); o.y = f2bf(gelu_fast(accA[2])) | (f2bf(gelu_fast(accA[3])) << 16); *(v2u*)(zb + (size_t)(16 * sc + mA) * SSMW) = o; }
          { v2u o; o.x = f2bf(gelu_fast(accB[0])) | (f2bf(gelu_fast(accB[1])) << 16); o.y = f2bf(gelu_fast(accB[2])) | (f2bf(gelu_fast(accB[3])) << 16); *(v2u*)(zb + (size_t)(16 * sc + mB) * SSMW) = o; }
      } }
    __syncthreads();
}

__device__ __forceinline__ void router_phase(const Frame& F0, int L, const float* xio, unsigned* ctl, unsigned char* ws) {
    const Frame F = refresh(F0);
    LAS f32x4* Wg = (LAS f32x4*)F.lds; LAS f32x4* Wl = (LAS f32x4*)(F.lds + 16384); LAS f32x4* Wh = (LAS f32x4*)(F.lds + 81920);
    const float* gf = inp(F, I_FFN_G) + L * DM; const float* wrg = inp(F, I_WRG) + (size_t)L * DM * NGRP; const float* wre = inp(F, I_WRE) + (size_t)L * NGRP * DM * EPG;
    for (int k = F.tid; k < DM; k += NTHREADS) Wg[k] = *(const f32x4*)(wrg + (size_t)k * 4) * gf[k];
    for (int idx = F.tid; idx < NGRP * DM; idx += NTHREADS) { const float g = gf[idx & (DM - 1)]; const f32x4* s = (const f32x4*)(wre + (size_t)idx * 8); Wl[idx] = s[0] * g; Wh[idx] = s[1] * g; }
    __syncthreads();
    const float* brg = inp(F, I_BRG) + L * NGRP; const float* bre = inp(F, I_BRE2) + L * NGRP * EPG;
    unsigned* cnt = ctl + CW_CNT + L * 64 * CNT_STRIDE; SlotInfo* slots = (SlotInfo*)(ws + WS_SLOT);
    const int gw = F.even ? (F.vcu / (F.G / 8)) * SEQ + (F.vcu % (F.G / 8)) * NWAVES + F.wave : F.vcu * NWAVES + F.wave, NGW = F.even ? (F.G / 8) * NWAVES : F.G * NWAVES;
    const int T_END = F.even ? (F.vcu / (F.G / 8) + 1) * SEQ : T;
    int my_t = -1, my_e0 = 0, my_e1 = 0; float my_w0 = 0.f, my_w1 = 0.f; int nr = 0;
    float xn_[16];
    { const float* xr = xio + (size_t)gw * DM + F.lane;
#pragma unroll
      for (int j = 0; j < 16; ++j) xn_[j] = xr[64 * j]; }
    for (int t = gw; t < T_END; t += NGW, ++nr) {
        float xv[16]; float ss = 0.f;
#pragma unroll
        for (int j = 0; j < 16; ++j) { xv[j] = xn_[j]; ss += xv[j] * xv[j]; }
        { const int tn = (t + NGW < T_END) ? t + NGW : t; const float* xr = xio + (size_t)tn * DM + F.lane;
#pragma unroll
          for (int j = 0; j < 16; ++j) xn_[j] = xr[64 * j]; }
        const float rs = rsqrtf(wave_sum(ss) * (1.f / DM) + EPS);
        f32x4 ag = {0.f, 0.f, 0.f, 0.f};
#pragma unroll
        for (int j = 0; j < 16; ++j) ag += Wg[F.lane + 64 * j] * xv[j];
        float lg[4];
#pragma unroll
        for (int c = 0; c < 4; ++c) lg[c] = wave_sum(ag[c]) * rs + brg[c];
        int grp = 0; float gmax = lg[0];
#pragma unroll
        for (int c = 1; c < 4; ++c) if (lg[c] > gmax) { gmax = lg[c]; grp = c; }
        float gden = 0.f;
#pragma unroll
        for (int c = 0; c < 4; ++c) gden += __expf(lg[c] - gmax);
        const float p_grp = 1.f / gden;
        grp = __builtin_amdgcn_readfirstlane(grp);
        f32x4 al = {0.f, 0.f, 0.f, 0.f}, ah = {0.f, 0.f, 0.f, 0.f};
#pragma unroll
        for (int j = 0; j < 16; ++j) { const int idx = grp * DM + F.lane + 64 * j; al += Wl[idx] * xv[j]; ah += Wh[idx] * xv[j]; }
        float le[8];
#pragma unroll
        for (int c = 0; c < 4; ++c) { le[c] = wave_sum(al[c]) * rs + bre[grp * EPG + c]; le[4 + c] = wave_sum(ah[c]) * rs + bre[grp * EPG + 4 + c]; }
        int i0 = 0; float v0 = le[0];
#pragma unroll
        for (int c = 1; c < 8; ++c) if (le[c] > v0) { v0 = le[c]; i0 = c; }
        int i1 = -1; float v1 = -3.0e38f;
#pragma unroll
        for (int c = 0; c < 8; ++c) if (c != i0 && le[c] > v1) { v1 = le[c]; i1 = c; }
        const float e1 = __expf(v1 - v0);
        const float w0 = p_grp / (1.f + e1), w1 = p_grp * e1 / (1.f + e1);
        if (F.lane == (nr & 63)) { my_t = t; my_e0 = grp * EPG + i0; my_e1 = grp * EPG + i1; my_w0 = w0; my_w1 = w1; }
        if ((nr & 63) == 63 || t + NGW >= T_END) {
            if (my_t >= 0) {
                const unsigned p0 = atomicAdd(cnt + my_e0 * CNT_STRIDE, 1u), p1 = atomicAdd(cnt + (32 + my_e1) * CNT_STRIDE, 1u);
                slots[(size_t)my_e0 * T + p0] = SlotInfo{my_t, my_w0}; slots[(size_t)(32 + my_e1) * T + p1] = SlotInfo{my_t, my_w1};
            }
            my_t = -1;
        }
    }
}
constexpr int LDS_TB_OFF = 143360;
__device__ __forceinline__ void moe_tables(const Frame& F0, int L, unsigned* ctl) {
    const Frame F = refresh(F0);
    LAS int* tb = (LAS int*)(F.lds + LDS_TB_OFF); LAS int* tc = tb + 80;
    if (F.tid < 64) tc[F.tid] = (int)__hip_atomic_load(ctl + CW_CNT + (L * 64 + F.tid) * CNT_STRIDE, __ATOMIC_RELAXED, __HIP_MEMORY_SCOPE_AGENT);
    __syncthreads();
    if (F.tid == 0) { int s = 0; for (int i = 0; i < 64; ++i) { tb[i] = s; s += (tc[i] + 255) >> 8; } tb[64] = s; }
    __syncthreads();
    if (F.tid < 64) { const int t0 = tb[F.tid], t1 = tb[F.tid + 1]; for (int t = t0; t < t1; ++t) tb[160 + t] = F.tid; }
    __syncthreads();
}
__device__ __forceinline__ void moe_gather_tables(const Frame& F0, const pg8::MoeSched& S, const SlotInfo* slots, const float* part) {
    const Frame F = refresh(F0);
    LAS unsigned* tokoff = (LAS unsigned*)(F.lds + PG8_TOKOFF_OFF); LAS float* ri = (LAS float*)(F.lds + PG8_ROWINFO_OFF);
    pg8::Unit u;
    for (int i = 0; i < 4 && S.next(i, u); ++i) {
        if (F.tid < 256) { const int p = u.mt * 256 + F.tid; SlotInfo si = SlotInfo{0, 0.f};
            if (p < u.cnt) si = slots[(size_t)(u.k * 32 + u.e) * T + p];
            const float rs = pg8::rowscale16(part, si.token);
            tokoff[i * 256 + F.tid] = (unsigned)si.token * (unsigned)(DM * 2); ri[(i * 256 + F.tid) * 2] = si.w; ri[(i * 256 + F.tid) * 2 + 1] = rs; }
    }
    __syncthreads();
}
__device__ __forceinline__ void moe_down_tables(const Frame& F0, const pg8::MoeSched& S, const SlotInfo* slots) {
    const Frame F = refresh(F0);
    LAS int* tk = (LAS int*)(F.lds + PG8_TOKOFF_OFF);
    pg8::Unit u;
    for (int i = 0; i < 4 && S.next(i, u); ++i) {
        if (F.tid < 256) { const int p = u.mt * 256 + F.tid; tk[i * 256 + F.tid] = (p < u.cnt) ? slots[(size_t)(u.k * 32 + u.e) * T + p].token : -1; }
    }
    __syncthreads();
}
__device__ __forceinline__ void fill_rowscales(const Frame& F0, const pg8::StaticOrder& S, const float* part) {
    const Frame F = refresh(F0);
    LAS float* rsl = (LAS float*)(F.lds + PG8_RS_OFF);
    pg8::Unit u; const int half = F.tid >> 8, r = F.tid & 255;
    for (int i = 0; i < 8; i += 2) { if (S.next(i + half, u)) rsl[(i + half) * 256 + r] = pg8::rowscale16(part, u.pm * 256 + r); }
    __syncthreads();
}

__global__ void __launch_bounds__(NTHREADS, 2) mega_fwd(Args args) {
    extern __shared__ __attribute__((aligned(16))) unsigned char lds_raw[];
    Frame Fk;
    Fk.lds = (LAS unsigned char*)lds_raw;
    Fk.tid = threadIdx.x; Fk.lane = Fk.tid & 63; Fk.wave = __builtin_amdgcn_readfirstlane(Fk.tid >> 6);
    Fk.G = gridDim.x; { const int bx = blockIdx.x; Fk.vcu = (Fk.G % 8 == 0) ? (bx % 8) * (Fk.G / 8) + bx / 8 : bx; Fk.cid = bx; Fk.even = 0; }
    const Frame& F = Fk;
    volatile LAS unsigned* MISC = (volatile LAS unsigned*)(F.lds + MISC_OFF);
    if (F.tid < 64) MISC[F.tid] = 0u;
    if (F.tid < N_IN) ((LAS unsigned long long*)(F.lds + PTAB_OFF))[F.tid] = (unsigned long long)args.in[F.tid];
    __syncthreads();
    unsigned char* const ws = args.ws;
    XcdBarrier bar = xcd_barrier_post((unsigned*)(ws + WS_CTL) + CW_BAR, MISC + 8);
#define GRID_BAR() xcd_barrier(bar)
#define PHASE_WS unsigned long long wv_ = (unsigned long long)ws; asm volatile("" : "+s"(wv_)); GAS unsigned char* const w_ = (GAS unsigned char*)wv_
    constexpr size_t PARTSZ = (size_t)T * 16 * 4;
    const int NGW = F.G * NWAVES;

    { PHASE_WS; const Frame F = refresh(Fk); const int gw = F.vcu * NWAVES + F.wave;
      float* part = (float*)(w_ + WS_PART); bf16* X0 = (bf16*)(w_ + WS_X0); bf16* PB = (bf16*)(w_ + WS_PB); float* lamv = (float*)(w_ + WS_MISC);
    for (int m = gw; m < T; m += NGW) {
        const f32x4* xr = (const f32x4*)(inp(F, I_X) + (size_t)m * DM) + F.lane; float s = 0.f;
        v2u* o8 = (v2u*)(X0 + (size_t)m * DM) + F.lane;
#pragma unroll
        for (int j = 0; j < 4; ++j) { const f32x4 v = xr[64 * j]; s += v.x * v.x + v.y * v.y + v.z * v.z + v.w * v.w;
            v2u w; w.x = f2bf(v.x) | (f2bf(v.y) << 16); w.y = f2bf(v.z) | (f2bf(v.w) << 16); o8[64 * j] = w; }
        s = wave_sum(s);
        if (F.lane < 16) part[(size_t)m * 16 + F.lane] = (F.lane == 0) ? s : 0.f;
    }
    for (size_t i = (size_t)(blockIdx.x * NTHREADS + F.tid) * 4; i < (size_t)DEPTH * T * PLE; i += (size_t)F.G * NTHREADS * 4) {
        const f32x4 v = *(const f32x4*)(inp(F, I_P) + i); v2u w; w.x = f2bf(v.x) | (f2bf(v.y) << 16); w.y = f2bf(v.z) | (f2bf(v.w) << 16); *(v2u*)(PB + i) = w; }
    if (blockIdx.x == 0 && F.tid < DEPTH) {
        const float* lq = inp(F, I_LAMQK) + F.tid * 4 * HD; float s1 = 0.f, s2 = 0.f;
        for (int j = 0; j < HD; ++j) { s1 += lq[j] * lq[HD + j]; s2 += lq[2 * HD + j] * lq[3 * HD + j]; }
        lamv[F.tid] = expf(s1) - expf(s2) + lam_init_for(F.tid);
    }
    convert_weights(Fk, 0, (unsigned char*)(w_ + WS_WT));
    ssm_tables(Fk, 0, (unsigned char*)(w_ + WS_SSMT));
    }
    GRID_BAR();
    { const unsigned ev = MISC[8 + 3], hx = MISC[8 + 2], hr = MISC[8 + 4];
      if (ev) { Fk.even = 1; Fk.vcu = (int)(hx * (unsigned)(Fk.G / 8) + hr); Fk.cid = (int)(hr * 8u + hx); } }
#define LOCAL_BAR() do { if (Fk.even) xcc_barrier(bar); else xcd_barrier(bar); } while (0)

#define GEMM_PHASE(EPI, Aptr, WOFF, N_, K_, E_) do { pg8::Gemm g_{(const pg8::bf16_t*)(Aptr), (const pg8::bf16_t*)(unsigned char*)(w_ + WS_WT + (WOFF)), T, (N_), (K_)}; pg8::StaticOrder S_; S_.init(T, (N_), F.G, F.cid); \
        pg8::gemm_phase<EPI, pg8::StaticOrder, true, true>(F.lds, g_, S_, E_); } while (0)
#define P_XA ((bf16*)(unsigned char*)(w_ + ((L & 1) ? WS_X1 : WS_X0)))
#define P_XB ((bf16*)(unsigned char*)(w_ + ((L & 1) ? WS_X0 : WS_X1)))
#define P_PART ((float*)(unsigned char*)(w_ + WS_PART + (size_t)(L & 1) * PARTSZ))
#define P_PART2 ((float*)(unsigned char*)(w_ + WS_PART + (size_t)((L & 1) ^ 1) * PARTSZ))
#define P_(T_, OFF) ((T_*)(unsigned char*)(w_ + (OFF)))
#pragma unroll 1
    for (int L = 0; L < DEPTH; ++L) {
        if (L > 0) { { PHASE_WS; convert_weights(Fk, L, (unsigned char*)(w_ + WS_WT)); ssm_tables(Fk, L, (unsigned char*)(w_ + WS_SSMT)); } GRID_BAR(); }
        { PHASE_WS; pg8::EpiWinF E{F.lds, P_(bf16, WS_Q), P_(bf16, WS_K), P_(bf16, WS_V), P_(bf16, WS_U), P_(bf16, WS_GATES), inp(F, I_QG) + L * 2 * HD, inp(F, I_KG) + L * 2 * HD, inp(F, I_BGATE) + L * 2 * DM};
          { pg8::StaticOrder S0; S0.init(T, INW, F.G, F.cid); fill_rowscales(Fk, S0, P_PART); }
          GEMM_PHASE(pg8::EpiWinF, P_XA, WT_WIN, INW, DM, E); }
        LOCAL_BAR();
        { PHASE_WS;
          for (int it = F.vcu; it < BATCH * NG; it += F.G)
              ssm_item_mfma(Fk, L, it, P_(const bf16, WS_U), P_(bf16, WS_Z), P_(const unsigned char, WS_SSMT),
                            (float*)((unsigned char*)P_XB + (size_t)(F.vcu >> 5) * (4 * MiB) + (size_t)(F.vcu & 31) * 65536)); }
        { PHASE_WS; const Frame F = refresh(Fk);
          const float lam = P_(float, WS_MISC)[L]; const float oml = 1.f - lam_init_for(L); const float* subln = inp(F, I_SUBLN) + L * 2 * HD;
          static_assert(attn_body::ATTN_LDS_BYTES <= PTAB_OFF, "attention LDS");
          for (int v = F.vcu; v < BATCH * NH * 4; v += F.G) {
              const int bh = v >> 2, s = v & 3;
#pragma unroll 1
              for (int i = 0; i < 2; ++i)
                  attn_body::dattn_unit<8>(bh >> 3, bh & 7, i ? s : 7 - s, P_(const attn_body::bf16, WS_Q), P_(const attn_body::bf16, WS_K), P_(const attn_body::bf16, WS_V), P_(attn_body::bf16, WS_Q), (char*)lds_raw, lam, subln, oml);
          } }
        LOCAL_BAR();
        { PHASE_WS; pg8::EpiGluF E{P_(bf16, WS_Z), P_(bf16, WS_Z2), inp(F, I_BGLU) + L * SSMW}; GEMM_PHASE(pg8::EpiGluF, P_(bf16, WS_Z), WT_WGLU, SSMW, SSMW, E); }
        LOCAL_BAR();
        { PHASE_WS; pg8::EpiGateF E{P_(bf16, WS_GATES), DM, nullptr, P_(bf16, WS_PARTS)}; GEMM_PHASE(pg8::EpiGateF, P_(bf16, WS_Z2), WT_WSU, DM, SSMW, E); }
        LOCAL_BAR();
        { PHASE_WS; pg8::EpiGateF E{P_(bf16, WS_GATES), 0, P_(bf16, WS_PARTS), P_(bf16, WS_MIXED)}; GEMM_PHASE(pg8::EpiGateF, P_(bf16, WS_Q), WT_WAU, DM, VW, E); }
        LOCAL_BAR();
        { PHASE_WS; const float* xbase = (L == 0) ? inp(F, I_X) : args.out;
          pg8::EpiResF E{xbase, args.out, P_XB, P_PART2}; GEMM_PHASE(pg8::EpiResF, P_(bf16, WS_MIXED), WT_WOUT, DM, DM, E); }
        LOCAL_BAR();
        { PHASE_WS; pg8::EpiPlainF E{P_(bf16, WS_PLE), 2 * DM};        GEMM_PHASE(pg8::EpiPlainF, P_(bf16, WS_PB) + (size_t)L * T * PLE, WT_WPLE, DM, PLE, E);
          router_phase(Fk, L, args.out, P_(unsigned, WS_CTL), (unsigned char*)w_); }
        GRID_BAR();
        { PHASE_WS; moe_tables(Fk, L, P_(unsigned, WS_CTL));
          pg8::MoeSched S{(LAS const int*)(F.lds + LDS_TB_OFF), (LAS const int*)(F.lds + LDS_TB_OFF) + 80, F.G, F.cid, 0};
          moe_gather_tables(Fk, S, P_(const SlotInfo, WS_SLOT), P_PART2);
          pg8::Gemm g{(const pg8::bf16_t*)P_XB, (const pg8::bf16_t*)(unsigned char*)(w_ + WS_WT + WT_WGU), T, 512, DM};
          pg8::EpiActF E{P_(pg8::bf16_t, WS_ACT), F.lds};
          pg8::gemm_phase_g<pg8::EpiActF, pg8::MoeSched>(F.lds, g, S, E); }
        GRID_BAR();
        { PHASE_WS; moe_tables(Fk, L, P_(unsigned, WS_CTL));
          pg8::MoeSched S{(LAS const int*)(F.lds + LDS_TB_OFF), (LAS const int*)(F.lds + LDS_TB_OFF) + 80, F.G, F.cid, 1};
          pg8::Gemm g{P_(const pg8::bf16_t, WS_ACT), (const pg8::bf16_t*)(unsigned char*)(w_ + WS_WT + WT_WD), T, DM, EFF};
          moe_down_tables(Fk, S, P_(const SlotInfo, WS_SLOT));
          pg8::EpiDownF<0> E{F.lds, args.out, P_XA, P_PART};
          pg8::gemm_phase<pg8::EpiDownF<0>, pg8::MoeSched, true, true>(F.lds, g, S, E); }
        GRID_BAR();
        { PHASE_WS; moe_tables(Fk, L, P_(unsigned, WS_CTL));
          pg8::MoeSched S{(LAS const int*)(F.lds + LDS_TB_OFF), (LAS const int*)(F.lds + LDS_TB_OFF) + 80, F.G, F.cid, 2};
          pg8::Gemm g{P_(const pg8::bf16_t, WS_ACT), (const pg8::bf16_t*)(unsigned char*)(w_ + WS_WT + WT_WD), T, DM, EFF};
          moe_down_tables(Fk, S, P_(const SlotInfo, WS_SLOT));
          pg8::EpiDownF<1> E{F.lds, args.out, P_XA, P_PART};
          pg8::gemm_phase<pg8::EpiDownF<1>, pg8::MoeSched, true, true>(F.lds, g, S, E); }
        GRID_BAR();
        { PHASE_WS; pg8::EpiPleF E{F.lds, P_(bf16, WS_PLE), args.out, P_XB, P_PART2};
          { pg8::StaticOrder S0; S0.init(T, DM, F.G, F.cid); fill_rowscales(Fk, S0, P_PART); }
          GEMM_PHASE(pg8::EpiPleF, P_XA, WT_WPG, DM, DM, E); }
        GRID_BAR();
    }
}

extern "C" void kernel_launch(void* const* d_in, const int* in_sizes, int n_in, void* d_out, int out_size, void* d_ws, size_t ws_size, hipStream_t stream) {
    static int grid = 0;
    if (grid == 0) {
        if (n_in != N_IN || in_sizes[0] != T * DM || out_size != T * DM || ws_size < WS_END) {
            fprintf(stderr, "kernel_launch: unexpected problem (n_in %d, in0 %d, out %d, ws %zu); nothing launched\n", n_in, n_in > 0 ? in_sizes[0] : -1, out_size, ws_size); grid = -1; return; }
        int dev = 0, cus = 0, per_cu = 0;
        if (hipGetDevice(&dev) != hipSuccess || hipDeviceGetAttribute(&cus, hipDeviceAttributeMultiprocessorCount, dev) != hipSuccess) { grid = -1; return; }
        if (hipFuncSetAttribute((const void*)mega_fwd, hipFuncAttributeMaxDynamicSharedMemorySize, LDS_BYTES) != hipSuccess) { fprintf(stderr, "kernel_launch: hipFuncSetAttribute failed\n"); grid = -1; return; }
        if (hipOccupancyMaxActiveBlocksPerMultiprocessor(&per_cu, (const void*)mega_fwd, NTHREADS, LDS_BYTES) != hipSuccess || per_cu < 1)
            fprintf(stderr, "kernel_launch: note: occupancy query reports %d workgroups per CU\n", per_cu);
        (void)hipGetLastError();
        grid = cus;
    }
    if (grid < 0) return;
    if (hipMemsetAsync((char*)d_ws + WS_CTL, 0, CTL_ZERO_BYTES, stream) != hipSuccess) { fprintf(stderr, "kernel_launch: memset failed\n"); return; }
    Args a{};
    for (int i = 0; i < N_IN; ++i) a.in[i] = (const float*)d_in[i];
    a.out = (float*)d_out; a.ws = (unsigned char*)d_ws;
    hipLaunchKernelGGL(mega_fwd, dim3(grid), dim3(NTHREADS), LDS_BYTES, stream, a);
    const hipError_t le = hipPeekAtLastError();
    if (le != hipSuccess) fprintf(stderr, "kernel_launch: launch failed: %s\n", hipGetErrorName(le));
}
```

```cpp
#include <hip/hip_runtime.h>
#include <cstdio>
#include <cstdint>
#include <cmath>
#include <hip/hip_bf16.h>

#define GAS __attribute__((address_space(1)))
#define LAS __attribute__((address_space(3)))
typedef unsigned short bf16;
typedef unsigned v4u __attribute__((ext_vector_type(4)));
typedef unsigned v2u __attribute__((ext_vector_type(2)));
typedef float f32x4 __attribute__((ext_vector_type(4)));

constexpr int DM = 1024, BATCH = 8, SEQ = 2048, T = BATCH * SEQ, DEPTH = 2;
constexpr int NH = 8, HD = 64, QKW = 1024, VW = 1024, SSMW = 512, SG = 16, NG = 32, SP = 64;
constexpr int INW = 5632, NGRP = 4, EPG = 8, NEXP = 32, EFF = 256, PLE = 256;
constexpr float EPS = 1e-6f;
constexpr float C2 = 0.125f * 1.4426950408889634f;
constexpr int NWAVES = 8, NTHREADS = 512;

enum { I_X = 0, I_P, I_ATTN_G, I_WIN, I_BGATE, I_QG, I_KG, I_LAMQK, I_SUBLN, I_WAU, I_LRE, I_LIM, I_LSTEP, I_BRE, I_BIM, I_CRE, I_CIM,
       I_SSMD, I_WGLU, I_BGLU, I_WSU, I_WOUT, I_FFN_G, I_WRG, I_BRG, I_WRE, I_BRE2, I_WEG, I_WEU, I_WED, I_PLE_G, I_WPG, I_WPLE, N_IN };

constexpr size_t MiB = 1u << 20;
constexpr size_t WS_CTL = 0, CTL_ZERO_BYTES = 1 * MiB;
constexpr size_t WS_PART = 1 * MiB;
constexpr size_t WS_MISC = 3 * MiB;
constexpr size_t WS_SLOT = 4 * MiB;
constexpr size_t WS_WT = 16 * MiB;
constexpr size_t WS_X0 = 84 * MiB, WS_X1 = 116 * MiB;
constexpr size_t WS_Q = 148 * MiB, WS_K = 180 * MiB, WS_V = 212 * MiB;
constexpr size_t WS_U = 244 * MiB, WS_Z = 260 * MiB;
constexpr size_t WS_GATES = 276 * MiB;
constexpr size_t WS_PB = 340 * MiB;
constexpr size_t WS_SSMT = 356 * MiB;
constexpr size_t WS_END = 364 * MiB;
constexpr size_t WS_Z2 = WS_U, WS_MIXED = WS_K, WS_PARTS = WS_V, WS_PLE = WS_GATES, WS_OTMP = WS_X0, WS_ACT = WS_V;
struct SlotInfo { int token; float w; };
constexpr int CW_BAR = 4096;
constexpr int CW_CNT = 16384, CNT_STRIDE = 64;

__device__ __forceinline__ unsigned f2bf(float f) { unsigned u = __builtin_bit_cast(unsigned, f); return (u + 0x7fffu + ((u >> 16) & 1u)) >> 16; }
__device__ __forceinline__ float bf2f(unsigned b) { return __builtin_bit_cast(float, b << 16); }
__device__ __forceinline__ float bflo(unsigned w) { return __builtin_bit_cast(float, w << 16); }
__device__ __forceinline__ float bfhi(unsigned w) { return __builtin_bit_cast(float, w & 0xffff0000u); }
__device__ __forceinline__ float wave_sum(float v) {
#pragma unroll
    for (int o = 1; o < 64; o <<= 1) v += __shfl_xor(v, o);
    return v;
}
__device__ __forceinline__ float sigmoidf_(float x) { return 1.f / (1.f + __expf(-x)); }
__device__ __forceinline__ float gelu_tanh(float x) { const float u = 0.7978845608028654f * (x + 0.044715f * x * x * x); return 0.5f * x * (1.f + tanhf(u)); }
__device__ __forceinline__ float rowscale(const float* part, int row) {
    const f32x4* p = (const f32x4*)(part + (size_t)row * 16);
    float s = 0.f;
#pragma unroll
    for (int i = 0; i < 4; ++i) { const f32x4 v = p[i]; s += v.x; s += v.y; s += v.z; s += v.w; }
    return rsqrtf(s * (1.f / DM) + EPS);
}
__host__ __device__ inline float lam_init_for(int i) { return 0.8f - 0.6f * expf(-0.3f * (float)i); }

#define XB_TMO      128
#define XB_XCNT(j)  (256  + 64 * (j))
#define XB_XSUB(j)  (1280 + 64 * (j))
#define XB_XGEN(j)  (2304 + 64 * (j))
#define XB_TOP      3328
#define XB_TOPGEN   3392
#define XB_LSUB(j)  (3456 + 64 * (j))
#define XB_LGEN(j)  (4480 + 64 * (j))
#define XCD_BAR_WORDS 5504
#define XB_SPIN_CAP (1u << 22)
__device__ __forceinline__ unsigned xb_ld(unsigned* p)              { return __hip_atomic_load(p, __ATOMIC_RELAXED, __HIP_MEMORY_SCOPE_AGENT); }
__device__ __forceinline__ unsigned xb_add(unsigned* p, unsigned v) { return __hip_atomic_fetch_add(p, v, __ATOMIC_RELAXED, __HIP_MEMORY_SCOPE_AGENT); }
__device__ __forceinline__ unsigned xb_xcc_id() { return (unsigned)__builtin_amdgcn_s_getreg((3 << 11) | 20) & 0xFu; }
#define XB_SPIN(cond, bar) do { unsigned _sp = 0; while (cond) { __builtin_amdgcn_s_sleep(1); \
    if ((++_sp & 255u) == 0u) { if (xb_ld(&(bar)[XB_TMO])) break; if (_sp > XB_SPIN_CAP) { atomicAdd(&(bar)[XB_TMO], 1u); break; } } } } while (0)
struct XcdBarrier { unsigned* bar; unsigned x; volatile LAS unsigned* st; };
__device__ __forceinline__ XcdBarrier xcd_barrier_post(unsigned* bar, volatile LAS unsigned* st) {
    XcdBarrier b; b.bar = bar; b.x = 0; b.st = st;
    if (threadIdx.x == 0) { const unsigned x = xb_xcc_id(); st[2] = x; st[4] = xb_add(&bar[XB_XCNT(x)], 1u); }
    return b;
}
__device__ __forceinline__ void xcd_barrier_complete(unsigned* bar, unsigned x, unsigned& nloc, unsigned& nx) {
    const unsigned G = gridDim.x * gridDim.y * gridDim.z;
    unsigned sum, cnt, mine, sp = 0u;
    for (;;) {
        sum = 0u; cnt = 0u; mine = 0u;
#pragma unroll
        for (unsigned j = 0; j < 16; ++j) { const unsigned c = xb_ld(&bar[XB_XCNT(j)]); sum += c; cnt += (c > 0u) ? 1u : 0u; mine = (j == x) ? c : mine; }
        if (sum == G) break;
        __builtin_amdgcn_s_sleep(1);
        if ((++sp & 255u) == 0u) { if (xb_ld(&bar[XB_TMO])) break; if (sp > XB_SPIN_CAP) { atomicAdd(&bar[XB_TMO], 1u); break; } }
    }
    nloc = mine > 0u ? mine : 1u; nx = cnt > 0u ? cnt : 1u;
}
__device__ __forceinline__ unsigned xcd_census_even(unsigned* bar) {
    const unsigned G = gridDim.x; unsigned ok = (G % 8u == 0u) ? 1u : 0u;
#pragma unroll
    for (unsigned j = 0; j < 16; ++j) { const unsigned c = xb_ld(&bar[XB_XCNT(j)]); if (c != (j < 8u ? G / 8u : 0u)) ok = 0u; }
    return ok;
}
__device__ __forceinline__ void xcd_barrier(const XcdBarrier& b) {
    asm volatile("s_waitcnt vmcnt(0)" ::: "memory");
    __syncthreads();
    if (threadIdx.x == 0) {
        unsigned* bar = b.bar;
        __builtin_amdgcn_s_waitcnt(0);
        unsigned nloc = b.st[0], nx = b.st[1]; const unsigned bx = b.st[2];
        if (nloc == 0u) { xcd_barrier_complete(bar, bx, nloc, nx); b.st[0] = nloc; b.st[1] = nx; b.st[3] = xcd_census_even(bar); }
        const unsigned old = xb_add(&bar[XB_XSUB(bx)], 1u);
        const unsigned gen = old / nloc;
        if (old + 1u == (gen + 1u) * nloc) {
            __builtin_amdgcn_fence(__ATOMIC_RELEASE, "agent");
            asm volatile("s_waitcnt vmcnt(0)" ::: "memory");
            const unsigned og = xb_add(&bar[XB_TOP], 1u);
            const unsigned tg = og / nx;
            if (og + 1u == (tg + 1u) * nx) xb_add(&bar[XB_TOPGEN], 1u);
            else XB_SPIN(xb_ld(&bar[XB_TOPGEN]) == tg, bar);
            __builtin_amdgcn_fence(__ATOMIC_ACQUIRE, "agent");
            xb_add(&bar[XB_XGEN(bx)], 1u);
            asm volatile("s_waitcnt vmcnt(0)" ::: "memory");
        } else {
            XB_SPIN(xb_ld(&bar[XB_XGEN(bx)]) == gen, bar);
            __builtin_amdgcn_fence(__ATOMIC_ACQUIRE, "agent");
            asm volatile("s_waitcnt vmcnt(0)" ::: "memory");
        }
    }
    __syncthreads();
}

__device__ __forceinline__ void xcc_barrier(const XcdBarrier& b) {
    asm volatile("s_waitcnt vmcnt(0)" ::: "memory");
    __syncthreads();
    if (threadIdx.x == 0) {
        unsigned* bar = b.bar;
        __builtin_amdgcn_s_waitcnt(0);
        const unsigned nloc = b.st[0], bx = b.st[2];
        const unsigned old = xb_add(&bar[XB_LSUB(bx)], 1u);
        const unsigned gen = old / nloc;
        if (old + 1u == (gen + 1u) * nloc) xb_add(&bar[XB_LGEN(bx)], 1u);
        else XB_SPIN(xb_ld(&bar[XB_LGEN(bx)]) == gen, bar);
        __builtin_amdgcn_fence(__ATOMIC_ACQUIRE, "agent");
        asm volatile("s_waitcnt vmcnt(0)" ::: "memory");
    }
    __syncthreads();
}

constexpr int LDS_BYTES = 160 * 1024 - 1024;
constexpr int MISC_OFF = LDS_BYTES - 256;
constexpr int PTAB_OFF = LDS_BYTES - 1024;

struct Args { const float* in[N_IN]; float* out; unsigned char* ws; };

struct Frame {
    LAS unsigned char* lds;
    int tid, lane, wave, vcu, G, cid, even;
};
__device__ __forceinline__ Frame refresh(const Frame& F0) {
    Frame F = F0; int t = F0.tid; asm volatile("" : "+v"(t)); F.tid = t; F.lane = t & 63; F.wave = __builtin_amdgcn_readfirstlane(t >> 6); return F;
}
__device__ __forceinline__ const float* inp(const Frame& F, int i) {
    const LAS unsigned* p = (const LAS unsigned*)(F.lds + PTAB_OFF) + 2 * i;
    const unsigned lo = __builtin_amdgcn_readfirstlane(p[0]), hi = __builtin_amdgcn_readfirstlane(p[1]);
    return (const float*)(const GAS float*)(((unsigned long long)hi << 32) | lo);
}

namespace pg8 {
#define PG8_LAS __attribute__((address_space(3)))
typedef unsigned short bf16_t;
typedef short bf16x8 __attribute__((ext_vector_type(8)));
typedef float f32x4 __attribute__((ext_vector_type(4)));
typedef unsigned u32x4 __attribute__((ext_vector_type(4)));
constexpr int BM = 256, BK = 64, HALF = 128, HTB = HALF * BK * 2  , STAGE_BYTES = 8 * HTB, NXCD = 8, WGM = 8;

__host__ __device__ __forceinline__ int lds_byte(int r, int c) { const int st = (r >> 4) * 2 + (c >> 5), rr = r & 15, cc = c & 31, ob = rr * 64 + cc * 2; return st * 1024 + (ob ^ (((ob >> 9) & 1) << 5)); }
__host__ __device__ __forceinline__ void stage_rc(int b, int& R, int& C) { const int st = b / 1024, sb = b % 1024, swz = sb ^ (((sb >> 9) & 1) << 5); R = (st >> 1) * 16 + swz / 64; C = (st & 1) * 32 + (swz % 64) / 2; }
__host__ __device__ __forceinline__ int perm32(int rho) { const int n = rho >> 4, i = rho & 15; return 8 * (i >> 2) + 4 * n + (i & 3); }

struct Unit { int pm, pn, e, mt, cnt, pl, k, slot; };
struct Gemm { const bf16_t* A; const bf16_t* Bt; int M, N, K; };

struct StaticOrder {
    int nM, nN, nwg, G, c;
    __host__ __device__ __forceinline__ void init(int M, int N, int G_, int c_) { nM = M / BM; nN = N / BM; nwg = nM * nN; G = G_; c = c_; }
    __host__ __device__ __forceinline__ bool next(int i, Unit& u) const {
        const long L = (long)i * G + c; if (L >= nwg) return false;
        int wgid = (int)L; { const int q = nwg / NXCD, r = nwg % NXCD, xcd = wgid % NXCD, off = wgid / NXCD; wgid = (xcd < r ? xcd * (q + 1) : r * (q + 1) + (xcd - r) * q) + off; }
        const int nig = WGM * nN, gid = wgid / nig, fm = gid * WGM, gsz = (nM - fm) < WGM ? (nM - fm) : WGM;
        u.pm = fm + ((wgid % nig) % gsz); u.pn = (wgid % nig) / gsz; u.slot = i; return true;
    }
    __device__ __forceinline__ void a_ready(const Unit&) const {}
    __device__ __forceinline__ void done(const Unit&) const {}
};
typedef float f32x2_t __attribute__((ext_vector_type(2))); typedef __bf16 bf16x2_t __attribute__((ext_vector_type(2)));
__device__ __forceinline__ unsigned cvt_pk_bf16(float lo, float hi) { f32x2_t v = {lo, hi}; bf16x2_t b = __builtin_convertvector(v, bf16x2_t); return __builtin_bit_cast(unsigned, b); }

__device__ __forceinline__ float rowscale16(const float* part, int row) {
    const f32x4* p = (const f32x4*)(part + (size_t)row * 16); float s = 0.f;
#pragma unroll
    for (int i = 0; i < 4; ++i) { const f32x4 v = p[i]; s += v[0]; s += v[1]; s += v[2]; s += v[3]; }
    return rsqrtf(s * (1.f / 1024.f) + EPS);
}
__device__ __forceinline__ u32x4 pack8(f32x4 a, f32x4 b) { u32x4 w; w.x = cvt_pk_bf16(a[0], a[1]); w.y = cvt_pk_bf16(a[2], a[3]); w.z = cvt_pk_bf16(b[0], b[1]); w.w = cvt_pk_bf16(b[2], b[3]); return w; }
__device__ __forceinline__ void unpack8(u32x4 w, f32x4& a, f32x4& b) {
    a = (f32x4){__builtin_bit_cast(float, w.x << 16), __builtin_bit_cast(float, w.x & 0xffff0000u), __builtin_bit_cast(float, w.y << 16), __builtin_bit_cast(float, w.y & 0xffff0000u)};
    b = (f32x4){__builtin_bit_cast(float, w.z << 16), __builtin_bit_cast(float, w.z & 0xffff0000u), __builtin_bit_cast(float, w.w << 16), __builtin_bit_cast(float, w.w & 0xffff0000u)};
}
__device__ __forceinline__ float sig1(float x) { return __builtin_amdgcn_rcpf(1.f + __builtin_amdgcn_exp2f(-1.4426950408889634f * x)); }
__device__ __forceinline__ f32x4 sig4(f32x4 x) { return (f32x4){sig1(x[0]), sig1(x[1]), sig1(x[2]), sig1(x[3])}; }
__device__ __forceinline__ float dot4(f32x4 x) { return (x[0] * x[0] + x[1] * x[1]) + (x[2] * x[2] + x[3] * x[3]); }

#define PG8_TOKOFF_OFF 131072
#define PG8_ROWINFO_OFF 135168
#define PG8_RS_OFF 144384
struct EpiWinF {
    static constexpr bool PERM = false, AFTER_DRAIN = false;
    PG8_LAS const unsigned char* lds; bf16_t *q, *k, *v, *u, *gates; const float *qg, *kg, *bgate;
    __device__ __forceinline__ void operator()(const f32x4 (&acc)[2][2][4][2], const Unit& un, int wr, int wc, int, int) const {
        int l_ = threadIdx.x; asm volatile("" : "+v"(l_)); const int fr = l_ & 15, fq = (l_ >> 4) & 3;
        const int pn = un.pn, rl0 = wr * 64 + fr; const size_t row0 = (size_t)un.pm * BM + rl0;
        PG8_LAS const float* rsl = (PG8_LAS const float*)(lds + PG8_RS_OFF) + un.slot * 256 + rl0;
        if (pn < 8) {
            const bool isq = pn < 4; bf16_t* dst = isq ? q : k; const int cb = (pn & 3) * 256 + wc * 64 + fq * 8;
            const float* gn = (isq ? qg : kg) + (wc & 1) * 64 + fq * 8; const float sc = isq ? C2 : 1.f;
            f32x4 gv[2][2];
#pragma unroll
            for (int bj = 0; bj < 2; ++bj)
#pragma unroll
                for (int n = 0; n < 2; ++n) gv[bj][n] = *(const f32x4*)(gn + bj * 32 + n * 4) * sc;
#pragma unroll
            for (int ai = 0; ai < 2; ++ai)
#pragma unroll
                for (int m = 0; m < 4; ++m) {
                    const float rs = rsl[ai * HALF + m * 16];
                    float ss = (dot4(acc[ai][0][m][0]) + dot4(acc[ai][0][m][1])) + (dot4(acc[ai][1][m][0]) + dot4(acc[ai][1][m][1]));
                    ss += __shfl_xor(ss, 16); ss += __shfl_xor(ss, 32);
                    const float inv = rsqrtf(ss * rs * rs * (1.f / 64.f) + EPS) * rs;
                    bf16_t* rowp = dst + (row0 + ai * HALF + m * 16) * 1024 + cb;
#pragma unroll
                    for (int bj = 0; bj < 2; ++bj) *(u32x4*)(rowp + bj * 32) = pack8(acc[ai][bj][m][0] * inv * gv[bj][0], acc[ai][bj][m][1] * inv * gv[bj][1]);
                }
        } else if (pn < 14) {
            bf16_t* dst; int ld, cb;
            if (pn < 12) { dst = v; ld = 1024; cb = (pn - 8) * 256; } else { dst = u; ld = 512; cb = (pn - 12) * 256; }
            cb += wc * 64 + fq * 8;
#pragma unroll
            for (int ai = 0; ai < 2; ++ai)
#pragma unroll
                for (int m = 0; m < 4; ++m) {
                    const float rs = rsl[ai * HALF + m * 16];
                    bf16_t* rowp = dst + (row0 + ai * HALF + m * 16) * ld + cb;
#pragma unroll
                    for (int bj = 0; bj < 2; ++bj) *(u32x4*)(rowp + bj * 32) = pack8(acc[ai][bj][m][0] * rs, acc[ai][bj][m][1] * rs);
                }
        } else {
            const int cb = (pn - 14) * 256 + wc * 64 + fq * 8;
            f32x4 bv[2][2];
#pragma unroll
            for (int bj = 0; bj < 2; ++bj)
#pragma unroll
                for (int n = 0; n < 2; ++n) bv[bj][n] = *(const f32x4*)(bgate + cb + bj * 32 + n * 4);
#pragma unroll
            for (int ai = 0; ai < 2; ++ai)
#pragma unroll
                for (int m = 0; m < 4; ++m) {
                    const float rs = rsl[ai * HALF + m * 16];
                    bf16_t* rowp = gates + (row0 + ai * HALF + m * 16) * 2048 + cb;
#pragma unroll
                    for (int bj = 0; bj < 2; ++bj) *(u32x4*)(rowp + bj * 32) = pack8(sig4(acc[ai][bj][m][0] * rs + bv[bj][0]), sig4(acc[ai][bj][m][1] * rs + bv[bj][1]));
                }
        }
    }
};
struct EpiGluF {
    static constexpr bool PERM = false, AFTER_DRAIN = false;
    const bf16_t* z; bf16_t* z2; const float* b;
    __device__ __forceinline__ void operator()(const f32x4 (&acc)[2][2][4][2], const Unit& un, int wr, int wc, int, int) const {
        int l_ = threadIdx.x; asm volatile("" : "+v"(l_)); const int fr = l_ & 15, fq = (l_ >> 4) & 3;
        const int cb = un.pn * 256 + wc * 64 + fq * 8; const size_t row0 = (size_t)un.pm * BM + wr * 64 + fr;
        f32x4 bv[2][2];
#pragma unroll
        for (int bj = 0; bj < 2; ++bj)
#pragma unroll
            for (int n = 0; n < 2; ++n) bv[bj][n] = *(const f32x4*)(b + cb + bj * 32 + n * 4);
#pragma unroll
        for (int ai = 0; ai < 2; ++ai) {
            u32x4 zw[4][2];
#pragma unroll
            for (int m = 0; m < 4; ++m)
#pragma unroll
                for (int bj = 0; bj < 2; ++bj) zw[m][bj] = *(const u32x4*)(z + (row0 + ai * HALF + m * 16) * 512 + cb + bj * 32);
#pragma unroll
            for (int m = 0; m < 4; ++m)
#pragma unroll
                for (int bj = 0; bj < 2; ++bj) { f32x4 z0, z1; unpack8(zw[m][bj], z0, z1);
                    *(u32x4*)(z2 + (row0 + ai * HALF + m * 16) * 512 + cb + bj * 32) = pack8(z0 * sig4(acc[ai][bj][m][0] + bv[bj][0]), z1 * sig4(acc[ai][bj][m][1] + bv[bj][1])); }
        }
    }
};
struct EpiPlainF {
    static constexpr bool PERM = false, AFTER_DRAIN = false;
    bf16_t* o; int ld;
    __device__ __forceinline__ void operator()(const f32x4 (&acc)[2][2][4][2], const Unit& un, int wr, int wc, int, int) const {
        int l_ = threadIdx.x; asm volatile("" : "+v"(l_)); const int fr = l_ & 15, fq = (l_ >> 4) & 3;
        const int row0 = un.pm * BM + wr * 64 + fr, cb = un.pn * 256 + wc * 64 + fq * 8;
#pragma unroll
        for (int ai = 0; ai < 2; ++ai)
#pragma unroll
            for (int m = 0; m < 4; ++m) {
                const int row = row0 + ai * HALF + m * 16;
#pragma unroll
                for (int bj = 0; bj < 2; ++bj) *(u32x4*)(o + (size_t)row * ld + cb + bj * 32) = pack8(acc[ai][bj][m][0], acc[ai][bj][m][1]);
            }
    }
};
struct EpiGateF {
    static constexpr bool PERM = false, AFTER_DRAIN = false;
    const bf16_t* gates; int goff; const bf16_t* add; bf16_t* o;
    __device__ __forceinline__ void operator()(const f32x4 (&acc)[2][2][4][2], const Unit& un, int wr, int wc, int, int) const {
        int l_ = threadIdx.x; asm volatile("" : "+v"(l_)); const int fr = l_ & 15, fq = (l_ >> 4) & 3;
        const int cb = un.pn * 256 + wc * 64 + fq * 8; const size_t row0 = (size_t)un.pm * BM + wr * 64 + fr;
#pragma unroll
        for (int ai = 0; ai < 2; ++ai) {
            u32x4 gw[4][2], aw[4][2];
#pragma unroll
            for (int m = 0; m < 4; ++m)
#pragma unroll
                for (int bj = 0; bj < 2; ++bj) { const size_t row = row0 + ai * HALF + m * 16; const int c = cb + bj * 32;
                    gw[m][bj] = *(const u32x4*)(gates + row * 2048 + goff + c); if (add) aw[m][bj] = *(const u32x4*)(add + row * 1024 + c); }
#pragma unroll
            for (int m = 0; m < 4; ++m)
#pragma unroll
                for (int bj = 0; bj < 2; ++bj) { const size_t row = row0 + ai * HALF + m * 16; const int c = cb + bj * 32; f32x4 g0, g1; unpack8(gw[m][bj], g0, g1);
                    f32x4 v0 = g0 * acc[ai][bj][m][0], v1 = g1 * acc[ai][bj][m][1];
                    if (add) { f32x4 a0, a1; unpack8(aw[m][bj], a0, a1); v0 += a0; v1 += a1; }
                    *(u32x4*)(o + row * 1024 + c) = pack8(v0, v1); }
        }
    }
};
struct EpiResF {
    static constexpr bool PERM = false, AFTER_DRAIN = false;
    const float* base; float* out; bf16_t* xb; float* part;
    __device__ __forceinline__ void operator()(const f32x4 (&acc)[2][2][4][2], const Unit& un, int wr, int wc, int, int) const {
        int l_ = threadIdx.x; asm volatile("" : "+v"(l_)); const int fr = l_ & 15, fq = (l_ >> 4) & 3;
        const int cb = un.pn * 256 + wc * 64 + fq * 8; const size_t row0 = (size_t)un.pm * BM + wr * 64 + fr;
#pragma unroll
        for (int ai = 0; ai < 2; ++ai) {
            f32x4 bl[4][2][2];
#pragma unroll
            for (int m = 0; m < 4; ++m)
#pragma unroll
                for (int bj = 0; bj < 2; ++bj) { const size_t o = (row0 + ai * HALF + m * 16) * 1024 + cb + bj * 32; bl[m][bj][0] = *(const f32x4*)(base + o); bl[m][bj][1] = *(const f32x4*)(base + o + 4); }
#pragma unroll
            for (int m = 0; m < 4; ++m) {
                const size_t row = row0 + ai * HALF + m * 16; float ss = 0.f;
#pragma unroll
                for (int bj = 0; bj < 2; ++bj) { const size_t o = row * 1024 + cb + bj * 32;
                    const f32x4 v0 = bl[m][bj][0] + acc[ai][bj][m][0], v1 = bl[m][bj][1] + acc[ai][bj][m][1];
                    *(f32x4*)(out + o) = v0; *(f32x4*)(out + o + 4) = v1; *(u32x4*)(xb + o) = pack8(v0, v1); ss += dot4(v0) + dot4(v1); }
                ss += __shfl_xor(ss, 16); ss += __shfl_xor(ss, 32);
                if (fq == 0) part[row * 16 + un.pn * 4 + wc] = ss;
            }
        }
    }
};
struct EpiPleF {
    static constexpr bool PERM = false, AFTER_DRAIN = false;
    PG8_LAS const unsigned char* lds; const bf16_t* ple; float* out; bf16_t* xb; float* part_out;
    __device__ __forceinline__ void operator()(const f32x4 (&acc)[2][2][4][2], const Unit& un, int wr, int wc, int, int) const {
        int l_ = threadIdx.x; asm volatile("" : "+v"(l_)); const int fr = l_ & 15, fq = (l_ >> 4) & 3;
        const int cb = un.pn * 256 + wc * 64 + fq * 8, rl0 = wr * 64 + fr; const size_t row0 = (size_t)un.pm * BM + rl0;
        PG8_LAS const float* rsl = (PG8_LAS const float*)(lds + PG8_RS_OFF) + un.slot * 256 + rl0;
#pragma unroll
        for (int ai = 0; ai < 2; ++ai)
#pragma unroll
            for (int mp = 0; mp < 2; ++mp) {
                u32x4 pw[2][2]; f32x4 xl[2][2][2];
#pragma unroll
                for (int mm = 0; mm < 2; ++mm)
#pragma unroll
                    for (int bj = 0; bj < 2; ++bj) { const size_t o = (row0 + ai * HALF + (2 * mp + mm) * 16) * 1024 + cb + bj * 32; pw[mm][bj] = *(const u32x4*)(ple + 2 * o - (cb + bj * 32)); xl[mm][bj][0] = *(const f32x4*)(out + o); xl[mm][bj][1] = *(const f32x4*)(out + o + 4); }
#pragma unroll
                for (int mm = 0; mm < 2; ++mm) {
                    const int m = 2 * mp + mm; const size_t row = row0 + ai * HALF + m * 16; const float rs = rsl[ai * HALF + m * 16]; float ss = 0.f;
#pragma unroll
                    for (int bj = 0; bj < 2; ++bj) { const size_t o = row * 1024 + cb + bj * 32; f32x4 p0, p1; unpack8(pw[mm][bj], p0, p1);
                        const f32x4 v0 = xl[mm][bj][0] + sig4(acc[ai][bj][m][0] * rs) * p0, v1 = xl[mm][bj][1] + sig4(acc[ai][bj][m][1] * rs) * p1;
                        *(f32x4*)(out + o) = v0; *(f32x4*)(out + o + 4) = v1; *(u32x4*)(xb + o) = pack8(v0, v1); ss += dot4(v0) + dot4(v1); }
                    ss += __shfl_xor(ss, 16); ss += __shfl_xor(ss, 32);
                    if (fq == 0) part_out[row * 16 + un.pn * 4 + wc] = ss;
                }
            }
    }
};
template <class Epi, class Sched, bool ALIGN_EPI = false, bool SP2 = false>
__device__ __forceinline__ void gemm_phase(PG8_LAS unsigned char* lds, const Gemm g, const Sched& S, const Epi& E) {
    int tid_ = threadIdx.x; asm volatile("" : "+v"(tid_)); const int tid = tid_, wid = __builtin_amdgcn_readfirstlane(tid >> 6), lane = tid & 63, wr = wid >> 2, wc = wid & 3, fr = lane & 15, fq = lane >> 4;
    const int K = g.K, nt = K / BK;
    unsigned voffA[2], voffB[2];
#pragma unroll
    for (int i = 0; i < 2; ++i) { int R, C; stage_rc(tid * 16 + i * 8192, R, C); const int Rb = Epi::PERM ? ((R & ~31) + perm32(R & 31)) : R;
        voffA[i] = (unsigned)(R * K + C) * 2u; voffB[i] = (unsigned)(Rb * K + C) * 2u; }
    const size_t kstep = (size_t)(BK * 2);
    const size_t hstep = (size_t)HALF * K * 2;
    const size_t tstep = 2 * hstep;
    const unsigned ldsw = (unsigned)wid * 1024u;
    const int aoff = lds_byte(wr * 64 + fr, fq * 8), boff = lds_byte(wc * 32 + fr, fq * 8);
#define PG8_SA(b, h) (((b) * 2 + (h)) * HTB)
#define PG8_SB(b, h) ((4 + (b) * 2 + (h)) * HTB)
#define PG8_STAGE(bufoff, gbase, voff) do { _Pragma("unroll") for (int _i = 0; _i < 2; ++_i) \
        __builtin_amdgcn_global_load_lds((const unsigned*)((const char*)(gbase) + (voff)[_i]), (PG8_LAS unsigned*)(lds + (bufoff) + ldsw + _i * 8192), 16, 0, 0); } while (0)
#define PG8_LDA(dst, b, h) do { _Pragma("unroll") for (int m = 0; m < 4; ++m) _Pragma("unroll") for (int k = 0; k < 2; ++k) dst[m][k] = *(const PG8_LAS bf16x8*)(lds + PG8_SA(b, h) + aoff + m * 2048 + k * 1024); } while (0)
#define PG8_LDB(dst, b, h) do { _Pragma("unroll") for (int n = 0; n < 2; ++n) _Pragma("unroll") for (int k = 0; k < 2; ++k) dst[n][k] = *(const PG8_LAS bf16x8*)(lds + PG8_SB(b, h) + boff + n * 2048 + k * 1024); } while (0)
#define PG8_MMA(ai, bj, At, Bt) do { __builtin_amdgcn_s_setprio(1); _Pragma("unroll") for (int m = 0; m < 4; ++m) _Pragma("unroll") for (int n = 0; n < 2; ++n) _Pragma("unroll") for (int k = 0; k < 2; ++k) \
        acc[ai][bj][m][n] = __builtin_amdgcn_mfma_f32_16x16x32_bf16(Bt[n][k], At[m][k], acc[ai][bj][m][n], 0, 0, 0); __builtin_amdgcn_s_setprio(0); } while (0)
#define PG8_WAIT_V(n) asm volatile("s_waitcnt vmcnt(" #n ")" ::: "memory")
#define PG8_WAIT_L(n) asm volatile("s_waitcnt lgkmcnt(" #n ")" ::: "memory")
#define PG8_BAR __builtin_amdgcn_s_barrier()
#define PG8_SCHED __builtin_amdgcn_sched_barrier(0)
    Unit cur, nxt; int ui = 0;
    if (!S.next(0, cur)) return;
    f32x4 acc[2][2][4][2];
#pragma unroll
    for (int a = 0; a < 2; ++a)
#pragma unroll
        for (int b = 0; b < 2; ++b)
#pragma unroll
            for (int m = 0; m < 4; ++m)
#pragma unroll
                for (int n = 0; n < 2; ++n) acc[a][b][m][n] = (f32x4){0.f, 0.f, 0.f, 0.f};
    bf16x8 At[4][2], B0[2][2], B1[2][2];
    const char* cA = (const char*)g.A + (size_t)cur.pm * tstep; const char* cB = (const char*)g.Bt + (size_t)cur.pn * tstep;
    S.a_ready(cur);
    if constexpr (SP2) {
        PG8_STAGE(PG8_SB(0, 0), cB, voffB); PG8_STAGE(PG8_SB(0, 1), cB + hstep, voffB); PG8_STAGE(PG8_SA(0, 0), cA, voffA); PG8_STAGE(PG8_SA(0, 1), cA + hstep, voffA);
        if (wr == 1) PG8_BAR;
        PG8_WAIT_V(2); PG8_BAR;
        PG8_STAGE(PG8_SB(1, 0), cB + kstep, voffB); PG8_STAGE(PG8_SA(1, 0), cA + kstep, voffA); PG8_STAGE(PG8_SB(1, 1), cB + hstep + kstep, voffB);
        PG8_WAIT_V(6); PG8_BAR;
    } else {
        PG8_STAGE(PG8_SB(0, 0), cB, voffB); PG8_STAGE(PG8_SA(0, 0), cA, voffA); PG8_STAGE(PG8_SB(0, 1), cB + hstep, voffB); PG8_STAGE(PG8_SA(0, 1), cA + hstep, voffA);
        if (wr == 1) PG8_BAR;
        PG8_WAIT_V(4); PG8_BAR;
        PG8_STAGE(PG8_SB(1, 0), cB + kstep, voffB); PG8_STAGE(PG8_SA(1, 0), cA + kstep, voffA); PG8_STAGE(PG8_SB(1, 1), cB + hstep + kstep, voffB);
        PG8_WAIT_V(6); PG8_BAR;
    }
    for (;;) {
        const bool has_next = S.next(ui + 1, nxt);
        const char* nA = has_next ? (const char*)g.A + (size_t)nxt.pm * tstep : cA; const char* nB = has_next ? (const char*)g.Bt + (size_t)nxt.pn * tstep : cB;
#pragma unroll 1
        for (int t = 0; t < nt; t += 2) {
            const bool last = (t == nt - 2);
            const char* a1 = cA + (size_t)(t + 1) * kstep;
            const char* a2 = last ? nA : cA + (size_t)(t + 2) * kstep; const char* b2 = last ? nB : cB + (size_t)(t + 2) * kstep;
            const char* a3 = a2 + kstep; const char* b3 = b2 + kstep;
            if (last && has_next) S.a_ready(nxt);
            if constexpr (SP2) {
            PG8_LDB(B0, 0, 0); PG8_LDB(B1, 0, 1); PG8_SCHED; PG8_LDA(At, 0, 0); PG8_STAGE(PG8_SA(1, 1), a1 + hstep, voffA);
            PG8_WAIT_V(8); PG8_WAIT_L(0); PG8_BAR; PG8_MMA(0, 0, At, B0); PG8_MMA(0, 1, At, B1); PG8_BAR; PG8_SCHED;
            PG8_LDA(At, 0, 1); PG8_STAGE(PG8_SB(0, 0), b2, voffB); PG8_STAGE(PG8_SB(0, 1), b2 + hstep, voffB); PG8_STAGE(PG8_SA(0, 0), a2, voffA);
            PG8_WAIT_V(8); PG8_WAIT_L(0); PG8_BAR; PG8_MMA(1, 0, At, B0); PG8_MMA(1, 1, At, B1); PG8_BAR; PG8_SCHED;
            PG8_LDB(B0, 1, 0); PG8_LDB(B1, 1, 1); PG8_SCHED; PG8_LDA(At, 1, 0); PG8_STAGE(PG8_SA(0, 1), a2 + hstep, voffA);
            PG8_WAIT_V(8); PG8_WAIT_L(0); PG8_BAR; PG8_MMA(0, 0, At, B0); PG8_MMA(0, 1, At, B1); PG8_BAR; PG8_SCHED;
            PG8_LDA(At, 1, 1); PG8_STAGE(PG8_SB(1, 0), b3, voffB); PG8_STAGE(PG8_SB(1, 1), b3 + hstep, voffB); PG8_STAGE(PG8_SA(1, 0), a3, voffA);
            PG8_WAIT_V(8); PG8_WAIT_L(0); PG8_BAR; PG8_MMA(1, 0, At, B0); PG8_MMA(1, 1, At, B1); PG8_BAR; PG8_SCHED;
            } else {
            PG8_LDB(B0, 0, 0); PG8_SCHED; PG8_LDA(At, 0, 0); PG8_STAGE(PG8_SA(1, 1), a1 + hstep, voffA);
            PG8_WAIT_L(8); PG8_BAR; PG8_WAIT_L(0); PG8_MMA(0, 0, At, B0); PG8_BAR; PG8_SCHED;
            PG8_LDB(B1, 0, 1); PG8_STAGE(PG8_SB(0, 0), b2, voffB);
            PG8_BAR; PG8_WAIT_L(0); PG8_MMA(0, 1, At, B1); PG8_BAR;
            PG8_LDA(At, 0, 1); PG8_STAGE(PG8_SA(0, 0), a2, voffA);
            PG8_BAR; PG8_WAIT_L(0); PG8_MMA(1, 0, At, B0); PG8_BAR; PG8_SCHED;
            PG8_STAGE(PG8_SB(0, 1), b2 + hstep, voffB);
            PG8_WAIT_V(6); PG8_BAR; PG8_MMA(1, 1, At, B1); PG8_BAR;
            PG8_LDB(B0, 1, 0); PG8_SCHED; PG8_LDA(At, 1, 0); PG8_STAGE(PG8_SA(0, 1), a2 + hstep, voffA);
            PG8_WAIT_L(8); PG8_BAR; PG8_WAIT_L(0); PG8_MMA(0, 0, At, B0); PG8_BAR; PG8_SCHED;
            PG8_LDB(B1, 1, 1); PG8_STAGE(PG8_SB(1, 0), b3, voffB);
            PG8_BAR; PG8_WAIT_L(0); PG8_MMA(0, 1, At, B1); PG8_BAR;
            PG8_LDA(At, 1, 1); PG8_STAGE(PG8_SA(1, 0), a3, voffA);
            PG8_BAR; PG8_WAIT_L(0); PG8_MMA(1, 0, At, B0); PG8_BAR; PG8_SCHED;
            PG8_STAGE(PG8_SB(1, 1), b3 + hstep, voffB);
            PG8_WAIT_V(6); PG8_BAR; PG8_MMA(1, 1, At, B1); PG8_BAR;
            }
        }
        if constexpr (ALIGN_EPI) { if (wr == 0) PG8_BAR; }
        if constexpr (!Epi::AFTER_DRAIN) { E(acc, cur, wr, wc, fr, fq); S.done(cur); }
        if (!has_next) break;
#pragma unroll
        for (int a = 0; a < 2; ++a)
#pragma unroll
            for (int b = 0; b < 2; ++b)
#pragma unroll
                for (int m = 0; m < 4; ++m)
#pragma unroll
                    for (int n = 0; n < 2; ++n) acc[a][b][m][n] = (f32x4){0.f, 0.f, 0.f, 0.f};
        cur = nxt; cA = nA; cB = nB; ++ui;
        if constexpr (ALIGN_EPI) { if (wr == 1) PG8_BAR; }
    }
    PG8_WAIT_V(0);
    if constexpr (!ALIGN_EPI) { if (wr == 0) PG8_BAR; }
    PG8_BAR;
    if constexpr (Epi::AFTER_DRAIN) { E.fused(acc, cur, wr, wc, fr, fq, lds, wid, lane); S.done(cur); }
#undef PG8_SA
#undef PG8_SB
#undef PG8_STAGE
#undef PG8_LDA
#undef PG8_LDB
#undef PG8_MMA
#undef PG8_WAIT_V
#undef PG8_WAIT_L
#undef PG8_BAR
#undef PG8_SCHED
}

struct EpiActF {
    static constexpr bool PERM = false, AFTER_DRAIN = false;
    bf16_t* act; PG8_LAS const unsigned char* lds;
    __device__ __forceinline__ void operator()(const f32x4 (&acc)[2][2][4][2], const Unit& un, int wr, int wc, int, int) const {
        int l_ = threadIdx.x; asm volatile("" : "+v"(l_)); const int fr = l_ & 15, fq = (l_ >> 4) & 3;
        typedef float f32x2v __attribute__((ext_vector_type(2)));
        PG8_LAS const f32x2v* ri = (PG8_LAS const f32x2v*)(lds + PG8_ROWINFO_OFF) + un.slot * 256;
#pragma unroll
        for (int ai = 0; ai < 2; ++ai)
#pragma unroll
            for (int m = 0; m < 4; ++m) {
                const int r = ai * HALF + wr * 64 + m * 16 + fr; const f32x2v wi = ri[r]; const float w = wi.x, rs = wi.y;
                f32x4 a[2];
#pragma unroll
                for (int n = 0; n < 2; ++n) { const f32x4 g = acc[ai][0][m][n] * rs, u = acc[ai][1][m][n] * rs; a[n] = g * sig4(g) * u * w; }
                *(u32x4*)(act + ((size_t)un.pm * 256 + r) * 256 + un.pl * 128 + wc * 32 + fq * 8) = pack8(a[0], a[1]);
            }
    }
};
template <int KK> struct EpiDownF {
    static constexpr bool PERM = false, AFTER_DRAIN = false;
    PG8_LAS const unsigned char* lds; float* out; bf16_t* xb; float* part;
    __device__ __forceinline__ void operator()(const f32x4 (&acc)[2][2][4][2], const Unit& un, int wr, int wc, int, int) const {
        int l_ = threadIdx.x; asm volatile("" : "+v"(l_)); const int fr = l_ & 15, fq = (l_ >> 4) & 3;
        const int cb = un.pl * 256 + wc * 64 + fq * 8;
        PG8_LAS const int* tk = (PG8_LAS const int*)(lds + PG8_TOKOFF_OFF) + un.slot * 256 + wr * 64 + fr;
#pragma unroll
        for (int ai = 0; ai < 2; ++ai) {
            int tok[4]; f32x4 bl[4][2][2];
#pragma unroll
            for (int m = 0; m < 4; ++m) { tok[m] = tk[ai * HALF + m * 16]; const size_t rb = (size_t)(tok[m] < 0 ? 0 : tok[m]) * 1024 + cb;
#pragma unroll
                for (int bj = 0; bj < 2; ++bj) { bl[m][bj][0] = *(const f32x4*)(out + rb + bj * 32); bl[m][bj][1] = *(const f32x4*)(out + rb + bj * 32 + 4); } }
#pragma unroll
            for (int m = 0; m < 4; ++m) {
                const bool valid = tok[m] >= 0; const size_t rb = (size_t)(valid ? tok[m] : 0) * 1024 + cb; float ss = 0.f;
#pragma unroll
                for (int bj = 0; bj < 2; ++bj) { const size_t o = rb + bj * 32;
                    const f32x4 v0 = bl[m][bj][0] + acc[ai][bj][m][0], v1 = bl[m][bj][1] + acc[ai][bj][m][1];
                    if (valid) { *(f32x4*)(out + o) = v0; *(f32x4*)(out + o + 4) = v1; if (KK) *(u32x4*)(xb + o) = pack8(v0, v1); }
                    ss += dot4(v0) + dot4(v1); }
                if (KK) { ss += __shfl_xor(ss, 16); ss += __shfl_xor(ss, 32); if (valid && fq == 0) part[(size_t)tok[m] * 16 + un.pl * 4 + wc] = ss; }
            }
        }
    }
};
struct EpiDownStoreF {
    static constexpr bool PERM = false, AFTER_DRAIN = false;
    PG8_LAS const unsigned char* lds; bf16_t* d; size_t kstride;
    __device__ __forceinline__ void operator()(const f32x4 (&acc)[2][2][4][2], const Unit& un, int wr, int wc, int, int) const {
        int l_ = threadIdx.x; asm volatile("" : "+v"(l_)); const int fr = l_ & 15, fq = (l_ >> 4) & 3;
        const int cb = un.pl * 256 + wc * 64 + fq * 8;
        PG8_LAS const int* tk = (PG8_LAS const int*)(lds + PG8_TOKOFF_OFF) + un.slot * 256 + wr * 64 + fr;
        bf16_t* dk = d + (size_t)un.k * kstride;
#pragma unroll
        for (int ai = 0; ai < 2; ++ai)
#pragma unroll
            for (int m = 0; m < 4; ++m) {
                const int tok = tk[ai * HALF + m * 16];
                if (tok >= 0) {
#pragma unroll
                    for (int bj = 0; bj < 2; ++bj) *(u32x4*)(dk + (size_t)tok * 1024 + cb + bj * 32) = pack8(acc[ai][bj][m][0], acc[ai][bj][m][1]);
                }
            }
    }
};
__device__ __forceinline__ int ldsu(PG8_LAS const int* p) { return __builtin_amdgcn_readfirstlane(*p); }
struct MoeSched {
    PG8_LAS const int* tb; PG8_LAS const int* tc; int G, c, mode;
    __device__ __forceinline__ bool next(int i, Unit& u) const {
        const int gi = i * G + c; int ti, pl;
        if (mode == 0) { ti = gi >> 1; pl = gi & 1; if (ti >= ldsu(tb + 64)) return false; }
        else if (mode == 3) { ti = gi >> 2; pl = gi & 3; if (ti >= ldsu(tb + 64)) return false; }
        else { ti = gi >> 2; pl = gi & 3; const int n0 = ldsu(tb + 32); if (mode == 2) { ti += n0; if (ti >= ldsu(tb + 64)) return false; } else if (ti >= n0) return false; }
        const int ke = ldsu(tb + 160 + ti);
        u.pm = ti; u.e = ke & 31; u.k = ke >> 5; u.mt = ti - ldsu(tb + ke); u.cnt = ldsu(tc + ke); u.pl = pl; u.slot = i; u.pn = (ke & 31) * (mode == 0 ? 2 : 4) + pl;
        return true;
    }
    __device__ __forceinline__ void a_ready(const Unit&) const {}
    __device__ __forceinline__ void done(const Unit&) const {}
};
template <class Epi, class Sched>
__device__ __forceinline__ void gemm_phase_g(PG8_LAS unsigned char* lds, const Gemm g, const Sched& S, const Epi& E) {
    int tid_ = threadIdx.x; asm volatile("" : "+v"(tid_)); const int tid = tid_, wid = __builtin_amdgcn_readfirstlane(tid >> 6), lane = tid & 63, wr = wid >> 2, wc = wid & 3, fr = lane & 15, fq = lane >> 4;
    const int K = g.K, nt = K / BK;
    unsigned voffB[2]; int RA[2]; unsigned CA2[2];
#pragma unroll
    for (int i = 0; i < 2; ++i) { int R, C; stage_rc(tid * 16 + i * 8192, R, C); voffB[i] = (unsigned)(R * K + C) * 2u; RA[i] = R; CA2[i] = (unsigned)C * 2u; }
    const size_t kstep = (size_t)(BK * 2), hstep = (size_t)HALF * K * 2, tstep = 2 * hstep;
    const unsigned ldsw = (unsigned)wid * 1024u;
    const int aoff = lds_byte(wr * 64 + fr, fq * 8), boff = lds_byte(wc * 32 + fr, fq * 8);
    PG8_LAS const unsigned* tokoff = (PG8_LAS const unsigned*)(lds + PG8_TOKOFF_OFF);
#define PG8_SA(b, h) (((b) * 2 + (h)) * HTB)
#define PG8_SB(b, h) ((4 + (b) * 2 + (h)) * HTB)
#define PG8_STAGE(bufoff, gbase, voff) do { _Pragma("unroll") for (int _i = 0; _i < 2; ++_i) \
        __builtin_amdgcn_global_load_lds((const unsigned*)((const char*)(gbase) + (voff)[_i]), (PG8_LAS unsigned*)(lds + (bufoff) + ldsw + _i * 8192), 16, 0, 0); } while (0)
#define PG8_STAGE_A(bufoff, gbase, o0, o1) do { \
        __builtin_amdgcn_global_load_lds((const unsigned*)((const char*)(gbase) + (o0)), (PG8_LAS unsigned*)(lds + (bufoff) + ldsw), 16, 0, 0); \
        __builtin_amdgcn_global_load_lds((const unsigned*)((const char*)(gbase) + (o1)), (PG8_LAS unsigned*)(lds + (bufoff) + ldsw + 8192), 16, 0, 0); } while (0)
#define PG8_GOFF(slot, d00, d01, d10, d11) do { PG8_LAS const unsigned* t_ = tokoff + (slot) * 256; \
        d00 = t_[RA[0]] + CA2[0]; d01 = t_[RA[1]] + CA2[1]; d10 = t_[128 + RA[0]] + CA2[0]; d11 = t_[128 + RA[1]] + CA2[1]; } while (0)
#define PG8_LDA(dst, b, h) do { _Pragma("unroll") for (int m = 0; m < 4; ++m) _Pragma("unroll") for (int k = 0; k < 2; ++k) dst[m][k] = *(const PG8_LAS bf16x8*)(lds + PG8_SA(b, h) + aoff + m * 2048 + k * 1024); } while (0)
#define PG8_LDB(dst, b, h) do { _Pragma("unroll") for (int n = 0; n < 2; ++n) _Pragma("unroll") for (int k = 0; k < 2; ++k) dst[n][k] = *(const PG8_LAS bf16x8*)(lds + PG8_SB(b, h) + boff + n * 2048 + k * 1024); } while (0)
#define PG8_MMA(ai, bj, At, Bt) do { __builtin_amdgcn_s_setprio(1); _Pragma("unroll") for (int m = 0; m < 4; ++m) _Pragma("unroll") for (int n = 0; n < 2; ++n) _Pragma("unroll") for (int k = 0; k < 2; ++k) \
        acc[ai][bj][m][n] = __builtin_amdgcn_mfma_f32_16x16x32_bf16(Bt[n][k], At[m][k], acc[ai][bj][m][n], 0, 0, 0); __builtin_amdgcn_s_setprio(0); } while (0)
#define PG8_WAIT_V(n) asm volatile("s_waitcnt vmcnt(" #n ")" ::: "memory")
#define PG8_WAIT_L(n) asm volatile("s_waitcnt lgkmcnt(" #n ")" ::: "memory")
#define PG8_BAR __builtin_amdgcn_s_barrier()
#define PG8_SCHED __builtin_amdgcn_sched_barrier(0)
    Unit cur, nxt; int ui = 0;
    if (!S.next(0, cur)) return;
    f32x4 acc[2][2][4][2];
#pragma unroll
    for (int a = 0; a < 2; ++a)
#pragma unroll
        for (int b = 0; b < 2; ++b)
#pragma unroll
            for (int m = 0; m < 4; ++m)
#pragma unroll
                for (int n = 0; n < 2; ++n) acc[a][b][m][n] = (f32x4){0.f, 0.f, 0.f, 0.f};
    bf16x8 At[4][2], B0[2][2], B1[2][2];
    unsigned gc00, gc01, gc10, gc11;
    PG8_GOFF(0, gc00, gc01, gc10, gc11);
    const char* A0 = (const char*)g.A; const char* cB = (const char*)g.Bt + (size_t)cur.pn * tstep;
    PG8_STAGE(PG8_SB(0, 0), cB, voffB); PG8_STAGE(PG8_SB(0, 1), cB + hstep, voffB); PG8_STAGE_A(PG8_SA(0, 0), A0, gc00, gc01); PG8_STAGE_A(PG8_SA(0, 1), A0, gc10, gc11);
    if (wr == 1) PG8_BAR;
    PG8_WAIT_V(2); PG8_BAR;
    PG8_STAGE(PG8_SB(1, 0), cB + kstep, voffB); PG8_STAGE_A(PG8_SA(1, 0), A0 + kstep, gc00, gc01); PG8_STAGE(PG8_SB(1, 1), cB + hstep + kstep, voffB);
    PG8_WAIT_V(6); PG8_BAR;
    for (;;) {
        const bool has_next = S.next(ui + 1, nxt);
        const char* nB = has_next ? (const char*)g.Bt + (size_t)nxt.pn * tstep : cB;
#pragma unroll 1
        for (int t = 0; t < nt; t += 2) {
            const bool last = (t == nt - 2);
            const char* a1 = A0 + (size_t)(t + 1) * kstep;
            const char* a2 = last ? A0 : A0 + (size_t)(t + 2) * kstep; const char* b2 = last ? nB : cB + (size_t)(t + 2) * kstep;
            const char* a3 = a2 + kstep; const char* b3 = b2 + kstep;
            unsigned g200 = gc00, g201 = gc01, g210 = gc10, g211 = gc11;
            if (last && has_next) { PG8_GOFF(ui + 1, g200, g201, g210, g211); }
            PG8_LDB(B0, 0, 0); PG8_LDB(B1, 0, 1); PG8_SCHED; PG8_LDA(At, 0, 0); PG8_STAGE_A(PG8_SA(1, 1), a1, gc10, gc11);
            PG8_WAIT_V(8); PG8_WAIT_L(0); PG8_BAR; PG8_MMA(0, 0, At, B0); PG8_MMA(0, 1, At, B1); PG8_BAR; PG8_SCHED;
            PG8_LDA(At, 0, 1); PG8_STAGE(PG8_SB(0, 0), b2, voffB); PG8_STAGE(PG8_SB(0, 1), b2 + hstep, voffB); PG8_STAGE_A(PG8_SA(0, 0), a2, g200, g201);
            PG8_WAIT_V(8); PG8_WAIT_L(0); PG8_BAR; PG8_MMA(1, 0, At, B0); PG8_MMA(1, 1, At, B1); PG8_BAR; PG8_SCHED;
            PG8_LDB(B0, 1, 0); PG8_LDB(B1, 1, 1); PG8_SCHED; PG8_LDA(At, 1, 0); PG8_STAGE_A(PG8_SA(0, 1), a2, g210, g211);
            PG8_WAIT_V(8); PG8_WAIT_L(0); PG8_BAR; PG8_MMA(0, 0, At, B0); PG8_MMA(0, 1, At, B1); PG8_BAR; PG8_SCHED;
            PG8_LDA(At, 1, 1); PG8_STAGE(PG8_SB(1, 0), b3, voffB); PG8_STAGE(PG8_SB(1, 1), b3 + hstep, voffB); PG8_STAGE_A(PG8_SA(1, 0), a3, g200, g201);
            PG8_WAIT_V(8); PG8_WAIT_L(0); PG8_BAR; PG8_MMA(1, 0, At, B0); PG8_MMA(1, 1, At, B1); PG8_BAR; PG8_SCHED;
        }
        if (wr == 0) PG8_BAR;
        E(acc, cur, wr, wc, fr, fq);
        if (!has_next) break;
#pragma unroll
        for (int a = 0; a < 2; ++a)
#pragma unroll
            for (int b = 0; b < 2; ++b)
#pragma unroll
                for (int m = 0; m < 4; ++m)
#pragma unroll
                    for (int n = 0; n < 2; ++n) acc[a][b][m][n] = (f32x4){0.f, 0.f, 0.f, 0.f};
        cur = nxt; cB = nB; ++ui; PG8_GOFF(ui, gc00, gc01, gc10, gc11);
        if (wr == 1) PG8_BAR;
    }
    PG8_WAIT_V(0);
    PG8_BAR;
#undef PG8_SA
#undef PG8_SB
#undef PG8_STAGE
#undef PG8_STAGE_A
#undef PG8_GOFF
#undef PG8_LDA
#undef PG8_LDB
#undef PG8_MMA
#undef PG8_WAIT_V
#undef PG8_WAIT_L
#undef PG8_BAR
#undef PG8_SCHED
}

}

__device__ __forceinline__ int p64_row(int c) { const int cl = c & 255; return (c & ~255) + 128 * ((cl >> 5) & 1) + 32 * (cl >> 6) + 16 * ((cl >> 2) & 1) + 4 * ((cl >> 3) & 3) + (cl & 3); }
__device__ __forceinline__ unsigned pk2(float lo, float hi) { return f2bf(lo) | (f2bf(hi) << 16); }
__device__ __forceinline__ int gu_row(int ff, int isup) { const int fl = ff & 127; return 256 * (ff >> 7) + 128 * isup + 32 * (fl >> 5) + 16 * ((fl >> 2) & 1) + 4 * ((fl >> 3) & 3) + (fl & 3); }
template <int MODE>
__device__ __forceinline__ void transpose_item(const float* W, int K, int N, bf16* WT, const float* gain, LAS float* scr, int item, int lane) {
    const int nblk = N / 32, kb = item / nblk, nb = item % nblk, k0 = 64 * kb, n0 = 32 * nb;
    const float* wp = W + (size_t)(k0 + (lane >> 5)) * N + n0 + (lane & 31);
    float wv[32];
#pragma unroll
    for (int i = 0; i < 32; ++i) wv[i] = wp[(size_t)(2 * i) * N];
    const int c = lane & 7;
    f32x4 g0 = {1.f, 1.f, 1.f, 1.f}, g1 = {1.f, 1.f, 1.f, 1.f};
    if (gain) { g0 = *(const f32x4*)(gain + k0 + 8 * c); g1 = *(const f32x4*)(gain + k0 + 8 * c + 4); }
#pragma unroll
    for (int i = 0; i < 32; ++i) scr[(2 * i + (lane >> 5)) * 33 + (lane & 31)] = wv[i];
    asm volatile("s_waitcnt lgkmcnt(0)" ::: "memory");
#pragma unroll
    for (int j = 0; j < 4; ++j) { const int n = (lane >> 3) + 8 * j; const LAS float* s = scr + (8 * c) * 33 + n;
        v4u o; o.x = pk2(s[0 * 33] * g0[0], s[1 * 33] * g0[1]); o.y = pk2(s[2 * 33] * g0[2], s[3 * 33] * g0[3]); o.z = pk2(s[4 * 33] * g1[0], s[5 * 33] * g1[1]); o.w = pk2(s[6 * 33] * g1[2], s[7 * 33] * g1[3]);
        const int drow = MODE == 0 ? p64_row(n0 + n) : gu_row(n0 + n, MODE == 2);
        *(v4u*)(WT + (size_t)drow * K + k0 + 8 * c) = o; }
    asm volatile("s_waitcnt lgkmcnt(0)" ::: "memory");
}
constexpr size_t WT_WIN = 0, WT_WAU = 12 * MiB, WT_WOUT = 14 * MiB, WT_WPG = 16 * MiB, WT_WGLU = 18 * MiB, WT_WSU = 18 * MiB + 512 * 1024, WT_WPLE = 19 * MiB + 512 * 1024, WT_WGU = 20 * MiB, WT_WD = 52 * MiB;
__device__ __forceinline__ void convert_weights(const Frame& F0, int L, unsigned char* wt) {
    const Frame F = refresh(F0);
    LAS float* scr = (LAS float*)(F.lds + F.wave * 16384);
    const int gw = F.vcu * NWAVES + F.wave, NGW = F.G * NWAVES;
    constexpr int I_IN = (DM / 64) * (INW / 32), I_SQ = (DM / 64) * (DM / 32), I_GLU = (SSMW / 64) * (SSMW / 32), I_SU = (SSMW / 64) * (DM / 32), I_PL = (PLE / 64) * (DM / 32);
    constexpr int I_EX = NEXP * 128;
    constexpr int NIT = I_IN + 3 * I_SQ + I_GLU + I_SU + I_PL + 3 * I_EX;
    for (int it = gw; it < NIT; it += NGW) {
        int r = it;
        if (r < I_IN) { transpose_item<0>(inp(F, I_WIN) + (size_t)L * DM * INW, DM, INW, (bf16*)(wt + WT_WIN), inp(F, I_ATTN_G) + L * DM, scr, r, F.lane); continue; } r -= I_IN;
        if (r < I_SQ) { transpose_item<0>(inp(F, I_WAU) + (size_t)L * DM * DM, DM, DM, (bf16*)(wt + WT_WAU), nullptr, scr, r, F.lane); continue; } r -= I_SQ;
        if (r < I_SQ) { transpose_item<0>(inp(F, I_WOUT) + (size_t)L * DM * DM, DM, DM, (bf16*)(wt + WT_WOUT), nullptr, scr, r, F.lane); continue; } r -= I_SQ;
        if (r < I_SQ) { transpose_item<0>(inp(F, I_WPG) + (size_t)L * DM * DM, DM, DM, (bf16*)(wt + WT_WPG), inp(F, I_PLE_G) + L * DM, scr, r, F.lane); continue; } r -= I_SQ;
        if (r < I_GLU) { transpose_item<0>(inp(F, I_WGLU) + (size_t)L * SSMW * SSMW, SSMW, SSMW, (bf16*)(wt + WT_WGLU), nullptr, scr, r, F.lane); continue; } r -= I_GLU;
        if (r < I_SU) { transpose_item<0>(inp(F, I_WSU) + (size_t)L * SSMW * DM, SSMW, DM, (bf16*)(wt + WT_WSU), nullptr, scr, r, F.lane); continue; } r -= I_SU;
        if (r < I_PL) { transpose_item<0>(inp(F, I_WPLE) + (size_t)L * PLE * DM, PLE, DM, (bf16*)(wt + WT_WPLE), nullptr, scr, r, F.lane); continue; } r -= I_PL;
        if (r < I_EX) { const int e = r >> 7; transpose_item<1>(inp(F, I_WEG) + ((size_t)L * NEXP + e) * DM * EFF, DM, EFF, (bf16*)(wt + WT_WGU) + (size_t)e * 512 * DM, inp(F, I_FFN_G) + L * DM, scr, r & 127, F.lane); continue; } r -= I_EX;
        if (r < I_EX) { const int e = r >> 7; transpose_item<2>(inp(F, I_WEU) + ((size_t)L * NEXP + e) * DM * EFF, DM, EFF, (bf16*)(wt + WT_WGU) + (size_t)e * 512 * DM, inp(F, I_FFN_G) + L * DM, scr, r & 127, F.lane); continue; } r -= I_EX;
        { const int e = r >> 7; transpose_item<0>(inp(F, I_WED) + ((size_t)L * NEXP + e) * EFF * DM, EFF, DM, (bf16*)(wt + WT_WD) + (size_t)e * DM * EFF, nullptr, scr, r & 127, F.lane); }
    }
}
#include <hip/hip_bf16.h>
namespace attn_body {
using bf16=__hip_bfloat16;
using bf16x8=__attribute__((ext_vector_type(8)))short;
using s16x4=__attribute__((ext_vector_type(4)))short;
using f32x16=__attribute__((ext_vector_type(16)))float;
using u32x4=__attribute__((ext_vector_type(4)))unsigned;
constexpr int BATCH=8,NHEAD=16,SEQ=2048,D=64,DM=NHEAD*D;
constexpr int NW=8,QBLK=32,QB=QBLK*NW,KVBLK=64,NQB=SEQ/QB;
constexpr int ATTN_PITCH=DM, ATTN_UNIT_ROWS=QB;
__device__ __forceinline__ int crow(int r,int hi){return (r&3)+8*(r>>2)+4*hi;}
#define SBAR() __builtin_amdgcn_sched_barrier(0)
__device__ __forceinline__ void cmask(f32x16&p0,f32x16&p1,int jb,int qrel,int hi){
  const float NEG=-INFINITY; int kb=64*jb+4*hi;
  #pragma unroll
  for(int r=0;r<16;++r){int kv=kb+(r&3)+8*(r>>2); if(kv>qrel)p0[r]=NEG; if(kv+32>qrel)p1[r]=NEG;}
}

constexpr int NSLOT=3, SLOTB=8192;
constexpr int LDS_K=0, LDS_V=NSLOT*SLOTB, LDS_WS=2*NSLOT*SLOTB, LDS_OST=LDS_WS+NW*64*4, LDS_BYTES=LDS_OST+NW*4096;
constexpr float C2=0.125f*1.4426950408889634f;
__device__ __forceinline__ void glds16(const void*gsrc,unsigned lds_dst){unsigned keep;
  asm volatile("s_mov_b32 %0, m0\n\ts_mov_b32 m0, %2\n\ts_nop 0\n\tglobal_load_lds_dwordx4 %1, off\n\ts_mov_b32 m0, %0":"=&s"(keep):"v"(gsrc),"s"(lds_dst):"memory");}
__device__ __forceinline__ float max3f(float a,float b,float c){float r;asm("v_max3_f32 %0, %1, %2, %3":"=v"(r):"v"(a),"v"(b),"v"(c));return r;}
__device__ __forceinline__ float max2f(float a,float b){float r;asm("v_max_f32_e32 %0, %1, %2":"=v"(r):"v"(a),"v"(b));return r;}
__device__ __forceinline__ float fadd_s(float a,float b){float r;asm("v_add_f32_e32 %0, %1, %2":"=v"(r):"v"(a),"v"(b));return r;}
__device__ __forceinline__ float fsub_s(float a,float b){float r;asm("v_sub_f32_e32 %0, %1, %2":"=v"(r):"v"(a),"v"(b));return r;}
typedef float f32x2_t __attribute__((ext_vector_type(2))); typedef __bf16 bf16x2_t __attribute__((ext_vector_type(2)));
__device__ __forceinline__ unsigned cvtpk_s(float lo,float hi){f32x2_t v={lo,hi};bf16x2_t b=__builtin_convertvector(v,bf16x2_t);return __builtin_bit_cast(unsigned,b);}
#define WAIT_BAR(N) asm volatile("s_waitcnt vmcnt(" #N ") lgkmcnt(0)\n\ts_barrier":::"memory")

__device__ __forceinline__ void qkt(f32x16&p0,f32x16&p1,const char*Kslot,const bf16x8*qr,const f32x16&negm,int r32,int hi){
  const char*kb=Kslot+hi*1024+r32*16;
  #pragma unroll
  for(int d0=0;d0<4;++d0){
    const bf16x8 b0=*reinterpret_cast<const bf16x8*>(kb+d0*2048);
    const bf16x8 b1=*reinterpret_cast<const bf16x8*>(kb+d0*2048+512);
    if(d0==0){p0=__builtin_amdgcn_mfma_f32_32x32x16_bf16(b0,qr[0],negm,0,0,0);p1=__builtin_amdgcn_mfma_f32_32x32x16_bf16(b1,qr[0],negm,0,0,0);}
    else{p0=__builtin_amdgcn_mfma_f32_32x32x16_bf16(b0,qr[d0],p0,0,0,0);p1=__builtin_amdgcn_mfma_f32_32x32x16_bf16(b1,qr[d0],p1,0,0,0);}}
}
typedef __attribute__((address_space(3))) const char* lds_cptr;
typedef short v4i16_t __attribute__((ext_vector_type(4)));
__device__ __forceinline__ void kload8(bf16x8*kf,lds_cptr kp){
  kf[0]=*(const __attribute__((address_space(3))) bf16x8*)(kp);      kf[1]=*(const __attribute__((address_space(3))) bf16x8*)(kp+512);
  kf[2]=*(const __attribute__((address_space(3))) bf16x8*)(kp+2048); kf[3]=*(const __attribute__((address_space(3))) bf16x8*)(kp+2560);
  kf[4]=*(const __attribute__((address_space(3))) bf16x8*)(kp+4096); kf[5]=*(const __attribute__((address_space(3))) bf16x8*)(kp+4608);
  kf[6]=*(const __attribute__((address_space(3))) bf16x8*)(kp+6144); kf[7]=*(const __attribute__((address_space(3))) bf16x8*)(kp+6656);
}
__device__ __forceinline__ void kload2(bf16x8*kf,lds_cptr kp,int j){ kf[2*j]=*(const __attribute__((address_space(3))) bf16x8*)(kp+j*2048); kf[2*j+1]=*(const __attribute__((address_space(3))) bf16x8*)(kp+j*2048+512); }
__device__ __forceinline__ s16x4 vtr(lds_cptr p){ return __builtin_bit_cast(s16x4,__builtin_amdgcn_ds_read_tr16_b64_v4i16((__attribute__((address_space(3))) v4i16_t*)p)); }
__device__ __forceinline__ float rowmax(const f32x16&p0,const f32x16&p1){
  float a=max3f(p0[0],p0[1],p1[0]),b=max3f(p0[2],p0[3],p1[1]);a=max3f(a,p1[2],p1[3]);
  #pragma unroll
  for(int r=4;r<16;r+=4){a=max3f(a,p0[r],p0[r+1]);b=max3f(b,p0[r+2],p0[r+3]);a=max3f(a,p1[r],p1[r+1]);b=max3f(b,p1[r+2],p1[r+3]);}
  const float m=max2f(a,b);
  auto rr=__builtin_amdgcn_permlane32_swap(__float_as_uint(m),__float_as_uint(m),false,false);
  return max2f(__uint_as_float(rr[0]),__uint_as_float(rr[1]));
}
__device__ __forceinline__ void pv(f32x16*o,int vb,bf16x8 pa0,bf16x8 pa1,bf16x8 pa2,bf16x8 pa3){
  #pragma unroll
  for(int d0=0;d0<2;++d0){s16x4 lo[4],hi[4];
    #pragma unroll
    for(int ks=0;ks<4;++ks){
      asm volatile("ds_read_b64_tr_b16 %0,%1 offset:%c2":"=&v"(lo[ks]):"v"(vb),"i"(d0*4096+ks*1024):"memory");
      asm volatile("ds_read_b64_tr_b16 %0,%1 offset:%c2":"=&v"(hi[ks]):"v"(vb),"i"(d0*4096+ks*1024+512):"memory");}
    asm volatile("s_waitcnt lgkmcnt(0)":::"memory");SBAR();
    #define PK(k) (bf16x8){lo[k][0],lo[k][1],lo[k][2],lo[k][3],hi[k][0],hi[k][1],hi[k][2],hi[k][3]}
    o[d0]=__builtin_amdgcn_mfma_f32_32x32x16_bf16(pa0,PK(0),o[d0],0,0,0);
    o[d0]=__builtin_amdgcn_mfma_f32_32x32x16_bf16(pa1,PK(1),o[d0],0,0,0);
    o[d0]=__builtin_amdgcn_mfma_f32_32x32x16_bf16(pa2,PK(2),o[d0],0,0,0);
    o[d0]=__builtin_amdgcn_mfma_f32_32x32x16_bf16(pa3,PK(3),o[d0],0,0,0);
    #undef PK
  }
}

#ifndef ATTN_STORE16
#define ATTN_STORE16(p,v) (*(u32x4*)(p)=(v))
#endif
template<int THRL> __device__ __forceinline__ void attn_pass(int b,int hq,int hv,int qb,const bf16*Q,const bf16*K,const bf16*V,char*shm,f32x16 (&o)[2],float (&rli)[16]){
  int tid_=threadIdx.x; asm volatile("":"+v"(tid_)); const int tid=tid_,lane=tid&63,r32=lane&31,hi=lane>>5; const int wid=__builtin_amdgcn_readfirstlane(tid>>6);
  const long rowbase=(long)b*SEQ; const int q0=qb*QB;
  const bf16*Qw=Q+(rowbase+q0+wid*QBLK)*DM+hq*D;
  const bf16*Kh=K+rowbase*DM+hq*D,*Vh=V+rowbase*DM+hv*D;
  const unsigned lds0=(unsigned)(uintptr_t)shm;
  float*wsf=(float*)(shm+LDS_WS)+wid*64;
  const bf16*ksrc=Kh+(long)lane*DM+wid*8;
  const bf16*vsrc=Vh+(long)(16*(wid&3)+(lane>>2))*DM+(wid>>2)*32+(lane&3)*8;
  const unsigned kdst=lds0+LDS_K+wid*1024, vdst=lds0+LDS_V+wid*1024;
  #define DMA_K(t,slot) glds16(ksrc+(long)(t)*KVBLK*DM,(unsigned)__builtin_amdgcn_readfirstlane(kdst+(slot)))
  #define DMA_V(t,slot) glds16(vsrc+(long)(t)*KVBLK*DM,(unsigned)__builtin_amdgcn_readfirstlane(vdst+(slot)))
  const int vb0=(int)(lds0+LDS_V)+((lane>>4)&1)*32+(lane&3)*8+(4*hi+((lane&15)>>2))*64;
  const char*Kbase=shm+LDS_K; bf16x8 kf[8];
  const lds_cptr shm3=(lds_cptr)shm; const lds_cptr kp0=shm3+LDS_K+hi*1024+r32*16; const lds_cptr vp0=shm3+LDS_V+((lane>>4)&1)*32+(lane&3)*8+(4*hi+((lane&15)>>2))*64;
  const int NT=(q0+QB)/KVBLK;
  DMA_K(0,0);DMA_V(0,0);DMA_K(1,SLOTB);
  bf16x8 qr[4];
  #pragma unroll
  for(int d0=0;d0<4;++d0)qr[d0]=*reinterpret_cast<const bf16x8*>(&Qw[(long)r32*DM+d0*16+hi*8]);
  float mhat=0.f,l_reg=0.f;o[0]=f32x16{};o[1]=f32x16{};f32x16 negm=f32x16{};asm volatile("":"+v"(negm));
  const int qrel=wid*QBLK+r32;
  #define CMASK(P0,P1,t) do{int jb_=(t)-(NT-4); if(jb_>=0)cmask(P0,P1,jb_,qrel,hi);}while(0)
  bool resc=false;
  #define START(P0,P1) do{ const float rm=rowmax(P0,P1); resc=false; \
    { const float dl=rm; mhat=fadd_s(mhat,dl); \
      _Pragma("unroll") for(int r=0;r<16;++r){P0[r]=fsub_s(P0[r],dl);P1[r]=fsub_s(P1[r],dl);} \
      _Pragma("unroll") for(int r=0;r<16;++r)negm[r]=-mhat; asm volatile("":"+v"(negm)); } \
    _Pragma("unroll") for(int r=0;r<16;++r)P0[r]=__builtin_amdgcn_exp2f(P0[r]); }while(0)
  #define RESC() do{ if(resc){ asm volatile("s_waitcnt lgkmcnt(0)":::"memory"); \
      _Pragma("unroll") for(int d_=0;d_<2;++d_) _Pragma("unroll") for(int r=0;r<16;++r)o[d_][r]*=wsf[crow(r,hi)]; } }while(0)
  f32x16 pA0,pA1,pB0,pB1;
  int sl_prev=0,sl_cur=0,sl_next=SLOTB;
  #define ROT() do{sl_prev=sl_cur;sl_cur=sl_next;sl_next=(sl_next==(NSLOT-1)*SLOTB)?0:sl_next+SLOTB;}while(0)
  DMA_K(2,2*SLOTB);
  WAIT_BAR(3);
  qkt(pA0,pA1,Kbase,qr,negm,r32,hi);asm volatile("s_nop 15\n\ts_nop 7":"+v"(pA0),"+v"(pA1));CMASK(pA0,pA1,0);
  START(pA0,pA1);
  _Pragma("unroll") for(int r=0;r<16;++r)pA1[r]=__builtin_amdgcn_exp2f(pA1[r]);
  WAIT_BAR(0);
  DMA_K(3,0);DMA_V(1,SLOTB);
  ROT();
  kload8(kf,kp0+sl_cur);
  WAIT_BAR(2);
  s16x4 vlo[8],vhi[8]; u32x4 pw0,pw1,pw2,pw3;
  #define PKW(P,B) cvtpk_s(P[B],P[B+1])
  #define PAF(k) __builtin_bit_cast(bf16x8,pw##k)
  #define VFR(i) (bf16x8){vlo[i][0],vlo[i][1],vlo[i][2],vlo[i][3],vhi[i][0],vhi[i][1],vhi[i][2],vhi[i][3]}
  #define PIN(x) asm volatile("":"+v"(x))
  #define MX3(a,b,c) __builtin_fmaxf(__builtin_fmaxf((a),(b)),(c))
  #define GAPA(MF,A0,A1,A2,A3,W0,W1,PW) do{ MF; sacc+=A0; sacc+=A1; sacc+=A2; sacc+=A3; PIN(sacc); W0; W1; PIN(PW); SBAR(); }while(0)
  #define EX(v) __builtin_amdgcn_exp2f(v)
  #define GAPB(MF,X,B) do{ MF; X[B]=EX(X[B]); X[B+1]=EX(X[B+1]); X[B+2]=EX(X[B+2]); X[B+3]=EX(X[B+3]); PIN(X); SBAR(); }while(0)
  #define VRD(i) do{ vlo[i]=vtr(vp_+(((i)>>2)*4096+((i)&3)*1024)); vhi[i]=vtr(vp_+(((i)>>2)*4096+((i)&3)*1024+512)); }while(0)
  #define KRD(G,j) do{ if(G){ kload2(kf,kp0+sl_next,j); SBAR(); } }while(0)
  #define STEP(C0,C1,P0,P1,t,GK,GV,GL) do{ SBAR(); \
    const lds_cptr vp_=vp0+sl_prev; \
    VRD(0); SBAR(); float sacc=(P0[0]+P0[1]); \
    GAPA(C0=__builtin_amdgcn_mfma_f32_32x32x16_bf16(kf[0],qr[0],negm,0,0,0), P0[2],P0[3],P0[4],P0[5],     pw0[0]=PKW(P0,0), pw0[1]=PKW(P0,2), pw0); \
    VRD(4); SBAR(); GAPA(C1=__builtin_amdgcn_mfma_f32_32x32x16_bf16(kf[1],qr[0],negm,0,0,0), P0[6],P0[7],P0[8],P0[9],     pw0[2]=PKW(P0,4), pw0[3]=PKW(P0,6), pw0); \
    VRD(1); SBAR(); GAPA(C0=__builtin_amdgcn_mfma_f32_32x32x16_bf16(kf[2],qr[1],C0,0,0,0),   P0[10],P0[11],P0[12],P0[13], pw1[0]=PKW(P0,8), pw1[1]=PKW(P0,10), pw1); \
    VRD(5); SBAR(); GAPA(C1=__builtin_amdgcn_mfma_f32_32x32x16_bf16(kf[3],qr[1],C1,0,0,0),   P0[14],P0[15],P1[0],P1[1],   pw1[2]=PKW(P0,12),pw1[3]=PKW(P0,14), pw1); \
    VRD(2); SBAR(); GAPA(C0=__builtin_amdgcn_mfma_f32_32x32x16_bf16(kf[4],qr[2],C0,0,0,0),   P1[2],P1[3],P1[4],P1[5],     pw2[0]=PKW(P1,0), pw2[1]=PKW(P1,2), pw2); \
    VRD(6); SBAR(); GAPA(C1=__builtin_amdgcn_mfma_f32_32x32x16_bf16(kf[5],qr[2],C1,0,0,0),   P1[6],P1[7],P1[8],P1[9],     pw2[2]=PKW(P1,4), pw2[3]=PKW(P1,6), pw2); \
    VRD(3); SBAR(); GAPA(C0=__builtin_amdgcn_mfma_f32_32x32x16_bf16(kf[6],qr[3],C0,0,0,0),   P1[10],P1[11],P1[12],P1[13], pw3[0]=PKW(P1,8), pw3[1]=PKW(P1,10), pw3); \
    VRD(7); SBAR(); GAPA(C1=__builtin_amdgcn_mfma_f32_32x32x16_bf16(kf[7],qr[3],C1,0,0,0),   P1[14],P1[15],0.f,0.f,       pw3[2]=PKW(P1,12),pw3[3]=PKW(P1,14), pw3); \
    l_reg+=sacc; \
    if(GK){DMA_K((t)+3,sl_cur);} if(GV){DMA_V((t)+1,sl_next);} \
    CMASK(C0,C1,t); \
    { float a=MX3(C0[0],C0[1],C1[0]),b=MX3(C0[2],C0[3],C1[1]); a=MX3(a,C1[2],C1[3]); \
      _Pragma("unroll") for(int r=4;r<16;r+=4){a=MX3(a,C0[r],C0[r+1]);b=MX3(b,C0[r+2],C0[r+3]);a=MX3(a,C1[r],C1[r+1]);b=MX3(b,C1[r+2],C1[r+3]);} \
      float rm=__builtin_fmaxf(a,b); { auto rr=__builtin_amdgcn_permlane32_swap(__float_as_uint(rm),__float_as_uint(rm),false,false); rm=__builtin_fmaxf(__uint_as_float(rr[0]),__uint_as_float(rr[1])); } \
      resc=false; \
      if(__builtin_expect(__any(rm>(float)THRL),0)){ const float dl=__builtin_fmaxf(rm,0.f); mhat+=dl; \
        _Pragma("unroll") for(int r=0;r<16;++r){C0[r]-=dl;C1[r]-=dl;} \
        _Pragma("unroll") for(int r=0;r<16;++r)negm[r]=-mhat; asm volatile("":"+v"(negm)); \
        const float f=__builtin_amdgcn_exp2f(-dl); l_reg*=f; if(hi==0)wsf[r32]=f; resc=true; } } \
    SBAR(); \
    GAPB(o[0]=__builtin_amdgcn_mfma_f32_32x32x16_bf16(PAF(0),VFR(0),o[0],0,0,0), C0,0); \
    GAPB(o[1]=__builtin_amdgcn_mfma_f32_32x32x16_bf16(PAF(0),VFR(4),o[1],0,0,0), C0,4); \
    KRD(GL,0); GAPB(o[0]=__builtin_amdgcn_mfma_f32_32x32x16_bf16(PAF(1),VFR(1),o[0],0,0,0), C0,8); \
    KRD(GL,1); GAPB(o[1]=__builtin_amdgcn_mfma_f32_32x32x16_bf16(PAF(1),VFR(5),o[1],0,0,0), C0,12); \
    KRD(GL,2); GAPB(o[0]=__builtin_amdgcn_mfma_f32_32x32x16_bf16(PAF(2),VFR(2),o[0],0,0,0), C1,0); \
    KRD(GL,3); GAPB(o[1]=__builtin_amdgcn_mfma_f32_32x32x16_bf16(PAF(2),VFR(6),o[1],0,0,0), C1,4); \
    GAPB(o[0]=__builtin_amdgcn_mfma_f32_32x32x16_bf16(PAF(3),VFR(3),o[0],0,0,0), C1,8); \
    GAPB(o[1]=__builtin_amdgcn_mfma_f32_32x32x16_bf16(PAF(3),VFR(7),o[1],0,0,0), C1,12); \
    }while(0)
  int t=1;
  #undef CMASK
  #define CMASK(P0,P1,t) do{}while(0)
  for(;t+5<NT;t+=2){
    STEP(pB0,pB1,pA0,pA1,t,true,true,true);     WAIT_BAR(2); RESC(); ROT();
    STEP(pA0,pA1,pB0,pB1,t+1,true,true,true);   WAIT_BAR(2); RESC(); ROT();
  }
  #undef CMASK
  #define CMASK(P0,P1,t) do{int jb_=(t)-(NT-4); if(jb_>=0)cmask(P0,P1,jb_,qrel,hi);}while(0)
  #define ENDW(tt) do{ if((tt)+3<NT){WAIT_BAR(2);} else if((tt)+2<NT){WAIT_BAR(1);} else {WAIT_BAR(0);} }while(0)
  for(;t+1<NT;t+=2){
    STEP(pB0,pB1,pA0,pA1,t,(t+3<NT),(t+1<NT),(t+1<NT));       ENDW(t);   RESC(); ROT();
    STEP(pA0,pA1,pB0,pB1,t+1,(t+4<NT),(t+2<NT),(t+2<NT));     ENDW(t+1); RESC(); ROT();
  }
  STEP(pB0,pB1,pA0,pA1,NT-1,false,false,false); RESC();
  { float sacc=pB0[0]+pB0[1]; _Pragma("unroll") for(int r=2;r<16;++r)sacc+=pB0[r]; _Pragma("unroll") for(int r=0;r<16;++r)sacc+=pB1[r]; l_reg+=sacc;
    pw0=(u32x4){PKW(pB0,0),PKW(pB0,2),PKW(pB0,4),PKW(pB0,6)};pw1=(u32x4){PKW(pB0,8),PKW(pB0,10),PKW(pB0,12),PKW(pB0,14)};pw2=(u32x4){PKW(pB1,0),PKW(pB1,2),PKW(pB1,4),PKW(pB1,6)};pw3=(u32x4){PKW(pB1,8),PKW(pB1,10),PKW(pB1,12),PKW(pB1,14)};
    SBAR(); pv(o,vb0+sl_cur,PAF(0),PAF(1),PAF(2),PAF(3)); }
  #undef PKW
  #undef PAF
  #undef VFR
  #undef PIN
  #undef MX3
  #undef GAPA
  #undef GAPB
  #undef EX
  #undef VRD
  #undef KRD
  #undef STEP
  #undef ENDW
  {auto rr=__builtin_amdgcn_permlane32_swap(__float_as_uint(l_reg),__float_as_uint(l_reg),false,false);l_reg=__uint_as_float(rr[0])+__uint_as_float(rr[1]);}
  if(hi==0)wsf[32+r32]=l_reg;asm volatile("s_waitcnt lgkmcnt(0)":::"memory");
  #pragma unroll
  for(int r=0;r<16;++r)rli[r]=__builtin_amdgcn_rcpf(wsf[32+crow(r,hi)]);
  asm volatile("s_waitcnt lgkmcnt(0)\n\ts_barrier":::"memory");
  #undef DMA_K
  #undef DMA_V
  #undef CMASK
  #undef START
  #undef RESC
  #undef ROT
}
constexpr int LDS_STASH=LDS_BYTES, LDS_SSQ=LDS_STASH+NW*8192, ATTN_LDS_BYTES=LDS_SSQ+NW*128;
template<int THRL> __device__ __forceinline__ void dattn_unit(int b,int h,int qb,const bf16*Q,const bf16*K,const bf16*V,bf16*O,char*shm,float lam,const float*subln,float oml){
  #pragma unroll 1
  for(int pass=0;pass<4;++pass){
    const int m=pass&1,vh=pass>>1;
    f32x16 o[2]; float rli[16];
    attn_pass<THRL>(b,2*h+m,2*h+vh,qb,Q,K,V,shm,o,rli);
    int tid_=threadIdx.x; asm volatile("":"+v"(tid_)); const int tid=tid_,lane=tid&63,r32=lane&31,hi=lane>>5; const int wid=__builtin_amdgcn_readfirstlane(tid>>6);
    float*stash=(float*)(shm+LDS_STASH)+wid*2048; float*ssq0=(float*)(shm+LDS_SSQ)+wid*32; float*wsf=(float*)(shm+LDS_WS)+wid*64;
    unsigned short*stg=(unsigned short*)(shm+LDS_OST)+wid*2048;
    const long orow0=((long)b*SEQ+(long)qb*QB+wid*QBLK)*DM+h*128;
    if(m==0){
      #pragma unroll
      for(int d0=0;d0<2;++d0)
        #pragma unroll
        for(int r=0;r<16;++r)stash[(d0*16+r)*64+lane]=o[d0][r]*rli[r];
    }else{
      float sq[16];
      #pragma unroll
      for(int r=0;r<16;++r){ const float a0=stash[r*64+lane]-lam*o[0][r]*rli[r], a1=stash[(16+r)*64+lane]-lam*o[1][r]*rli[r]; o[0][r]=a0;o[1][r]=a1;sq[r]=a0*a0+a1*a1; }
      #pragma unroll
      for(int r=0;r<16;++r){ float s=sq[r]; s+=__shfl_xor(s,1);s+=__shfl_xor(s,2);s+=__shfl_xor(s,4);s+=__shfl_xor(s,8);s+=__shfl_xor(s,16); sq[r]=s; }
      if(vh==0){
        if(r32==0){
          #pragma unroll
          for(int r=0;r<16;++r)ssq0[crow(r,hi)]=sq[r]; }
        #pragma unroll
        for(int r=0;r<16;++r){const int orow=crow(r,hi); stg[orow*64+r32]=(unsigned short)(cvtpk_s(o[0][r],0.f)&0xffffu); stg[orow*64+32+r32]=(unsigned short)(cvtpk_s(o[1][r],0.f)&0xffffu);}
      }else{
        float rsc[16];
        #pragma unroll
        for(int r=0;r<16;++r)rsc[r]=__builtin_amdgcn_rsqf((sq[r]+ssq0[crow(r,hi)])*(1.f/128.f)+1e-6f)*oml;
        if(r32==0){
          #pragma unroll
          for(int r=0;r<16;++r)wsf[32+crow(r,hi)]=rsc[r]; }
        asm volatile("s_waitcnt lgkmcnt(0)":::"memory");
        { const int ch=lane&7; const float4 g0=*(const float4*)(subln+ch*8),g1=*(const float4*)(subln+ch*8+4);
          #pragma unroll
          for(int i=0;i<4;++i){const int row=i*8+(lane>>3); const u32x4 v=*(const u32x4*)(stg+row*64+ch*8); const float rs_=wsf[32+row];
            u32x4 w;
            w.x=cvtpk_s(__uint_as_float(v.x<<16)*rs_*g0.x,__uint_as_float(v.x&0xffff0000u)*rs_*g0.y); w.y=cvtpk_s(__uint_as_float(v.y<<16)*rs_*g0.z,__uint_as_float(v.y&0xffff0000u)*rs_*g0.w);
            w.z=cvtpk_s(__uint_as_float(v.z<<16)*rs_*g1.x,__uint_as_float(v.z&0xffff0000u)*rs_*g1.y); w.w=cvtpk_s(__uint_as_float(v.w<<16)*rs_*g1.z,__uint_as_float(v.w&0xffff0000u)*rs_*g1.w);
            *(u32x4*)((unsigned short*)O+orow0+(long)row*DM+ch*8)=w; } }
        asm volatile("s_waitcnt lgkmcnt(0)":::"memory");
        { const float ga=subln[64+r32],gb=subln[96+r32];
          #pragma unroll
          for(int r=0;r<16;++r){const int orow=crow(r,hi); stg[orow*64+r32]=(unsigned short)(cvtpk_s(o[0][r]*rsc[r]*ga,0.f)&0xffffu); stg[orow*64+32+r32]=(unsigned short)(cvtpk_s(o[1][r]*rsc[r]*gb,0.f)&0xffffu);}
          asm volatile("s_waitcnt lgkmcnt(0)":::"memory");
          #pragma unroll
          for(int i=0;i<4;++i){const int row=i*8+(lane>>3),ch=lane&7; const u32x4 v=*(const u32x4*)(stg+row*64+ch*8); *(u32x4*)((unsigned short*)O+orow0+(long)row*DM+64+ch*8)=v;} }
        asm volatile("s_waitcnt lgkmcnt(0)":::"memory");
      }
    }
  }
}
#undef SBAR
#undef WAIT_BAR
}

constexpr size_t SSM_F16_OFF = 0, SSM_TG_OFF = 2 * MiB;
constexpr int SSM_XLD = 392;
typedef short bf16x8_t __attribute__((ext_vector_type(8)));
__device__ __forceinline__ void ssm_tables(const Frame& F0, int L, unsigned char* base) {
    const Frame F = refresh(F0);
    LAS float* ap_re = (LAS float*)F.lds; LAS float* ap_im = ap_re + 17 * 64;
    LAS float* bb_re = ap_im + 17 * 64;   LAS float* bb_im = bb_re + 1024;
    LAS float* cc_re = bb_im + 1024;      LAS float* cc_im = cc_re + 1024;
    LAS float* kt = cc_im + 1024;         LAS float* dd = kt + 4096;
    const int tid = F.tid;
    for (int item = F.vcu; item < NG * 8; item += F.G) {
        const int g = item >> 3, part = item & 7;
        __syncthreads();
        if (tid < 64) {
            const int p = tid; const float dt = expf(inp(F, I_LSTEP)[L * NG + g]);
            const float lr = inp(F, I_LRE)[(L * NG + g) * SP + p], li = inp(F, I_LIM)[(L * NG + g) * SP + p];
            for (int tau = 0; tau <= 16; ++tau) { const float mg = expf(lr * dt * (float)tau); float sn, cs; sincosf(li * dt * (float)tau, &sn, &cs); ap_re[tau * 64 + p] = mg * cs; ap_im[tau * 64 + p] = mg * sn; }
            const float ab_re = ap_re[64 + p], ab_im = ap_im[64 + p];
            const float den = lr * lr + li * li, nr = ab_re - 1.f;
            const float coef_re = (nr * lr + ab_im * li) / den, coef_im = (ab_im * lr - nr * li) / den;
            const float* br = inp(F, I_BRE) + ((size_t)(L * NG + g) * SP + p) * SG; const float* bi = inp(F, I_BIM) + ((size_t)(L * NG + g) * SP + p) * SG;
            for (int h = 0; h < 16; ++h) { bb_re[p * 16 + h] = coef_re * br[h] - coef_im * bi[h]; bb_im[p * 16 + h] = coef_re * bi[h] + coef_im * br[h]; }
        }
        for (int i = tid; i < 1024; i += NTHREADS) { cc_re[i] = inp(F, I_CRE)[(size_t)(L * NG + g) * SG * SP + i]; cc_im[i] = inp(F, I_CIM)[(size_t)(L * NG + g) * SG * SP + i]; }
        if (tid < 16) dd[tid] = inp(F, I_SSMD)[(L * NG + g) * SG + tid];
        __syncthreads();
        unsigned* F16 = (unsigned*)(base + SSM_F16_OFF) + (size_t)g * 128 * 128;
        for (int i3 = tid; i3 < 16 * 128; i3 += NTHREADS) {
            const int i2 = part * 16 * 128 + i3, row = i2 >> 7, col = (i2 & 127) * 2, p = row & 63, j = col >> 4, h0 = col & 15;
            const float ar = ap_re[(15 - j) * 64 + p], ai = ap_im[(15 - j) * 64 + p];
            float v[2];
#pragma unroll
            for (int q = 0; q < 2; ++q) { const float br = bb_re[p * 16 + h0 + q], bi = bb_im[p * 16 + h0 + q]; v[q] = row < 64 ? (ar * br - ai * bi) : (ar * bi + ai * br); }
            F16[i2] = f2bf(v[0]) | (f2bf(v[1]) << 16);
        }
        for (int i = tid; i < (2 * part + 2) * 256; i += NTHREADS) {
            const int tau = i >> 8, h = (i >> 4) & 15, hp = i & 15; float acc = 0.f;
            for (int p = 0; p < 64; ++p) { const float ar = ap_re[tau * 64 + p], ai = ap_im[tau * 64 + p], br = bb_re[p * 16 + hp], bi = bb_im[p * 16 + hp];
                const float er = ar * br - ai * bi, ei = ar * bi + ai * br; acc += cc_re[h * 64 + p] * er - cc_im[h * 64 + p] * ei; }
            kt[i] = acc;
        }
        __syncthreads();
        unsigned* TG = (unsigned*)(base + SSM_TG_OFF) + (size_t)g * 256 * 192;
        for (int i3 = tid; i3 < 32 * 128; i3 += NTHREADS) {
            const int i2 = part * 32 * 128 + i3, row = i2 >> 7, col = (i2 & 127) * 2, i = row >> 4, h = row & 15, j = col >> 4, h0 = col & 15;
            float v[2] = {0.f, 0.f};
            if (j <= i) {
#pragma unroll
                for (int q = 0; q < 2; ++q) { v[q] = kt[((i - j) * 16 + h) * 16 + h0 + q]; if (i == j && h == h0 + q) v[q] += dd[h]; } }
            TG[row * 192 + (i2 & 127)] = f2bf(v[0]) | (f2bf(v[1]) << 16);
        }
        for (int i3 = tid; i3 < 32 * 64; i3 += NTHREADS) {
            const int i2 = part * 32 * 64 + i3, row = i2 >> 6, c = (i2 & 63) * 2, i = row >> 4, h = row & 15;
            float v[2];
#pragma unroll
            for (int q = 0; q < 2; ++q) { const int p = (c + q) & 63; const float ar = ap_re[(i + 1) * 64 + p], ai = ap_im[(i + 1) * 64 + p], cr = cc_re[h * 64 + p], ci = cc_im[h * 64 + p];
                v[q] = (c + q) < 64 ? (cr * ar - ci * ai) : -(cr * ai + ci * ar); }
            TG[row * 192 + 128 + (i2 & 63)] = f2bf(v[0]) | (f2bf(v[1]) << 16);
        }
    }
    __syncthreads();
}
__device__ __forceinline__ float gelu_fast(float x) { const float u = 1.5957691216057308f * (x + 0.044715f * x * x * x); return x - x * __builtin_amdgcn_rcpf(1.f + __expf(u)); }
__device__ __forceinline__ void ssm_item_mfma(const Frame& F0, int L, int it, const bf16* U, bf16* Z, const unsigned char* tbase, float* vscr) {
    const Frame F = refresh(F0);
    const int g = it & 31, b = it >> 5, tid = F.tid, lane = F.lane, w = F.wave, lr16 = lane & 15, q = lane >> 4;
    LAS unsigned char* X = F.lds;
    { const bf16* ub = U + (size_t)b * SEQ * SSMW + g * 16;
#pragma unroll
      for (int r = 0; r < 4; ++r) { const int t = tid + r * NTHREADS; const v4u* sp = (const v4u*)(ub + (size_t)t * SSMW); const v4u a = sp[0], c = sp[1];
          LAS v4u* dp = (LAS v4u*)(X + (t >> 4) * (SSM_XLD * 2) + (t & 15) * 32); dp[0] = a; dp[1] = c; } }
    __syncthreads();
    { const bf16* F16 = (const bf16*)(tbase + SSM_F16_OFF) + (size_t)g * 128 * 256 + (size_t)(16 * w + lr16) * 256 + 8 * q;
      bf16x8_t af[8];
#pragma unroll
      for (int ks = 0; ks < 8; ++ks) af[ks] = *(const bf16x8_t*)(F16 + ks * 32);
#pragma unroll 1
      for (int nt = 0; nt < 8; ++nt) {
          f32x4 acc = {0.f, 0.f, 0.f, 0.f};
          LAS const unsigned char* xr = X + (16 * nt + lr16) * (SSM_XLD * 2) + 16 * q;
#pragma unroll
          for (int ks = 0; ks < 8; ++ks) { const bf16x8_t bf = *(LAS const bf16x8_t*)(xr + ks * 64); acc = __builtin_amdgcn_mfma_f32_16x16x32_bf16(af[ks], bf, acc, 0, 0, 0); }
          *(f32x4*)(vscr + (size_t)(16 * nt + lr16) * 128 + 16 * w + 4 * q) = acc;
      } }
    asm volatile("s_waitcnt vmcnt(0)" ::: "memory");
    __syncthreads();
    if (w == 0) {
        __builtin_amdgcn_fence(__ATOMIC_ACQUIRE, "agent");
        const int p = lane; const float dt = expf(inp(F, I_LSTEP)[L * NG + g]);
        const float lr = inp(F, I_LRE)[(L * NG + g) * SP + p], li = inp(F, I_LIM)[(L * NG + g) * SP + p];
        const float mg = expf(lr * dt * 16.f); float sn, cs; sincosf(li * dt * 16.f, &sn, &cs); const float a_re = mg * cs, a_im = mg * sn;
        float s_re = 0.f, s_im = 0.f;
        LAS unsigned short* xs = (LAS unsigned short*)X + 256 + p;
#pragma unroll 1
        for (int c0 = 0; c0 < 128; c0 += 16) {
            float vr[16], vi[16];
#pragma unroll
            for (int j = 0; j < 16; ++j) { vr[j] = vscr[(c0 + j) * 128 + p]; vi[j] = vscr[(c0 + j) * 128 + 64 + p]; }
#pragma unroll
            for (int j = 0; j < 16; ++j) {
                xs[(c0 + j) * SSM_XLD] = (unsigned short)f2bf(s_re); xs[(c0 + j) * SSM_XLD + 64] = (unsigned short)f2bf(s_im);
                const float t_re = a_re * s_re - a_im * s_im + vr[j], t_im = a_re * s_im + a_im * s_re + vi[j]; s_re = t_re; s_im = t_im;
            }
        }
    }
    __syncthreads();
    { const int mA = w, mB = 15 - w, limA = mA >> 1, limB = mB >> 1;
      const bf16* TGa = (const bf16*)(tbase + SSM_TG_OFF) + (size_t)g * 256 * 384 + (size_t)(16 * mA + lr16) * 384 + 8 * q;
      const bf16* TGb = (const bf16*)(tbase + SSM_TG_OFF) + (size_t)g * 256 * 384 + (size_t)(16 * mB + lr16) * 384 + 8 * q;
      bf16x8_t fa[12], fb[12];
#pragma unroll
      for (int ks = 0; ks < 12; ++ks) { const bf16x8_t zz = {0, 0, 0, 0, 0, 0, 0, 0}; fa[ks] = (ks >= 8 || ks <= limA) ? *(const bf16x8_t*)(TGa + ks * 32) : zz; fb[ks] = (ks >= 8 || ks <= limB) ? *(const bf16x8_t*)(TGb + ks * 32) : zz; }
      bf16* zb = Z + (size_t)b * SEQ * SSMW + g * 16 + 4 * q;
#pragma unroll 1
      for (int nt = 0; nt < 8; ++nt) {
          f32x4 accA = {0.f, 0.f, 0.f, 0.f}, accB = {0.f, 0.f, 0.f, 0.f};
          LAS const unsigned char* xr = X + (16 * nt + lr16) * (SSM_XLD * 2) + 16 * q;
#pragma unroll
          for (int ks = 0; ks < 12; ++ks) { const bf16x8_t bf = *(LAS const bf16x8_t*)(xr + ks * 64);
              if (ks >= 8 || ks <= limA) accA = __builtin_amdgcn_mfma_f32_16x16x32_bf16(fa[ks], bf, accA, 0, 0, 0);
              if (ks >= 8 || ks <= limB) accB = __builtin_amdgcn_mfma_f32_16x16x32_bf16(fb[ks], bf, accB, 0, 0, 0); }
          const int sc = 16 * nt + lr16;
          { v2u o; o.x = f2bf(gelu_fast(accA[0])) | (f2bf(gelu_fast(accA[1])) << 16); o.y = f2bf(gelu_fast(accA[2])) | (f2bf(gelu_fast(accA[3])) << 16); *(v2u*)(zb + (size_t)(16 * sc + mA) * SSMW) = o; }
          { v2u o; o.x = f2bf(gelu_fast(accB[0])) | (f2bf(gelu_fast(accB[1])) << 16); o.y = f2bf(gelu_fast(accB[2])) | (f2bf(gelu_fast(accB[3])) << 16); *(v2u*)(zb + (size_t)(16 * sc + mB) * SSMW) = o; }
      } }
    __syncthreads();
}

__device__ __forceinline__ void router_phase(const Frame& F0, int L, const float* xio, unsigned* ctl, unsigned char* ws) {
    const Frame F = refresh(F0);
    LAS f32x4* Wg = (LAS f32x4*)F.lds; LAS f32x4* Wl = (LAS f32x4*)(F.lds + 16384); LAS f32x4* Wh = (LAS f32x4*)(F.lds + 81920);
    const float* gf = inp(F, I_FFN_G) + L * DM; const float* wrg = inp(F, I_WRG) + (size_t)L * DM * NGRP; const float* wre = inp(F, I_WRE) + (size_t)L * NGRP * DM * EPG;
    for (int k = F.tid; k < DM; k += NTHREADS) Wg[k] = *(const f32x4*)(wrg + (size_t)k * 4) * gf[k];
    for (int idx = F.tid; idx < NGRP * DM; idx += NTHREADS) { const float g = gf[idx & (DM - 1)]; const f32x4* s = (const f32x4*)(wre + (size_t)idx * 8); Wl[idx] = s[0] * g; Wh[idx] = s[1] * g; }
    __syncthreads();
    const float* brg = inp(F, I_BRG) + L * NGRP; const float* bre = inp(F, I_BRE2) + L * NGRP * EPG;
    unsigned* cnt = ctl + CW_CNT + L * 64 * CNT_STRIDE; SlotInfo* slots = (SlotInfo*)(ws + WS_SLOT);
    const int gw = F.even ? (F.vcu / (F.G / 8)) * SEQ + (F.vcu % (F.G / 8)) * NWAVES + F.wave : F.vcu * NWAVES + F.wave, NGW = F.even ? (F.G / 8) * NWAVES : F.G * NWAVES;
    const int T_END = F.even ? (F.vcu / (F.G / 8) + 1) * SEQ : T;
    int my_t = -1, my_e0 = 0, my_e1 = 0; float my_w0 = 0.f, my_w1 = 0.f; int nr = 0;
    float xn_[16];
    { const float* xr = xio + (size_t)gw * DM + F.lane;
#pragma unroll
      for (int j = 0; j < 16; ++j) xn_[j] = xr[64 * j]; }
    for (int t = gw; t < T_END; t += NGW, ++nr) {
        float xv[16]; float ss = 0.f;
#pragma unroll
        for (int j = 0; j < 16; ++j) { xv[j] = xn_[j]; ss += xv[j] * xv[j]; }
        { const int tn = (t + NGW < T_END) ? t + NGW : t; const float* xr = xio + (size_t)tn * DM + F.lane;
#pragma unroll
          for (int j = 0; j < 16; ++j) xn_[j] = xr[64 * j]; }
        const float rs = rsqrtf(wave_sum(ss) * (1.f / DM) + EPS);
        f32x4 ag = {0.f, 0.f, 0.f, 0.f};
#pragma unroll
        for (int j = 0; j < 16; ++j) ag += Wg[F.lane + 64 * j] * xv[j];
        float lg[4];
#pragma unroll
        for (int c = 0; c < 4; ++c) lg[c] = wave_sum(ag[c]) * rs + brg[c];
        int grp = 0; float gmax = lg[0];
#pragma unroll
        for (int c = 1; c < 4; ++c) if (lg[c] > gmax) { gmax = lg[c]; grp = c; }
        float gden = 0.f;
#pragma unroll
        for (int c = 0; c < 4; ++c) gden += __expf(lg[c] - gmax);
        const float p_grp = 1.f / gden;
        grp = __builtin_amdgcn_readfirstlane(grp);
        f32x4 al = {0.f, 0.f, 0.f, 0.f}, ah = {0.f, 0.f, 0.f, 0.f};
#pragma unroll
        for (int j = 0; j < 16; ++j) { const int idx = grp * DM + F.lane + 64 * j; al += Wl[idx] * xv[j]; ah += Wh[idx] * xv[j]; }
        float le[8];
#pragma unroll
        for (int c = 0; c < 4; ++c) { le[c] = wave_sum(al[c]) * rs + bre[grp * EPG + c]; le[4 + c] = wave_sum(ah[c]) * rs + bre[grp * EPG + 4 + c]; }
        int i0 = 0; float v0 = le[0];
#pragma unroll
        for (int c = 1; c < 8; ++c) if (le[c] > v0) { v0 = le[c]; i0 = c; }
        int i1 = -1; float v1 = -3.0e38f;
#pragma unroll
        for (int c = 0; c < 8; ++c) if (c != i0 && le[c] > v1) { v1 = le[c]; i1 = c; }
        const float e1 = __expf(v1 - v0);
        const float w0 = p_grp / (1.f + e1), w1 = p_grp * e1 / (1.f + e1);
        if (F.lane == (nr & 63)) { my_t = t; my_e0 = grp * EPG + i0; my_e1 = grp * EPG + i1; my_w0 = w0; my_w1 = w1; }
        if ((nr & 63) == 63 || t + NGW >= T_END) {
            if (my_t >= 0) {
                const unsigned p0 = atomicAdd(cnt + my_e0 * CNT_STRIDE, 1u), p1 = atomicAdd(cnt + (32 + my_e1) * CNT_STRIDE, 1u);
                slots[(size_t)my_e0 * T + p0] = SlotInfo{my_t, my_w0}; slots[(size_t)(32 + my_e1) * T + p1] = SlotInfo{my_t, my_w1};
            }
            my_t = -1;
        }
    }
}
constexpr int LDS_TB_OFF = 143360;
__device__ __forceinline__ void moe_tables(const Frame& F0, int L, unsigned* ctl) {
    const Frame F = refresh(F0);
    LAS int* tb = (LAS int*)(F.lds + LDS_TB_OFF); LAS int* tc = tb + 80;
    if (F.tid < 64) tc[F.tid] = (int)__hip_atomic_load(ctl + CW_CNT + (L * 64 + F.tid) * CNT_STRIDE, __ATOMIC_RELAXED, __HIP_MEMORY_SCOPE_AGENT);
    __syncthreads();
    if (F.tid == 0) { int s = 0; for (int i = 0; i < 64; ++i) { tb[i] = s; s += (tc[i] + 255) >> 8; } tb[64] = s; }
    __syncthreads();
    if (F.tid < 64) { const int t0 = tb[F.tid], t1 = tb[F.tid + 1]; for (int t = t0; t < t1; ++t) tb[160 + t] = F.tid; }
    __syncthreads();
}
__device__ __forceinline__ void moe_gather_tables(const Frame& F0, const pg8::MoeSched& S, const SlotInfo* slots, const float* part) {
    const Frame F = refresh(F0);
    LAS unsigned* tokoff = (LAS unsigned*)(F.lds + PG8_TOKOFF_OFF); LAS float* ri = (LAS float*)(F.lds + PG8_ROWINFO_OFF);
    pg8::Unit u;
    for (int i = 0; i < 4 && S.next(i, u); ++i) {
        if (F.tid < 256) { const int p = u.mt * 256 + F.tid; SlotInfo si = SlotInfo{0, 0.f};
            if (p < u.cnt) si = slots[(size_t)(u.k * 32 + u.e) * T + p];
            const float rs = pg8::rowscale16(part, si.token);
            tokoff[i * 256 + F.tid] = (unsigned)si.token * (unsigned)(DM * 2); ri[(i * 256 + F.tid) * 2] = si.w; ri[(i * 256 + F.tid) * 2 + 1] = rs; }
    }
    __syncthreads();
}
__device__ __forceinline__ void moe_down_tables(const Frame& F0, const pg8::MoeSched& S, const SlotInfo* slots) {
    const Frame F = refresh(F0);
    LAS int* tk = (LAS int*)(F.lds + PG8_TOKOFF_OFF);
    pg8::Unit u;
    for (int i = 0; i < 4 && S.next(i, u); ++i) {
        if (F.tid < 256) { const int p = u.mt * 256 + F.tid; tk[i * 256 + F.tid] = (p < u.cnt) ? slots[(size_t)(u.k * 32 + u.e) * T + p].token : -1; }
    }
    __syncthreads();
}
__device__ __forceinline__ void moe_combine(const Frame& F0, int pm, int pn, float* x, const bf16* d0, const bf16* d1, bf16* xb, float* part) {
    const Frame F = refresh(F0);
    const int ch = F.lane & 31, rsub = F.lane >> 5;
#pragma unroll 2
    for (int it = 0; it < 16; ++it) {
        const size_t row = (size_t)pm * 256 + it * 16 + F.wave * 2 + rsub; const size_t o = row * 1024 + pn * 256 + ch * 8;
        const f32x4 a0 = *(const f32x4*)(x + o), a1 = *(const f32x4*)(x + o + 4); const v4u w0 = *(const v4u*)(d0 + o), w1 = *(const v4u*)(d1 + o);
        f32x4 v0, v1;
        v0.x = (a0.x + bflo(w0.x)) + bflo(w1.x); v0.y = (a0.y + bfhi(w0.x)) + bfhi(w1.x); v0.z = (a0.z + bflo(w0.y)) + bflo(w1.y); v0.w = (a0.w + bfhi(w0.y)) + bfhi(w1.y);
        v1.x = (a1.x + bflo(w0.z)) + bflo(w1.z); v1.y = (a1.y + bfhi(w0.z)) + bfhi(w1.z); v1.z = (a1.z + bflo(w0.w)) + bflo(w1.w); v1.w = (a1.w + bfhi(w0.w)) + bfhi(w1.w);
        *(f32x4*)(x + o) = v0; *(f32x4*)(x + o + 4) = v1;
        v4u ob; ob.x = f2bf(v0.x) | (f2bf(v0.y) << 16); ob.y = f2bf(v0.z) | (f2bf(v0.w) << 16); ob.z = f2bf(v1.x) | (f2bf(v1.y) << 16); ob.w = f2bf(v1.z) | (f2bf(v1.w) << 16);
        *(v4u*)(xb + o) = ob;
        float ss = (v0.x * v0.x + v0.y * v0.y) + (v0.z * v0.z + v0.w * v0.w) + (v1.x * v1.x + v1.y * v1.y) + (v1.z * v1.z + v1.w * v1.w);
        ss += __shfl_xor(ss, 1); ss += __shfl_xor(ss, 2); ss += __shfl_xor(ss, 4); ss += __shfl_xor(ss, 8); ss += __shfl_xor(ss, 16);
        if (ch < 4) part[row * 16 + pn * 4 + ch] = (ch == 0) ? ss : 0.f;
    }
}
__device__ __forceinline__ void fill_rowscales(const Frame& F0, const pg8::StaticOrder& S, const float* part) {
    const Frame F = refresh(F0);
    LAS float* rsl = (LAS float*)(F.lds + PG8_RS_OFF);
    pg8::Unit u; const int half = F.tid >> 8, r = F.tid & 255;
    for (int i = 0; i < 8; i += 2) { if (S.next(i + half, u)) rsl[(i + half) * 256 + r] = pg8::rowscale16(part, u.pm * 256 + r); }
    __syncthreads();
}

__global__ void __launch_bounds__(NTHREADS, 2) mega_fwd(Args args) {
    extern __shared__ __attribute__((aligned(16))) unsigned char lds_raw[];
    Frame Fk;
    Fk.lds = (LAS unsigned char*)lds_raw;
    Fk.tid = threadIdx.x; Fk.lane = Fk.tid & 63; Fk.wave = __builtin_amdgcn_readfirstlane(Fk.tid >> 6);
    Fk.G = gridDim.x; { const int bx = blockIdx.x; Fk.vcu = (Fk.G % 8 == 0) ? (bx % 8) * (Fk.G / 8) + bx / 8 : bx; Fk.cid = bx; Fk.even = 0; }
    const Frame& F = Fk;
    volatile LAS unsigned* MISC = (volatile LAS unsigned*)(F.lds + MISC_OFF);
    if (F.tid < 64) MISC[F.tid] = 0u;
    if (F.tid < N_IN) ((LAS unsigned long long*)(F.lds + PTAB_OFF))[F.tid] = (unsigned long long)args.in[F.tid];
    __syncthreads();
    unsigned char* const ws = args.ws;
    XcdBarrier bar = xcd_barrier_post((unsigned*)(ws + WS_CTL) + CW_BAR, MISC + 8);
#define GRID_BAR() xcd_barrier(bar)
#define PHASE_WS unsigned long long wv_ = (unsigned long long)ws; asm volatile("" : "+s"(wv_)); GAS unsigned char* const w_ = (GAS unsigned char*)wv_
    constexpr size_t PARTSZ = (size_t)T * 16 * 4;
    const int NGW = F.G * NWAVES;

    { PHASE_WS; const Frame F = refresh(Fk); const int gw = F.vcu * NWAVES + F.wave;
      float* part = (float*)(w_ + WS_PART); bf16* X0 = (bf16*)(w_ + WS_X0); bf16* PB = (bf16*)(w_ + WS_PB); float* lamv = (float*)(w_ + WS_MISC);
    for (int m = gw; m < T; m += NGW) {
        const f32x4* xr = (const f32x4*)(inp(F, I_X) + (size_t)m * DM) + F.lane; float s = 0.f;
        v2u* o8 = (v2u*)(X0 + (size_t)m * DM) + F.lane;
#pragma unroll
        for (int j = 0; j < 4; ++j) { const f32x4 v = xr[64 * j]; s += v.x * v.x + v.y * v.y + v.z * v.z + v.w * v.w;
            v2u w; w.x = f2bf(v.x) | (f2bf(v.y) << 16); w.y = f2bf(v.z) | (f2bf(v.w) << 16); o8[64 * j] = w; }
        s = wave_sum(s);
        if (F.lane < 16) part[(size_t)m * 16 + F.lane] = (F.lane == 0) ? s : 0.f;
    }
    for (size_t i = (size_t)(blockIdx.x * NTHREADS + F.tid) * 4; i < (size_t)DEPTH * T * PLE; i += (size_t)F.G * NTHREADS * 4) {
        const f32x4 v = *(const f32x4*)(inp(F, I_P) + i); v2u w; w.x = f2bf(v.x) | (f2bf(v.y) << 16); w.y = f2bf(v.z) | (f2bf(v.w) << 16); *(v2u*)(PB + i) = w; }
    if (blockIdx.x == 0 && F.tid < DEPTH) {
        const float* lq = inp(F, I_LAMQK) + F.tid * 4 * HD; float s1 = 0.f, s2 = 0.f;
        for (int j = 0; j < HD; ++j) { s1 += lq[j] * lq[HD + j]; s2 += lq[2 * HD + j] * lq[3 * HD + j]; }
        lamv[F.tid] = expf(s1) - expf(s2) + lam_init_for(F.tid);
    }
    convert_weights(Fk, 0, (unsigned char*)(w_ + WS_WT));
    ssm_tables(Fk, 0, (unsigned char*)(w_ + WS_SSMT));
    }
    GRID_BAR();
    { const unsigned ev = MISC[8 + 3], hx = MISC[8 + 2], hr = MISC[8 + 4];
      if (ev) { Fk.even = 1; Fk.vcu = (int)(hx * (unsigned)(Fk.G / 8) + hr); Fk.cid = (int)(hr * 8u + hx); } }
#define LOCAL_BAR() do { if (Fk.even) xcc_barrier(bar); else xcd_barrier(bar); } while (0)

#define GEMM_PHASE(EPI, Aptr, WOFF, N_, K_, E_) do { pg8::Gemm g_{(const pg8::bf16_t*)(Aptr), (const pg8::bf16_t*)(unsigned char*)(w_ + WS_WT + (WOFF)), T, (N_), (K_)}; pg8::StaticOrder S_; S_.init(T, (N_), F.G, F.cid); \
        pg8::gemm_phase<EPI, pg8::StaticOrder, true, true>(F.lds, g_, S_, E_); } while (0)
#define P_XA ((bf16*)(unsigned char*)(w_ + ((L & 1) ? WS_X1 : WS_X0)))
#define P_XB ((bf16*)(unsigned char*)(w_ + ((L & 1) ? WS_X0 : WS_X1)))
#define P_PART ((float*)(unsigned char*)(w_ + WS_PART + (size_t)(L & 1) * PARTSZ))
#define P_PART2 ((float*)(unsigned char*)(w_ + WS_PART + (size_t)((L & 1) ^ 1) * PARTSZ))
#define P_(T_, OFF) ((T_*)(unsigned char*)(w_ + (OFF)))
#pragma unroll 1
    for (int L = 0; L < DEPTH; ++L) {
        if (L > 0) { { PHASE_WS; convert_weights(Fk, L, (unsigned char*)(w_ + WS_WT)); ssm_tables(Fk, L, (unsigned char*)(w_ + WS_SSMT)); } GRID_BAR(); }
        { PHASE_WS; pg8::EpiWinF E{F.lds, P_(bf16, WS_Q), P_(bf16, WS_K), P_(bf16, WS_V), P_(bf16, WS_U), P_(bf16, WS_GATES), inp(F, I_QG) + L * 2 * HD, inp(F, I_KG) + L * 2 * HD, inp(F, I_BGATE) + L * 2 * DM};
          { pg8::StaticOrder S0; S0.init(T, INW, F.G, F.cid); fill_rowscales(Fk, S0, P_PART); }
          GEMM_PHASE(pg8::EpiWinF, P_XA, WT_WIN, INW, DM, E); }
        LOCAL_BAR();
        { PHASE_WS;
          for (int it = F.vcu; it < BATCH * NG; it += F.G)
              ssm_item_mfma(Fk, L, it, P_(const bf16, WS_U), P_(bf16, WS_Z), P_(const unsigned char, WS_SSMT),
                            (float*)((unsigned char*)P_XB + (size_t)(F.vcu >> 5) * (4 * MiB) + (size_t)(F.vcu & 31) * 65536)); }
        { PHASE_WS; const Frame F = refresh(Fk);
          const float lam = P_(float, WS_MISC)[L]; const float oml = 1.f - lam_init_for(L); const float* subln = inp(F, I_SUBLN) + L * 2 * HD;
          static_assert(attn_body::ATTN_LDS_BYTES <= PTAB_OFF, "attention LDS");
          for (int v = F.vcu; v < BATCH * NH * 4; v += F.G) {
              const int bh = v >> 2, s = v & 3;
#pragma unroll 1
              for (int i = 0; i < 2; ++i)
                  attn_body::dattn_unit<8>(bh >> 3, bh & 7, i ? s : 7 - s, P_(const attn_body::bf16, WS_Q), P_(const attn_body::bf16, WS_K), P_(const attn_body::bf16, WS_V), P_(attn_body::bf16, WS_Q), (char*)lds_raw, lam, subln, oml);
          } }
        LOCAL_BAR();
        { PHASE_WS; pg8::EpiGluF E{P_(bf16, WS_Z), P_(bf16, WS_Z2), inp(F, I_BGLU) + L * SSMW}; GEMM_PHASE(pg8::EpiGluF, P_(bf16, WS_Z), WT_WGLU, SSMW, SSMW, E); }
        LOCAL_BAR();
        { PHASE_WS; pg8::EpiGateF E{P_(bf16, WS_GATES), DM, nullptr, P_(bf16, WS_PARTS)}; GEMM_PHASE(pg8::EpiGateF, P_(bf16, WS_Z2), WT_WSU, DM, SSMW, E); }
        LOCAL_BAR();
        { PHASE_WS; pg8::EpiGateF E{P_(bf16, WS_GATES), 0, P_(bf16, WS_PARTS), P_(bf16, WS_MIXED)}; GEMM_PHASE(pg8::EpiGateF, P_(bf16, WS_Q), WT_WAU, DM, VW, E); }
        LOCAL_BAR();
        { PHASE_WS; const float* xbase = (L == 0) ? inp(F, I_X) : args.out;
          pg8::EpiResF E{xbase, args.out, P_XB, P_PART2}; GEMM_PHASE(pg8::EpiResF, P_(bf16, WS_MIXED), WT_WOUT, DM, DM, E); }
        LOCAL_BAR();
        { PHASE_WS; pg8::EpiPlainF E{P_(bf16, WS_PLE), 2 * DM};        GEMM_PHASE(pg8::EpiPlainF, P_(bf16, WS_PB) + (size_t)L * T * PLE, WT_WPLE, DM, PLE, E);
          router_phase(Fk, L, args.out, P_(unsigned, WS_CTL), (unsigned char*)w_); }
        GRID_BAR();
        { PHASE_WS; moe_tables(Fk, L, P_(unsigned, WS_CTL));
          pg8::MoeSched S{(LAS const int*)(F.lds + LDS_TB_OFF), (LAS const int*)(F.lds + LDS_TB_OFF) + 80, F.G, F.cid, 0};
          moe_gather_tables(Fk, S, P_(const SlotInfo, WS_SLOT), P_PART2);
          pg8::Gemm g{(const pg8::bf16_t*)P_XB, (const pg8::bf16_t*)(unsigned char*)(w_ + WS_WT + WT_WGU), T, 512, DM};
          pg8::EpiActF E{P_(pg8::bf16_t, WS_ACT), F.lds};
          pg8::gemm_phase_g<pg8::EpiActF, pg8::MoeSched>(F.lds, g, S, E); }
        GRID_BAR();
        { PHASE_WS; moe_tables(Fk, L, P_(unsigned, WS_CTL));
          pg8::MoeSched S{(LAS const int*)(F.lds + LDS_TB_OFF), (LAS const int*)(F.lds + LDS_TB_OFF) + 80, F.G, F.cid, 3};
          pg8::Gemm g{P_(const pg8::bf16_t, WS_ACT), (const pg8::bf16_t*)(unsigned char*)(w_ + WS_WT + WT_WD), T, DM, EFF};
          moe_down_tables(Fk, S, P_(const SlotInfo, WS_SLOT));
          pg8::EpiDownStoreF E{F.lds, P_(pg8::bf16_t, WS_Q), (size_t)(WS_K - WS_Q) / 2};
          pg8::gemm_phase<pg8::EpiDownStoreF, pg8::MoeSched, true, true>(F.lds, g, S, E); }
        GRID_BAR();
        { PHASE_WS; pg8::StaticOrder S0; S0.init(T, DM, F.G, F.cid); pg8::Unit u0;
          for (int i = 0; S0.next(i, u0); ++i) moe_combine(Fk, u0.pm, u0.pn, args.out, P_(const bf16, WS_Q), P_(const bf16, WS_K), P_XA, P_PART); }
        LOCAL_BAR();
        { PHASE_WS; pg8::EpiPleF E{F.lds, P_(bf16, WS_PLE), args.out, P_XB, P_PART2};
          { pg8::StaticOrder S0; S0.init(T, DM, F.G, F.cid); fill_rowscales(Fk, S0, P_PART); }
          GEMM_PHASE(pg8::EpiPleF, P_XA, WT_WPG, DM, DM, E); }
        GRID_BAR();
    }
}

extern "C" void kernel_launch(void* const* d_in, const int* in_sizes, int n_in, void* d_out, int out_size, void* d_ws, size_t ws_size, hipStream_t stream) {
    static int grid = 0;
    if (grid == 0) {
        if (n_in != N_IN || in_sizes[0] != T * DM || out_size != T * DM || ws_size < WS_END) {
            fprintf(stderr, "kernel_launch: unexpected problem (n_in %d, in0 %d, out %d, ws %zu); nothing launched\n", n_in, n_in > 0 ? in_sizes[0] : -1, out_size, ws_size); grid = -1; return; }
        int dev = 0, cus = 0, per_cu = 0;
        if (hipGetDevice(&dev) != hipSuccess || hipDeviceGetAttribute(&cus, hipDeviceAttributeMultiprocessorCount, dev) != hipSuccess) { grid = -1; return; }
        if (hipFuncSetAttribute((const void*)mega_fwd, hipFuncAttributeMaxDynamicSharedMemorySize, LDS_BYTES) != hipSuccess) { fprintf(stderr, "kernel_launch: hipFuncSetAttribute failed\n"); grid = -1; return; }
        if (hipOccupancyMaxActiveBlocksPerMultiprocessor(&per_cu, (const void*)mega_fwd, NTHREADS, LDS_BYTES) != hipSuccess || per_cu < 1)
            fprintf(stderr, "kernel_launch: note: occupancy query reports %d workgroups per CU\n", per_cu);
        (void)hipGetLastError();
        grid = cus;
    }
    if (grid < 0) return;
    if (hipMemsetAsync((char*)d_ws + WS_CTL, 0, CTL_ZERO_BYTES, stream) != hipSuccess) { fprintf(stderr, "kernel_launch: memset failed\n"); return; }
    Args a{};
    for (int i = 0; i < N_IN; ++i) a.in[i] = (const float*)d_in[i];
    a.out = (float*)d_out; a.ws = (unsigned char*)d_ws;
    hipLaunchKernelGGL(mega_fwd, dim3(grid), dim3(NTHREADS), LDS_BYTES, stream, a);
    const hipError_t le = hipPeekAtLastError();
    if (le != hipSuccess) fprintf(stderr, "kernel_launch: launch failed: %s\n", hipGetErrorName(le));
}
```

```cpp
#include <hip/hip_runtime.h>
#include <cstdio>
#include <cstdint>
#include <cmath>
#include <hip/hip_bf16.h>

#define GAS __attribute__((address_space(1)))
#define LAS __attribute__((address_space(3)))
typedef unsigned short bf16;
typedef unsigned v4u __attribute__((ext_vector_type(4)));
typedef unsigned v2u __attribute__((ext_vector_type(2)));
typedef float f32x4 __attribute__((ext_vector_type(4)));

constexpr int DM = 1024, BATCH = 8, SEQ = 2048, T = BATCH * SEQ, DEPTH = 2;
constexpr int NH = 8, HD = 64, QKW = 1024, VW = 1024, SSMW = 512, SG = 16, NG = 32, SP = 64;
constexpr int INW = 5632, NGRP = 4, EPG = 8, NEXP = 32, EFF = 256, PLE = 256;
constexpr float EPS = 1e-6f;
constexpr float C2 = 0.125f * 1.4426950408889634f;
constexpr int NWAVES = 8, NTHREADS = 512;

enum { I_X = 0, I_P, I_ATTN_G, I_WIN, I_BGATE, I_QG, I_KG, I_LAMQK, I_SUBLN, I_WAU, I_LRE, I_LIM, I_LSTEP, I_BRE, I_BIM, I_CRE, I_CIM,
       I_SSMD, I_WGLU, I_BGLU, I_WSU, I_WOUT, I_FFN_G, I_WRG, I_BRG, I_WRE, I_BRE2, I_WEG, I_WEU, I_WED, I_PLE_G, I_WPG, I_WPLE, N_IN };

constexpr size_t MiB = 1u << 20;
constexpr size_t WS_CTL = 0, CTL_ZERO_BYTES = 1 * MiB;
constexpr size_t WS_PART = 1 * MiB;
constexpr size_t WS_MISC = 3 * MiB;
constexpr size_t WS_SLOT = 4 * MiB;
constexpr size_t WS_WT = 16 * MiB;
constexpr size_t WS_X0 = 84 * MiB, WS_X1 = 116 * MiB;
constexpr size_t WS_Q = 148 * MiB, WS_K = 180 * MiB, WS_V = 212 * MiB;
constexpr size_t WS_U = 244 * MiB, WS_Z = 260 * MiB;
constexpr size_t WS_GATES = 276 * MiB;
constexpr size_t WS_PB = 340 * MiB;
constexpr size_t WS_SSMT = 356 * MiB;
constexpr size_t WS_END = 364 * MiB;
constexpr size_t WS_Z2 = WS_U, WS_MIXED = WS_K, WS_PARTS = WS_V, WS_PLE = WS_GATES, WS_OTMP = WS_X0, WS_ACT = WS_V;
struct SlotInfo { int token; float w; };
constexpr int CW_BAR = 4096;
constexpr int CW_CNT = 16384, CNT_STRIDE = 64;

__device__ __forceinline__ unsigned f2bf(float f) { unsigned u = __builtin_bit_cast(unsigned, f); return (u + 0x7fffu + ((u >> 16) & 1u)) >> 16; }
__device__ __forceinline__ float bf2f(unsigned b) { return __builtin_bit_cast(float, b << 16); }
__device__ __forceinline__ float bflo(unsigned w) { return __builtin_bit_cast(float, w << 16); }
__device__ __forceinline__ float bfhi(unsigned w) { return __builtin_bit_cast(float, w & 0xffff0000u); }
__device__ __forceinline__ float wave_sum(float v) {
#pragma unroll
    for (int o = 1; o < 64; o <<= 1) v += __shfl_xor(v, o);
    return v;
}
__device__ __forceinline__ float sigmoidf_(float x) { return 1.f / (1.f + __expf(-x)); }
__device__ __forceinline__ float gelu_tanh(float x) { const float u = 0.7978845608028654f * (x + 0.044715f * x * x * x); return 0.5f * x * (1.f + tanhf(u)); }
__device__ __forceinline__ float rowscale(const float* part, int row) {
    const f32x4* p = (const f32x4*)(part + (size_t)row * 16);
    float s = 0.f;
#pragma unroll
    for (int i = 0; i < 4; ++i) { const f32x4 v = p[i]; s += v.x; s += v.y; s += v.z; s += v.w; }
    return rsqrtf(s * (1.f / DM) + EPS);
}
__host__ __device__ inline float lam_init_for(int i) { return 0.8f - 0.6f * expf(-0.3f * (float)i); }

#define XB_TMO      128
#define XB_XCNT(j)  (256  + 64 * (j))
#define XB_XSUB(j)  (1280 + 64 * (j))
#define XB_XGEN(j)  (2304 + 64 * (j))
#define XB_TOP      3328
#define XB_TOPGEN   3392
#define XB_LSUB(j)  (3456 + 64 * (j))
#define XB_LGEN(j)  (4480 + 64 * (j))
#define XCD_BAR_WORDS 5504
#define XB_SPIN_CAP (1u << 22)
__device__ __forceinline__ unsigned xb_ld(unsigned* p)              { return __hip_atomic_load(p, __ATOMIC_RELAXED, __HIP_MEMORY_SCOPE_AGENT); }
__device__ __forceinline__ unsigned xb_add(unsigned* p, unsigned v) { return __hip_atomic_fetch_add(p, v, __ATOMIC_RELAXED, __HIP_MEMORY_SCOPE_AGENT); }
__device__ __forceinline__ unsigned xb_xcc_id() { return (unsigned)__builtin_amdgcn_s_getreg((3 << 11) | 20) & 0xFu; }
#define XB_SPIN(cond, bar) do { unsigned _sp = 0; while (cond) { __builtin_amdgcn_s_sleep(1); \
    if ((++_sp & 255u) == 0u) { if (xb_ld(&(bar)[XB_TMO])) break; if (_sp > XB_SPIN_CAP) { atomicAdd(&(bar)[XB_TMO], 1u); break; } } } } while (0)
struct XcdBarrier { unsigned* bar; unsigned x; volatile LAS unsigned* st; };
__device__ __forceinline__ XcdBarrier xcd_barrier_post(unsigned* bar, volatile LAS unsigned* st) {
    XcdBarrier b; b.bar = bar; b.x = 0; b.st = st;
    if (threadIdx.x == 0) { const unsigned x = xb_xcc_id(); st[2] = x; st[4] = xb_add(&bar[XB_XCNT(x)], 1u); }
    return b;
}
__device__ __forceinline__ void xcd_barrier_complete(unsigned* bar, unsigned x, unsigned& nloc, unsigned& nx) {
    const unsigned G = gridDim.x * gridDim.y * gridDim.z;
    unsigned sum, cnt, mine, sp = 0u;
    for (;;) {
        sum = 0u; cnt = 0u; mine = 0u;
#pragma unroll
        for (unsigned j = 0; j < 16; ++j) { const unsigned c = xb_ld(&bar[XB_XCNT(j)]); sum += c; cnt += (c > 0u) ? 1u : 0u; mine = (j == x) ? c : mine; }
        if (sum == G) break;
        __builtin_amdgcn_s_sleep(1);
        if ((++sp & 255u) == 0u) { if (xb_ld(&bar[XB_TMO])) break; if (sp > XB_SPIN_CAP) { atomicAdd(&bar[XB_TMO], 1u); break; } }
    }
    nloc = mine > 0u ? mine : 1u; nx = cnt > 0u ? cnt : 1u;
}
__device__ __forceinline__ unsigned xcd_census_even(unsigned* bar) {
    const unsigned G = gridDim.x; unsigned ok = (G % 8u == 0u) ? 1u : 0u;
#pragma unroll
    for (unsigned j = 0; j < 16; ++j) { const unsigned c = xb_ld(&bar[XB_XCNT(j)]); if (c != (j < 8u ? G / 8u : 0u)) ok = 0u; }
    return ok;
}
__device__ __forceinline__ void xcd_barrier(const XcdBarrier& b) {
    asm volatile("s_waitcnt vmcnt(0)" ::: "memory");
    __syncthreads();
    if (threadIdx.x == 0) {
        unsigned* bar = b.bar;
        __builtin_amdgcn_s_waitcnt(0);
        unsigned nloc = b.st[0], nx = b.st[1]; const unsigned bx = b.st[2];
        if (nloc == 0u) { xcd_barrier_complete(bar, bx, nloc, nx); b.st[0] = nloc; b.st[1] = nx; b.st[3] = xcd_census_even(bar); }
        const unsigned old = xb_add(&bar[XB_XSUB(bx)], 1u);
        const unsigned gen = old / nloc;
        if (old + 1u == (gen + 1u) * nloc) {
            __builtin_amdgcn_fence(__ATOMIC_RELEASE, "agent");
            asm volatile("s_waitcnt vmcnt(0)" ::: "memory");
            const unsigned og = xb_add(&bar[XB_TOP], 1u);
            const unsigned tg = og / nx;
            if (og + 1u == (tg + 1u) * nx) xb_add(&bar[XB_TOPGEN], 1u);
            else XB_SPIN(xb_ld(&bar[XB_TOPGEN]) == tg, bar);
            __builtin_amdgcn_fence(__ATOMIC_ACQUIRE, "agent");
            xb_add(&bar[XB_XGEN(bx)], 1u);
            asm volatile("s_waitcnt vmcnt(0)" ::: "memory");
        } else {
            XB_SPIN(xb_ld(&bar[XB_XGEN(bx)]) == gen, bar);
            __builtin_amdgcn_fence(__ATOMIC_ACQUIRE, "agent");
            asm volatile("s_waitcnt vmcnt(0)" ::: "memory");
        }
    }
    __syncthreads();
}

__device__ __forceinline__ void xcc_barrier(const XcdBarrier& b) {
    asm volatile("s_waitcnt vmcnt(0)" ::: "memory");
    __syncthreads();
    if (threadIdx.x == 0) {
        unsigned* bar = b.bar;
        __builtin_amdgcn_s_waitcnt(0);
        const unsigned nloc = b.st[0], bx = b.st[2];
        const unsigned old = xb_add(&bar[XB_LSUB(bx)], 1u);
        const unsigned gen = old / nloc;
        if (old + 1u == (gen + 1u) * nloc) xb_add(&bar[XB_LGEN(bx)], 1u);
        else XB_SPIN(xb_ld(&bar[XB_LGEN(bx)]) == gen, bar);
        __builtin_amdgcn_fence(__ATOMIC_ACQUIRE, "agent");
        asm volatile("s_waitcnt vmcnt(0)" ::: "memory");
    }
    __syncthreads();
}

constexpr int LDS_BYTES = 160 * 1024 - 1024;
constexpr int MISC_OFF = LDS_BYTES - 256;
constexpr int PTAB_OFF = LDS_BYTES - 1024;

struct Args { const float* in[N_IN]; float* out; unsigned char* ws; };

struct Frame {
    LAS unsigned char* lds;
    int tid, lane, wave, vcu, G, cid, even;
};
__device__ __forceinline__ Frame refresh(const Frame& F0) {
    Frame F = F0; int t = F0.tid; asm volatile("" : "+v"(t)); F.tid = t; F.lane = t & 63; F.wave = __builtin_amdgcn_readfirstlane(t >> 6); return F;
}
__device__ __forceinline__ const float* inp(const Frame& F, int i) {
    const LAS unsigned* p = (const LAS unsigned*)(F.lds + PTAB_OFF) + 2 * i;
    const unsigned lo = __builtin_amdgcn_readfirstlane(p[0]), hi = __builtin_amdgcn_readfirstlane(p[1]);
    return (const float*)(const GAS float*)(((unsigned long long)hi << 32) | lo);
}

namespace pg8 {
#define PG8_LAS __attribute__((address_space(3)))
typedef unsigned short bf16_t;
typedef short bf16x8 __attribute__((ext_vector_type(8)));
typedef float f32x4 __attribute__((ext_vector_type(4)));
typedef unsigned u32x4 __attribute__((ext_vector_type(4)));
constexpr int BM = 256, BK = 64, HALF = 128, HTB = HALF * BK * 2  , STAGE_BYTES = 8 * HTB, NXCD = 8, WGM = 8;

__host__ __device__ __forceinline__ int lds_byte(int r, int c) { const int st = (r >> 4) * 2 + (c >> 5), rr = r & 15, cc = c & 31, ob = rr * 64 + cc * 2; return st * 1024 + (ob ^ (((ob >> 9) & 1) << 5)); }
__host__ __device__ __forceinline__ void stage_rc(int b, int& R, int& C) { const int st = b / 1024, sb = b % 1024, swz = sb ^ (((sb >> 9) & 1) << 5); R = (st >> 1) * 16 + swz / 64; C = (st & 1) * 32 + (swz % 64) / 2; }
__host__ __device__ __forceinline__ int perm32(int rho) { const int n = rho >> 4, i = rho & 15; return 8 * (i >> 2) + 4 * n + (i & 3); }

struct Unit { int pm, pn, e, mt, cnt, pl, k, slot; };
struct Gemm { const bf16_t* A; const bf16_t* Bt; int M, N, K; };

struct StaticOrder {
    int nM, nN, nwg, G, c;
    __host__ __device__ __forceinline__ void init(int M, int N, int G_, int c_) { nM = M / BM; nN = N / BM; nwg = nM * nN; G = G_; c = c_; }
    __host__ __device__ __forceinline__ bool next(int i, Unit& u) const {
        const long L = (long)i * G + c; if (L >= nwg) return false;
        int wgid = (int)L; { const int q = nwg / NXCD, r = nwg % NXCD, xcd = wgid % NXCD, off = wgid / NXCD; wgid = (xcd < r ? xcd * (q + 1) : r * (q + 1) + (xcd - r) * q) + off; }
        const int nig = WGM * nN, gid = wgid / nig, fm = gid * WGM, gsz = (nM - fm) < WGM ? (nM - fm) : WGM;
        u.pm = fm + ((wgid % nig) % gsz); u.pn = (wgid % nig) / gsz; u.slot = i; return true;
    }
    __device__ __forceinline__ void a_ready(const Unit&) const {}
    __device__ __forceinline__ void done(const Unit&) const {}
};
typedef float f32x2_t __attribute__((ext_vector_type(2))); typedef __bf16 bf16x2_t __attribute__((ext_vector_type(2)));
__device__ __forceinline__ unsigned cvt_pk_bf16(float lo, float hi) { f32x2_t v = {lo, hi}; bf16x2_t b = __builtin_convertvector(v, bf16x2_t); return __builtin_bit_cast(unsigned, b); }

__device__ __forceinline__ float rowscale16(const float* part, int row) {
    const f32x4* p = (const f32x4*)(part + (size_t)row * 16); float s = 0.f;
#pragma unroll
    for (int i = 0; i < 4; ++i) { const f32x4 v = p[i]; s += v[0]; s += v[1]; s += v[2]; s += v[3]; }
    return rsqrtf(s * (1.f / 1024.f) + EPS);
}
__device__ __forceinline__ u32x4 pack8(f32x4 a, f32x4 b) { u32x4 w; w.x = cvt_pk_bf16(a[0], a[1]); w.y = cvt_pk_bf16(a[2], a[3]); w.z = cvt_pk_bf16(b[0], b[1]); w.w = cvt_pk_bf16(b[2], b[3]); return w; }
__device__ __forceinline__ void unpack8(u32x4 w, f32x4& a, f32x4& b) {
    a = (f32x4){__builtin_bit_cast(float, w.x << 16), __builtin_bit_cast(float, w.x & 0xffff0000u), __builtin_bit_cast(float, w.y << 16), __builtin_bit_cast(float, w.y & 0xffff0000u)};
    b = (f32x4){__builtin_bit_cast(float, w.z << 16), __builtin_bit_cast(float, w.z & 0xffff0000u), __builtin_bit_cast(float, w.w << 16), __builtin_bit_cast(float, w.w & 0xffff0000u)};
}
__device__ __forceinline__ float sig1(float x) { return __builtin_amdgcn_rcpf(1.f + __builtin_amdgcn_exp2f(-1.4426950408889634f * x)); }
__device__ __forceinline__ f32x4 sig4(f32x4 x) { return (f32x4){sig1(x[0]), sig1(x[1]), sig1(x[2]), sig1(x[3])}; }
__device__ __forceinline__ float dot4(f32x4 x) { return (x[0] * x[0] + x[1] * x[1]) + (x[2] * x[2] + x[3] * x[3]); }

#define PG8_TOKOFF_OFF 131072
#define PG8_ROWINFO_OFF 135168
#define PG8_RS_OFF 144384
struct EpiWinF {
    static constexpr bool PERM = false, AFTER_DRAIN = false;
    PG8_LAS const unsigned char* lds; bf16_t *q, *k, *v, *u, *gates; const float *qg, *kg, *bgate;
    __device__ __forceinline__ void operator()(const f32x4 (&acc)[2][2][4][2], const Unit& un, int wr, int wc, int, int) const {
        int l_ = threadIdx.x; asm volatile("" : "+v"(l_)); const int fr = l_ & 15, fq = (l_ >> 4) & 3;
        const int pn = un.pn, rl0 = wr * 64 + fr; const size_t row0 = (size_t)un.pm * BM + rl0;
        PG8_LAS const float* rsl = (PG8_LAS const float*)(lds + PG8_RS_OFF) + un.slot * 256 + rl0;
        if (pn < 8) {
            const bool isq = pn < 4; bf16_t* dst = isq ? q : k; const int cb = (pn & 3) * 256 + wc * 64 + fq * 8;
            const float* gn = (isq ? qg : kg) + (wc & 1) * 64 + fq * 8; const float sc = isq ? C2 : 1.f;
            f32x4 gv[2][2];
#pragma unroll
            for (int bj = 0; bj < 2; ++bj)
#pragma unroll
                for (int n = 0; n < 2; ++n) gv[bj][n] = *(const f32x4*)(gn + bj * 32 + n * 4) * sc;
#pragma unroll
            for (int ai = 0; ai < 2; ++ai)
#pragma unroll
                for (int m = 0; m < 4; ++m) {
                    const float rs = rsl[ai * HALF + m * 16];
                    float ss = (dot4(acc[ai][0][m][0]) + dot4(acc[ai][0][m][1])) + (dot4(acc[ai][1][m][0]) + dot4(acc[ai][1][m][1]));
                    ss += __shfl_xor(ss, 16); ss += __shfl_xor(ss, 32);
                    const float inv = rsqrtf(ss * rs * rs * (1.f / 64.f) + EPS) * rs;
                    bf16_t* rowp = dst + (row0 + ai * HALF + m * 16) * 1024 + cb;
#pragma unroll
                    for (int bj = 0; bj < 2; ++bj) *(u32x4*)(rowp + bj * 32) = pack8(acc[ai][bj][m][0] * inv * gv[bj][0], acc[ai][bj][m][1] * inv * gv[bj][1]);
                }
        } else if (pn < 14) {
            bf16_t* dst; int ld, cb;
            if (pn < 12) { dst = v; ld = 1024; cb = (pn - 8) * 256; } else { dst = u; ld = 512; cb = (pn - 12) * 256; }
            cb += wc * 64 + fq * 8;
#pragma unroll
            for (int ai = 0; ai < 2; ++ai)
#pragma unroll
                for (int m = 0; m < 4; ++m) {
                    const float rs = rsl[ai * HALF + m * 16];
                    bf16_t* rowp = dst + (row0 + ai * HALF + m * 16) * ld + cb;
#pragma unroll
                    for (int bj = 0; bj < 2; ++bj) *(u32x4*)(rowp + bj * 32) = pack8(acc[ai][bj][m][0] * rs, acc[ai][bj][m][1] * rs);
                }
        } else {
            const int cb = (pn - 14) * 256 + wc * 64 + fq * 8;
            f32x4 bv[2][2];
#pragma unroll
            for (int bj = 0; bj < 2; ++bj)
#pragma unroll
                for (int n = 0; n < 2; ++n) bv[bj][n] = *(const f32x4*)(bgate + cb + bj * 32 + n * 4);
#pragma unroll
            for (int ai = 0; ai < 2; ++ai)
#pragma unroll
                for (int m = 0; m < 4; ++m) {
                    const float rs = rsl[ai * HALF + m * 16];
                    bf16_t* rowp = gates + (row0 + ai * HALF + m * 16) * 2048 + cb;
#pragma unroll
                    for (int bj = 0; bj < 2; ++bj) *(u32x4*)(rowp + bj * 32) = pack8(sig4(acc[ai][bj][m][0] * rs + bv[bj][0]), sig4(acc[ai][bj][m][1] * rs + bv[bj][1]));
                }
        }
    }
};
struct EpiGluF {
    static constexpr bool PERM = false, AFTER_DRAIN = false;
    const bf16_t* z; bf16_t* z2; const float* b;
    __device__ __forceinline__ void operator()(const f32x4 (&acc)[2][2][4][2], const Unit& un, int wr, int wc, int, int) const {
        int l_ = threadIdx.x; asm volatile("" : "+v"(l_)); const int fr = l_ & 15, fq = (l_ >> 4) & 3;
        const int cb = un.pn * 256 + wc * 64 + fq * 8; const size_t row0 = (size_t)un.pm * BM + wr * 64 + fr;
        f32x4 bv[2][2];
#pragma unroll
        for (int bj = 0; bj < 2; ++bj)
#pragma unroll
            for (int n = 0; n < 2; ++n) bv[bj][n] = *(const f32x4*)(b + cb + bj * 32 + n * 4);
#pragma unroll
        for (int ai = 0; ai < 2; ++ai) {
            u32x4 zw[4][2];
#pragma unroll
            for (int m = 0; m < 4; ++m)
#pragma unroll
                for (int bj = 0; bj < 2; ++bj) zw[m][bj] = *(const u32x4*)(z + (row0 + ai * HALF + m * 16) * 512 + cb + bj * 32);
#pragma unroll
            for (int m = 0; m < 4; ++m)
#pragma unroll
                for (int bj = 0; bj < 2; ++bj) { f32x4 z0, z1; unpack8(zw[m][bj], z0, z1);
                    *(u32x4*)(z2 + (row0 + ai * HALF + m * 16) * 512 + cb + bj * 32) = pack8(z0 * sig4(acc[ai][bj][m][0] + bv[bj][0]), z1 * sig4(acc[ai][bj][m][1] + bv[bj][1])); }
        }
    }
};
struct EpiPlainF {
    static constexpr bool PERM = false, AFTER_DRAIN = false;
    bf16_t* o; int ld;
    __device__ __forceinline__ void operator()(const f32x4 (&acc)[2][2][4][2], const Unit& un, int wr, int wc, int, int) const {
        int l_ = threadIdx.x; asm volatile("" : "+v"(l_)); const int fr = l_ & 15, fq = (l_ >> 4) & 3;
        const int row0 = un.pm * BM + wr * 64 + fr, cb = un.pn * 256 + wc * 64 + fq * 8;
#pragma unroll
        for (int ai = 0; ai < 2; ++ai)
#pragma unroll
            for (int m = 0; m < 4; ++m) {
                const int row = row0 + ai * HALF + m * 16;
#pragma unroll
                for (int bj = 0; bj < 2; ++bj) *(u32x4*)(o + (size_t)row * ld + cb + bj * 32) = pack8(acc[ai][bj][m][0], acc[ai][bj][m][1]);
            }
    }
};
struct EpiGateF {
    static constexpr bool PERM = false, AFTER_DRAIN = false;
    const bf16_t* gates; int goff; const bf16_t* add; bf16_t* o;
    __device__ __forceinline__ void operator()(const f32x4 (&acc)[2][2][4][2], const Unit& un, int wr, int wc, int, int) const {
        int l_ = threadIdx.x; asm volatile("" : "+v"(l_)); const int fr = l_ & 15, fq = (l_ >> 4) & 3;
        const int cb = un.pn * 256 + wc * 64 + fq * 8; const size_t row0 = (size_t)un.pm * BM + wr * 64 + fr;
#pragma unroll
        for (int ai = 0; ai < 2; ++ai) {
            u32x4 gw[4][2], aw[4][2];
#pragma unroll
            for (int m = 0; m < 4; ++m)
#pragma unroll
                for (int bj = 0; bj < 2; ++bj) { const size_t row = row0 + ai * HALF + m * 16; const int c = cb + bj * 32;
                    gw[m][bj] = *(const u32x4*)(gates + row * 2048 + goff + c); if (add) aw[m][bj] = *(const u32x4*)(add + row * 1024 + c); }
#pragma unroll
            for (int m = 0; m < 4; ++m)
#pragma unroll
                for (int bj = 0; bj < 2; ++bj) { const size_t row = row0 + ai * HALF + m * 16; const int c = cb + bj * 32; f32x4 g0, g1; unpack8(gw[m][bj], g0, g1);
                    f32x4 v0 = g0 * acc[ai][bj][m][0], v1 = g1 * acc[ai][bj][m][1];
                    if (add) { f32x4 a0, a1; unpack8(aw[m][bj], a0, a1); v0 += a0; v1 += a1; }
                    *(u32x4*)(o + row * 1024 + c) = pack8(v0, v1); }
        }
    }
};
struct EpiResF {
    static constexpr bool PERM = false, AFTER_DRAIN = false;
    const float* base; float* out; bf16_t* xb; float* part;
    __device__ __forceinline__ void operator()(const f32x4 (&acc)[2][2][4][2], const Unit& un, int wr, int wc, int, int) const {
        int l_ = threadIdx.x; asm volatile("" : "+v"(l_)); const int fr = l_ & 15, fq = (l_ >> 4) & 3;
        const int cb = un.pn * 256 + wc * 64 + fq * 8; const size_t row0 = (size_t)un.pm * BM + wr * 64 + fr;
#pragma unroll
        for (int ai = 0; ai < 2; ++ai) {
            f32x4 bl[4][2][2];
#pragma unroll
            for (int m = 0; m < 4; ++m)
#pragma unroll
                for (int bj = 0; bj < 2; ++bj) { const size_t o = (row0 + ai * HALF + m * 16) * 1024 + cb + bj * 32; bl[m][bj][0] = *(const f32x4*)(base + o); bl[m][bj][1] = *(const f32x4*)(base + o + 4); }
#pragma unroll
            for (int m = 0; m < 4; ++m) {
                const size_t row = row0 + ai * HALF + m * 16; float ss = 0.f;
#pragma unroll
                for (int bj = 0; bj < 2; ++bj) { const size_t o = row * 1024 + cb + bj * 32;
                    const f32x4 v0 = bl[m][bj][0] + acc[ai][bj][m][0], v1 = bl[m][bj][1] + acc[ai][bj][m][1];
                    *(f32x4*)(out + o) = v0; *(f32x4*)(out + o + 4) = v1; *(u32x4*)(xb + o) = pack8(v0, v1); ss += dot4(v0) + dot4(v1); }
                ss += __shfl_xor(ss, 16); ss += __shfl_xor(ss, 32);
                if (fq == 0) part[row * 16 + un.pn * 4 + wc] = ss;
            }
        }
    }
};
struct EpiPleF {
    static constexpr bool PERM = false, AFTER_DRAIN = false;
    PG8_LAS const unsigned char* lds; const bf16_t* ple; float* out; bf16_t* xb; float* part_out;
    __device__ __forceinline__ void operator()(const f32x4 (&acc)[2][2][4][2], const Unit& un, int wr, int wc, int, int) const {
        int l_ = threadIdx.x; asm volatile("" : "+v"(l_)); const int fr = l_ & 15, fq = (l_ >> 4) & 3;
        const int cb = un.pn * 256 + wc * 64 + fq * 8, rl0 = wr * 64 + fr; const size_t row0 = (size_t)un.pm * BM + rl0;
        PG8_LAS const float* rsl = (PG8_LAS const float*)(lds + PG8_RS_OFF) + un.slot * 256 + rl0;
#pragma unroll
        for (int ai = 0; ai < 2; ++ai)
#pragma unroll
            for (int mp = 0; mp < 2; ++mp) {
                u32x4 pw[2][2]; f32x4 xl[2][2][2];
#pragma unroll
                for (int mm = 0; mm < 2; ++mm)
#pragma unroll
                    for (int bj = 0; bj < 2; ++bj) { const size_t o = (row0 + ai * HALF + (2 * mp + mm) * 16) * 1024 + cb + bj * 32; pw[mm][bj] = *(const u32x4*)(ple + 2 * o - (cb + bj * 32)); xl[mm][bj][0] = *(const f32x4*)(out + o); xl[mm][bj][1] = *(const f32x4*)(out + o + 4); }
#pragma unroll
                for (int mm = 0; mm < 2; ++mm) {
                    const int m = 2 * mp + mm; const size_t row = row0 + ai * HALF + m * 16; const float rs = rsl[ai * HALF + m * 16]; float ss = 0.f;
#pragma unroll
                    for (int bj = 0; bj < 2; ++bj) { const size_t o = row * 1024 + cb + bj * 32; f32x4 p0, p1; unpack8(pw[mm][bj], p0, p1);
                        const f32x4 v0 = xl[mm][bj][0] + sig4(acc[ai][bj][m][0] * rs) * p0, v1 = xl[mm][bj][1] + sig4(acc[ai][bj][m][1] * rs) * p1;
                        *(f32x4*)(out + o) = v0; *(f32x4*)(out + o + 4) = v1; *(u32x4*)(xb + o) = pack8(v0, v1); ss += dot4(v0) + dot4(v1); }
                    ss += __shfl_xor(ss, 16); ss += __shfl_xor(ss, 32);
                    if (fq == 0) part_out[row * 16 + un.pn * 4 + wc] = ss;
                }
            }
    }
};
template <class Epi, class Sched, bool ALIGN_EPI = false, bool SP2 = false>
__device__ __forceinline__ void gemm_phase(PG8_LAS unsigned char* lds, const Gemm g, const Sched& S, const Epi& E) {
    int tid_ = threadIdx.x; asm volatile("" : "+v"(tid_)); const int tid = tid_, wid = __builtin_amdgcn_readfirstlane(tid >> 6), lane = tid & 63, wr = wid >> 2, wc = wid & 3, fr = lane & 15, fq = lane >> 4;
    const int K = g.K, nt = K / BK;
    unsigned voffA[2], voffB[2];
#pragma unroll
    for (int i = 0; i < 2; ++i) { int R, C; stage_rc(tid * 16 + i * 8192, R, C); const int Rb = Epi::PERM ? ((R & ~31) + perm32(R & 31)) : R;
        voffA[i] = (unsigned)(R * K + C) * 2u; voffB[i] = (unsigned)(Rb * K + C) * 2u; }
    const size_t kstep = (size_t)(BK * 2);
    const size_t hstep = (size_t)HALF * K * 2;
    const size_t tstep = 2 * hstep;
    const unsigned ldsw = (unsigned)wid * 1024u;
    const int aoff = lds_byte(wr * 64 + fr, fq * 8), boff = lds_byte(wc * 32 + fr, fq * 8);
#define PG8_SA(b, h) (((b) * 2 + (h)) * HTB)
#define PG8_SB(b, h) ((4 + (b) * 2 + (h)) * HTB)
#define PG8_STAGE(bufoff, gbase, voff) do { _Pragma("unroll") for (int _i = 0; _i < 2; ++_i) \
        __builtin_amdgcn_global_load_lds((const unsigned*)((const char*)(gbase) + (voff)[_i]), (PG8_LAS unsigned*)(lds + (bufoff) + ldsw + _i * 8192), 16, 0, 0); } while (0)
#define PG8_LDA(dst, b, h) do { _Pragma("unroll") for (int m = 0; m < 4; ++m) _Pragma("unroll") for (int k = 0; k < 2; ++k) dst[m][k] = *(const PG8_LAS bf16x8*)(lds + PG8_SA(b, h) + aoff + m * 2048 + k * 1024); } while (0)
#define PG8_LDB(dst, b, h) do { _Pragma("unroll") for (int n = 0; n < 2; ++n) _Pragma("unroll") for (int k = 0; k < 2; ++k) dst[n][k] = *(const PG8_LAS bf16x8*)(lds + PG8_SB(b, h) + boff + n * 2048 + k * 1024); } while (0)
#define PG8_MMA(ai, bj, At, Bt) do { __builtin_amdgcn_s_setprio(1); _Pragma("unroll") for (int m = 0; m < 4; ++m) _Pragma("unroll") for (int n = 0; n < 2; ++n) _Pragma("unroll") for (int k = 0; k < 2; ++k) \
        acc[ai][bj][m][n] = __builtin_amdgcn_mfma_f32_16x16x32_bf16(Bt[n][k], At[m][k], acc[ai][bj][m][n], 0, 0, 0); __builtin_amdgcn_s_setprio(0); } while (0)
#define PG8_WAIT_V(n) asm volatile("s_waitcnt vmcnt(" #n ")" ::: "memory")
#define PG8_WAIT_L(n) asm volatile("s_waitcnt lgkmcnt(" #n ")" ::: "memory")
#define PG8_BAR __builtin_amdgcn_s_barrier()
#define PG8_SCHED __builtin_amdgcn_sched_barrier(0)
    Unit cur, nxt; int ui = 0;
    if (!S.next(0, cur)) return;
    f32x4 acc[2][2][4][2];
#pragma unroll
    for (int a = 0; a < 2; ++a)
#pragma unroll
        for (int b = 0; b < 2; ++b)
#pragma unroll
            for (int m = 0; m < 4; ++m)
#pragma unroll
                for (int n = 0; n < 2; ++n) acc[a][b][m][n] = (f32x4){0.f, 0.f, 0.f, 0.f};
    bf16x8 At[4][2], B0[2][2], B1[2][2];
    const char* cA = (const char*)g.A + (size_t)cur.pm * tstep; const char* cB = (const char*)g.Bt + (size_t)cur.pn * tstep;
    S.a_ready(cur);
    if constexpr (SP2) {
        PG8_STAGE(PG8_SB(0, 0), cB, voffB); PG8_STAGE(PG8_SB(0, 1), cB + hstep, voffB); PG8_STAGE(PG8_SA(0, 0), cA, voffA); PG8_STAGE(PG8_SA(0, 1), cA + hstep, voffA);
        if (wr == 1) PG8_BAR;
        PG8_WAIT_V(2); PG8_BAR;
        PG8_STAGE(PG8_SB(1, 0), cB + kstep, voffB); PG8_STAGE(PG8_SA(1, 0), cA + kstep, voffA); PG8_STAGE(PG8_SB(1, 1), cB + hstep + kstep, voffB);
        PG8_WAIT_V(6); PG8_BAR;
    } else {
        PG8_STAGE(PG8_SB(0, 0), cB, voffB); PG8_STAGE(PG8_SA(0, 0), cA, voffA); PG8_STAGE(PG8_SB(0, 1), cB + hstep, voffB); PG8_STAGE(PG8_SA(0, 1), cA + hstep, voffA);
        if (wr == 1) PG8_BAR;
        PG8_WAIT_V(4); PG8_BAR;
        PG8_STAGE(PG8_SB(1, 0), cB + kstep, voffB); PG8_STAGE(PG8_SA(1, 0), cA + kstep, voffA); PG8_STAGE(PG8_SB(1, 1), cB + hstep + kstep, voffB);
        PG8_WAIT_V(6); PG8_BAR;
    }
    for (;;) {
        const bool has_next = S.next(ui + 1, nxt);
        const char* nA = has_next ? (const char*)g.A + (size_t)nxt.pm * tstep : cA; const char* nB = has_next ? (const char*)g.Bt + (size_t)nxt.pn * tstep : cB;
#pragma unroll 1
        for (int t = 0; t < nt; t += 2) {
            const bool last = (t == nt - 2);
            const char* a1 = cA + (size_t)(t + 1) * kstep;
            const char* a2 = last ? nA : cA + (size_t)(t + 2) * kstep; const char* b2 = last ? nB : cB + (size_t)(t + 2) * kstep;
            const char* a3 = a2 + kstep; const char* b3 = b2 + kstep;
            if (last && has_next) S.a_ready(nxt);
            if constexpr (SP2) {
            PG8_LDB(B0, 0, 0); PG8_LDB(B1, 0, 1); PG8_SCHED; PG8_LDA(At, 0, 0); PG8_STAGE(PG8_SA(1, 1), a1 + hstep, voffA);
            PG8_WAIT_V(8); PG8_WAIT_L(0); PG8_BAR; PG8_MMA(0, 0, At, B0); PG8_MMA(0, 1, At, B1); PG8_BAR; PG8_SCHED;
            PG8_LDA(At, 0, 1); PG8_STAGE(PG8_SB(0, 0), b2, voffB); PG8_STAGE(PG8_SB(0, 1), b2 + hstep, voffB); PG8_STAGE(PG8_SA(0, 0), a2, voffA);
            PG8_WAIT_V(8); PG8_WAIT_L(0); PG8_BAR; PG8_MMA(1, 0, At, B0); PG8_MMA(1, 1, At, B1); PG8_BAR; PG8_SCHED;
            PG8_LDB(B0, 1, 0); PG8_LDB(B1, 1, 1); PG8_SCHED; PG8_LDA(At, 1, 0); PG8_STAGE(PG8_SA(0, 1), a2 + hstep, voffA);
            PG8_WAIT_V(8); PG8_WAIT_L(0); PG8_BAR; PG8_MMA(0, 0, At, B0); PG8_MMA(0, 1, At, B1); PG8_BAR; PG8_SCHED;
            PG8_LDA(At, 1, 1); PG8_STAGE(PG8_SB(1, 0), b3, voffB); PG8_STAGE(PG8_SB(1, 1), b3 + hstep, voffB); PG8_STAGE(PG8_SA(1, 0), a3, voffA);
            PG8_WAIT_V(8); PG8_WAIT_L(0); PG8_BAR; PG8_MMA(1, 0, At, B0); PG8_MMA(1, 1, At, B1); PG8_BAR; PG8_SCHED;
            } else {
            PG8_LDB(B0, 0, 0); PG8_SCHED; PG8_LDA(At, 0, 0); PG8_STAGE(PG8_SA(1, 1), a1 + hstep, voffA);
            PG8_WAIT_L(8); PG8_BAR; PG8_WAIT_L(0); PG8_MMA(0, 0, At, B0); PG8_BAR; PG8_SCHED;
            PG8_LDB(B1, 0, 1); PG8_STAGE(PG8_SB(0, 0), b2, voffB);
            PG8_BAR; PG8_WAIT_L(0); PG8_MMA(0, 1, At, B1); PG8_BAR;
            PG8_LDA(At, 0, 1); PG8_STAGE(PG8_SA(0, 0), a2, voffA);
            PG8_BAR; PG8_WAIT_L(0); PG8_MMA(1, 0, At, B0); PG8_BAR; PG8_SCHED;
            PG8_STAGE(PG8_SB(0, 1), b2 + hstep, voffB);
            PG8_WAIT_V(6); PG8_BAR; PG8_MMA(1, 1, At, B1); PG8_BAR;
            PG8_LDB(B0, 1, 0); PG8_SCHED; PG8_LDA(At, 1, 0); PG8_STAGE(PG8_SA(0, 1), a2 + hstep, voffA);
            PG8_WAIT_L(8); PG8_BAR; PG8_WAIT_L(0); PG8_MMA(0, 0, At, B0); PG8_BAR; PG8_SCHED;
            PG8_LDB(B1, 1, 1); PG8_STAGE(PG8_SB(1, 0), b3, voffB);
            PG8_BAR; PG8_WAIT_L(0); PG8_MMA(0, 1, At, B1); PG8_BAR;
            PG8_LDA(At, 1, 1); PG8_STAGE(PG8_SA(1, 0), a3, voffA);
            PG8_BAR; PG8_WAIT_L(0); PG8_MMA(1, 0, At, B0); PG8_BAR; PG8_SCHED;
            PG8_STAGE(PG8_SB(1, 1), b3 + hstep, voffB);
            PG8_WAIT_V(6); PG8_BAR; PG8_MMA(1, 1, At, B1); PG8_BAR;
            }
        }
        if constexpr (ALIGN_EPI) { if (wr == 0) PG8_BAR; }
        if constexpr (!Epi::AFTER_DRAIN) { E(acc, cur, wr, wc, fr, fq); S.done(cur); }
        if (!has_next) break;
#pragma unroll
        for (int a = 0; a < 2; ++a)
#pragma unroll
            for (int b = 0; b < 2; ++b)
#pragma unroll
                for (int m = 0; m < 4; ++m)
#pragma unroll
                    for (int n = 0; n < 2; ++n) acc[a][b][m][n] = (f32x4){0.f, 0.f, 0.f, 0.f};
        cur = nxt; cA = nA; cB = nB; ++ui;
        if constexpr (ALIGN_EPI) { if (wr == 1) PG8_BAR; }
    }
    PG8_WAIT_V(0);
    if constexpr (!ALIGN_EPI) { if (wr == 0) PG8_BAR; }
    PG8_BAR;
    if constexpr (Epi::AFTER_DRAIN) { E.fused(acc, cur, wr, wc, fr, fq, lds, wid, lane); S.done(cur); }
#undef PG8_SA
#undef PG8_SB
#undef PG8_STAGE
#undef PG8_LDA
#undef PG8_LDB
#undef PG8_MMA
#undef PG8_WAIT_V
#undef PG8_WAIT_L
#undef PG8_BAR
#undef PG8_SCHED
}

struct EpiActF {
    static constexpr bool PERM = false, AFTER_DRAIN = false;
    bf16_t* act; PG8_LAS const unsigned char* lds;
    __device__ __forceinline__ void operator()(const f32x4 (&acc)[2][2][4][2], const Unit& un, int wr, int wc, int, int) const {
        int l_ = threadIdx.x; asm volatile("" : "+v"(l_)); const int fr = l_ & 15, fq = (l_ >> 4) & 3;
        typedef float f32x2v __attribute__((ext_vector_type(2)));
        PG8_LAS const f32x2v* ri = (PG8_LAS const f32x2v*)(lds + PG8_ROWINFO_OFF) + un.slot * 256;
#pragma unroll
        for (int ai = 0; ai < 2; ++ai)
#pragma unroll
            for (int m = 0; m < 4; ++m) {
                const int r = ai * HALF + wr * 64 + m * 16 + fr; const f32x2v wi = ri[r]; const float w = wi.x, rs = wi.y;
                f32x4 a[2];
#pragma unroll
                for (int n = 0; n < 2; ++n) { const f32x4 g = acc[ai][0][m][n] * rs, u = acc[ai][1][m][n] * rs; a[n] = g * sig4(g) * u * w; }
                *(u32x4*)(act + ((size_t)un.pm * 256 + r) * 256 + un.pl * 128 + wc * 32 + fq * 8) = pack8(a[0], a[1]);
            }
    }
};
template <int KK> struct EpiDownF {
    static constexpr bool PERM = false, AFTER_DRAIN = false;
    PG8_LAS const unsigned char* lds; float* out; bf16_t* xb; float* part;
    __device__ __forceinline__ void operator()(const f32x4 (&acc)[2][2][4][2], const Unit& un, int wr, int wc, int, int) const {
        int l_ = threadIdx.x; asm volatile("" : "+v"(l_)); const int fr = l_ & 15, fq = (l_ >> 4) & 3;
        const int cb = un.pl * 256 + wc * 64 + fq * 8;
        PG8_LAS const int* tk = (PG8_LAS const int*)(lds + PG8_TOKOFF_OFF) + un.slot * 256 + wr * 64 + fr;
#pragma unroll
        for (int ai = 0; ai < 2; ++ai) {
            int tok[4]; f32x4 bl[4][2][2];
#pragma unroll
            for (int m = 0; m < 4; ++m) { tok[m] = tk[ai * HALF + m * 16]; const size_t rb = (size_t)(tok[m] < 0 ? 0 : tok[m]) * 1024 + cb;
#pragma unroll
                for (int bj = 0; bj < 2; ++bj) { bl[m][bj][0] = *(const f32x4*)(out + rb + bj * 32); bl[m][bj][1] = *(const f32x4*)(out + rb + bj * 32 + 4); } }
#pragma unroll
            for (int m = 0; m < 4; ++m) {
                const bool valid = tok[m] >= 0; const size_t rb = (size_t)(valid ? tok[m] : 0) * 1024 + cb; float ss = 0.f;
#pragma unroll
                for (int bj = 0; bj < 2; ++bj) { const size_t o = rb + bj * 32;
                    const f32x4 v0 = bl[m][bj][0] + acc[ai][bj][m][0], v1 = bl[m][bj][1] + acc[ai][bj][m][1];
                    if (valid) { *(f32x4*)(out + o) = v0; *(f32x4*)(out + o + 4) = v1; if (KK) *(u32x4*)(xb + o) = pack8(v0, v1); }
                    ss += dot4(v0) + dot4(v1); }
                if (KK) { ss += __shfl_xor(ss, 16); ss += __shfl_xor(ss, 32); if (valid && fq == 0) part[(size_t)tok[m] * 16 + un.pl * 4 + wc] = ss; }
            }
        }
    }
};
struct EpiDownStoreF {
    static constexpr bool PERM = false, AFTER_DRAIN = false;
    PG8_LAS const unsigned char* lds; bf16_t* d; size_t kstride;
    __device__ __forceinline__ void operator()(const f32x4 (&acc)[2][2][4][2], const Unit& un, int wr, int wc, int, int) const {
        int l_ = threadIdx.x; asm volatile("" : "+v"(l_)); const int fr = l_ & 15, fq = (l_ >> 4) & 3;
        const int cb = un.pl * 256 + wc * 64 + fq * 8;
        PG8_LAS const int* tk = (PG8_LAS const int*)(lds + PG8_TOKOFF_OFF) + un.slot * 256 + wr * 64 + fr;
        bf16_t* dk = d + (size_t)un.k * kstride;
#pragma unroll
        for (int ai = 0; ai < 2; ++ai)
#pragma unroll
            for (int m = 0; m < 4; ++m) {
                const int tok = tk[ai * HALF + m * 16];
                if (tok >= 0) {
#pragma unroll
                    for (int bj = 0; bj < 2; ++bj) *(u32x4*)(dk + (size_t)tok * 1024 + cb + bj * 32) = pack8(acc[ai][bj][m][0], acc[ai][bj][m][1]);
                }
            }
    }
};
__device__ __forceinline__ int ldsu(PG8_LAS const int* p) { return __builtin_amdgcn_readfirstlane(*p); }
struct MoeSched {
    PG8_LAS const int* tb; PG8_LAS const int* tc; int G, c, mode;
    __device__ __forceinline__ bool next(int i, Unit& u) const {
        const int gi = i * G + c; int ti, pl;
        if (mode == 0) { ti = gi >> 1; pl = gi & 1; if (ti >= ldsu(tb + 64)) return false; }
        else if (mode == 3) { ti = gi >> 2; pl = gi & 3; if (ti >= ldsu(tb + 64)) return false; }
        else { ti = gi >> 2; pl = gi & 3; const int n0 = ldsu(tb + 32); if (mode == 2) { ti += n0; if (ti >= ldsu(tb + 64)) return false; } else if (ti >= n0) return false; }
        const int ke = ldsu(tb + 160 + ti);
        u.pm = ti; u.e = ke & 31; u.k = ke >> 5; u.mt = ti - ldsu(tb + ke); u.cnt = ldsu(tc + ke); u.pl = pl; u.slot = i; u.pn = (ke & 31) * (mode == 0 ? 2 : 4) + pl;
        return true;
    }
    __device__ __forceinline__ void a_ready(const Unit&) const {}
    __device__ __forceinline__ void done(const Unit&) const {}
};
template <class Epi, class Sched>
__device__ __forceinline__ void gemm_phase_g(PG8_LAS unsigned char* lds, const Gemm g, const Sched& S, const Epi& E) {
    int tid_ = threadIdx.x; asm volatile("" : "+v"(tid_)); const int tid = tid_, wid = __builtin_amdgcn_readfirstlane(tid >> 6), lane = tid & 63, wr = wid >> 2, wc = wid & 3, fr = lane & 15, fq = lane >> 4;
    const int K = g.K, nt = K / BK;
    unsigned voffB[2]; int RA[2]; unsigned CA2[2];
#pragma unroll
    for (int i = 0; i < 2; ++i) { int R, C; stage_rc(tid * 16 + i * 8192, R, C); voffB[i] = (unsigned)(R * K + C) * 2u; RA[i] = R; CA2[i] = (unsigned)C * 2u; }
    const size_t kstep = (size_t)(BK * 2), hstep = (size_t)HALF * K * 2, tstep = 2 * hstep;
    const unsigned ldsw = (unsigned)wid * 1024u;
    const int aoff = lds_byte(wr * 64 + fr, fq * 8), boff = lds_byte(wc * 32 + fr, fq * 8);
    PG8_LAS const unsigned* tokoff = (PG8_LAS const unsigned*)(lds + PG8_TOKOFF_OFF);
#define PG8_SA(b, h) (((b) * 2 + (h)) * HTB)
#define PG8_SB(b, h) ((4 + (b) * 2 + (h)) * HTB)
#define PG8_STAGE(bufoff, gbase, voff) do { _Pragma("unroll") for (int _i = 0; _i < 2; ++_i) \
        __builtin_amdgcn_global_load_lds((const unsigned*)((const char*)(gbase) + (voff)[_i]), (PG8_LAS unsigned*)(lds + (bufoff) + ldsw + _i * 8192), 16, 0, 0); } while (0)
#define PG8_STAGE_A(bufoff, gbase, o0, o1) do { \
        __builtin_amdgcn_global_load_lds((const unsigned*)((const char*)(gbase) + (o0)), (PG8_LAS unsigned*)(lds + (bufoff) + ldsw), 16, 0, 0); \
        __builtin_amdgcn_global_load_lds((const unsigned*)((const char*)(gbase) + (o1)), (PG8_LAS unsigned*)(lds + (bufoff) + ldsw + 8192), 16, 0, 0); } while (0)
#define PG8_GOFF(slot, d00, d01, d10, d11) do { PG8_LAS const unsigned* t_ = tokoff + (slot) * 256; \
        d00 = t_[RA[0]] + CA2[0]; d01 = t_[RA[1]] + CA2[1]; d10 = t_[128 + RA[0]] + CA2[0]; d11 = t_[128 + RA[1]] + CA2[1]; } while (0)
#define PG8_LDA(dst, b, h) do { _Pragma("unroll") for (int m = 0; m < 4; ++m) _Pragma("unroll") for (int k = 0; k < 2; ++k) dst[m][k] = *(const PG8_LAS bf16x8*)(lds + PG8_SA(b, h) + aoff + m * 2048 + k * 1024); } while (0)
#define PG8_LDB(dst, b, h) do { _Pragma("unroll") for (int n = 0; n < 2; ++n) _Pragma("unroll") for (int k = 0; k < 2; ++k) dst[n][k] = *(const PG8_LAS bf16x8*)(lds + PG8_SB(b, h) + boff + n * 2048 + k * 1024); } while (0)
#define PG8_MMA(ai, bj, At, Bt) do { __builtin_amdgcn_s_setprio(1); _Pragma("unroll") for (int m = 0; m < 4; ++m) _Pragma("unroll") for (int n = 0; n < 2; ++n) _Pragma("unroll") for (int k = 0; k < 2; ++k) \
        acc[ai][bj][m][n] = __builtin_amdgcn_mfma_f32_16x16x32_bf16(Bt[n][k], At[m][k], acc[ai][bj][m][n], 0, 0, 0); __builtin_amdgcn_s_setprio(0); } while (0)
#define PG8_WAIT_V(n) asm volatile("s_waitcnt vmcnt(" #n ")" ::: "memory")
#define PG8_WAIT_L(n) asm volatile("s_waitcnt lgkmcnt(" #n ")" ::: "memory")
#define PG8_BAR __builtin_amdgcn_s_barrier()
#define PG8_SCHED __builtin_amdgcn_sched_barrier(0)
    Unit cur, nxt; int ui = 0;
    if (!S.next(0, cur)) return;
    f32x4 acc[2][2][4][2];
#pragma unroll
    for (int a = 0; a < 2; ++a)
#pragma unroll
        for (int b = 0; b < 2; ++b)
#pragma unroll
            for (int m = 0; m < 4; ++m)
#pragma unroll
                for (int n = 0; n < 2; ++n) acc[a][b][m][n] = (f32x4){0.f, 0.f, 0.f, 0.f};
    bf16x8 At[4][2], B0[2][2], B1[2][2];
    unsigned gc00, gc01, gc10, gc11;
    PG8_GOFF(0, gc00, gc01, gc10, gc11);
    const char* A0 = (const char*)g.A; const char* cB = (const char*)g.Bt + (size_t)cur.pn * tstep;
    PG8_STAGE(PG8_SB(0, 0), cB, voffB); PG8_STAGE(PG8_SB(0, 1), cB + hstep, voffB); PG8_STAGE_A(PG8_SA(0, 0), A0, gc00, gc01); PG8_STAGE_A(PG8_SA(0, 1), A0, gc10, gc11);
    if (wr == 1) PG8_BAR;
    PG8_WAIT_V(2); PG8_BAR;
    PG8_STAGE(PG8_SB(1, 0), cB + kstep, voffB); PG8_STAGE_A(PG8_SA(1, 0), A0 + kstep, gc00, gc01); PG8_STAGE(PG8_SB(1, 1), cB + hstep + kstep, voffB);
    PG8_WAIT_V(6); PG8_BAR;
    for (;;) {
        const bool has_next = S.next(ui + 1, nxt);
        const char* nB = has_next ? (const char*)g.Bt + (size_t)nxt.pn * tstep : cB;
#pragma unroll 1
        for (int t = 0; t < nt; t += 2) {
            const bool last = (t == nt - 2);
            const char* a1 = A0 + (size_t)(t + 1) * kstep;
            const char* a2 = last ? A0 : A0 + (size_t)(t + 2) * kstep; const char* b2 = last ? nB : cB + (size_t)(t + 2) * kstep;
            const char* a3 = a2 + kstep; const char* b3 = b2 + kstep;
            unsigned g200 = gc00, g201 = gc01, g210 = gc10, g211 = gc11;
            if (last && has_next) { PG8_GOFF(ui + 1, g200, g201, g210, g211); }
            PG8_LDB(B0, 0, 0); PG8_LDB(B1, 0, 1); PG8_SCHED; PG8_LDA(At, 0, 0); PG8_STAGE_A(PG8_SA(1, 1), a1, gc10, gc11);
            PG8_WAIT_V(8); PG8_WAIT_L(0); PG8_BAR; PG8_MMA(0, 0, At, B0); PG8_MMA(0, 1, At, B1); PG8_BAR; PG8_SCHED;
            PG8_LDA(At, 0, 1); PG8_STAGE(PG8_SB(0, 0), b2, voffB); PG8_STAGE(PG8_SB(0, 1), b2 + hstep, voffB); PG8_STAGE_A(PG8_SA(0, 0), a2, g200, g201);
            PG8_WAIT_V(8); PG8_WAIT_L(0); PG8_BAR; PG8_MMA(1, 0, At, B0); PG8_MMA(1, 1, At, B1); PG8_BAR; PG8_SCHED;
            PG8_LDB(B0, 1, 0); PG8_LDB(B1, 1, 1); PG8_SCHED; PG8_LDA(At, 1, 0); PG8_STAGE_A(PG8_SA(0, 1), a2, g210, g211);
            PG8_WAIT_V(8); PG8_WAIT_L(0); PG8_BAR; PG8_MMA(0, 0, At, B0); PG8_MMA(0, 1, At, B1); PG8_BAR; PG8_SCHED;
            PG8_LDA(At, 1, 1); PG8_STAGE(PG8_SB(1, 0), b3, voffB); PG8_STAGE(PG8_SB(1, 1), b3 + hstep, voffB); PG8_STAGE_A(PG8_SA(1, 0), a3, g200, g201);
            PG8_WAIT_V(8); PG8_WAIT_L(0); PG8_BAR; PG8_MMA(1, 0, At, B0); PG8_MMA(1, 1, At, B1); PG8_BAR; PG8_SCHED;
        }
        if (wr == 0) PG8_BAR;
        E(acc, cur, wr, wc, fr, fq);
        if (!has_next) break;
#pragma unroll
        for (int a = 0; a < 2; ++a)
#pragma unroll
            for (int b = 0; b < 2; ++b)
#pragma unroll
                for (int m = 0; m < 4; ++m)
#pragma unroll
                    for (int n = 0; n < 2; ++n) acc[a][b][m][n] = (f32x4){0.f, 0.f, 0.f, 0.f};
        cur = nxt; cB = nB; ++ui; PG8_GOFF(ui, gc00, gc01, gc10, gc11);
        if (wr == 1) PG8_BAR;
    }
    PG8_WAIT_V(0);
    PG8_BAR;
#undef PG8_SA
#undef PG8_SB
#undef PG8_STAGE
#undef PG8_STAGE_A
#undef PG8_GOFF
#undef PG8_LDA
#undef PG8_LDB
#undef PG8_MMA
#undef PG8_WAIT_V
#undef PG8_WAIT_L
#undef PG8_BAR
#undef PG8_SCHED
}

}

__device__ __forceinline__ int p64_row(int c) { const int cl = c & 255; return (c & ~255) + 128 * ((cl >> 5) & 1) + 32 * (cl >> 6) + 16 * ((cl >> 2) & 1) + 4 * ((cl >> 3) & 3) + (cl & 3); }
__device__ __forceinline__ unsigned pk2(float lo, float hi) { return f2bf(lo) | (f2bf(hi) << 16); }
__device__ __forceinline__ int gu_row(int ff, int isup) { const int fl = ff & 127; return 256 * (ff >> 7) + 128 * isup + 32 * (fl >> 5) + 16 * ((fl >> 2) & 1) + 4 * ((fl >> 3) & 3) + (fl & 3); }
template <int MODE>
__device__ __forceinline__ void transpose_item(const float* W, int K, int N, bf16* WT, const float* gain, LAS float* scr, int item, int lane) {
    const int nblk = N / 32, kb = item / nblk, nb = item % nblk, k0 = 64 * kb, n0 = 32 * nb;
    const float* wp = W + (size_t)(k0 + (lane >> 5)) * N + n0 + (lane & 31);
    float wv[32];
#pragma unroll
    for (int i = 0; i < 32; ++i) wv[i] = wp[(size_t)(2 * i) * N];
    const int c = lane & 7;
    f32x4 g0 = {1.f, 1.f, 1.f, 1.f}, g1 = {1.f, 1.f, 1.f, 1.f};
    if (gain) { g0 = *(const f32x4*)(gain + k0 + 8 * c); g1 = *(const f32x4*)(gain + k0 + 8 * c + 4); }
#pragma unroll
    for (int i = 0; i < 32; ++i) scr[(2 * i + (lane >> 5)) * 33 + (lane & 31)] = wv[i];
    asm volatile("s_waitcnt lgkmcnt(0)" ::: "memory");
#pragma unroll
    for (int j = 0; j < 4; ++j) { const int n = (lane >> 3) + 8 * j; const LAS float* s = scr + (8 * c) * 33 + n;
        v4u o; o.x = pk2(s[0 * 33] * g0[0], s[1 * 33] * g0[1]); o.y = pk2(s[2 * 33] * g0[2], s[3 * 33] * g0[3]); o.z = pk2(s[4 * 33] * g1[0], s[5 * 33] * g1[1]); o.w = pk2(s[6 * 33] * g1[2], s[7 * 33] * g1[3]);
        const int drow = MODE == 0 ? p64_row(n0 + n) : gu_row(n0 + n, MODE == 2);
        *(v4u*)(WT + (size_t)drow * K + k0 + 8 * c) = o; }
    asm volatile("s_waitcnt lgkmcnt(0)" ::: "memory");
}
constexpr size_t WT_WIN = 0, WT_WAU = 12 * MiB, WT_WOUT = 14 * MiB, WT_WPG = 16 * MiB, WT_WGLU = 18 * MiB, WT_WSU = 18 * MiB + 512 * 1024, WT_WPLE = 19 * MiB + 512 * 1024, WT_WGU = 20 * MiB, WT_WD = 52 * MiB;
__device__ __forceinline__ void convert_weights(const Frame& F0, int L, unsigned char* wt) {
    const Frame F = refresh(F0);
    LAS float* scr = (LAS float*)(F.lds + F.wave * 16384);
    const int gw = F.vcu * NWAVES + F.wave, NGW = F.G * NWAVES;
    constexpr int I_IN = (DM / 64) * (INW / 32), I_SQ = (DM / 64) * (DM / 32), I_GLU = (SSMW / 64) * (SSMW / 32), I_SU = (SSMW / 64) * (DM / 32), I_PL = (PLE / 64) * (DM / 32);
    constexpr int I_EX = NEXP * 128;
    constexpr int NIT = I_IN + 3 * I_SQ + I_GLU + I_SU + I_PL + 3 * I_EX;
    for (int it = gw; it < NIT; it += NGW) {
        int r = it;
        if (r < I_IN) { transpose_item<0>(inp(F, I_WIN) + (size_t)L * DM * INW, DM, INW, (bf16*)(wt + WT_WIN), inp(F, I_ATTN_G) + L * DM, scr, r, F.lane); continue; } r -= I_IN;
        if (r < I_SQ) { transpose_item<0>(inp(F, I_WAU) + (size_t)L * DM * DM, DM, DM, (bf16*)(wt + WT_WAU), nullptr, scr, r, F.lane); continue; } r -= I_SQ;
        if (r < I_SQ) { transpose_item<0>(inp(F, I_WOUT) + (size_t)L * DM * DM, DM, DM, (bf16*)(wt + WT_WOUT), nullptr, scr, r, F.lane); continue; } r -= I_SQ;
        if (r < I_SQ) { transpose_item<0>(inp(F, I_WPG) + (size_t)L * DM * DM, DM, DM, (bf16*)(wt + WT_WPG), inp(F, I_PLE_G) + L * DM, scr, r, F.lane); continue; } r -= I_SQ;
        if (r < I_GLU) { transpose_item<0>(inp(F, I_WGLU) + (size_t)L * SSMW * SSMW, SSMW, SSMW, (bf16*)(wt + WT_WGLU), nullptr, scr, r, F.lane); continue; } r -= I_GLU;
        if (r < I_SU) { transpose_item<0>(inp(F, I_WSU) + (size_t)L * SSMW * DM, SSMW, DM, (bf16*)(wt + WT_WSU), nullptr, scr, r, F.lane); continue; } r -= I_SU;
        if (r < I_PL) { transpose_item<0>(inp(F, I_WPLE) + (size_t)L * PLE * DM, PLE, DM, (bf16*)(wt + WT_WPLE), nullptr, scr, r, F.lane); continue; } r -= I_PL;
        if (r < I_EX) { const int e = r >> 7; transpose_item<1>(inp(F, I_WEG) + ((size_t)L * NEXP + e) * DM * EFF, DM, EFF, (bf16*)(wt + WT_WGU) + (size_t)e * 512 * DM, inp(F, I_FFN_G) + L * DM, scr, r & 127, F.lane); continue; } r -= I_EX;
        if (r < I_EX) { const int e = r >> 7; transpose_item<2>(inp(F, I_WEU) + ((size_t)L * NEXP + e) * DM * EFF, DM, EFF, (bf16*)(wt + WT_WGU) + (size_t)e * 512 * DM, inp(F, I_FFN_G) + L * DM, scr, r & 127, F.lane); continue; } r -= I_EX;
        { const int e = r >> 7; transpose_item<0>(inp(F, I_WED) + ((size_t)L * NEXP + e) * EFF * DM, EFF, DM, (bf16*)(wt + WT_WD) + (size_t)e * DM * EFF, nullptr, scr, r & 127, F.lane); }
    }
}
#include <hip/hip_bf16.h>
namespace attn_body {
using bf16=__hip_bfloat16;
using bf16x8=__attribute__((ext_vector_type(8)))short;
using s16x4=__attribute__((ext_vector_type(4)))short;
using f32x16=__attribute__((ext_vector_type(16)))float;
using u32x4=__attribute__((ext_vector_type(4)))unsigned;
constexpr int BATCH=8,NHEAD=16,SEQ=2048,D=64,DM=NHEAD*D;
constexpr int NW=8,QBLK=32,QB=QBLK*NW,KVBLK=64,NQB=SEQ/QB;
constexpr int ATTN_PITCH=DM, ATTN_UNIT_ROWS=QB;
__device__ __forceinline__ int crow(int r,int hi){return (r&3)+8*(r>>2)+4*hi;}
#define SBAR() __builtin_amdgcn_sched_barrier(0)
__device__ __forceinline__ void cmask(f32x16&p0,f32x16&p1,int jb,int qrel,int hi){
  const float NEG=-INFINITY; int kb=64*jb+4*hi;
  #pragma unroll
  for(int r=0;r<16;++r){int kv=kb+(r&3)+8*(r>>2); if(kv>qrel)p0[r]=NEG; if(kv+32>qrel)p1[r]=NEG;}
}

constexpr int NSLOT=3, SLOTB=8192;
constexpr int LDS_K=0, LDS_V=NSLOT*SLOTB, LDS_WS=2*NSLOT*SLOTB, LDS_OST=LDS_WS+NW*64*4, LDS_BYTES=LDS_OST+NW*4096;
constexpr float C2=0.125f*1.4426950408889634f;
__device__ __forceinline__ void glds16(const void*gsrc,unsigned lds_dst){unsigned keep;
  asm volatile("s_mov_b32 %0, m0\n\ts_mov_b32 m0, %2\n\ts_nop 0\n\tglobal_load_lds_dwordx4 %1, off\n\ts_mov_b32 m0, %0":"=&s"(keep):"v"(gsrc),"s"(lds_dst):"memory");}
__device__ __forceinline__ float max3f(float a,float b,float c){float r;asm("v_max3_f32 %0, %1, %2, %3":"=v"(r):"v"(a),"v"(b),"v"(c));return r;}
__device__ __forceinline__ float max2f(float a,float b){float r;asm("v_max_f32_e32 %0, %1, %2":"=v"(r):"v"(a),"v"(b));return r;}
__device__ __forceinline__ float fadd_s(float a,float b){float r;asm("v_add_f32_e32 %0, %1, %2":"=v"(r):"v"(a),"v"(b));return r;}
__device__ __forceinline__ float fsub_s(float a,float b){float r;asm("v_sub_f32_e32 %0, %1, %2":"=v"(r):"v"(a),"v"(b));return r;}
typedef float f32x2_t __attribute__((ext_vector_type(2))); typedef __bf16 bf16x2_t __attribute__((ext_vector_type(2)));
__device__ __forceinline__ unsigned cvtpk_s(float lo,float hi){f32x2_t v={lo,hi};bf16x2_t b=__builtin_convertvector(v,bf16x2_t);return __builtin_bit_cast(unsigned,b);}
#define WAIT_BAR(N) asm volatile("s_waitcnt vmcnt(" #N ") lgkmcnt(0)\n\ts_barrier":::"memory")

__device__ __forceinline__ void qkt(f32x16&p0,f32x16&p1,const char*Kslot,const bf16x8*qr,const f32x16&negm,int r32,int hi){
  const char*kb=Kslot+hi*1024+r32*16;
  #pragma unroll
  for(int d0=0;d0<4;++d0){
    const bf16x8 b0=*reinterpret_cast<const bf16x8*>(kb+d0*2048);
    const bf16x8 b1=*reinterpret_cast<const bf16x8*>(kb+d0*2048+512);
    if(d0==0){p0=__builtin_amdgcn_mfma_f32_32x32x16_bf16(b0,qr[0],negm,0,0,0);p1=__builtin_amdgcn_mfma_f32_32x32x16_bf16(b1,qr[0],negm,0,0,0);}
    else{p0=__builtin_amdgcn_mfma_f32_32x32x16_bf16(b0,qr[d0],p0,0,0,0);p1=__builtin_amdgcn_mfma_f32_32x32x16_bf16(b1,qr[d0],p1,0,0,0);}}
}
typedef __attribute__((address_space(3))) const char* lds_cptr;
typedef short v4i16_t __attribute__((ext_vector_type(4)));
__device__ __forceinline__ void kload8(bf16x8*kf,lds_cptr kp){
  kf[0]=*(const __attribute__((address_space(3))) bf16x8*)(kp);      kf[1]=*(const __attribute__((address_space(3))) bf16x8*)(kp+512);
  kf[2]=*(const __attribute__((address_space(3))) bf16x8*)(kp+2048); kf[3]=*(const __attribute__((address_space(3))) bf16x8*)(kp+2560);
  kf[4]=*(const __attribute__((address_space(3))) bf16x8*)(kp+4096); kf[5]=*(const __attribute__((address_space(3))) bf16x8*)(kp+4608);
  kf[6]=*(const __attribute__((address_space(3))) bf16x8*)(kp+6144); kf[7]=*(const __attribute__((address_space(3))) bf16x8*)(kp+6656);
}
__device__ __forceinline__ void kload2(bf16x8*kf,lds_cptr kp,int j){ kf[2*j]=*(const __attribute__((address_space(3))) bf16x8*)(kp+j*2048); kf[2*j+1]=*(const __attribute__((address_space(3))) bf16x8*)(kp+j*2048+512); }
__device__ __forceinline__ s16x4 vtr(lds_cptr p){ return __builtin_bit_cast(s16x4,__builtin_amdgcn_ds_read_tr16_b64_v4i16((__attribute__((address_space(3))) v4i16_t*)p)); }
__device__ __forceinline__ float rowmax(const f32x16&p0,const f32x16&p1){
  float a=max3f(p0[0],p0[1],p1[0]),b=max3f(p0[2],p0[3],p1[1]);a=max3f(a,p1[2],p1[3]);
  #pragma unroll
  for(int r=4;r<16;r+=4){a=max3f(a,p0[r],p0[r+1]);b=max3f(b,p0[r+2],p0[r+3]);a=max3f(a,p1[r],p1[r+1]);b=max3f(b,p1[r+2],p1[r+3]);}
  const float m=max2f(a,b);
  auto rr=__builtin_amdgcn_permlane32_swap(__float_as_uint(m),__float_as_uint(m),false,false);
  return max2f(__uint_as_float(rr[0]),__uint_as_float(rr[1]));
}
__device__ __forceinline__ void pv(f32x16*o,int vb,bf16x8 pa0,bf16x8 pa1,bf16x8 pa2,bf16x8 pa3){
  #pragma unroll
  for(int d0=0;d0<2;++d0){s16x4 lo[4],hi[4];
    #pragma unroll
    for(int ks=0;ks<4;++ks){
      asm volatile("ds_read_b64_tr_b16 %0,%1 offset:%c2":"=&v"(lo[ks]):"v"(vb),"i"(d0*4096+ks*1024):"memory");
      asm volatile("ds_read_b64_tr_b16 %0,%1 offset:%c2":"=&v"(hi[ks]):"v"(vb),"i"(d0*4096+ks*1024+512):"memory");}
    asm volatile("s_waitcnt lgkmcnt(0)":::"memory");SBAR();
    #define PK(k) (bf16x8){lo[k][0],lo[k][1],lo[k][2],lo[k][3],hi[k][0],hi[k][1],hi[k][2],hi[k][3]}
    o[d0]=__builtin_amdgcn_mfma_f32_32x32x16_bf16(pa0,PK(0),o[d0],0,0,0);
    o[d0]=__builtin_amdgcn_mfma_f32_32x32x16_bf16(pa1,PK(1),o[d0],0,0,0);
    o[d0]=__builtin_amdgcn_mfma_f32_32x32x16_bf16(pa2,PK(2),o[d0],0,0,0);
    o[d0]=__builtin_amdgcn_mfma_f32_32x32x16_bf16(pa3,PK(3),o[d0],0,0,0);
    #undef PK
  }
}

#ifndef ATTN_STORE16
#define ATTN_STORE16(p,v) (*(u32x4*)(p)=(v))
#endif
template<int THRL> __device__ __forceinline__ void attn_pass(int b,int hq,int hv,int qb,const bf16*Q,const bf16*K,const bf16*V,char*shm,f32x16 (&o)[2],float (&rli)[16],bool pre_issued,int nhq,int nhv){
  int tid_=threadIdx.x; asm volatile("":"+v"(tid_)); const int tid=tid_,lane=tid&63,r32=lane&31,hi=lane>>5; const int wid=__builtin_amdgcn_readfirstlane(tid>>6);
  const long rowbase=(long)b*SEQ; const int q0=qb*QB;
  const bf16*Qw=Q+(rowbase+q0+wid*QBLK)*DM+hq*D;
  const bf16*Kh=K+rowbase*DM+hq*D,*Vh=V+rowbase*DM+hv*D;
  const unsigned lds0=(unsigned)(uintptr_t)shm;
  float*wsf=(float*)(shm+LDS_WS)+wid*64;
  const bf16*ksrc=Kh+(long)lane*DM+wid*8;
  const bf16*vsrc=Vh+(long)(16*(wid&3)+(lane>>2))*DM+(wid>>2)*32+(lane&3)*8;
  const unsigned kdst=lds0+LDS_K+wid*1024, vdst=lds0+LDS_V+wid*1024;
  #define DMA_K(t,slot) glds16(ksrc+(long)(t)*KVBLK*DM,(unsigned)__builtin_amdgcn_readfirstlane(kdst+(slot)))
  #define DMA_V(t,slot) glds16(vsrc+(long)(t)*KVBLK*DM,(unsigned)__builtin_amdgcn_readfirstlane(vdst+(slot)))
  const int vb0=(int)(lds0+LDS_V)+((lane>>4)&1)*32+(lane&3)*8+(4*hi+((lane&15)>>2))*64;
  const char*Kbase=shm+LDS_K; bf16x8 kf[8];
  const lds_cptr shm3=(lds_cptr)shm; const lds_cptr kp0=shm3+LDS_K+hi*1024+r32*16; const lds_cptr vp0=shm3+LDS_V+((lane>>4)&1)*32+(lane&3)*8+(4*hi+((lane&15)>>2))*64;
  const int NT=(q0+QB)/KVBLK;
  if(!pre_issued){DMA_K(0,0);DMA_V(0,0);DMA_K(1,SLOTB);}
  bf16x8 qr[4];
  #pragma unroll
  for(int d0=0;d0<4;++d0)qr[d0]=*reinterpret_cast<const bf16x8*>(&Qw[(long)r32*DM+d0*16+hi*8]);
  float mhat=0.f,l_reg=0.f;o[0]=f32x16{};o[1]=f32x16{};f32x16 negm=f32x16{};asm volatile("":"+v"(negm));
  const int qrel=wid*QBLK+r32;
  #define CMASK(P0,P1,t) do{int jb_=(t)-(NT-4); if(jb_>=0)cmask(P0,P1,jb_,qrel,hi);}while(0)
  bool resc=false;
  #define START(P0,P1) do{ const float rm=rowmax(P0,P1); resc=false; \
    { const float dl=rm; mhat=fadd_s(mhat,dl); \
      _Pragma("unroll") for(int r=0;r<16;++r){P0[r]=fsub_s(P0[r],dl);P1[r]=fsub_s(P1[r],dl);} \
      _Pragma("unroll") for(int r=0;r<16;++r)negm[r]=-mhat; asm volatile("":"+v"(negm)); } \
    _Pragma("unroll") for(int r=0;r<16;++r)P0[r]=__builtin_amdgcn_exp2f(P0[r]); }while(0)
  #define RESC() do{ if(resc){ asm volatile("s_waitcnt lgkmcnt(0)":::"memory"); \
      _Pragma("unroll") for(int d_=0;d_<2;++d_) _Pragma("unroll") for(int r=0;r<16;++r)o[d_][r]*=wsf[crow(r,hi)]; } }while(0)
  f32x16 pA0,pA1,pB0,pB1;
  int sl_prev=0,sl_cur=0,sl_next=SLOTB;
  #define ROT() do{sl_prev=sl_cur;sl_cur=sl_next;sl_next=(sl_next==(NSLOT-1)*SLOTB)?0:sl_next+SLOTB;}while(0)
  DMA_K(2,2*SLOTB);
  WAIT_BAR(3);
  qkt(pA0,pA1,Kbase,qr,negm,r32,hi);asm volatile("s_nop 15\n\ts_nop 7":"+v"(pA0),"+v"(pA1));CMASK(pA0,pA1,0);
  START(pA0,pA1);
  _Pragma("unroll") for(int r=0;r<16;++r)pA1[r]=__builtin_amdgcn_exp2f(pA1[r]);
  WAIT_BAR(0);
  DMA_K(3,0);DMA_V(1,SLOTB);
  ROT();
  kload8(kf,kp0+sl_cur);
  WAIT_BAR(2);
  s16x4 vlo[8],vhi[8]; u32x4 pw0,pw1,pw2,pw3;
  #define PKW(P,B) cvtpk_s(P[B],P[B+1])
  #define PAF(k) __builtin_bit_cast(bf16x8,pw##k)
  #define VFR(i) (bf16x8){vlo[i][0],vlo[i][1],vlo[i][2],vlo[i][3],vhi[i][0],vhi[i][1],vhi[i][2],vhi[i][3]}
  #define PIN(x) asm volatile("":"+v"(x))
  #define MX3(a,b,c) __builtin_fmaxf(__builtin_fmaxf((a),(b)),(c))
  #define GAPA(MF,A0,A1,A2,A3,W0,W1,PW) do{ MF; sacc+=A0; sacc+=A1; sacc+=A2; sacc+=A3; PIN(sacc); W0; W1; PIN(PW); SBAR(); }while(0)
  #define EX(v) __builtin_amdgcn_exp2f(v)
  #define GAPB(MF,X,B) do{ MF; X[B]=EX(X[B]); X[B+1]=EX(X[B+1]); X[B+2]=EX(X[B+2]); X[B+3]=EX(X[B+3]); PIN(X); SBAR(); }while(0)
  #define VRD(i) do{ vlo[i]=vtr(vp_+(((i)>>2)*4096+((i)&3)*1024)); vhi[i]=vtr(vp_+(((i)>>2)*4096+((i)&3)*1024+512)); }while(0)
  #define KRD(G,j) do{ if(G){ kload2(kf,kp0+sl_next,j); SBAR(); } }while(0)
  #define STEP(C0,C1,P0,P1,t,GK,GV,GL) do{ SBAR(); \
    const lds_cptr vp_=vp0+sl_prev; \
    VRD(0); SBAR(); float sacc=(P0[0]+P0[1]); \
    GAPA(C0=__builtin_amdgcn_mfma_f32_32x32x16_bf16(kf[0],qr[0],negm,0,0,0), P0[2],P0[3],P0[4],P0[5],     pw0[0]=PKW(P0,0), pw0[1]=PKW(P0,2), pw0); \
    VRD(4); SBAR(); GAPA(C1=__builtin_amdgcn_mfma_f32_32x32x16_bf16(kf[1],qr[0],negm,0,0,0), P0[6],P0[7],P0[8],P0[9],     pw0[2]=PKW(P0,4), pw0[3]=PKW(P0,6), pw0); \
    VRD(1); SBAR(); GAPA(C0=__builtin_amdgcn_mfma_f32_32x32x16_bf16(kf[2],qr[1],C0,0,0,0),   P0[10],P0[11],P0[12],P0[13], pw1[0]=PKW(P0,8), pw1[1]=PKW(P0,10), pw1); \
    VRD(5); SBAR(); GAPA(C1=__builtin_amdgcn_mfma_f32_32x32x16_bf16(kf[3],qr[1],C1,0,0,0),   P0[14],P0[15],P1[0],P1[1],   pw1[2]=PKW(P0,12),pw1[3]=PKW(P0,14), pw1); \
    VRD(2); SBAR(); GAPA(C0=__builtin_amdgcn_mfma_f32_32x32x16_bf16(kf[4],qr[2],C0,0,0,0),   P1[2],P1[3],P1[4],P1[5],     pw2[0]=PKW(P1,0), pw2[1]=PKW(P1,2), pw2); \
    VRD(6); SBAR(); GAPA(C1=__builtin_amdgcn_mfma_f32_32x32x16_bf16(kf[5],qr[2],C1,0,0,0),   P1[6],P1[7],P1[8],P1[9],     pw2[2]=PKW(P1,4), pw2[3]=PKW(P1,6), pw2); \
    VRD(3); SBAR(); GAPA(C0=__builtin_amdgcn_mfma_f32_32x32x16_bf16(kf[6],qr[3],C0,0,0,0),   P1[10],P1[11],P1[12],P1[13], pw3[0]=PKW(P1,8), pw3[1]=PKW(P1,10), pw3); \
    VRD(7); SBAR(); GAPA(C1=__builtin_amdgcn_mfma_f32_32x32x16_bf16(kf[7],qr[3],C1,0,0,0),   P1[14],P1[15],0.f,0.f,       pw3[2]=PKW(P1,12),pw3[3]=PKW(P1,14), pw3); \
    l_reg+=sacc; \
    if(GK){DMA_K((t)+3,sl_cur);} if(GV){DMA_V((t)+1,sl_next);} \
    CMASK(C0,C1,t); \
    { float a=MX3(C0[0],C0[1],C1[0]),b=MX3(C0[2],C0[3],C1[1]); a=MX3(a,C1[2],C1[3]); \
      _Pragma("unroll") for(int r=4;r<16;r+=4){a=MX3(a,C0[r],C0[r+1]);b=MX3(b,C0[r+2],C0[r+3]);a=MX3(a,C1[r],C1[r+1]);b=MX3(b,C1[r+2],C1[r+3]);} \
      float rm=__builtin_fmaxf(a,b); { auto rr=__builtin_amdgcn_permlane32_swap(__float_as_uint(rm),__float_as_uint(rm),false,false); rm=__builtin_fmaxf(__uint_as_float(rr[0]),__uint_as_float(rr[1])); } \
      resc=false; \
      if(__builtin_expect(__any(rm>(float)THRL),0)){ const float dl=__builtin_fmaxf(rm,0.f); mhat+=dl; \
        _Pragma("unroll") for(int r=0;r<16;++r){C0[r]-=dl;C1[r]-=dl;} \
        _Pragma("unroll") for(int r=0;r<16;++r)negm[r]=-mhat; asm volatile("":"+v"(negm)); \
        const float f=__builtin_amdgcn_exp2f(-dl); l_reg*=f; if(hi==0)wsf[r32]=f; resc=true; } } \
    SBAR(); \
    GAPB(o[0]=__builtin_amdgcn_mfma_f32_32x32x16_bf16(PAF(0),VFR(0),o[0],0,0,0), C0,0); \
    GAPB(o[1]=__builtin_amdgcn_mfma_f32_32x32x16_bf16(PAF(0),VFR(4),o[1],0,0,0), C0,4); \
    KRD(GL,0); GAPB(o[0]=__builtin_amdgcn_mfma_f32_32x32x16_bf16(PAF(1),VFR(1),o[0],0,0,0), C0,8); \
    KRD(GL,1); GAPB(o[1]=__builtin_amdgcn_mfma_f32_32x32x16_bf16(PAF(1),VFR(5),o[1],0,0,0), C0,12); \
    KRD(GL,2); GAPB(o[0]=__builtin_amdgcn_mfma_f32_32x32x16_bf16(PAF(2),VFR(2),o[0],0,0,0), C1,0); \
    KRD(GL,3); GAPB(o[1]=__builtin_amdgcn_mfma_f32_32x32x16_bf16(PAF(2),VFR(6),o[1],0,0,0), C1,4); \
    GAPB(o[0]=__builtin_amdgcn_mfma_f32_32x32x16_bf16(PAF(3),VFR(3),o[0],0,0,0), C1,8); \
    GAPB(o[1]=__builtin_amdgcn_mfma_f32_32x32x16_bf16(PAF(3),VFR(7),o[1],0,0,0), C1,12); \
    }while(0)
  int t=1;
  #undef CMASK
  #define CMASK(P0,P1,t) do{}while(0)
  for(;t+5<NT;t+=2){
    STEP(pB0,pB1,pA0,pA1,t,true,true,true);     WAIT_BAR(2); RESC(); ROT();
    STEP(pA0,pA1,pB0,pB1,t+1,true,true,true);   WAIT_BAR(2); RESC(); ROT();
  }
  #undef CMASK
  #define CMASK(P0,P1,t) do{int jb_=(t)-(NT-4); if(jb_>=0)cmask(P0,P1,jb_,qrel,hi);}while(0)
  #define ENDW(tt) do{ if((tt)+3<NT){WAIT_BAR(2);} else if((tt)+2<NT){WAIT_BAR(1);} else {WAIT_BAR(0);} }while(0)
  for(;t+1<NT;t+=2){
    STEP(pB0,pB1,pA0,pA1,t,(t+3<NT),(t+1<NT),(t+1<NT));       ENDW(t);   RESC(); ROT();
    STEP(pA0,pA1,pB0,pB1,t+1,(t+4<NT),(t+2<NT),(t+2<NT));     ENDW(t+1); RESC(); ROT();
  }
  STEP(pB0,pB1,pA0,pA1,NT-1,false,false,false); RESC();
  { float sacc=pB0[0]+pB0[1]; _Pragma("unroll") for(int r=2;r<16;++r)sacc+=pB0[r]; _Pragma("unroll") for(int r=0;r<16;++r)sacc+=pB1[r]; l_reg+=sacc;
    pw0=(u32x4){PKW(pB0,0),PKW(pB0,2),PKW(pB0,4),PKW(pB0,6)};pw1=(u32x4){PKW(pB0,8),PKW(pB0,10),PKW(pB0,12),PKW(pB0,14)};pw2=(u32x4){PKW(pB1,0),PKW(pB1,2),PKW(pB1,4),PKW(pB1,6)};pw3=(u32x4){PKW(pB1,8),PKW(pB1,10),PKW(pB1,12),PKW(pB1,14)};
    SBAR(); pv(o,vb0+sl_cur,PAF(0),PAF(1),PAF(2),PAF(3)); }
  #undef PKW
  #undef PAF
  #undef VFR
  #undef PIN
  #undef MX3
  #undef GAPA
  #undef GAPB
  #undef EX
  #undef VRD
  #undef KRD
  #undef STEP
  #undef ENDW
  {auto rr=__builtin_amdgcn_permlane32_swap(__float_as_uint(l_reg),__float_as_uint(l_reg),false,false);l_reg=__uint_as_float(rr[0])+__uint_as_float(rr[1]);}
  if(hi==0)wsf[32+r32]=l_reg;asm volatile("s_waitcnt lgkmcnt(0)":::"memory");
  #pragma unroll
  for(int r=0;r<16;++r)rli[r]=__builtin_amdgcn_rcpf(wsf[32+crow(r,hi)]);
  asm volatile("s_waitcnt lgkmcnt(0)\n\ts_barrier":::"memory");
  if(nhq>=0){ const bf16*kn=K+rowbase*DM+nhq*D+(long)lane*DM+wid*8; const bf16*vn=V+rowbase*DM+nhv*D+(long)(16*(wid&3)+(lane>>2))*DM+(wid>>2)*32+(lane&3)*8;
    glds16(kn,(unsigned)__builtin_amdgcn_readfirstlane(kdst)); glds16(vn,(unsigned)__builtin_amdgcn_readfirstlane(vdst)); glds16(kn+(long)KVBLK*DM,(unsigned)__builtin_amdgcn_readfirstlane(kdst+SLOTB)); }
  #undef DMA_K
  #undef DMA_V
  #undef CMASK
  #undef START
  #undef RESC
  #undef ROT
}
constexpr int LDS_STASH=LDS_BYTES, LDS_SSQ=LDS_STASH+NW*8192, ATTN_LDS_BYTES=LDS_SSQ+NW*128;
template<int THRL> __device__ __forceinline__ void dattn_unit(int b,int h,int qb,const bf16*Q,const bf16*K,const bf16*V,bf16*O,char*shm,float lam,const float*subln,float oml){
  #pragma unroll 1
  for(int pass=0;pass<4;++pass){
    const int m=pass&1,vh=pass>>1;
    f32x16 o[2]; float rli[16];
    attn_pass<THRL>(b,2*h+m,2*h+vh,qb,Q,K,V,shm,o,rli,pass>0,pass<3?2*h+((pass+1)&1):-1,pass<3?2*h+((pass+1)>>1):-1);
    int tid_=threadIdx.x; asm volatile("":"+v"(tid_)); const int tid=tid_,lane=tid&63,r32=lane&31,hi=lane>>5; const int wid=__builtin_amdgcn_readfirstlane(tid>>6);
    float*stash=(float*)(shm+LDS_STASH)+wid*2048; float*ssq0=(float*)(shm+LDS_SSQ)+wid*32; float*wsf=(float*)(shm+LDS_WS)+wid*64;
    unsigned short*stg=(unsigned short*)(shm+LDS_OST)+wid*2048;
    const long orow0=((long)b*SEQ+(long)qb*QB+wid*QBLK)*DM+h*128;
    if(m==0){
      #pragma unroll
      for(int d0=0;d0<2;++d0)
        #pragma unroll
        for(int r=0;r<16;++r)stash[(d0*16+r)*64+lane]=o[d0][r]*rli[r];
    }else{
      float sq[16];
      #pragma unroll
      for(int r=0;r<16;++r){ const float a0=stash[r*64+lane]-lam*o[0][r]*rli[r], a1=stash[(16+r)*64+lane]-lam*o[1][r]*rli[r]; o[0][r]=a0;o[1][r]=a1;sq[r]=a0*a0+a1*a1; }
      #pragma unroll
      for(int r=0;r<16;++r){ float s=sq[r]; s+=__shfl_xor(s,1);s+=__shfl_xor(s,2);s+=__shfl_xor(s,4);s+=__shfl_xor(s,8);s+=__shfl_xor(s,16); sq[r]=s; }
      if(vh==0){
        if(r32==0){
          #pragma unroll
          for(int r=0;r<16;++r)ssq0[crow(r,hi)]=sq[r]; }
        #pragma unroll
        for(int r=0;r<16;++r){const int orow=crow(r,hi); stg[orow*64+r32]=(unsigned short)(cvtpk_s(o[0][r],0.f)&0xffffu); stg[orow*64+32+r32]=(unsigned short)(cvtpk_s(o[1][r],0.f)&0xffffu);}
      }else{
        float rsc[16];
        #pragma unroll
        for(int r=0;r<16;++r)rsc[r]=__builtin_amdgcn_rsqf((sq[r]+ssq0[crow(r,hi)])*(1.f/128.f)+1e-6f)*oml;
        if(r32==0){
          #pragma unroll
          for(int r=0;r<16;++r)wsf[32+crow(r,hi)]=rsc[r]; }
        asm volatile("s_waitcnt lgkmcnt(0)":::"memory");
        { const int ch=lane&7; const float4 g0=*(const float4*)(subln+ch*8),g1=*(const float4*)(subln+ch*8+4);
          #pragma unroll
          for(int i=0;i<4;++i){const int row=i*8+(lane>>3); const u32x4 v=*(const u32x4*)(stg+row*64+ch*8); const float rs_=wsf[32+row];
            u32x4 w;
            w.x=cvtpk_s(__uint_as_float(v.x<<16)*rs_*g0.x,__uint_as_float(v.x&0xffff0000u)*rs_*g0.y); w.y=cvtpk_s(__uint_as_float(v.y<<16)*rs_*g0.z,__uint_as_float(v.y&0xffff0000u)*rs_*g0.w);
            w.z=cvtpk_s(__uint_as_float(v.z<<16)*rs_*g1.x,__uint_as_float(v.z&0xffff0000u)*rs_*g1.y); w.w=cvtpk_s(__uint_as_float(v.w<<16)*rs_*g1.z,__uint_as_float(v.w&0xffff0000u)*rs_*g1.w);
            *(u32x4*)((unsigned short*)O+orow0+(long)row*DM+ch*8)=w; } }
        asm volatile("s_waitcnt lgkmcnt(0)":::"memory");
        { const float ga=subln[64+r32],gb=subln[96+r32];
          #pragma unroll
          for(int r=0;r<16;++r){const int orow=crow(r,hi); stg[orow*64+r32]=(unsigned short)(cvtpk_s(o[0][r]*rsc[r]*ga,0.f)&0xffffu); stg[orow*64+32+r32]=(unsigned short)(cvtpk_s(o[1][r]*rsc[r]*gb,0.f)&0xffffu);}
          asm volatile("s_waitcnt lgkmcnt(0)":::"memory");
          #pragma unroll
          for(int i=0;i<4;++i){const int row=i*8+(lane>>3),ch=lane&7; const u32x4 v=*(const u32x4*)(stg+row*64+ch*8); *(u32x4*)((unsigned short*)O+orow0+(long)row*DM+64+ch*8)=v;} }
        asm volatile("s_waitcnt lgkmcnt(0)":::"memory");
      }
    }
  }
}
#undef SBAR
#undef WAIT_BAR
}

constexpr size_t SSM_F16_OFF = 0, SSM_TG_OFF = 2 * MiB;
constexpr int SSM_XLD = 392;
typedef short bf16x8_t __attribute__((ext_vector_type(8)));
__device__ __forceinline__ void ssm_tables(const Frame& F0, int L, unsigned char* base) {
    const Frame F = refresh(F0);
    LAS float* ap_re = (LAS float*)F.lds; LAS float* ap_im = ap_re + 17 * 64;
    LAS float* bb_re = ap_im + 17 * 64;   LAS float* bb_im = bb_re + 1024;
    LAS float* cc_re = bb_im + 1024;      LAS float* cc_im = cc_re + 1024;
    LAS float* kt = cc_im + 1024;         LAS float* dd = kt + 4096;
    const int tid = F.tid;
    for (int item = F.vcu; item < NG * 8; item += F.G) {
        const int g = item >> 3, part = item & 7;
        __syncthreads();
        if (tid < 64) {
            const int p = tid; const float dt = expf(inp(F, I_LSTEP)[L * NG + g]);
            const float lr = inp(F, I_LRE)[(L * NG + g) * SP + p], li = inp(F, I_LIM)[(L * NG + g) * SP + p];
            for (int tau = 0; tau <= 16; ++tau) { const float mg = expf(lr * dt * (float)tau); float sn, cs; sincosf(li * dt * (float)tau, &sn, &cs); ap_re[tau * 64 + p] = mg * cs; ap_im[tau * 64 + p] = mg * sn; }
            const float ab_re = ap_re[64 + p], ab_im = ap_im[64 + p];
            const float den = lr * lr + li * li, nr = ab_re - 1.f;
            const float coef_re = (nr * lr + ab_im * li) / den, coef_im = (ab_im * lr - nr * li) / den;
            const float* br = inp(F, I_BRE) + ((size_t)(L * NG + g) * SP + p) * SG; const float* bi = inp(F, I_BIM) + ((size_t)(L * NG + g) * SP + p) * SG;
            for (int h = 0; h < 16; ++h) { bb_re[p * 16 + h] = coef_re * br[h] - coef_im * bi[h]; bb_im[p * 16 + h] = coef_re * bi[h] + coef_im * br[h]; }
        }
        for (int i = tid; i < 1024; i += NTHREADS) { cc_re[i] = inp(F, I_CRE)[(size_t)(L * NG + g) * SG * SP + i]; cc_im[i] = inp(F, I_CIM)[(size_t)(L * NG + g) * SG * SP + i]; }
        if (tid < 16) dd[tid] = inp(F, I_SSMD)[(L * NG + g) * SG + tid];
        __syncthreads();
        unsigned* F16 = (unsigned*)(base + SSM_F16_OFF) + (size_t)g * 128 * 128;
        for (int i3 = tid; i3 < 16 * 128; i3 += NTHREADS) {
            const int i2 = part * 16 * 128 + i3, row = i2 >> 7, col = (i2 & 127) * 2, p = row & 63, j = col >> 4, h0 = col & 15;
            const float ar = ap_re[(15 - j) * 64 + p], ai = ap_im[(15 - j) * 64 + p];
            float v[2];
#pragma unroll
            for (int q = 0; q < 2; ++q) { const float br = bb_re[p * 16 + h0 + q], bi = bb_im[p * 16 + h0 + q]; v[q] = row < 64 ? (ar * br - ai * bi) : (ar * bi + ai * br); }
            F16[i2] = f2bf(v[0]) | (f2bf(v[1]) << 16);
        }
        for (int i = tid; i < (2 * part + 2) * 256; i += NTHREADS) {
            const int tau = i >> 8, h = (i >> 4) & 15, hp = i & 15; float acc = 0.f;
            for (int p = 0; p < 64; ++p) { const float ar = ap_re[tau * 64 + p], ai = ap_im[tau * 64 + p], br = bb_re[p * 16 + hp], bi = bb_im[p * 16 + hp];
                const float er = ar * br - ai * bi, ei = ar * bi + ai * br; acc += cc_re[h * 64 + p] * er - cc_im[h * 64 + p] * ei; }
            kt[i] = acc;
        }
        __syncthreads();
        unsigned* TG = (unsigned*)(base + SSM_TG_OFF) + (size_t)g * 256 * 192;
        for (int i3 = tid; i3 < 32 * 128; i3 += NTHREADS) {
            const int i2 = part * 32 * 128 + i3, row = i2 >> 7, col = (i2 & 127) * 2, i = row >> 4, h = row & 15, j = col >> 4, h0 = col & 15;
            float v[2] = {0.f, 0.f};
            if (j <= i) {
#pragma unroll
                for (int q = 0; q < 2; ++q) { v[q] = kt[((i - j) * 16 + h) * 16 + h0 + q]; if (i == j && h == h0 + q) v[q] += dd[h]; } }
            TG[row * 192 + (i2 & 127)] = f2bf(v[0]) | (f2bf(v[1]) << 16);
        }
        for (int i3 = tid; i3 < 32 * 64; i3 += NTHREADS) {
            const int i2 = part * 32 * 64 + i3, row = i2 >> 6, c = (i2 & 63) * 2, i = row >> 4, h = row & 15;
            float v[2];
#pragma unroll
            for (int q = 0; q < 2; ++q) { const int p = (c + q) & 63; const float ar = ap_re[(i + 1) * 64 + p], ai = ap_im[(i + 1) * 64 + p], cr = cc_re[h * 64 + p], ci = cc_im[h * 64 + p];
                v[q] = (c + q) < 64 ? (cr * ar - ci * ai) : -(cr * ai + ci * ar); }
            TG[row * 192 + 128 + (i2 & 63)] = f2bf(v[0]) | (f2bf(v[1]) << 16);
        }
    }
    __syncthreads();
}
__device__ __forceinline__ float gelu_fast(float x) { const float u = 1.5957691216057308f * (x + 0.044715f * x * x * x); return x - x * __builtin_amdgcn_rcpf(1.f + __expf(u)); }
__device__ __forceinline__ void ssm_item_mfma(const Frame& F0, int L, int it, const bf16* U, bf16* Z, const unsigned char* tbase, float* vscr) {
    const Frame F = refresh(F0);
    const int g = it & 31, b = it >> 5, tid = F.tid, lane = F.lane, w = F.wave, lr16 = lane & 15, q = lane >> 4;
    LAS unsigned char* X = F.lds;
    { const bf16* ub = U + (size_t)b * SEQ * SSMW + g * 16;
#pragma unroll
      for (int r = 0; r < 4; ++r) { const int t = tid + r * NTHREADS; const v4u* sp = (const v4u*)(ub + (size_t)t * SSMW); const v4u a = sp[0], c = sp[1];
          LAS v4u* dp = (LAS v4u*)(X + (t >> 4) * (SSM_XLD * 2) + (t & 15) * 32); dp[0] = a; dp[1] = c; } }
    __syncthreads();
    { const bf16* F16 = (const bf16*)(tbase + SSM_F16_OFF) + (size_t)g * 128 * 256 + (size_t)(16 * w + lr16) * 256 + 8 * q;
      bf16x8_t af[8];
#pragma unroll
      for (int ks = 0; ks < 8; ++ks) af[ks] = *(const bf16x8_t*)(F16 + ks * 32);
#pragma unroll 1
      for (int nt = 0; nt < 8; ++nt) {
          f32x4 acc = {0.f, 0.f, 0.f, 0.f};
          LAS const unsigned char* xr = X + (16 * nt + lr16) * (SSM_XLD * 2) + 16 * q;
#pragma unroll
          for (int ks = 0; ks < 8; ++ks) { const bf16x8_t bf = *(LAS const bf16x8_t*)(xr + ks * 64); acc = __builtin_amdgcn_mfma_f32_16x16x32_bf16(af[ks], bf, acc, 0, 0, 0); }
          *(f32x4*)(vscr + (size_t)(16 * nt + lr16) * 128 + 16 * w + 4 * q) = acc;
      } }
    asm volatile("s_waitcnt vmcnt(0)" ::: "memory");
    __syncthreads();
    if (w == 0) {
        __builtin_amdgcn_fence(__ATOMIC_ACQUIRE, "agent");
        const int p = lane; const float dt = expf(inp(F, I_LSTEP)[L * NG + g]);
        const float lr = inp(F, I_LRE)[(L * NG + g) * SP + p], li = inp(F, I_LIM)[(L * NG + g) * SP + p];
        const float mg = expf(lr * dt * 16.f); float sn, cs; sincosf(li * dt * 16.f, &sn, &cs); const float a_re = mg * cs, a_im = mg * sn;
        float s_re = 0.f, s_im = 0.f;
        LAS unsigned short* xs = (LAS unsigned short*)X + 256 + p;
#pragma unroll 1
        for (int c0 = 0; c0 < 128; c0 += 16) {
            float vr[16], vi[16];
#pragma unroll
            for (int j = 0; j < 16; ++j) { vr[j] = vscr[(c0 + j) * 128 + p]; vi[j] = vscr[(c0 + j) * 128 + 64 + p]; }
#pragma unroll
            for (int j = 0; j < 16; ++j) {
                xs[(c0 + j) * SSM_XLD] = (unsigned short)f2bf(s_re); xs[(c0 + j) * SSM_XLD + 64] = (unsigned short)f2bf(s_im);
                const float t_re = a_re * s_re - a_im * s_im + vr[j], t_im = a_re * s_im + a_im * s_re + vi[j]; s_re = t_re; s_im = t_im;
            }
        }
    }
    __syncthreads();
    { const int mA = w, mB = 15 - w, limA = mA >> 1, limB = mB >> 1;
      const bf16* TGa = (const bf16*)(tbase + SSM_TG_OFF) + (size_t)g * 256 * 384 + (size_t)(16 * mA + lr16) * 384 + 8 * q;
      const bf16* TGb = (const bf16*)(tbase + SSM_TG_OFF) + (size_t)g * 256 * 384 + (size_t)(16 * mB + lr16) * 384 + 8 * q;
      bf16x8_t fa[12], fb[12];
#pragma unroll
      for (int ks = 0; ks < 12; ++ks) { const bf16x8_t zz = {0, 0, 0, 0, 0, 0, 0, 0}; fa[ks] = (ks >= 8 || ks <= limA) ? *(const bf16x8_t*)(TGa + ks * 32) : zz; fb[ks] = (ks >= 8 || ks <= limB) ? *(const bf16x8_t*)(TGb + ks * 32) : zz; }
      bf16* zb = Z + (size_t)b * SEQ * SSMW + g * 16 + 4 * q;
#pragma unroll 1
      for (int nt = 0; nt < 8; ++nt) {
          f32x4 accA = {0.f, 0.f, 0.f, 0.f}, accB = {0.f, 0.f, 0.f, 0.f};
          LAS const unsigned char* xr = X + (16 * nt + lr16) * (SSM_XLD * 2) + 16 * q;
#pragma unroll
          for (int ks = 0; ks < 12; ++ks) { const bf16x8_t bf = *(LAS const bf16x8_t*)(xr + ks * 64);
              if (ks >= 8 || ks <= limA) accA = __builtin_amdgcn_mfma_f32_16x16x32_bf16(fa[ks], bf, accA, 0, 0, 0);
              if (ks >= 8 || ks <= limB) accB = __builtin_amdgcn_mfma_f32_16x16x32_bf16(fb[ks], bf, accB, 0, 0, 0); }
          const int sc = 16 * nt + lr16;
          { v2u o; o.x = f2bf(gelu_fast(accA[0])) | (f2bf(gelu_fast(accA[1])) << 16); o.y = f2bf(gelu_fast(accA[2])) | (f2bf(gelu_fast(accA[3])) << 16); *(v2u*)(zb + (size_t)(16 * sc + mA) * SSMW) = o; }
          { v2u o; o.x = f2bf(gelu_fast(accB[0])) | (f2bf(gelu_fast(accB[1])) << 16); o.y = f2bf(gelu_fast(accB[2])) | (f2bf(gelu_fast(accB[3])) << 16); *(v2u*)(zb + (size_t)(16 * sc + mB) * SSMW) = o; }
      } }
    __syncthreads();
}

__device__ __forceinline__ void router_phase(const Frame& F0, int L, const float* xio, unsigned* ctl, unsigned char* ws) {
    const Frame F = refresh(F0);
    LAS f32x4* Wg = (LAS f32x4*)F.lds; LAS f32x4* Wl = (LAS f32x4*)(F.lds + 16384); LAS f32x4* Wh = (LAS f32x4*)(F.lds + 81920);
    const float* gf = inp(F, I_FFN_G) + L * DM; const float* wrg = inp(F, I_WRG) + (size_t)L * DM * NGRP; const float* wre = inp(F, I_WRE) + (size_t)L * NGRP * DM * EPG;
    for (int k = F.tid; k < DM; k += NTHREADS) Wg[k] = *(const f32x4*)(wrg + (size_t)k * 4) * gf[k];
    for (int idx = F.tid; idx < NGRP * DM; idx += NTHREADS) { const float g = gf[idx & (DM - 1)]; const f32x4* s = (const f32x4*)(wre + (size_t)idx * 8); Wl[idx] = s[0] * g; Wh[idx] = s[1] * g; }
    __syncthreads();
    const float* brg = inp(F, I_BRG) + L * NGRP; const float* bre = inp(F, I_BRE2) + L * NGRP * EPG;
    unsigned* cnt = ctl + CW_CNT + L * 64 * CNT_STRIDE; SlotInfo* slots = (SlotInfo*)(ws + WS_SLOT);
    const int gw = F.even ? (F.vcu / (F.G / 8)) * SEQ + (F.vcu % (F.G / 8)) * NWAVES + F.wave : F.vcu * NWAVES + F.wave, NGW = F.even ? (F.G / 8) * NWAVES : F.G * NWAVES;
    const int T_END = F.even ? (F.vcu / (F.G / 8) + 1) * SEQ : T;
    int my_t = -1, my_e0 = 0, my_e1 = 0; float my_w0 = 0.f, my_w1 = 0.f; int nr = 0;
    float xn_[16];
    { const float* xr = xio + (size_t)gw * DM + F.lane;
#pragma unroll
      for (int j = 0; j < 16; ++j) xn_[j] = xr[64 * j]; }
    for (int t = gw; t < T_END; t += NGW, ++nr) {
        float xv[16]; float ss = 0.f;
#pragma unroll
        for (int j = 0; j < 16; ++j) { xv[j] = xn_[j]; ss += xv[j] * xv[j]; }
        { const int tn = (t + NGW < T_END) ? t + NGW : t; const float* xr = xio + (size_t)tn * DM + F.lane;
#pragma unroll
          for (int j = 0; j < 16; ++j) xn_[j] = xr[64 * j]; }
        const float rs = rsqrtf(wave_sum(ss) * (1.f / DM) + EPS);
        f32x4 ag = {0.f, 0.f, 0.f, 0.f};
#pragma unroll
        for (int j = 0; j < 16; ++j) ag += Wg[F.lane + 64 * j] * xv[j];
        float lg[4];
#pragma unroll
        for (int c = 0; c < 4; ++c) lg[c] = wave_sum(ag[c]) * rs + brg[c];
        int grp = 0; float gmax = lg[0];
#pragma unroll
        for (int c = 1; c < 4; ++c) if (lg[c] > gmax) { gmax = lg[c]; grp = c; }
        float gden = 0.f;
#pragma unroll
        for (int c = 0; c < 4; ++c) gden += __expf(lg[c] - gmax);
        const float p_grp = 1.f / gden;
        grp = __builtin_amdgcn_readfirstlane(grp);
        f32x4 al = {0.f, 0.f, 0.f, 0.f}, ah = {0.f, 0.f, 0.f, 0.f};
#pragma unroll
        for (int j = 0; j < 16; ++j) { const int idx = grp * DM + F.lane + 64 * j; al += Wl[idx] * xv[j]; ah += Wh[idx] * xv[j]; }
        float le[8];
#pragma unroll
        for (int c = 0; c < 4; ++c) { le[c] = wave_sum(al[c]) * rs + bre[grp * EPG + c]; le[4 + c] = wave_sum(ah[c]) * rs + bre[grp * EPG + 4 + c]; }
        int i0 = 0; float v0 = le[0];
#pragma unroll
        for (int c = 1; c < 8; ++c) if (le[c] > v0) { v0 = le[c]; i0 = c; }
        int i1 = -1; float v1 = -3.0e38f;
#pragma unroll
        for (int c = 0; c < 8; ++c) if (c != i0 && le[c] > v1) { v1 = le[c]; i1 = c; }
        const float e1 = __expf(v1 - v0);
        const float w0 = p_grp / (1.f + e1), w1 = p_grp * e1 / (1.f + e1);
        if (F.lane == (nr & 63)) { my_t = t; my_e0 = grp * EPG + i0; my_e1 = grp * EPG + i1; my_w0 = w0; my_w1 = w1; }
        if ((nr & 63) == 63 || t + NGW >= T_END) {
            if (my_t >= 0) {
                const unsigned p0 = atomicAdd(cnt + my_e0 * CNT_STRIDE, 1u), p1 = atomicAdd(cnt + (32 + my_e1) * CNT_STRIDE, 1u);
                slots[(size_t)my_e0 * T + p0] = SlotInfo{my_t, my_w0}; slots[(size_t)(32 + my_e1) * T + p1] = SlotInfo{my_t, my_w1};
            }
            my_t = -1;
        }
    }
}
constexpr int LDS_TB_OFF = 143360;
__device__ __forceinline__ void moe_tables(const Frame& F0, int L, unsigned* ctl) {
    const Frame F = refresh(F0);
    LAS int* tb = (LAS int*)(F.lds + LDS_TB_OFF); LAS int* tc = tb + 80;
    if (F.tid < 64) tc[F.tid] = (int)__hip_atomic_load(ctl + CW_CNT + (L * 64 + F.tid) * CNT_STRIDE, __ATOMIC_RELAXED, __HIP_MEMORY_SCOPE_AGENT);
    __syncthreads();
    if (F.tid == 0) { int s = 0; for (int i = 0; i < 64; ++i) { tb[i] = s; s += (tc[i] + 255) >> 8; } tb[64] = s; }
    __syncthreads();
    if (F.tid < 64) { const int t0 = tb[F.tid], t1 = tb[F.tid + 1]; for (int t = t0; t < t1; ++t) tb[160 + t] = F.tid; }
    __syncthreads();
}
__device__ __forceinline__ void moe_gather_tables(const Frame& F0, const pg8::MoeSched& S, const SlotInfo* slots, const float* part) {
    const Frame F = refresh(F0);
    LAS unsigned* tokoff = (LAS unsigned*)(F.lds + PG8_TOKOFF_OFF); LAS float* ri = (LAS float*)(F.lds + PG8_ROWINFO_OFF);
    pg8::Unit u;
    for (int i = 0; i < 4 && S.next(i, u); ++i) {
        if (F.tid < 256) { const int p = u.mt * 256 + F.tid; SlotInfo si = SlotInfo{0, 0.f};
            if (p < u.cnt) si = slots[(size_t)(u.k * 32 + u.e) * T + p];
            const float rs = pg8::rowscale16(part, si.token);
            tokoff[i * 256 + F.tid] = (unsigned)si.token * (unsigned)(DM * 2); ri[(i * 256 + F.tid) * 2] = si.w; ri[(i * 256 + F.tid) * 2 + 1] = rs; }
    }
    __syncthreads();
}
__device__ __forceinline__ void moe_down_tables(const Frame& F0, const pg8::MoeSched& S, const SlotInfo* slots) {
    const Frame F = refresh(F0);
    LAS int* tk = (LAS int*)(F.lds + PG8_TOKOFF_OFF);
    pg8::Unit u;
    for (int i = 0; i < 4 && S.next(i, u); ++i) {
        if (F.tid < 256) { const int p = u.mt * 256 + F.tid; tk[i * 256 + F.tid] = (p < u.cnt) ? slots[(size_t)(u.k * 32 + u.e) * T + p].token : -1; }
    }
    __syncthreads();
}
__device__ __forceinline__ void moe_combine(const Frame& F0, int pm, int pn, float* x, const bf16* d0, const bf16* d1, bf16* xb, float* part) {
    const Frame F = refresh(F0);
    const int ch = F.lane & 31, rsub = F.lane >> 5;
#pragma unroll 2
    for (int it = 0; it < 16; ++it) {
        const size_t row = (size_t)pm * 256 + it * 16 + F.wave * 2 + rsub; const size_t o = row * 1024 + pn * 256 + ch * 8;
        const f32x4 a0 = *(const f32x4*)(x + o), a1 = *(const f32x4*)(x + o + 4); const v4u w0 = *(const v4u*)(d0 + o), w1 = *(const v4u*)(d1 + o);
        f32x4 v0, v1;
        v0.x = (a0.x + bflo(w0.x)) + bflo(w1.x); v0.y = (a0.y + bfhi(w0.x)) + bfhi(w1.x); v0.z = (a0.z + bflo(w0.y)) + bflo(w1.y); v0.w = (a0.w + bfhi(w0.y)) + bfhi(w1.y);
        v1.x = (a1.x + bflo(w0.z)) + bflo(w1.z); v1.y = (a1.y + bfhi(w0.z)) + bfhi(w1.z); v1.z = (a1.z + bflo(w0.w)) + bflo(w1.w); v1.w = (a1.w + bfhi(w0.w)) + bfhi(w1.w);
        *(f32x4*)(x + o) = v0; *(f32x4*)(x + o + 4) = v1;
        v4u ob; ob.x = f2bf(v0.x) | (f2bf(v0.y) << 16); ob.y = f2bf(v0.z) | (f2bf(v0.w) << 16); ob.z = f2bf(v1.x) | (f2bf(v1.y) << 16); ob.w = f2bf(v1.z) | (f2bf(v1.w) << 16);
        *(v4u*)(xb + o) = ob;
        float ss = (v0.x * v0.x + v0.y * v0.y) + (v0.z * v0.z + v0.w * v0.w) + (v1.x * v1.x + v1.y * v1.y) + (v1.z * v1.z + v1.w * v1.w);
        ss += __shfl_xor(ss, 1); ss += __shfl_xor(ss, 2); ss += __shfl_xor(ss, 4); ss += __shfl_xor(ss, 8); ss += __shfl_xor(ss, 16);
        if (ch < 4) part[row * 16 + pn * 4 + ch] = (ch == 0) ? ss : 0.f;
    }
}
__device__ __forceinline__ void fill_rowscales(const Frame& F0, const pg8::StaticOrder& S, const float* part) {
    const Frame F = refresh(F0);
    LAS float* rsl = (LAS float*)(F.lds + PG8_RS_OFF);
    pg8::Unit u; const int half = F.tid >> 8, r = F.tid & 255;
    for (int i = 0; i < 8; i += 2) { if (S.next(i + half, u)) rsl[(i + half) * 256 + r] = pg8::rowscale16(part, u.pm * 256 + r); }
    __syncthreads();
}

__global__ void __launch_bounds__(NTHREADS, 2) mega_fwd(Args args) {
    extern __shared__ __attribute__((aligned(16))) unsigned char lds_raw[];
    Frame Fk;
    Fk.lds = (LAS unsigned char*)lds_raw;
    Fk.tid = threadIdx.x; Fk.lane = Fk.tid & 63; Fk.wave = __builtin_amdgcn_readfirstlane(Fk.tid >> 6);
    Fk.G = gridDim.x; { const int bx = blockIdx.x; Fk.vcu = (Fk.G % 8 == 0) ? (bx % 8) * (Fk.G / 8) + bx / 8 : bx; Fk.cid = bx; Fk.even = 0; }
    const Frame& F = Fk;
    volatile LAS unsigned* MISC = (volatile LAS unsigned*)(F.lds + MISC_OFF);
    if (F.tid < 64) MISC[F.tid] = 0u;
    if (F.tid < N_IN) ((LAS unsigned long long*)(F.lds + PTAB_OFF))[F.tid] = (unsigned long long)args.in[F.tid];
    __syncthreads();
    unsigned char* const ws = args.ws;
    XcdBarrier bar = xcd_barrier_post((unsigned*)(ws + WS_CTL) + CW_BAR, MISC + 8);
#define GRID_BAR() xcd_barrier(bar)
#define PHASE_WS unsigned long long wv_ = (unsigned long long)ws; asm volatile("" : "+s"(wv_)); GAS unsigned char* const w_ = (GAS unsigned char*)wv_
    constexpr size_t PARTSZ = (size_t)T * 16 * 4;
    const int NGW = F.G * NWAVES;

    { PHASE_WS; const Frame F = refresh(Fk); const int gw = F.vcu * NWAVES + F.wave;
      float* part = (float*)(w_ + WS_PART); bf16* X0 = (bf16*)(w_ + WS_X0); bf16* PB = (bf16*)(w_ + WS_PB); float* lamv = (float*)(w_ + WS_MISC);
    for (int m = gw; m < T; m += NGW) {
        const f32x4* xr = (const f32x4*)(inp(F, I_X) + (size_t)m * DM) + F.lane; float s = 0.f;
        v2u* o8 = (v2u*)(X0 + (size_t)m * DM) + F.lane;
#pragma unroll
        for (int j = 0; j < 4; ++j) { const f32x4 v = xr[64 * j]; s += v.x * v.x + v.y * v.y + v.z * v.z + v.w * v.w;
            v2u w; w.x = f2bf(v.x) | (f2bf(v.y) << 16); w.y = f2bf(v.z) | (f2bf(v.w) << 16); o8[64 * j] = w; }
        s = wave_sum(s);
        if (F.lane < 16) part[(size_t)m * 16 + F.lane] = (F.lane == 0) ? s : 0.f;
    }
    for (size_t i = (size_t)(blockIdx.x * NTHREADS + F.tid) * 4; i < (size_t)DEPTH * T * PLE; i += (size_t)F.G * NTHREADS * 4) {
        const f32x4 v = *(const f32x4*)(inp(F, I_P) + i); v2u w; w.x = f2bf(v.x) | (f2bf(v.y) << 16); w.y = f2bf(v.z) | (f2bf(v.w) << 16); *(v2u*)(PB + i) = w; }
    if (blockIdx.x == 0 && F.tid < DEPTH) {
        const float* lq = inp(F, I_LAMQK) + F.tid * 4 * HD; float s1 = 0.f, s2 = 0.f;
        for (int j = 0; j < HD; ++j) { s1 += lq[j] * lq[HD + j]; s2 += lq[2 * HD + j] * lq[3 * HD + j]; }
        lamv[F.tid] = expf(s1) - expf(s2) + lam_init_for(F.tid);
    }
    convert_weights(Fk, 0, (unsigned char*)(w_ + WS_WT));
    ssm_tables(Fk, 0, (unsigned char*)(w_ + WS_SSMT));
    }
    GRID_BAR();
    { const unsigned ev = MISC[8 + 3], hx = MISC[8 + 2], hr = MISC[8 + 4];
      if (ev) { Fk.even = 1; Fk.vcu = (int)(hx * (unsigned)(Fk.G / 8) + hr); Fk.cid = (int)(hr * 8u + hx); } }
#define LOCAL_BAR() do { if (Fk.even) xcc_barrier(bar); else xcd_barrier(bar); } while (0)

#define GEMM_PHASE(EPI, Aptr, WOFF, N_, K_, E_) do { pg8::Gemm g_{(const pg8::bf16_t*)(Aptr), (const pg8::bf16_t*)(unsigned char*)(w_ + WS_WT + (WOFF)), T, (N_), (K_)}; pg8::StaticOrder S_; S_.init(T, (N_), F.G, F.cid); \
        pg8::gemm_phase<EPI, pg8::StaticOrder, true, true>(F.lds, g_, S_, E_); } while (0)
#define P_XA ((bf16*)(unsigned char*)(w_ + ((L & 1) ? WS_X1 : WS_X0)))
#define P_XB ((bf16*)(unsigned char*)(w_ + ((L & 1) ? WS_X0 : WS_X1)))
#define P_PART ((float*)(unsigned char*)(w_ + WS_PART + (size_t)(L & 1) * PARTSZ))
#define P_PART2 ((float*)(unsigned char*)(w_ + WS_PART + (size_t)((L & 1) ^ 1) * PARTSZ))
#define P_(T_, OFF) ((T_*)(unsigned char*)(w_ + (OFF)))
#pragma unroll 1
    for (int L = 0; L < DEPTH; ++L) {
        if (L > 0) { { PHASE_WS; convert_weights(Fk, L, (unsigned char*)(w_ + WS_WT)); ssm_tables(Fk, L, (unsigned char*)(w_ + WS_SSMT)); } GRID_BAR(); }
        { PHASE_WS; pg8::EpiWinF E{F.lds, P_(bf16, WS_Q), P_(bf16, WS_K), P_(bf16, WS_V), P_(bf16, WS_U), P_(bf16, WS_GATES), inp(F, I_QG) + L * 2 * HD, inp(F, I_KG) + L * 2 * HD, inp(F, I_BGATE) + L * 2 * DM};
          { pg8::StaticOrder S0; S0.init(T, INW, F.G, F.cid); fill_rowscales(Fk, S0, P_PART); }
          GEMM_PHASE(pg8::EpiWinF, P_XA, WT_WIN, INW, DM, E); }
        LOCAL_BAR();
        { PHASE_WS;
          for (int it = F.vcu; it < BATCH * NG; it += F.G)
              ssm_item_mfma(Fk, L, it, P_(const bf16, WS_U), P_(bf16, WS_Z), P_(const unsigned char, WS_SSMT),
                            (float*)((unsigned char*)P_XB + (size_t)(F.vcu >> 5) * (4 * MiB) + (size_t)(F.vcu & 31) * 65536)); }
        { PHASE_WS; const Frame F = refresh(Fk);
          const float lam = P_(float, WS_MISC)[L]; const float oml = 1.f - lam_init_for(L); const float* subln = inp(F, I_SUBLN) + L * 2 * HD;
          static_assert(attn_body::ATTN_LDS_BYTES <= PTAB_OFF, "attention LDS");
          for (int v = F.vcu; v < BATCH * NH * 4; v += F.G) {
              const int bh = v >> 2, s = v & 3;
#pragma unroll 1
              for (int i = 0; i < 2; ++i)
                  attn_body::dattn_unit<8>(bh >> 3, bh & 7, i ? s : 7 - s, P_(const attn_body::bf16, WS_Q), P_(const attn_body::bf16, WS_K), P_(const attn_body::bf16, WS_V), P_(attn_body::bf16, WS_Q), (char*)lds_raw, lam, subln, oml);
          } }
        LOCAL_BAR();
        { PHASE_WS; pg8::EpiGluF E{P_(bf16, WS_Z), P_(bf16, WS_Z2), inp(F, I_BGLU) + L * SSMW}; GEMM_PHASE(pg8::EpiGluF, P_(bf16, WS_Z), WT_WGLU, SSMW, SSMW, E); }
        LOCAL_BAR();
        { PHASE_WS; pg8::EpiGateF E{P_(bf16, WS_GATES), DM, nullptr, P_(bf16, WS_PARTS)}; GEMM_PHASE(pg8::EpiGateF, P_(bf16, WS_Z2), WT_WSU, DM, SSMW, E); }
        LOCAL_BAR();
        { PHASE_WS; pg8::EpiGateF E{P_(bf16, WS_GATES), 0, P_(bf16, WS_PARTS), P_(bf16, WS_MIXED)}; GEMM_PHASE(pg8::EpiGateF, P_(bf16, WS_Q), WT_WAU, DM, VW, E); }
        LOCAL_BAR();
        { PHASE_WS; const float* xbase = (L == 0) ? inp(F, I_X) : args.out;
          pg8::EpiResF E{xbase, args.out, P_XB, P_PART2}; GEMM_PHASE(pg8::EpiResF, P_(bf16, WS_MIXED), WT_WOUT, DM, DM, E); }
        LOCAL_BAR();
        { PHASE_WS; pg8::EpiPlainF E{P_(bf16, WS_PLE), 2 * DM};        GEMM_PHASE(pg8::EpiPlainF, P_(bf16, WS_PB) + (size_t)L * T * PLE, WT_WPLE, DM, PLE, E);
          router_phase(Fk, L, args.out, P_(unsigned, WS_CTL), (unsigned char*)w_); }
        GRID_BAR();
        { PHASE_WS; moe_tables(Fk, L, P_(unsigned, WS_CTL));
          pg8::MoeSched S{(LAS const int*)(F.lds + LDS_TB_OFF), (LAS const int*)(F.lds + LDS_TB_OFF) + 80, F.G, F.cid, 0};
          moe_gather_tables(Fk, S, P_(const SlotInfo, WS_SLOT), P_PART2);
          pg8::Gemm g{(const pg8::bf16_t*)P_XB, (const pg8::bf16_t*)(unsigned char*)(w_ + WS_WT + WT_WGU), T, 512, DM};
          pg8::EpiActF E{P_(pg8::bf16_t, WS_ACT), F.lds};
          pg8::gemm_phase_g<pg8::EpiActF, pg8::MoeSched>(F.lds, g, S, E); }
        GRID_BAR();
        { PHASE_WS; moe_tables(Fk, L, P_(unsigned, WS_CTL));
          pg8::MoeSched S{(LAS const int*)(F.lds + LDS_TB_OFF), (LAS const int*)(F.lds + LDS_TB_OFF) + 80, F.G, F.cid, 3};
          pg8::Gemm g{P_(const pg8::bf16_t, WS_ACT), (const pg8::bf16_t*)(unsigned char*)(w_ + WS_WT + WT_WD), T, DM, EFF};
          moe_down_tables(Fk, S, P_(const SlotInfo, WS_SLOT));
          pg8::EpiDownStoreF E{F.lds, P_(pg8::bf16_t, WS_Q), (size_t)(WS_K - WS_Q) / 2};
          pg8::gemm_phase<pg8::EpiDownStoreF, pg8::MoeSched, true, true>(F.lds, g, S, E); }
        GRID_BAR();
        { PHASE_WS; pg8::StaticOrder S0; S0.init(T, DM, F.G, F.cid); pg8::Unit u0;
          for (int i = 0; S0.next(i, u0); ++i) moe_combine(Fk, u0.pm, u0.pn, args.out, P_(const bf16, WS_Q), P_(const bf16, WS_K), P_XA, P_PART); }
        LOCAL_BAR();
        { PHASE_WS; pg8::EpiPleF E{F.lds, P_(bf16, WS_PLE), args.out, P_XB, P_PART2};
          { pg8::StaticOrder S0; S0.init(T, DM, F.G, F.cid); fill_rowscales(Fk, S0, P_PART); }
          GEMM_PHASE(pg8::EpiPleF, P_XA, WT_WPG, DM, DM, E); }
        if (L + 1 < DEPTH) GRID_BAR();
    }
}

extern "C" void kernel_launch(void* const* d_in, const int* in_sizes, int n_in, void* d_out, int out_size, void* d_ws, size_t ws_size, hipStream_t stream) {
    static int grid = 0;
    if (grid == 0) {
        if (n_in != N_IN || in_sizes[0] != T * DM || out_size != T * DM || ws_size < WS_END) {
            fprintf(stderr, "kernel_launch: unexpected problem (n_in %d, in0 %d, out %d, ws %zu); nothing launched\n", n_in, n_in > 0 ? in_sizes[0] : -1, out_size, ws_size); grid = -1; return; }
        int dev = 0, cus = 0, per_cu = 0;
        if (hipGetDevice(&dev) != hipSuccess || hipDeviceGetAttribute(&cus, hipDeviceAttributeMultiprocessorCount, dev) != hipSuccess) { grid = -1; return; }
        if (hipFuncSetAttribute((const void*)mega_fwd, hipFuncAttributeMaxDynamicSharedMemorySize, LDS_BYTES) != hipSuccess) { fprintf(stderr, "kernel_launch: hipFuncSetAttribute failed\n"); grid = -1; return; }
        if (hipOccupancyMaxActiveBlocksPerMultiprocessor(&per_cu, (const void*)mega_fwd, NTHREADS, LDS_BYTES) != hipSuccess || per_cu < 1)
            fprintf(stderr, "kernel_launch: note: occupancy query reports %d workgroups per CU\n", per_cu);
        (void)hipGetLastError();
        grid = cus;
    }
    if (grid < 0) return;
    if (hipMemsetAsync((char*)d_ws + WS_CTL, 0, CTL_ZERO_BYTES, stream) != hipSuccess) { fprintf(stderr, "kernel_launch: memset failed\n"); return; }
    Args a{};
    for (int i = 0; i < N_IN; ++i) a.in[i] = (const float*)d_in[i];
    a.out = (float*)d_out; a.ws = (unsigned char*)d_ws;
    hipLaunchKernelGGL(mega_fwd, dim3(grid), dim3(NTHREADS), LDS_BYTES, stream, a);
    const hipError_t le = hipPeekAtLastError();
    if (le != hipSuccess) fprintf(stderr, "kernel_launch: launch failed: %s\n", hipGetErrorName(le));
}
```
